# Optimizing an MI355X kernel written in HIP

```python
import jax, jax.numpy as jnp
from jax import lax
import numpy as np

D_MODEL = 1024
BATCH = 4
SEQ = 4096
DEPTH = 4

GRID_W = 64
CTX_LEN = 256
N_BRANCH = 3
BRANCH_WIDTH = D_MODEL // 2
RET_HEADS = 4
RET_HEAD_DIM = BRANCH_WIDTH // RET_HEADS
RET_WIDTH = RET_HEADS * RET_HEAD_DIM
RET_CHUNK = 128
LRU_WIDTH = BRANCH_WIDTH
LRU_BLOCKS = 8
LRU_BLOCK = LRU_WIDTH // LRU_BLOCKS
LRU_CONV = 4
LRU_CONV_PAD_LEFT = 1
LRU_C = 8.0
ATT_HEAD_DIM = 64
ATT_Q_HEADS = BRANCH_WIDTH // ATT_HEAD_DIM
ATT_KV_HEADS = 2
ATT_GROUP = ATT_Q_HEADS // ATT_KV_HEADS
ATT_WIDTH = ATT_Q_HEADS * ATT_HEAD_DIM
ATT_KV_WIDTH = ATT_KV_HEADS * ATT_HEAD_DIM
Q_BLOCK = 128
ROPE_THETA = 10000.0
D_FF = 256 * ((8 * D_MODEL // 3 + 255) // 256)
MACARON_WEIGHT = 0.5
N_SUB = 3
NORM_EPS = 1e-6
IN_SIZES = (RET_WIDTH, RET_WIDTH, RET_WIDTH, RET_WIDTH, LRU_WIDTH, LRU_WIDTH,
            ATT_WIDTH, ATT_KV_WIDTH, ATT_KV_WIDTH, N_BRANCH * D_MODEL)
D_IN = sum(IN_SIZES)

kernel_name = 'hybrid_retention_rglru_gqa_prefix_dit'


def _rms(x, g):
    xf = x.astype(jnp.float32)
    y = xf * lax.rsqrt(jnp.mean(xf * xf, axis=-1, keepdims=True) + NORM_EPS)
    return (y * g.astype(jnp.float32)).astype(x.dtype)


def _modulate(x, g, shift, scale):
    return _rms(x, g) * (1 + scale) + shift


def _swiglu(h, w_in, w_out):
    a, b = jnp.split(h @ w_in, 2, axis=-1)
    return (jax.nn.silu(a) * b) @ w_out


def _half_ffn(s, m, g, w_in, w_out):
    return MACARON_WEIGHT * m[:, 2] * _swiglu(_modulate(s, g, m[:, 0], m[:, 1]), w_in, w_out)


def _split_cols(z):
    offs = []
    acc = 0
    for s in IN_SIZES[:-1]:
        acc += s
        offs.append(acc)
    return jnp.split(z, offs, axis=-1)


def _heads(t, n_heads):
    return t.reshape(*t.shape[:-1], n_heads, t.shape[-1] // n_heads)


def _flip(t):
    return jnp.flip(t, axis=1)


def _same(t):
    return t


def _rope_half(x, ang):
    x1, x2 = jnp.split(x, 2, axis=-1)
    cos = jnp.cos(ang)[None, :, None, :].astype(x.dtype)
    sin = jnp.sin(ang)[None, :, None, :].astype(x.dtype)
    return jnp.concatenate([x1 * cos - x2 * sin, x1 * sin + x2 * cos], axis=-1)


def _axial_rope(x, rows, cols):
    half = x.shape[-1] // 2
    freqs = ROPE_THETA ** (-jnp.arange(0, half, 2, dtype=jnp.float32) / half)
    xr, xc = jnp.split(x, 2, axis=-1)
    return jnp.concatenate([_rope_half(xr, rows[:, None] * freqs[None]),
                            _rope_half(xc, cols[:, None] * freqs[None])], axis=-1)


def _retention_chunks(q, k, v, log_gamma, s0):
    B, L, H, _ = q.shape
    dv = v.shape[-1]
    n = L // RET_CHUNK
    pos = jnp.arange(RET_CHUNK, dtype=jnp.float32)
    diff = pos[:, None] - pos[None, :]
    lg = log_gamma.astype(jnp.float32)
    intra = jnp.where(diff[None] >= 0,
                      jnp.exp(jnp.maximum(diff, 0.0)[None] * lg[:, None, None]), 0.0).astype(q.dtype)
    q_decay = jnp.exp((pos[:, None] + 1.0) * lg[None]).astype(q.dtype)
    k_decay = jnp.exp((RET_CHUNK - 1.0 - pos)[:, None] * lg[None]).astype(q.dtype)
    s_decay = jnp.exp(RET_CHUNK * lg).astype(q.dtype)

    def to_chunks(t):
        return t.reshape(B, n, RET_CHUNK, *t.shape[2:]).swapaxes(0, 1)

    def step(s, blk):
        qc, kc, vc = blk
        scores = jnp.einsum('bihd,bjhd->bhij', qc, kc) * intra
        inner = jnp.einsum('bhij,bjhe->bihe', scores, vc)
        cross = jnp.einsum('bihd,bhde->bihe', qc, s) * q_decay[None, :, :, None]
        s_new = s * s_decay[None, :, None, None] + jnp.einsum(
            'bjhd,bjhe->bhde', kc * k_decay[None, :, :, None], vc)
        return s_new, inner + cross

    s_fin, out = lax.scan(step, s0, (to_chunks(q), to_chunks(k), to_chunks(v)))
    return out.swapaxes(0, 1).reshape(B, L, H, dv), s_fin


def _bidir_retention(qc, kc, vc, ql, kl, vl, log_gamma):
    s0 = jnp.zeros((ql.shape[0], RET_HEADS, RET_HEAD_DIM, RET_HEAD_DIM), ql.dtype)
    outs_c, outs_l = [], []
    for d in range(2):
        f = _flip if d else _same
        oc, sc = _retention_chunks(f(qc), f(kc), f(vc), log_gamma[d], s0)
        ol, _ = _retention_chunks(f(ql), f(kl), f(vl), log_gamma[d], sc)
        outs_c.append(f(oc))
        outs_l.append(f(ol))
    return outs_c[0] + outs_c[1], outs_l[0] + outs_l[1]


def _head_norm(y, g):
    yf = y.astype(jnp.float32)
    mu = jnp.mean(yf, axis=-1, keepdims=True)
    var = jnp.mean(jnp.square(yf - mu), axis=-1, keepdims=True)
    yn = ((yf - mu) * lax.rsqrt(var + NORM_EPS)).reshape(*y.shape[:2], -1)
    return (yn * g.astype(jnp.float32)).astype(y.dtype)


def _conv_centred(x, w, b):
    L = x.shape[1]
    xp = jnp.pad(x, ((0, 0), (LRU_CONV_PAD_LEFT, LRU_CONV - 1 - LRU_CONV_PAD_LEFT), (0, 0)))
    y = b
    for j in range(LRU_CONV):
        y = y + xp[:, j:j + L] * w[j]
    return y


def _block_diag(x, w, b):
    B, L, _ = x.shape
    y = jnp.einsum('blnc,ncd->blnd', x.reshape(B, L, LRU_BLOCKS, LRU_BLOCK), w)
    return y.reshape(B, L, LRU_WIDTH) + b


def _rglru_scan(x, w_a, b_a, w_x, b_x, lam, h0):
    r = jax.nn.sigmoid(_block_diag(x, w_a, b_a))
    i = jax.nn.sigmoid(_block_diag(x, w_x, b_x))
    log_a = (-LRU_C * r * jax.nn.softplus(-lam)).astype(jnp.float32)
    a = jnp.exp(log_a)
    u = jnp.sqrt(-jnp.expm1(2.0 * log_a)) * (i * x).astype(jnp.float32)

    def combine(p, q):
        a1, b1 = p
        a2, b2 = q
        return a1 * a2, a2 * b1 + b2

    a_cum, b_cum = lax.associative_scan(combine, (a, u), axis=1)
    h = b_cum + a_cum * h0[:, None]
    return h, h[:, -1]


def _bidir_rglru(xc, xl, w_a, b_a, w_x, b_x, lam):
    h0 = jnp.zeros((xl.shape[0], LRU_WIDTH), jnp.float32)
    outs_c, outs_l = [], []
    for d in range(2):
        f = _flip if d else _same
        hc, sc = _rglru_scan(f(xc), w_a[d], b_a[d], w_x[d], b_x[d], lam[d], h0)
        hl, _ = _rglru_scan(f(xl), w_a[d], b_a[d], w_x[d], b_x[d], lam[d], sc)
        outs_c.append(f(hc))
        outs_l.append(f(hl))
    return (outs_c[0] + outs_c[1]).astype(xc.dtype), (outs_l[0] + outs_l[1]).astype(xl.dtype)


def _attend(q, k, v):
    s = jnp.einsum('bqkgd,bskd->bkgqs', q, k).astype(jnp.float32) * (ATT_HEAD_DIM ** -0.5)
    p = jax.nn.softmax(s, axis=-1).astype(v.dtype)
    return jnp.einsum('bkgqs,bskd->bqkgd', p, v)


def _attend_blocks(q, k, v):
    B, T = q.shape[:2]
    nb = T // Q_BLOCK
    qb = q.reshape(B, nb, Q_BLOCK, ATT_KV_HEADS, ATT_GROUP, ATT_HEAD_DIM).swapaxes(0, 1)
    out = lax.map(lambda blk: _attend(blk, k, v), qb)
    return out.swapaxes(0, 1).reshape(B, T, ATT_WIDTH)


def _merge(y_ret, y_lru, y_att, gate_logits, w_branch, w_out):
    y = jnp.stack([y_ret, y_lru, y_att], axis=2)
    u = jnp.einsum('blnw,nwd->blnd', y, w_branch)
    g = jax.nn.sigmoid(gate_logits.reshape(*gate_logits.shape[:2], N_BRANCH, D_MODEL))
    return jnp.sum(g * u, axis=2) @ w_out


def _token_mix(hc, hl, p, rows, cols, ctx_out):
    rq_c, rk_c, rv_c, rg_c, lx_c, lz_c, aq_c, ak_c, av_c, gt_c = _split_cols(hc @ p['w_in'])
    rq_l, rk_l, rv_l, rg_l, lx_l, lz_l, aq_l, ak_l, av_l, gt_l = _split_cols(hl @ p['w_in'])
    k_scale = RET_HEAD_DIM ** -0.5
    ret_c, ret_l = _bidir_retention(
        _heads(rq_c, RET_HEADS), _heads(rk_c, RET_HEADS) * k_scale, _heads(rv_c, RET_HEADS),
        _axial_rope(_heads(rq_l, RET_HEADS), rows, cols),
        _axial_rope(_heads(rk_l, RET_HEADS) * k_scale, rows, cols),
        _heads(rv_l, RET_HEADS),
        jax.nn.log_sigmoid(p['ret_decay_logit']))
    lru_c, lru_l = _bidir_rglru(
        _conv_centred(lx_c, p['lru_conv_w'], p['lru_conv_b']),
        _conv_centred(lx_l, p['lru_conv_w'], p['lru_conv_b']),
        p['lru_w_a'], p['lru_b_a'], p['lru_w_x'], p['lru_b_x'], p['lru_lambda'])
    qc = _rms(_heads(aq_c, ATT_Q_HEADS), p['q_norm_g'])
    kc = _rms(_heads(ak_c, ATT_KV_HEADS), p['k_norm_g'])
    vc = _heads(av_c, ATT_KV_HEADS)
    ql = _axial_rope(_rms(_heads(aq_l, ATT_Q_HEADS), p['q_norm_g']), rows, cols)
    kl = _axial_rope(_rms(_heads(ak_l, ATT_KV_HEADS), p['k_norm_g']), rows, cols)
    vl = _heads(av_l, ATT_KV_HEADS)
    att_l = _attend_blocks(ql, jnp.concatenate([kc, kl], axis=1), jnp.concatenate([vc, vl], axis=1))
    y_l = _merge(_head_norm(ret_l, p['ret_norm_g']) * jax.nn.silu(rg_l),
                 jax.nn.gelu(lz_l) * lru_l, att_l, gt_l, p['w_branch'], p['w_out'])
    if not ctx_out:
        return y_l, None
    B, Lc = hc.shape[:2]
    att_c = _attend(qc.reshape(B, Lc, ATT_KV_HEADS, ATT_GROUP, ATT_HEAD_DIM), kc, vc).reshape(B, Lc, ATT_WIDTH)
    y_c = _merge(_head_norm(ret_c, p['ret_norm_g']) * jax.nn.silu(rg_c),
                 jax.nn.gelu(lz_c) * lru_c, att_c, gt_c, p['w_branch'], p['w_out'])
    return y_l, y_c


def setup_inputs(seed: int = 0) -> dict:
    key = jax.random.key(seed)
    ks = jax.random.split(key, 24)
    f32 = jnp.float32
    D = D_MODEL

    def nrm(k, shape, scale):
        return jax.random.normal(k, shape, f32) * scale

    gamma = 1.0 - 2.0 ** (-5.0 - jnp.arange(RET_HEADS, dtype=f32))
    ret_logit0 = jnp.log(gamma) - jnp.log1p(-gamma)
    u = jax.random.uniform(ks[12], (DEPTH, 2, LRU_WIDTH), f32, 0.9, 0.999)
    a0 = u ** (1.0 / LRU_C)
    lam = jnp.log(a0) - jnp.log1p(-a0)
    return {
        'x': nrm(ks[0], (BATCH, SEQ, D), 1.0),
        'c': nrm(ks[1], (BATCH, D), 1.0),
        'ctx': nrm(ks[2], (BATCH, CTX_LEN, D), 1.0),
        'c_ctx': nrm(ks[3], (D,), 1.0),
        'w_mod': nrm(ks[4], (DEPTH, D, N_SUB * 3 * D), 0.5 * D ** -0.5),
        'b_mod': nrm(ks[5], (DEPTH, N_SUB * 3 * D), 0.02),
        'norm_g': 1.0 + nrm(ks[6], (DEPTH, N_SUB, D), 0.02),
        'ffn_w_in': nrm(ks[7], (DEPTH, 2, D, 2 * D_FF), D ** -0.5),
        'ffn_w_out': nrm(ks[8], (DEPTH, 2, D_FF, D), D_FF ** -0.5),
        'w_in': nrm(ks[9], (DEPTH, D, D_IN), D ** -0.5),
        'ret_decay_logit': ret_logit0 + nrm(ks[10], (DEPTH, 2, RET_HEADS), 0.1),
        'ret_norm_g': 1.0 + nrm(ks[11], (DEPTH, RET_WIDTH), 0.02),
        'lru_conv_w': nrm(ks[13], (DEPTH, LRU_CONV, LRU_WIDTH), LRU_CONV ** -0.5),
        'lru_conv_b': nrm(ks[14], (DEPTH, LRU_WIDTH), 0.02),
        'lru_w_a': nrm(ks[15], (DEPTH, 2, LRU_BLOCKS, LRU_BLOCK, LRU_BLOCK), LRU_BLOCK ** -0.5),
        'lru_b_a': nrm(ks[16], (DEPTH, 2, LRU_WIDTH), 0.1),
        'lru_w_x': nrm(ks[17], (DEPTH, 2, LRU_BLOCKS, LRU_BLOCK, LRU_BLOCK), LRU_BLOCK ** -0.5),
        'lru_b_x': nrm(ks[18], (DEPTH, 2, LRU_WIDTH), 0.1),
        'lru_lambda': lam,
        'attn_q_norm_g': 1.0 + nrm(ks[19], (DEPTH, ATT_HEAD_DIM), 0.02),
        'attn_k_norm_g': 1.0 + nrm(ks[20], (DEPTH, ATT_HEAD_DIM), 0.02),
        'w_branch': nrm(ks[21], (DEPTH, N_BRANCH, BRANCH_WIDTH, D), BRANCH_WIDTH ** -0.5),
        'w_out': nrm(ks[22], (DEPTH, D, D), D ** -0.5),
        'final_norm_g': 1.0 + nrm(ks[23], (D,), 0.02),
    }


def reference(x, c, ctx, c_ctx, w_mod, b_mod, norm_g, ffn_w_in, ffn_w_out, w_in,
              ret_decay_logit, ret_norm_g, lru_conv_w, lru_conv_b, lru_w_a, lru_b_a,
              lru_w_x, lru_b_x, lru_lambda, attn_q_norm_g, attn_k_norm_g, w_branch,
              w_out, final_norm_g):
    seq = x.shape[1]
    n_rows = seq // GRID_W
    rows = jnp.repeat(jnp.arange(n_rows, dtype=jnp.float32), GRID_W)
    cols = jnp.tile(jnp.arange(GRID_W, dtype=jnp.float32), n_rows)
    s_lat = jax.nn.silu(c)
    s_ctx = jax.nn.silu(c_ctx)[None]
    xc = ctx
    for l in range(DEPTH):
        last = l == DEPTH - 1
        m_l = (s_lat @ w_mod[l] + b_mod[l]).reshape(-1, N_SUB, 3, 1, D_MODEL)
        m_c = (s_ctx @ w_mod[l] + b_mod[l]).reshape(1, N_SUB, 3, 1, D_MODEL)
        x = x + _half_ffn(x, m_l[:, 0], norm_g[l, 0], ffn_w_in[l, 0], ffn_w_out[l, 0])
        xc = xc + _half_ffn(xc, m_c[:, 0], norm_g[l, 0], ffn_w_in[l, 0], ffn_w_out[l, 0])
        p = {
            'w_in': w_in[l], 'ret_decay_logit': ret_decay_logit[l], 'ret_norm_g': ret_norm_g[l],
            'lru_conv_w': lru_conv_w[l], 'lru_conv_b': lru_conv_b[l],
            'lru_w_a': lru_w_a[l], 'lru_b_a': lru_b_a[l], 'lru_w_x': lru_w_x[l], 'lru_b_x': lru_b_x[l],
            'lru_lambda': lru_lambda[l], 'q_norm_g': attn_q_norm_g[l], 'k_norm_g': attn_k_norm_g[l],
            'w_branch': w_branch[l], 'w_out': w_out[l],
        }
        h_l = _modulate(x, norm_g[l, 1], m_l[:, 1, 0], m_l[:, 1, 1])
        h_c = _modulate(xc, norm_g[l, 1], m_c[:, 1, 0], m_c[:, 1, 1])
        y_l, y_c = _token_mix(h_c, h_l, p, rows, cols, not last)
        x = x + m_l[:, 1, 2] * y_l
        x = x + _half_ffn(x, m_l[:, 2], norm_g[l, 2], ffn_w_in[l, 1], ffn_w_out[l, 1])
        if not last:
            xc = xc + m_c[:, 1, 2] * y_c
            xc = xc + _half_ffn(xc, m_c[:, 2], norm_g[l, 2], ffn_w_in[l, 1], ffn_w_out[l, 1])
    return _rms(x, final_norm_g)
```

```cpp
#include <hip/hip_runtime.h>
#include <hip/hip_cooperative_groups.h>
#include <hip/hip_bf16.h>
#include <cstdio>
#include <cstdint>
#include <cmath>
namespace cg = cooperative_groups;
namespace pg8 {
#define PG8_LAS __attribute__((address_space(3)))
typedef unsigned short bf16_t;
typedef short bf16x8 __attribute__((ext_vector_type(8)));
typedef float f32x4 __attribute__((ext_vector_type(4)));
typedef unsigned u32x4 __attribute__((ext_vector_type(4)));
constexpr int BM = 256, BK = 64, HALF = 128, HTB = HALF * BK * 2  , STAGE_BYTES = 8 * HTB, NXCD = 8, WGM = 4;

__host__ __device__ __forceinline__ int lds_byte(int r, int c) { const int st = (r >> 4) * 2 + (c >> 5), rr = r & 15, cc = c & 31, ob = rr * 64 + cc * 2; return st * 1024 + (ob ^ (((ob >> 9) & 1) << 5)); }
__host__ __device__ __forceinline__ void stage_rc(int b, int& R, int& C) { const int st = b / 1024, sb = b % 1024, swz = sb ^ (((sb >> 9) & 1) << 5); R = (st >> 1) * 16 + swz / 64; C = (st & 1) * 32 + (swz % 64) / 2; }
__host__ __device__ __forceinline__ int perm32(int rho) { const int n = rho >> 4, i = rho & 15; return 8 * (i >> 2) + 4 * n + (i & 3); }

struct Unit { int pm, pn, k0, nk; };
struct Gemm { const bf16_t* A; const bf16_t* Bt; int M, N, K; };

struct StaticOrder {
    int nM, nN, nwg, G, c;
    __host__ __device__ void init(int M, int N, int G_, int c_) { nM = M / BM; nN = N / BM; nwg = nM * nN; G = G_; c = c_; }
    __host__ __device__ bool next(int i, Unit& u) const {
        const long L = (long)i * G + c; if (L >= nwg) return false;
        int wgid = (int)L; { const int q = nwg / NXCD, r = nwg % NXCD, xcd = wgid % NXCD, off = wgid / NXCD; wgid = (xcd < r ? xcd * (q + 1) : r * (q + 1) + (xcd - r) * q) + off; }
        const int nig = WGM * nN, gid = wgid / nig, fm = gid * WGM, gsz = (nM - fm) < WGM ? (nM - fm) : WGM;
        u.pm = fm + ((wgid % nig) % gsz); u.pn = (wgid % nig) / gsz; u.k0 = 0; u.nk = 0; return true;
    }
    __device__ __forceinline__ void a_ready(const Unit&) const {}
    __device__ __forceinline__ void done(const Unit&) const {}
};

typedef unsigned u32x2 __attribute__((ext_vector_type(2)));
__device__ __forceinline__ unsigned cvt_pk_bf16(float lo, float hi) { unsigned r; asm volatile("v_cvt_pk_bf16_f32 %0, %1, %2" : "=v"(r) : "v"(lo), "v"(hi)); return r; }
__device__ __forceinline__ float fast_sigmoid(float v) { return __builtin_amdgcn_rcpf(1.0f + __expf(-v)); }
__device__ __forceinline__ float bf_lo(unsigned w) { return __uint_as_float(w << 16); }
__device__ __forceinline__ float bf_hi(unsigned w) { return __uint_as_float(w & 0xffff0000u); }
struct EpiZ {
    static constexpr bool PERM = true, AFTER_DRAIN = false, CHAIN = false;
    bf16_t* O; int ldc;
    __device__ __forceinline__ void operator()(const f32x4 (&acc)[2][2][4][2], const Unit& u, int wr, int wc, int fr, int fq) const {
        const int row0 = u.pm * BM + wr * 64 + fr; const int col0 = u.pn * BM + wc * 32 + 8 * fq;
#pragma unroll
        for (int ai = 0; ai < 2; ++ai)
#pragma unroll
            for (int m = 0; m < 4; ++m) { bf16_t* rowp = O + (size_t)(row0 + ai * HALF + m * 16) * ldc + col0;
#pragma unroll
                for (int bj = 0; bj < 2; ++bj) { const f32x4 v0 = acc[ai][bj][m][0], v1 = acc[ai][bj][m][1];
                    u32x4 w; w.x = cvt_pk_bf16(v0[0], v0[1]); w.y = cvt_pk_bf16(v0[2], v0[3]); w.z = cvt_pk_bf16(v1[0], v1[1]); w.w = cvt_pk_bf16(v1[2], v1[3]);
                    *(u32x4*)(rowp + bj * HALF) = w; } }
    }
};
struct EpiSwiglu {
    static constexpr bool PERM = true, AFTER_DRAIN = false, CHAIN = false;
    bf16_t* O;
    __device__ __forceinline__ void operator()(const f32x4 (&acc)[2][2][4][2], const Unit& u, int wr, int wc, int fr, int fq) const {
        const int row0 = u.pm * BM + wr * 64 + fr; const int col0 = u.pn * HALF + wc * 32 + 8 * fq;
#pragma unroll
        for (int ai = 0; ai < 2; ++ai)
#pragma unroll
            for (int m = 0; m < 4; ++m) { bf16_t* rowp = O + (size_t)(row0 + ai * HALF + m * 16) * 2816 + col0;
                float h[8];
#pragma unroll
                for (int n = 0; n < 2; ++n)
#pragma unroll
                    for (int j = 0; j < 4; ++j) { const float a = acc[ai][0][m][n][j], b = acc[ai][1][m][n][j]; h[n * 4 + j] = a * fast_sigmoid(a) * b; }
                u32x4 w; w.x = cvt_pk_bf16(h[0], h[1]); w.y = cvt_pk_bf16(h[2], h[3]); w.z = cvt_pk_bf16(h[4], h[5]); w.w = cvt_pk_bf16(h[6], h[7]);
                *(u32x4*)rowp = w; }
    }
};
struct EpiResid {
    static constexpr bool PERM = false, AFTER_DRAIN = false, CHAIN = false;
    float* X; const float* gate; float scale; float* PARTC;
    __device__ __forceinline__ void operator()(const f32x4 (&acc)[2][2][4][2], const Unit& u, int wr, int wc, int fr, int fq) const {
        const int bb = u.pm / 17, mrow = (u.pm - bb * 17 == 0) ? 4 : bb;
        const int col0 = u.pn * BM + wc * 32 + 4 * fq;
        if (u.nk != 0) {
            const int sp = u.k0 / (u.nk * 64); float* base = PARTC + ((size_t)sp * 1024 + (size_t)bb * 256 + wr * 64 + fr) * 1024 + col0;
#pragma unroll
            for (int ai = 0; ai < 2; ++ai)
#pragma unroll
                for (int m = 0; m < 4; ++m)
#pragma unroll
                    for (int bj = 0; bj < 2; ++bj)
#pragma unroll
                        for (int n = 0; n < 2; ++n) *(f32x4*)(base + (size_t)(ai * HALF + m * 16) * 1024 + bj * HALF + n * 16) = acc[ai][bj][m][n];
            return; }
        const float* g = gate + (size_t)mrow * 9216;
        const int row0 = u.pm * BM + wr * 64 + fr;
        f32x4 gv[2][2];
#pragma unroll
        for (int bj = 0; bj < 2; ++bj)
#pragma unroll
            for (int n = 0; n < 2; ++n) gv[bj][n] = *(const f32x4*)(g + col0 + bj * HALF + n * 16) * scale;
#pragma unroll
        for (int ai = 0; ai < 2; ++ai)
#pragma unroll
            for (int m = 0; m < 4; ++m) { float* rowp = X + (size_t)(row0 + ai * HALF + m * 16) * 1024 + col0;
#pragma unroll
                for (int bj = 0; bj < 2; ++bj)
#pragma unroll
                    for (int n = 0; n < 2; ++n) { f32x4* p = (f32x4*)(rowp + bj * HALF + n * 16); *p = *p + gv[bj][n] * acc[ai][bj][m][n]; }
                asm volatile("" ::: "memory"); }
    }
};
struct EpiMerge {
    static constexpr bool PERM = false, AFTER_DRAIN = false, CHAIN = true;
    const bf16_t* Z; bf16_t* MG;
    __device__ __forceinline__ void operator()(const f32x4 (&acc)[2][2][4][2], const Unit& u, int wr, int wc, int fr, int fq) const {}
    __device__ __forceinline__ bool chain(f32x4 (&acc)[2][2][4][2], const Unit& u, int wr, int wc, int fr, int fq) const {
        const int n = u.pm / 68, pm = u.pm - n * 68, pn = u.pn & 3;
        const int row0 = pm * BM + wr * 64 + fr; const int col0 = pn * BM + wc * 32 + 4 * fq;
#pragma unroll
        for (int ai = 0; ai < 2; ++ai)
#pragma unroll
            for (int m = 0; m < 4; ++m) { const size_t row = (size_t)(row0 + ai * HALF + m * 16);
#pragma unroll
                for (int bj = 0; bj < 2; ++bj)
#pragma unroll
                    for (int nn = 0; nn < 2; ++nn) { const int col = col0 + bj * HALF + nn * 16;
                        const bf16_t* zp = Z + row * 6912 + 3840 + n * 1024 + col;
                        const u32x2 ga = *(const u32x2*)zp;
                        const float ea0 = 1.0f + __expf(-bf_lo(ga.x)), ea1 = 1.0f + __expf(-bf_hi(ga.x)), ea2 = 1.0f + __expf(-bf_lo(ga.y)), ea3 = 1.0f + __expf(-bf_hi(ga.y));
                        f32x4 sc;
                        if (n < 2) { const u32x2 gb = *(const u32x2*)(zp + 1024);
                            sc[0] = (1.0f + __expf(-bf_lo(gb.x))) * __builtin_amdgcn_rcpf(ea0); sc[1] = (1.0f + __expf(-bf_hi(gb.x))) * __builtin_amdgcn_rcpf(ea1);
                            sc[2] = (1.0f + __expf(-bf_lo(gb.y))) * __builtin_amdgcn_rcpf(ea2); sc[3] = (1.0f + __expf(-bf_hi(gb.y))) * __builtin_amdgcn_rcpf(ea3);
                            acc[ai][bj][m][nn] = acc[ai][bj][m][nn] * sc; }
                        else { sc[0] = __builtin_amdgcn_rcpf(ea0); sc[1] = __builtin_amdgcn_rcpf(ea1); sc[2] = __builtin_amdgcn_rcpf(ea2); sc[3] = __builtin_amdgcn_rcpf(ea3);
                            const f32x4 v = acc[ai][bj][m][nn] * sc; u32x2 w; w.x = cvt_pk_bf16(v[0], v[1]); w.y = cvt_pk_bf16(v[2], v[3]); *(u32x2*)(MG + row * 1024 + col) = w; } }
                asm volatile("" ::: "memory"); }
        return n < 2;
    }
};
struct MergeOrder {
    int G, c, latonly;
    __device__ bool next(int i, Unit& u) const {
        const int ti = i / 3, n = i - ti * 3; const int L = ti * G + c; if (L >= (latonly ? 256 : 272)) return false;
        const int t = L >> 2; const int pm = latonly ? ((t >> 4) * 17 + 1 + (t & 15)) : t;
        u.pm = n * 68 + pm; u.pn = n * 4 + (L & 3); u.k0 = 0; u.nk = 0; return true;
    }
    __device__ __forceinline__ void a_ready(const Unit&) const {}
    __device__ __forceinline__ void done(const Unit&) const {}
};
struct LastLayerOrder {
    StaticOrder so; int nextra;
    __device__ void init(int N, int G, int c, int nextra_) { so.init(64 * BM, N, G, c); nextra = nextra_; }
    __device__ bool next(int i, Unit& u) const {
        if (so.next(i, u)) { const int v = u.pm; u.pm = (v >> 4) * 17 + 1 + (v & 15); return true; }
        const int L = i * so.G + so.c - so.nwg; if (L < 0 || L >= nextra) return false;
        const int t = L / 7, q = L - t * 7; u.pm = t * 17; u.pn = (q < 4) ? 2 + q : (q < 6) ? 4 + q : 14; u.k0 = 0; u.nk = 0; return true;
    }
    __device__ __forceinline__ void a_ready(const Unit&) const {}
    __device__ __forceinline__ void done(const Unit&) const {}
};
struct LatOrder {
    int G, c;
    __device__ bool next(int i, Unit& u) const {
        const int L = i * G + c; if (L >= 256) return false;
        const int t = L >> 2; u.pm = (t >> 4) * 17 + 1 + (t & 15); u.pn = L & 3; u.k0 = 0; u.nk = 0; return true;
    }
    __device__ __forceinline__ void a_ready(const Unit&) const {}
    __device__ __forceinline__ void done(const Unit&) const {}
};
struct SplitOrder {
    int G, c, nsplit, nkt;
    __device__ bool next(int i, Unit& u) const {
        int L = i * G + c;
        if (L < 256) { const int t = L >> 2; u.pm = (t >> 4) * 17 + 1 + (t & 15); u.pn = L & 3; u.k0 = 0; u.nk = 0; return true; }
        L -= 256; if (L >= 16 * nsplit) return false;
        const int t = L / nsplit, s = L - t * nsplit;
        u.pm = (t >> 2) * 17; u.pn = t & 3; u.k0 = s * nkt * 64; u.nk = nkt; return true;
    }
    __device__ __forceinline__ void a_ready(const Unit&) const {}
    __device__ __forceinline__ void done(const Unit&) const {}
};
template <int KT, class Epi, class Sched, bool ALIGN_EPI = false, bool SP2 = false>
__device__ __forceinline__ void gemm_phase(PG8_LAS unsigned char* lds, const Gemm g, const Sched& S, const Epi& E, const int tid) {
    const int wid = __builtin_amdgcn_readfirstlane(tid >> 6), lane = tid & 63, wr = wid >> 2, wc = wid & 3, fr = lane & 15, fq = lane >> 4;
    constexpr int K = KT, nt = K / BK;
    unsigned voffA[2], voffB[2];
#pragma unroll
    for (int i = 0; i < 2; ++i) { int R, C; stage_rc(tid * 16 + i * 8192, R, C); const int Rb = Epi::PERM ? ((R & ~31) + perm32(R & 31)) : R;
        voffA[i] = (unsigned)(R * K + C) * 2u; voffB[i] = (unsigned)(Rb * K + C) * 2u; }
    const size_t kstep = (size_t)(BK * 2);
    const size_t hstep = (size_t)HALF * K * 2;
    const size_t tstep = 2 * hstep;
    const unsigned ldsw = (unsigned)wid * 1024u;
    const int aoff = lds_byte(wr * 64 + fr, fq * 8), boff = lds_byte(wc * 32 + fr, fq * 8);
#define PG8_SA(b, h) (((b) * 2 + (h)) * HTB)
#define PG8_SB(b, h) ((4 + (b) * 2 + (h)) * HTB)
#define PG8_STAGE(bufoff, gbase, voff) do { _Pragma("unroll") for (int _i = 0; _i < 2; ++_i) \
        __builtin_amdgcn_global_load_lds((const unsigned*)((const char*)(gbase) + (voff)[_i]), (PG8_LAS unsigned*)(lds + (bufoff) + ldsw + _i * 8192), 16, 0, 0); } while (0)
#define PG8_LDA(dst, b, h) do { _Pragma("unroll") for (int m = 0; m < 4; ++m) _Pragma("unroll") for (int k = 0; k < 2; ++k) dst[m][k] = *(const PG8_LAS bf16x8*)(lds + PG8_SA(b, h) + aoff + m * 2048 + k * 1024); } while (0)
#define PG8_LDB(dst, b, h) do { _Pragma("unroll") for (int n = 0; n < 2; ++n) _Pragma("unroll") for (int k = 0; k < 2; ++k) dst[n][k] = *(const PG8_LAS bf16x8*)(lds + PG8_SB(b, h) + boff + n * 2048 + k * 1024); } while (0)
#define PG8_MMA(ai, bj, At, Bt) do { __builtin_amdgcn_s_setprio(1); _Pragma("unroll") for (int m = 0; m < 4; ++m) _Pragma("unroll") for (int n = 0; n < 2; ++n) _Pragma("unroll") for (int k = 0; k < 2; ++k) \
        acc[ai][bj][m][n] = __builtin_amdgcn_mfma_f32_16x16x32_bf16(Bt[n][k], At[m][k], acc[ai][bj][m][n], 0, 0, 0); __builtin_amdgcn_s_setprio(0); } while (0)
#define PG8_WAIT_V(n) asm volatile("s_waitcnt vmcnt(" #n ")" ::: "memory")
#define PG8_WAIT_L(n) asm volatile("s_waitcnt lgkmcnt(" #n ")" ::: "memory")
#define PG8_BAR __builtin_amdgcn_s_barrier()
#define PG8_SCHED __builtin_amdgcn_sched_barrier(0)
    Unit cur{0, 0, 0, 0}, nxt{0, 0, 0, 0}; int ui = 0;
    if (!S.next(0, cur)) return;
    f32x4 acc[2][2][4][2];
#pragma unroll
    for (int a = 0; a < 2; ++a)
#pragma unroll
        for (int b = 0; b < 2; ++b)
#pragma unroll
            for (int m = 0; m < 4; ++m)
#pragma unroll
                for (int n = 0; n < 2; ++n) acc[a][b][m][n] = (f32x4){0.f, 0.f, 0.f, 0.f};
    bf16x8 At[4][2], B0[2][2], B1[2][2];
    const char* cA = (const char*)g.A + (size_t)cur.pm * tstep + (size_t)cur.k0 * 2; const char* cB = (const char*)g.Bt + (size_t)cur.pn * tstep + (size_t)cur.k0 * 2;
    S.a_ready(cur);
    if constexpr (SP2) {
        PG8_STAGE(PG8_SB(0, 0), cB, voffB); PG8_STAGE(PG8_SB(0, 1), cB + hstep, voffB); PG8_STAGE(PG8_SA(0, 0), cA, voffA); PG8_STAGE(PG8_SA(0, 1), cA + hstep, voffA);
        if (wr == 1) PG8_BAR;
        PG8_WAIT_V(2); PG8_BAR;
        PG8_STAGE(PG8_SB(1, 0), cB + kstep, voffB); PG8_STAGE(PG8_SA(1, 0), cA + kstep, voffA); PG8_STAGE(PG8_SB(1, 1), cB + hstep + kstep, voffB);
        PG8_WAIT_V(6); PG8_BAR;
    } else {
        PG8_STAGE(PG8_SB(0, 0), cB, voffB); PG8_STAGE(PG8_SA(0, 0), cA, voffA); PG8_STAGE(PG8_SB(0, 1), cB + hstep, voffB); PG8_STAGE(PG8_SA(0, 1), cA + hstep, voffA);
        if (wr == 1) PG8_BAR;
        PG8_WAIT_V(4); PG8_BAR;
        PG8_STAGE(PG8_SB(1, 0), cB + kstep, voffB); PG8_STAGE(PG8_SA(1, 0), cA + kstep, voffA); PG8_STAGE(PG8_SB(1, 1), cB + hstep + kstep, voffB);
        PG8_WAIT_V(6); PG8_BAR;
    }
    for (;;) {
        const bool has_next = S.next(ui + 1, nxt);
        const char* nA = has_next ? (const char*)g.A + (size_t)nxt.pm * tstep + (size_t)nxt.k0 * 2 : cA; const char* nB = has_next ? (const char*)g.Bt + (size_t)nxt.pn * tstep + (size_t)nxt.k0 * 2 : cB;
        const int ntu = cur.nk ? cur.nk : nt;
        for (int t = 0; t < ntu; t += 2) {
            const bool last = (t == ntu - 2);
            const char* a1 = cA + (size_t)(t + 1) * kstep;
            const char* a2 = last ? nA : cA + (size_t)(t + 2) * kstep; const char* b2 = last ? nB : cB + (size_t)(t + 2) * kstep;
            const char* a3 = a2 + kstep; const char* b3 = b2 + kstep;
            if (last && has_next) S.a_ready(nxt);
            if constexpr (SP2) {
            PG8_LDB(B0, 0, 0); PG8_LDB(B1, 0, 1); PG8_SCHED; PG8_LDA(At, 0, 0); PG8_STAGE(PG8_SA(1, 1), a1 + hstep, voffA);
            PG8_WAIT_V(8); PG8_WAIT_L(0); PG8_BAR; PG8_MMA(0, 0, At, B0); PG8_MMA(0, 1, At, B1); PG8_BAR; PG8_SCHED;
            PG8_LDA(At, 0, 1); PG8_STAGE(PG8_SB(0, 0), b2, voffB); PG8_STAGE(PG8_SB(0, 1), b2 + hstep, voffB); PG8_STAGE(PG8_SA(0, 0), a2, voffA);
            PG8_WAIT_V(8); PG8_WAIT_L(0); PG8_BAR; PG8_MMA(1, 0, At, B0); PG8_MMA(1, 1, At, B1); PG8_BAR; PG8_SCHED;
            PG8_LDB(B0, 1, 0); PG8_LDB(B1, 1, 1); PG8_SCHED; PG8_LDA(At, 1, 0); PG8_STAGE(PG8_SA(0, 1), a2 + hstep, voffA);
            PG8_WAIT_V(8); PG8_WAIT_L(0); PG8_BAR; PG8_MMA(0, 0, At, B0); PG8_MMA(0, 1, At, B1); PG8_BAR; PG8_SCHED;
            PG8_LDA(At, 1, 1); PG8_STAGE(PG8_SB(1, 0), b3, voffB); PG8_STAGE(PG8_SB(1, 1), b3 + hstep, voffB); PG8_STAGE(PG8_SA(1, 0), a3, voffA);
            PG8_WAIT_V(8); PG8_WAIT_L(0); PG8_BAR; PG8_MMA(1, 0, At, B0); PG8_MMA(1, 1, At, B1); PG8_BAR; PG8_SCHED;
            } else {
            PG8_LDB(B0, 0, 0); PG8_SCHED; PG8_LDA(At, 0, 0); PG8_STAGE(PG8_SA(1, 1), a1 + hstep, voffA);
            PG8_WAIT_L(8); PG8_BAR; PG8_WAIT_L(0); PG8_MMA(0, 0, At, B0); PG8_BAR; PG8_SCHED;
            PG8_LDB(B1, 0, 1); PG8_STAGE(PG8_SB(0, 0), b2, voffB);
            PG8_BAR; PG8_WAIT_L(0); PG8_MMA(0, 1, At, B1); PG8_BAR;
            PG8_LDA(At, 0, 1); PG8_STAGE(PG8_SA(0, 0), a2, voffA);
            PG8_BAR; PG8_WAIT_L(0); PG8_MMA(1, 0, At, B0); PG8_BAR; PG8_SCHED;
            PG8_STAGE(PG8_SB(0, 1), b2 + hstep, voffB);
            PG8_WAIT_V(6); PG8_BAR; PG8_MMA(1, 1, At, B1); PG8_BAR;
            PG8_LDB(B0, 1, 0); PG8_SCHED; PG8_LDA(At, 1, 0); PG8_STAGE(PG8_SA(0, 1), a2 + hstep, voffA);
            PG8_WAIT_L(8); PG8_BAR; PG8_WAIT_L(0); PG8_MMA(0, 0, At, B0); PG8_BAR; PG8_SCHED;
            PG8_LDB(B1, 1, 1); PG8_STAGE(PG8_SB(1, 0), b3, voffB);
            PG8_BAR; PG8_WAIT_L(0); PG8_MMA(0, 1, At, B1); PG8_BAR;
            PG8_LDA(At, 1, 1); PG8_STAGE(PG8_SA(1, 0), a3, voffA);
            PG8_BAR; PG8_WAIT_L(0); PG8_MMA(1, 0, At, B0); PG8_BAR; PG8_SCHED;
            PG8_STAGE(PG8_SB(1, 1), b3 + hstep, voffB);
            PG8_WAIT_V(6); PG8_BAR; PG8_MMA(1, 1, At, B1); PG8_BAR;
            }
        }
        if constexpr (ALIGN_EPI) { if (wr == 0) PG8_BAR; }
        bool keep_acc = false;
        if constexpr (!Epi::AFTER_DRAIN) { if constexpr (Epi::CHAIN) keep_acc = E.chain(acc, cur, wr, wc, fr, fq); else E(acc, cur, wr, wc, fr, fq); S.done(cur); }
        if (!has_next) break;
        if (!keep_acc) {
#pragma unroll
        for (int a = 0; a < 2; ++a)
#pragma unroll
            for (int b = 0; b < 2; ++b)
#pragma unroll
                for (int m = 0; m < 4; ++m)
#pragma unroll
                    for (int n = 0; n < 2; ++n) acc[a][b][m][n] = (f32x4){0.f, 0.f, 0.f, 0.f};
        }
        cur = nxt; cA = nA; cB = nB; ++ui;
        if constexpr (ALIGN_EPI) { if (wr == 1) PG8_BAR; }
    }
    PG8_WAIT_V(0);
    if constexpr (!ALIGN_EPI) { if (wr == 0) PG8_BAR; }
    PG8_BAR;
    if constexpr (Epi::AFTER_DRAIN) { E.fused(acc, cur, wr, wc, fr, fq, lds, wid, lane); S.done(cur); }
#undef PG8_SA
#undef PG8_SB
#undef PG8_STAGE
#undef PG8_LDA
#undef PG8_LDB
#undef PG8_MMA
#undef PG8_WAIT_V
#undef PG8_WAIT_L
#undef PG8_BAR
#undef PG8_SCHED
}
}
namespace attn_body {
using bf16=__hip_bfloat16;
using bf16x8=__attribute__((ext_vector_type(8)))short;
using s16x4=__attribute__((ext_vector_type(4)))short;
using f32x16=__attribute__((ext_vector_type(16)))float;
using u32x4=__attribute__((ext_vector_type(4)))unsigned;
constexpr int D=64,QP=512,KP=128,VP=6912,OP=512;
constexpr int NW=8,QBLK=32,QB=QBLK*NW,KVBLK=64;
__device__ __forceinline__ int crow(int r,int hi){return (r&3)+8*(r>>2)+4*hi;}
#define SBAR() __builtin_amdgcn_sched_barrier(0)
constexpr int NSLOT=3, SLOTB=8192;
constexpr int LDS_K=0, LDS_V=NSLOT*SLOTB, LDS_WS=2*NSLOT*SLOTB, LDS_OST=LDS_WS+NW*64*4, LDS_BYTES=LDS_OST+NW*4096;
constexpr float C2=0.125f*1.4426950408889634f;
__device__ __forceinline__ void glds16(const void*gsrc,unsigned lds_dst){unsigned keep;
  asm volatile("s_mov_b32 %0, m0\n\ts_mov_b32 m0, %2\n\ts_nop 0\n\tglobal_load_lds_dwordx4 %1, off\n\ts_mov_b32 m0, %0":"=&s"(keep):"v"(gsrc),"s"(lds_dst):"memory");}
__device__ __forceinline__ float max3f(float a,float b,float c){float r;asm("v_max3_f32 %0, %1, %2, %3":"=v"(r):"v"(a),"v"(b),"v"(c));return r;}
__device__ __forceinline__ float max2f(float a,float b){float r;asm("v_max_f32_e32 %0, %1, %2":"=v"(r):"v"(a),"v"(b));return r;}
__device__ __forceinline__ float fadd_s(float a,float b){float r;asm("v_add_f32_e32 %0, %1, %2":"=v"(r):"v"(a),"v"(b));return r;}
__device__ __forceinline__ float fsub_s(float a,float b){float r;asm("v_sub_f32_e32 %0, %1, %2":"=v"(r):"v"(a),"v"(b));return r;}
typedef float f32x2_t __attribute__((ext_vector_type(2))); typedef __bf16 bf16x2_t __attribute__((ext_vector_type(2)));
__device__ __forceinline__ unsigned cvtpk_s(float lo,float hi){f32x2_t v={lo,hi};bf16x2_t b=__builtin_convertvector(v,bf16x2_t);return __builtin_bit_cast(unsigned,b);}
#define WAIT_BAR(N) asm volatile("s_waitcnt vmcnt(" #N ") lgkmcnt(0)\n\ts_barrier":::"memory")

__device__ __forceinline__ void qkt(f32x16&p0,f32x16&p1,const char*Kslot,const bf16x8*qr,const f32x16&negm,int r32,int hi){
  const char*kb=Kslot+hi*1024+r32*16;
  #pragma unroll
  for(int d0=0;d0<4;++d0){
    const bf16x8 b0=*reinterpret_cast<const bf16x8*>(kb+d0*2048);
    const bf16x8 b1=*reinterpret_cast<const bf16x8*>(kb+d0*2048+512);
    if(d0==0){p0=__builtin_amdgcn_mfma_f32_32x32x16_bf16(b0,qr[0],negm,0,0,0);p1=__builtin_amdgcn_mfma_f32_32x32x16_bf16(b1,qr[0],negm,0,0,0);}
    else{p0=__builtin_amdgcn_mfma_f32_32x32x16_bf16(b0,qr[d0],p0,0,0,0);p1=__builtin_amdgcn_mfma_f32_32x32x16_bf16(b1,qr[d0],p1,0,0,0);}}
}
typedef __attribute__((address_space(3))) const char* lds_cptr;
typedef short v4i16_t __attribute__((ext_vector_type(4)));
__device__ __forceinline__ void kload8(bf16x8*kf,lds_cptr kp){
  kf[0]=*(const __attribute__((address_space(3))) bf16x8*)(kp);      kf[1]=*(const __attribute__((address_space(3))) bf16x8*)(kp+512);
  kf[2]=*(const __attribute__((address_space(3))) bf16x8*)(kp+2048); kf[3]=*(const __attribute__((address_space(3))) bf16x8*)(kp+2560);
  kf[4]=*(const __attribute__((address_space(3))) bf16x8*)(kp+4096); kf[5]=*(const __attribute__((address_space(3))) bf16x8*)(kp+4608);
  kf[6]=*(const __attribute__((address_space(3))) bf16x8*)(kp+6144); kf[7]=*(const __attribute__((address_space(3))) bf16x8*)(kp+6656);
}
__device__ __forceinline__ void kload2(bf16x8*kf,lds_cptr kp,int j){ kf[2*j]=*(const __attribute__((address_space(3))) bf16x8*)(kp+j*2048); kf[2*j+1]=*(const __attribute__((address_space(3))) bf16x8*)(kp+j*2048+512); }
__device__ __forceinline__ s16x4 vtr(lds_cptr p){ return __builtin_bit_cast(s16x4,__builtin_amdgcn_ds_read_tr16_b64_v4i16((__attribute__((address_space(3))) v4i16_t*)p)); }
__device__ __forceinline__ float rowmax(const f32x16&p0,const f32x16&p1){
  float a=max3f(p0[0],p0[1],p1[0]),b=max3f(p0[2],p0[3],p1[1]);a=max3f(a,p1[2],p1[3]);
  #pragma unroll
  for(int r=4;r<16;r+=4){a=max3f(a,p0[r],p0[r+1]);b=max3f(b,p0[r+2],p0[r+3]);a=max3f(a,p1[r],p1[r+1]);b=max3f(b,p1[r+2],p1[r+3]);}
  const float m=max2f(a,b);
  auto rr=__builtin_amdgcn_permlane32_swap(__float_as_uint(m),__float_as_uint(m),false,false);
  return max2f(__uint_as_float(rr[0]),__uint_as_float(rr[1]));
}
__device__ __forceinline__ void pv(f32x16*o,int vb,bf16x8 pa0,bf16x8 pa1,bf16x8 pa2,bf16x8 pa3){
  #pragma unroll
  for(int d0=0;d0<2;++d0){s16x4 lo[4],hi[4];
    #pragma unroll
    for(int ks=0;ks<4;++ks){
      asm volatile("ds_read_b64_tr_b16 %0,%1 offset:%c2":"=&v"(lo[ks]):"v"(vb),"i"(d0*4096+ks*1024):"memory");
      asm volatile("ds_read_b64_tr_b16 %0,%1 offset:%c2":"=&v"(hi[ks]):"v"(vb),"i"(d0*4096+ks*1024+512):"memory");}
    asm volatile("s_waitcnt lgkmcnt(0)":::"memory");SBAR();
    #define PK(k) (bf16x8){lo[k][0],lo[k][1],lo[k][2],lo[k][3],hi[k][0],hi[k][1],hi[k][2],hi[k][3]}
    o[d0]=__builtin_amdgcn_mfma_f32_32x32x16_bf16(pa0,PK(0),o[d0],0,0,0);
    o[d0]=__builtin_amdgcn_mfma_f32_32x32x16_bf16(pa1,PK(1),o[d0],0,0,0);
    o[d0]=__builtin_amdgcn_mfma_f32_32x32x16_bf16(pa2,PK(2),o[d0],0,0,0);
    o[d0]=__builtin_amdgcn_mfma_f32_32x32x16_bf16(pa3,PK(3),o[d0],0,0,0);
    #undef PK
  }
}

#ifndef ATTN_STORE16
#define ATTN_STORE16(p,v) (*(u32x4*)(p)=(v))
#endif
template<int THRL> __device__ __forceinline__ void attn_unit(long qrow0,long kvrow0,int hq,int kvh,int NT,const bf16*Q,const bf16*__restrict__ K,const bf16*__restrict__ V,bf16*O,char*shm,const int tid){
  const int lane=tid&63,r32=lane&31,hi=lane>>5; const int wid=__builtin_amdgcn_readfirstlane(tid>>6);
  const bf16*Qw=Q+(qrow0+wid*QBLK)*QP+hq*D;
  const bf16*Kh=K+kvrow0*KP+kvh*D,*Vh=V+kvrow0*VP+kvh*D;
  const unsigned lds0=(unsigned)(uintptr_t)shm;
  float*wsf=(float*)(shm+LDS_WS)+wid*64;
  const bf16*ksrc=Kh+(long)lane*KP+wid*8;
  const bf16*vsrc=Vh+(long)(16*(wid&3)+(lane>>2))*VP+(wid>>2)*32+(lane&3)*8;
  const unsigned kdst=lds0+LDS_K+wid*1024, vdst=lds0+LDS_V+wid*1024;
  #define DMA_K(t,slot) glds16(ksrc+(long)(t)*KVBLK*KP,(unsigned)__builtin_amdgcn_readfirstlane(kdst+(slot)))
  #define DMA_V(t,slot) glds16(vsrc+(long)(t)*KVBLK*VP,(unsigned)__builtin_amdgcn_readfirstlane(vdst+(slot)))
  const int vb0=(int)(lds0+LDS_V)+((lane>>4)&1)*32+(lane&3)*8+(4*hi+((lane&15)>>2))*64;
  const char*Kbase=shm+LDS_K; bf16x8 kf[8];
  const lds_cptr shm3=(lds_cptr)shm; const lds_cptr kp0=shm3+LDS_K+hi*1024+r32*16; const lds_cptr vp0=shm3+LDS_V+((lane>>4)&1)*32+(lane&3)*8+(4*hi+((lane&15)>>2))*64;
  DMA_K(0,0);DMA_V(0,0);DMA_K(1,SLOTB);
  bf16x8 qr[4];
  #pragma unroll
  for(int d0=0;d0<4;++d0)qr[d0]=*reinterpret_cast<const bf16x8*>(&Qw[(long)r32*QP+d0*16+hi*8]);
  float mhat=0.f,l_reg=0.f;float z0_=0.f;asm volatile("":"+v"(z0_));f32x16 o[2];f32x16 negm;
  #pragma unroll
  for(int r=0;r<16;++r){o[0][r]=z0_;o[1][r]=z0_;negm[r]=z0_;}
  asm volatile("":"+v"(negm));
  #define CMASK(P0,P1,t) do{}while(0)
  bool resc=false;
  #define START(P0,P1) do{ const float rm=rowmax(P0,P1); resc=false; \
    { const float dl=rm; mhat=fadd_s(mhat,dl); \
      _Pragma("unroll") for(int r=0;r<16;++r){P0[r]=fsub_s(P0[r],dl);P1[r]=fsub_s(P1[r],dl);} \
      _Pragma("unroll") for(int r=0;r<16;++r)negm[r]=-mhat; asm volatile("":"+v"(negm)); } \
    _Pragma("unroll") for(int r=0;r<16;++r)P0[r]=__builtin_amdgcn_exp2f(P0[r]); }while(0)
  #define RESC() do{ if(resc){ asm volatile("s_waitcnt lgkmcnt(0)":::"memory"); \
      _Pragma("unroll") for(int d_=0;d_<2;++d_) _Pragma("unroll") for(int r=0;r<16;++r)o[d_][r]*=wsf[crow(r,hi)]; } }while(0)
  f32x16 pA0,pA1,pB0,pB1;
  int sl_prev=0,sl_cur=0,sl_next=SLOTB;
  #define ROT() do{sl_prev=sl_cur;sl_cur=sl_next;sl_next=(sl_next==(NSLOT-1)*SLOTB)?0:sl_next+SLOTB;}while(0)
  DMA_K(2,2*SLOTB);
  WAIT_BAR(3);
  qkt(pA0,pA1,Kbase,qr,negm,r32,hi);asm volatile("s_nop 15\n\ts_nop 7":"+v"(pA0),"+v"(pA1));CMASK(pA0,pA1,0);
  START(pA0,pA1);
  _Pragma("unroll") for(int r=0;r<16;++r)pA1[r]=__builtin_amdgcn_exp2f(pA1[r]);
  WAIT_BAR(0);
  DMA_K(3,0);DMA_V(1,SLOTB);
  ROT();
  kload8(kf,kp0+sl_cur);
  WAIT_BAR(2);
  s16x4 vlo[8],vhi[8]; u32x4 pw0,pw1,pw2,pw3;
  #define PKW(P,B) cvtpk_s(P[B],P[B+1])
  #define PAF(k) __builtin_bit_cast(bf16x8,pw##k)
  #define VFR(i) (bf16x8){vlo[i][0],vlo[i][1],vlo[i][2],vlo[i][3],vhi[i][0],vhi[i][1],vhi[i][2],vhi[i][3]}
  #define PIN(x) asm volatile("":"+v"(x))
  #define MX3(a,b,c) __builtin_fmaxf(__builtin_fmaxf((a),(b)),(c))
  #define GAPA(MF,A0,A1,A2,A3,W0,W1,PW) do{ MF; sacc+=A0; sacc+=A1; sacc+=A2; sacc+=A3; PIN(sacc); W0; W1; PIN(PW); SBAR(); }while(0)
  #define EX(v) __builtin_amdgcn_exp2f(v)
  #define GAPB(MF,X,B) do{ MF; X[B]=EX(X[B]); X[B+1]=EX(X[B+1]); X[B+2]=EX(X[B+2]); X[B+3]=EX(X[B+3]); PIN(X); SBAR(); }while(0)
  #define VRD(i) do{ vlo[i]=vtr(vp_+(((i)>>2)*4096+((i)&3)*1024)); vhi[i]=vtr(vp_+(((i)>>2)*4096+((i)&3)*1024+512)); }while(0)
  #define KRD(G,j) do{ if(G){ kload2(kf,kp0+sl_next,j); SBAR(); } }while(0)
  #define STEP(C0,C1,P0,P1,t,GK,GV,GL) do{ SBAR(); \
    const lds_cptr vp_=vp0+sl_prev; \
    VRD(0); SBAR(); float sacc=(P0[0]+P0[1]); \
    GAPA(C0=__builtin_amdgcn_mfma_f32_32x32x16_bf16(kf[0],qr[0],negm,0,0,0), P0[2],P0[3],P0[4],P0[5],     pw0[0]=PKW(P0,0), pw0[1]=PKW(P0,2), pw0); \
    VRD(4); SBAR(); GAPA(C1=__builtin_amdgcn_mfma_f32_32x32x16_bf16(kf[1],qr[0],negm,0,0,0), P0[6],P0[7],P0[8],P0[9],     pw0[2]=PKW(P0,4), pw0[3]=PKW(P0,6), pw0); \
    VRD(1); SBAR(); GAPA(C0=__builtin_amdgcn_mfma_f32_32x32x16_bf16(kf[2],qr[1],C0,0,0,0),   P0[10],P0[11],P0[12],P0[13], pw1[0]=PKW(P0,8), pw1[1]=PKW(P0,10), pw1); \
    VRD(5); SBAR(); GAPA(C1=__builtin_amdgcn_mfma_f32_32x32x16_bf16(kf[3],qr[1],C1,0,0,0),   P0[14],P0[15],P1[0],P1[1],   pw1[2]=PKW(P0,12),pw1[3]=PKW(P0,14), pw1); \
    VRD(2); SBAR(); GAPA(C0=__builtin_amdgcn_mfma_f32_32x32x16_bf16(kf[4],qr[2],C0,0,0,0),   P1[2],P1[3],P1[4],P1[5],     pw2[0]=PKW(P1,0), pw2[1]=PKW(P1,2), pw2); \
    VRD(6); SBAR(); GAPA(C1=__builtin_amdgcn_mfma_f32_32x32x16_bf16(kf[5],qr[2],C1,0,0,0),   P1[6],P1[7],P1[8],P1[9],     pw2[2]=PKW(P1,4), pw2[3]=PKW(P1,6), pw2); \
    VRD(3); SBAR(); GAPA(C0=__builtin_amdgcn_mfma_f32_32x32x16_bf16(kf[6],qr[3],C0,0,0,0),   P1[10],P1[11],P1[12],P1[13], pw3[0]=PKW(P1,8), pw3[1]=PKW(P1,10), pw3); \
    VRD(7); SBAR(); GAPA(C1=__builtin_amdgcn_mfma_f32_32x32x16_bf16(kf[7],qr[3],C1,0,0,0),   P1[14],P1[15],0.f,0.f,       pw3[2]=PKW(P1,12),pw3[3]=PKW(P1,14), pw3); \
    l_reg+=sacc; \
    if(GK){DMA_K((t)+3,sl_cur);} if(GV){DMA_V((t)+1,sl_next);} \
    CMASK(C0,C1,t); \
    { float a=MX3(C0[0],C0[1],C1[0]),b=MX3(C0[2],C0[3],C1[1]); a=MX3(a,C1[2],C1[3]); \
      _Pragma("unroll") for(int r=4;r<16;r+=4){a=MX3(a,C0[r],C0[r+1]);b=MX3(b,C0[r+2],C0[r+3]);a=MX3(a,C1[r],C1[r+1]);b=MX3(b,C1[r+2],C1[r+3]);} \
      float rm=__builtin_fmaxf(a,b); { auto rr=__builtin_amdgcn_permlane32_swap(__float_as_uint(rm),__float_as_uint(rm),false,false); rm=__builtin_fmaxf(__uint_as_float(rr[0]),__uint_as_float(rr[1])); } \
      resc=false; \
      if(__builtin_expect(__any(rm>(float)THRL),0)){ const float dl=__builtin_fmaxf(rm,0.f); mhat+=dl; \
        _Pragma("unroll") for(int r=0;r<16;++r){C0[r]-=dl;C1[r]-=dl;} \
        _Pragma("unroll") for(int r=0;r<16;++r)negm[r]=-mhat; asm volatile("":"+v"(negm)); \
        const float f=__builtin_amdgcn_exp2f(-dl); l_reg*=f; if(hi==0)wsf[r32]=f; resc=true; } } \
    SBAR(); \
    GAPB(o[0]=__builtin_amdgcn_mfma_f32_32x32x16_bf16(PAF(0),VFR(0),o[0],0,0,0), C0,0); \
    GAPB(o[1]=__builtin_amdgcn_mfma_f32_32x32x16_bf16(PAF(0),VFR(4),o[1],0,0,0), C0,4); \
    KRD(GL,0); GAPB(o[0]=__builtin_amdgcn_mfma_f32_32x32x16_bf16(PAF(1),VFR(1),o[0],0,0,0), C0,8); \
    KRD(GL,1); GAPB(o[1]=__builtin_amdgcn_mfma_f32_32x32x16_bf16(PAF(1),VFR(5),o[1],0,0,0), C0,12); \
    KRD(GL,2); GAPB(o[0]=__builtin_amdgcn_mfma_f32_32x32x16_bf16(PAF(2),VFR(2),o[0],0,0,0), C1,0); \
    KRD(GL,3); GAPB(o[1]=__builtin_amdgcn_mfma_f32_32x32x16_bf16(PAF(2),VFR(6),o[1],0,0,0), C1,4); \
    GAPB(o[0]=__builtin_amdgcn_mfma_f32_32x32x16_bf16(PAF(3),VFR(3),o[0],0,0,0), C1,8); \
    GAPB(o[1]=__builtin_amdgcn_mfma_f32_32x32x16_bf16(PAF(3),VFR(7),o[1],0,0,0), C1,12); \
    }while(0)
  int t=1;
  #undef CMASK
  #define CMASK(P0,P1,t) do{}while(0)
  for(;t+5<NT;t+=2){
    STEP(pB0,pB1,pA0,pA1,t,true,true,true);     WAIT_BAR(2); RESC(); ROT();
    STEP(pA0,pA1,pB0,pB1,t+1,true,true,true);   WAIT_BAR(2); RESC(); ROT();
  }
  #undef CMASK
  #define CMASK(P0,P1,t) do{}while(0)
  #define ENDW(tt) do{ if((tt)+3<NT){WAIT_BAR(2);} else if((tt)+2<NT){WAIT_BAR(1);} else {WAIT_BAR(0);} }while(0)
  for(;t+1<NT;t+=2){
    STEP(pB0,pB1,pA0,pA1,t,(t+3<NT),(t+1<NT),(t+1<NT));       ENDW(t);   RESC(); ROT();
    STEP(pA0,pA1,pB0,pB1,t+1,(t+4<NT),(t+2<NT),(t+2<NT));     ENDW(t+1); RESC(); ROT();
  }
  STEP(pB0,pB1,pA0,pA1,NT-1,false,false,false); RESC();
  { float sacc=pB0[0]+pB0[1]; _Pragma("unroll") for(int r=2;r<16;++r)sacc+=pB0[r]; _Pragma("unroll") for(int r=0;r<16;++r)sacc+=pB1[r]; l_reg+=sacc;
    pw0=(u32x4){PKW(pB0,0),PKW(pB0,2),PKW(pB0,4),PKW(pB0,6)};pw1=(u32x4){PKW(pB0,8),PKW(pB0,10),PKW(pB0,12),PKW(pB0,14)};pw2=(u32x4){PKW(pB1,0),PKW(pB1,2),PKW(pB1,4),PKW(pB1,6)};pw3=(u32x4){PKW(pB1,8),PKW(pB1,10),PKW(pB1,12),PKW(pB1,14)};
    SBAR(); pv(o,vb0+sl_cur,PAF(0),PAF(1),PAF(2),PAF(3)); }
  #undef PKW
  #undef PAF
  #undef VFR
  #undef PIN
  #undef MX3
  #undef GAPA
  #undef GAPB
  #undef EX
  #undef VRD
  #undef KRD
  #undef STEP
  #undef ENDW
  {auto rr=__builtin_amdgcn_permlane32_swap(__float_as_uint(l_reg),__float_as_uint(l_reg),false,false);l_reg=__uint_as_float(rr[0])+__uint_as_float(rr[1]);}
  if(hi==0)wsf[32+r32]=l_reg;asm volatile("s_waitcnt lgkmcnt(0)":::"memory");
  float rli[16];
  #pragma unroll
  for(int r=0;r<16;++r)rli[r]=__builtin_amdgcn_rcpf(wsf[32+crow(r,hi)]);
  bf16*Ow=O+(qrow0+wid*QBLK)*OP+hq*D;
  { bf16*stg=(bf16*)(shm+LDS_OST)+wid*2048;
    #pragma unroll
    for(int r=0;r<16;++r){const int orow=crow(r,hi);
      #pragma unroll
      for(int d0=0;d0<2;++d0)stg[orow*64+d0*32+r32]=__float2bfloat16(o[d0][r]*rli[r]);}
    asm volatile("s_waitcnt lgkmcnt(0)":::"memory");
    #pragma unroll
    for(int i=0;i<4;++i){const int row=i*8+(lane>>3),ch=lane&7; const u32x4 v=*(const u32x4*)(stg+row*64+ch*8); ATTN_STORE16(Ow+(long)row*OP+ch*8,v);} }
  asm volatile("s_waitcnt lgkmcnt(0)\n\ts_barrier":::"memory");
  #undef DMA_K
  #undef DMA_V
  #undef CMASK
  #undef START
  #undef RESC
  #undef ROT
}
constexpr int ATTN_LDS_BYTES=LDS_BYTES;
#undef SBAR
#undef WAIT_BAR
}
#define LAS __attribute__((address_space(3)))
typedef unsigned short bf16;
typedef unsigned v4u __attribute__((ext_vector_type(4)));
typedef unsigned v2u __attribute__((ext_vector_type(2)));
typedef float f32x4 __attribute__((ext_vector_type(4)));
typedef short bf16x8 __attribute__((ext_vector_type(8)));
constexpr int NWAVES = 8;
constexpr int NB = 4, LAT = 4096, LCTX = 256, SROW = 4352, MTOK = 17408, DMODEL = 1024, DEPTH = 4, DFF = 2816, DIN = 6912, MODW = 9216;
constexpr int ZC_RQ = 0, ZC_RK = 512, ZC_RV = 1024, ZC_RG = 1536, ZC_LX = 2048, ZC_LZ = 2560, ZC_AQ = 3072, ZC_AK = 3584, ZC_AV = 3712, ZC_GT = 3840;
constexpr float NORM_EPS = 1e-6f;
constexpr size_t MiB = 1u << 20;
constexpr size_t WS_MOD = 1 * MiB, WS_ROPE = 2 * MiB, WS_SUMM = 3 * MiB, WS_HIN = 6 * MiB;
constexpr size_t WS_WSET = 54 * MiB;
constexpr size_t WS_WFI = 8 * MiB;
constexpr size_t WS_WFO = 30 * MiB;
constexpr size_t WS_WIN = 41 * MiB;
constexpr size_t WS_WB = 55 * MiB;
constexpr size_t WS_WO = 58 * MiB;
constexpr size_t WS_LRUW = 60 * MiB;
constexpr size_t WS_X = 116 * MiB;
constexpr size_t WS_HN = 184 * MiB;
constexpr size_t WS_Z = 218 * MiB;
constexpr size_t WS_QN = 448 * MiB;
constexpr size_t WS_KN = 465 * MiB;
constexpr size_t WS_Y = 470 * MiB;
constexpr size_t WS_U = 521 * MiB;
constexpr size_t WS_SIN = 589 * MiB;
constexpr size_t WS_PARTC = 624 * MiB;
constexpr size_t WS_END = 670 * MiB;
constexpr int LDS_BYTES = 147456;

__device__ __forceinline__ unsigned f2bf(float f) { unsigned u = __builtin_bit_cast(unsigned, f); return (u + 0x7fffu + ((u >> 16) & 1u)) >> 16; }
__device__ __forceinline__ unsigned pk2(float lo, float hi) { return f2bf(lo) | (f2bf(hi) << 16); }
__device__ __forceinline__ float bflo(unsigned w) { return __uint_as_float(w << 16); }
__device__ __forceinline__ float bfhi(unsigned w) { return __uint_as_float(w & 0xffff0000u); }
__device__ __forceinline__ float bf1(bf16 h) { return __uint_as_float(((unsigned)h) << 16); }
__device__ __forceinline__ void unpack8(const v4u w, float* f) { f[0] = bflo(w.x); f[1] = bfhi(w.x); f[2] = bflo(w.y); f[3] = bfhi(w.y); f[4] = bflo(w.z); f[5] = bfhi(w.z); f[6] = bflo(w.w); f[7] = bfhi(w.w); }
__device__ __forceinline__ float sigmoidf_(float v) { return __builtin_amdgcn_rcpf(1.0f + __expf(-v)); }
__device__ __forceinline__ float shx(float v, int m, int lane) { return __builtin_bit_cast(float, __builtin_amdgcn_ds_bpermute((lane ^ m) << 2, __builtin_bit_cast(int, v))); }
__device__ __forceinline__ float shi(float v, int src) { return __builtin_bit_cast(float, __builtin_amdgcn_ds_bpermute(src << 2, __builtin_bit_cast(int, v))); }
__device__ __forceinline__ float wave_sum(float v, int lane) {
#pragma unroll
    for (int o = 1; o < 64; o <<= 1) v += shx(v, o, lane);
    return v;
}
#define LDS_WAIT() asm volatile("s_waitcnt lgkmcnt(0)" ::: "memory")

struct Args { const float* in[24]; float* out; unsigned char* ws; int ph_lo, ph_hi; };
constexpr int ARGS_LDS_OFF = 139520;
struct AH { const LAS unsigned* w;
    __device__ __forceinline__ const float* in(int i) const { const unsigned lo = __builtin_amdgcn_readfirstlane(w[2 * i]), hi = __builtin_amdgcn_readfirstlane(w[2 * i + 1]); return (const float*)(((unsigned long long)hi << 32) | lo); }
    __device__ __forceinline__ float* out() const { const unsigned lo = __builtin_amdgcn_readfirstlane(w[48]), hi = __builtin_amdgcn_readfirstlane(w[49]); return (float*)(((unsigned long long)hi << 32) | lo); }
    __device__ __forceinline__ unsigned char* ws() const { const unsigned lo = __builtin_amdgcn_readfirstlane(w[50]), hi = __builtin_amdgcn_readfirstlane(w[51]); return (unsigned char*)(((unsigned long long)hi << 32) | lo); }
};
enum { I_X = 0, I_C, I_CTX, I_CCTX, I_WMOD, I_BMOD, I_NORMG, I_FFNIN, I_FFNOUT, I_WIN, I_RETLOGIT, I_RETG, I_CONVW, I_CONVB, I_LWA, I_LBA, I_LWX, I_LBX, I_LAM, I_QG, I_KG, I_WBR, I_WOUT, I_FG };

__device__ __forceinline__ void tr_item(const float* W, int N, int k0, int n0, bf16* WT, int K, int orow0, LAS float* scr, int lane) {
    const float* src = W + (size_t)k0 * N + n0 + lane;
#pragma unroll 1
    for (int i = 0; i < 64; i += 16) { float v[16];
#pragma unroll
        for (int r = 0; r < 16; ++r) v[r] = src[(size_t)(i + r) * N];
#pragma unroll
        for (int r = 0; r < 16; ++r) scr[(i + r) * 65 + lane] = v[r]; }
    LDS_WAIT(); asm volatile("" ::: "memory");
    const int c = lane & 7;
#pragma unroll
    for (int j = 0; j < 8; ++j) { const int n = (lane >> 3) + 8 * j; const LAS float* s = scr + (8 * c) * 65 + n;
        v4u o; o.x = pk2(s[0 * 65], s[1 * 65]); o.y = pk2(s[2 * 65], s[3 * 65]); o.z = pk2(s[4 * 65], s[5 * 65]); o.w = pk2(s[6 * 65], s[7 * 65]);
        *(v4u*)(WT + (size_t)(orow0 + n) * K + k0 + 8 * c) = o; }
    LDS_WAIT(); asm volatile("" ::: "memory");
}

__device__ __forceinline__ void phase_p0(const AH A, LAS unsigned char* lds, int tid, int G) {
    unsigned char* ws = A.ws();
    constexpr int NGEMV = 144;
    const int bx = blockIdx.x;
    if (bx < NGEMV || G <= NGEMV) {
        LAS float* sv = (LAS float*)lds;
        LAS float* red = sv + 5 * 1024;
        const float* c = A.in(I_C); const float* cctx = A.in(I_CCTX);
        for (int i = tid; i < 5 * 1024; i += 512) { const int r = i >> 10, k = i & 1023; const float v = (r < 4) ? c[r * 1024 + k] : cctx[k]; sv[i] = v / (1.0f + __expf(-v)); }
        __syncthreads();
        float* modbuf = (float*)(ws + WS_MOD);
        const float* wmod = A.in(I_WMOD); const float* bmod = A.in(I_BMOD);
        for (int item = bx; item < NGEMV; item += G) {
            const int l = item / 36, n0 = (item - l * 36) * 256, c4 = tid & 63, kg = tid >> 6;
            const f32x4* W = (const f32x4*)(wmod + (size_t)l * 1024 * MODW + n0) + c4;
            f32x4 acc[5];
#pragma unroll
            for (int r = 0; r < 5; ++r) acc[r] = (f32x4){0.f, 0.f, 0.f, 0.f};
#pragma unroll 8
            for (int k = kg * 128; k < kg * 128 + 128; ++k) { const f32x4 w = W[(size_t)k * (MODW / 4)];
#pragma unroll
                for (int r = 0; r < 5; ++r) acc[r] += w * sv[r * 1024 + k]; }
#pragma unroll
            for (int r = 0; r < 5; ++r) *(LAS f32x4*)(red + (kg * 5 + r) * 256 + c4 * 4) = acc[r];
            __syncthreads();
            for (int o = tid; o < 5 * 256; o += 512) { const int r = o >> 8, cc = o & 255; float s = 0.f;
#pragma unroll
                for (int q = 0; q < 8; ++q) s += red[(q * 5 + r) * 256 + cc];
                modbuf[(size_t)(l * 5 + r) * MODW + n0 + cc] = s + bmod[(size_t)l * MODW + n0 + cc]; }
            __syncthreads();
        }
    }
    if (bx >= NGEMV || G <= NGEMV) {
        const int wb = (G > NGEMV) ? bx - NGEMV : bx, nwb = (G > NGEMV) ? G - NGEMV : G;
        const f32x4* x4 = (const f32x4*)A.in(I_X); const f32x4* c4p = (const f32x4*)A.in(I_CTX); f32x4* X4 = (f32x4*)(ws + WS_X);
        const int total = MTOK * 256, stride = nwb * 512;
        for (int i = wb * 512 + tid; i < total; i += 4 * stride) { f32x4 v[4];
#pragma unroll
            for (int q = 0; q < 4; ++q) { const int ii = i + q * stride; if (ii < total) { const int row = ii >> 8, qq = ii & 255; const int b = row / SROW, s = row - b * SROW;
                v[q] = (s < LCTX) ? c4p[(size_t)(b * LCTX + s) * 256 + qq] : x4[(size_t)(b * LAT + s - LCTX) * 256 + qq]; } }
#pragma unroll
            for (int q = 0; q < 4; ++q) { const int ii = i + q * stride; if (ii < total) X4[ii] = v[q]; } }
        float* ra = (float*)(ws + WS_ROPE); float* rb = ra + 64 * 32 * 2;
        for (int i = wb * 512 + tid; i < 64 * 32 + 64 * 16; i += nwb * 512) {
            if (i < 64 * 32) { const int pos = i >> 5, f = i & 31; const float fr = powf(10000.0f, -(float)(2 * f) / 64.0f); const float ang = (float)pos * fr; ra[2 * i] = cosf(ang); ra[2 * i + 1] = sinf(ang); }
            else { const int j = i - 64 * 32; const int pos = j >> 4, f = j & 15; const float fr = powf(10000.0f, -(float)(2 * f) / 32.0f); const float ang = (float)pos * fr; rb[2 * j] = cosf(ang); rb[2 * j + 1] = sinf(ang); } }
    }
}

constexpr int CV_FI = 16 * 88, CV_FO = 44 * 16, CV_IN = 16 * 108, CV_BR = 8 * 16, CV_OUT = 16 * 16, CV_LRU = 32;
constexpr int CV_NIT = 2 * CV_FI + 2 * CV_FO + CV_IN + 3 * CV_BR + CV_OUT + CV_LRU;
__device__ __forceinline__ void convert_layer(const AH A, int l, int it_lo, int it_hi, LAS unsigned char* lds, int gw, int NGW, int wave, int lane) {
    unsigned char* ws = A.ws() + (size_t)(l & 1) * WS_WSET;
    LAS float* scr = (LAS float*)(lds + wave * 16640);
    for (int it = it_lo + gw; it < it_hi; it += NGW) {
        int r = it; bool done = false;
#pragma unroll
        for (int j = 0; j < 2; ++j) { if (!done) { if (r < CV_FI) { const int kb = r / 88, nb = r - kb * 88, n0 = nb * 64;
                const int orow0 = (n0 < DFF) ? ((n0 >> 7) * 256 + (n0 & 127)) : (((n0 - DFF) >> 7) * 256 + 128 + ((n0 - DFF) & 127));
                tr_item(A.in(I_FFNIN) + (size_t)(l * 2 + j) * 1024 * 5632, 5632, kb * 64, n0, (bf16*)(ws + WS_WFI) + (size_t)j * 5632 * 1024, 1024, orow0, scr, lane); done = true; } else r -= CV_FI; } }
#pragma unroll
        for (int j = 0; j < 2; ++j) { if (!done) { if (r < CV_FO) { const int kb = r >> 4, nb = r & 15;
                tr_item(A.in(I_FFNOUT) + (size_t)(l * 2 + j) * DFF * 1024, 1024, kb * 64, nb * 64, (bf16*)(ws + WS_WFO) + (size_t)j * 1024 * DFF, DFF, nb * 64, scr, lane); done = true; } else r -= CV_FO; } }
        if (!done) { if (r < CV_IN) { const int kb = r / 108, nb = r - kb * 108;
                tr_item(A.in(I_WIN) + (size_t)l * 1024 * DIN, DIN, kb * 64, nb * 64, (bf16*)(ws + WS_WIN), 1024, nb * 64, scr, lane); done = true; } else r -= CV_IN; }
#pragma unroll
        for (int n = 0; n < 3; ++n) { if (!done) { if (r < CV_BR) { const int kb = r >> 4, nb = r & 15;
                tr_item(A.in(I_WBR) + (size_t)(l * 3 + n) * 512 * 1024, 1024, kb * 64, nb * 64, (bf16*)(ws + WS_WB) + (size_t)n * 1024 * 512, 512, nb * 64, scr, lane); done = true; } else r -= CV_BR; } }
        if (!done) { if (r < CV_OUT) { const int kb = r >> 4, nb = r & 15;
                tr_item(A.in(I_WOUT) + (size_t)l * 1024 * 1024, 1024, kb * 64, nb * 64, (bf16*)(ws + WS_WO), 1024, nb * 64, scr, lane); done = true; } else r -= CV_OUT; }
        if (!done) { const int mat = r; const int g = mat >> 4, d = (mat >> 3) & 1, blk = mat & 7;
                const float* src = (g ? A.in(I_LWX) : A.in(I_LWA)) + (size_t)((l * 2 + d) * 8 + blk) * 4096;
                tr_item(src, 64, 0, 0, (bf16*)(ws + WS_LRUW) + (size_t)mat * 4096, 64, 0, scr, lane); }
    }
}

__device__ __forceinline__ void norm_rows(const AH A, int l, int sub, int gw, int NGW, int lane, int pend_ns, const float* pend_gate, float pend_scale) {
    unsigned char* ws = A.ws();
    const float* X = (const float*)(ws + WS_X); bf16* HN = (bf16*)(ws + WS_HN);
    const float* g = A.in(I_NORMG) + (size_t)(l * 3 + sub) * 1024;
    const float* modl = (const float*)(ws + WS_MOD) + (size_t)l * 5 * MODW + sub * 3072;
    f32x4 gv[4];
#pragma unroll
    for (int j = 0; j < 4; ++j) gv[j] = ((const f32x4*)g)[lane + 64 * j];
    f32x4 nx[4];
    if (gw < MTOK) {
#pragma unroll
        for (int j = 0; j < 4; ++j) nx[j] = ((const f32x4*)(X + (size_t)gw * 1024))[lane + 64 * j]; }
    for (int row = gw; row < MTOK; row += NGW) {
        const int b = row / SROW, s = row - b * SROW; const int mr = (s < LCTX) ? 4 : b;
        const f32x4* sh = (const f32x4*)(modl + (size_t)mr * MODW); const f32x4* sc = (const f32x4*)(modl + (size_t)mr * MODW + 1024);
        f32x4 v[4]; float ss = 0.f;
#pragma unroll
        for (int j = 0; j < 4; ++j) v[j] = nx[j];
        if (row + NGW < MTOK) {
#pragma unroll
            for (int j = 0; j < 4; ++j) nx[j] = ((const f32x4*)(X + (size_t)(row + NGW) * 1024))[lane + 64 * j]; }
        f32x4 scv[4], shv[4];
#pragma unroll
        for (int j = 0; j < 4; ++j) { scv[j] = sc[lane + 64 * j]; shv[j] = sh[lane + 64 * j]; }
        if (pend_ns > 0 && s < LCTX) {
            const f32x4* pc = (const f32x4*)((const float*)(ws + WS_PARTC) + (size_t)(b * LCTX + s) * 1024); const f32x4* pg = (const f32x4*)pend_gate;
            f32x4 a4[4] = {(f32x4){0.f, 0.f, 0.f, 0.f}, (f32x4){0.f, 0.f, 0.f, 0.f}, (f32x4){0.f, 0.f, 0.f, 0.f}, (f32x4){0.f, 0.f, 0.f, 0.f}};
            for (int sp = 0; sp < pend_ns; ++sp) {
#pragma unroll
                for (int j = 0; j < 4; ++j) a4[j] += pc[(size_t)sp * 262144 + lane + 64 * j]; }
            f32x4* xw = (f32x4*)(ws + WS_X) + (size_t)row * 256;
#pragma unroll
            for (int j = 0; j < 4; ++j) { v[j] += (pg[lane + 64 * j] * pend_scale) * a4[j]; xw[lane + 64 * j] = v[j]; }
        }
#pragma unroll
        for (int j = 0; j < 4; ++j) ss += (v[j].x * v[j].x + v[j].y * v[j].y) + (v[j].z * v[j].z + v[j].w * v[j].w);
        const float rstd = rsqrtf(wave_sum(ss, lane) * (1.0f / 1024.0f) + NORM_EPS);
        v2u* o = (v2u*)(HN + (size_t)row * 1024);
#pragma unroll
        for (int j = 0; j < 4; ++j) { const f32x4 y = (v[j] * rstd) * gv[j] * (scv[j] + 1.0f) + shv[j];
            v2u w; w.x = pk2(y.x, y.y); w.y = pk2(y.z, y.w); o[lane + 64 * j] = w; }
    }
}
__device__ __forceinline__ void final_rows(const AH A, int gw, int NGW, int lane) {
    const float* X = (const float*)(A.ws() + WS_X); const float* g = A.in(I_FG);
    f32x4 gv[4];
#pragma unroll
    for (int j = 0; j < 4; ++j) gv[j] = ((const f32x4*)g)[lane + 64 * j];
    f32x4 nx[4];
    if (gw < NB * LAT) { const int b = gw >> 12, t = gw & 4095;
#pragma unroll
        for (int j = 0; j < 4; ++j) nx[j] = ((const f32x4*)(X + (size_t)(b * SROW + LCTX + t) * 1024))[lane + 64 * j]; }
    for (int r = gw; r < NB * LAT; r += NGW) {
        f32x4 v[4]; float ss = 0.f;
#pragma unroll
        for (int j = 0; j < 4; ++j) v[j] = nx[j];
        if (r + NGW < NB * LAT) { const int r2 = r + NGW, b = r2 >> 12, t = r2 & 4095;
#pragma unroll
            for (int j = 0; j < 4; ++j) nx[j] = ((const f32x4*)(X + (size_t)(b * SROW + LCTX + t) * 1024))[lane + 64 * j]; }
#pragma unroll
        for (int j = 0; j < 4; ++j) ss += (v[j].x * v[j].x + v[j].y * v[j].y) + (v[j].z * v[j].z + v[j].w * v[j].w);
        const float rstd = rsqrtf(wave_sum(ss, lane) * (1.0f / 1024.0f) + NORM_EPS);
        f32x4* o = (f32x4*)(A.out() + (size_t)r * 1024);
#pragma unroll
        for (int j = 0; j < 4; ++j) o[lane + 64 * j] = (v[j] * rstd) * gv[j];
    }
}
#define XB_TMO      128
#define XB_XCNT(j)  (256  + 64 * (j))
#define XB_XSUB(j)  (1280 + 64 * (j))
#define XB_XGEN(j)  (2304 + 64 * (j))
#define XB_TOP      3328
#define XB_TOPGEN   3392
#define XCD_BAR_WORDS 3456
#define XB_SPIN_CAP (1u << 22)

__device__ __forceinline__ unsigned xb_ld(unsigned* p)              { return __hip_atomic_load(p, __ATOMIC_RELAXED, __HIP_MEMORY_SCOPE_AGENT); }
__device__ __forceinline__ unsigned xb_add(unsigned* p, unsigned v) { return __hip_atomic_fetch_add(p, v, __ATOMIC_RELAXED, __HIP_MEMORY_SCOPE_AGENT); }
__device__ __forceinline__ unsigned xb_xcc_id() { return (unsigned)__builtin_amdgcn_s_getreg((3 << 11) | 20) & 0xFu; }
#define XB_SPIN(cond, bar) do { unsigned _sp = 0; while (cond) { __builtin_amdgcn_s_sleep(1); \
    if ((++_sp & 255u) == 0u) { if (xb_ld(&(bar)[XB_TMO])) break; if (_sp > XB_SPIN_CAP) { atomicAdd(&(bar)[XB_TMO], 1u); break; } } } } while (0)

struct XcdBarrier {
    unsigned* bar; unsigned x;
    volatile LAS unsigned* st;
};

__device__ __forceinline__ XcdBarrier xcd_barrier_post(unsigned* bar, volatile LAS unsigned* st, bool t0) {
    XcdBarrier b; b.bar = bar; b.x = xb_xcc_id(); b.st = st;
    if (t0) (void)xb_add(&bar[XB_XCNT(b.x)], 1u);
    return b;
}
__device__ __forceinline__ void xcd_barrier_complete(unsigned* bar, unsigned x, unsigned& nloc, unsigned& nx) {
    const unsigned G = gridDim.x * gridDim.y * gridDim.z;
    unsigned sum, cnt, mine, sp = 0u;
    for (;;) {
        sum = 0u; cnt = 0u; mine = 0u;
#pragma unroll
        for (unsigned j = 0; j < 16; ++j) { const unsigned c = xb_ld(&bar[XB_XCNT(j)]); sum += c; cnt += (c > 0u) ? 1u : 0u; mine = (j == x) ? c : mine; }
        if (sum == G) break;
        __builtin_amdgcn_s_sleep(1);
        if ((++sp & 255u) == 0u) { if (xb_ld(&bar[XB_TMO])) break; if (sp > XB_SPIN_CAP) { atomicAdd(&bar[XB_TMO], 1u); break; } }
    }
    nloc = mine > 0u ? mine : 1u; nx = cnt > 0u ? cnt : 1u;
}

__device__ __forceinline__ void xcd_barrier(const XcdBarrier& b, bool t0) {
    asm volatile("s_waitcnt vmcnt(0)" ::: "memory");
    __syncthreads();
    if (t0) {
        unsigned* bar = b.bar;
        __builtin_amdgcn_s_waitcnt(0);
        unsigned nloc = b.st[0], nx = b.st[1];
        if (nloc == 0u) { xcd_barrier_complete(bar, b.x, nloc, nx); b.st[0] = nloc; b.st[1] = nx; }
        const unsigned old = xb_add(&bar[XB_XSUB(b.x)], 1u);
        const unsigned gen = old / nloc;
        if (old + 1u == (gen + 1u) * nloc) {
            __builtin_amdgcn_fence(__ATOMIC_RELEASE, "agent");
            asm volatile("s_waitcnt vmcnt(0)" ::: "memory");
            const unsigned og = xb_add(&bar[XB_TOP], 1u);
            const unsigned tg = og / nx;
            if (og + 1u == (tg + 1u) * nx) xb_add(&bar[XB_TOPGEN], 1u);
            else XB_SPIN(xb_ld(&bar[XB_TOPGEN]) == tg, bar);
            __builtin_amdgcn_fence(__ATOMIC_ACQUIRE, "agent");
            xb_add(&bar[XB_XGEN(b.x)], 1u);
            asm volatile("s_waitcnt vmcnt(0)" ::: "memory");
        } else {
            XB_SPIN(xb_ld(&bar[XB_XGEN(b.x)]) == gen, bar);
            __builtin_amdgcn_fence(__ATOMIC_ACQUIRE, "agent");
            asm volatile("s_waitcnt vmcnt(0)" ::: "memory");
        }
    }
    __syncthreads();
}
__device__ __forceinline__ void prep_qk(const AH A, int l, int gw, int NGW, int lane) {
    unsigned char* ws = A.ws();
    const bf16* Z = (const bf16*)(ws + WS_Z); bf16* QN = (bf16*)(ws + WS_QN); bf16* KN = (bf16*)(ws + WS_KN);
    const float* rb = (const float*)(ws + WS_ROPE) + 64 * 32 * 2;
    const int e0 = (lane & 7) * 8, hq = lane >> 3;
    float gq[8], gk[8];
#pragma unroll
    for (int j = 0; j < 8; ++j) { gq[j] = A.in(I_QG)[l * 64 + e0 + j]; gk[j] = A.in(I_KG)[l * 64 + e0 + j]; }
    constexpr float C2 = 0.125f * 1.4426950408889634f;
    for (int row = gw; row < MTOK; row += NGW) {
        const int b = row / SROW, s = row - b * SROW; const bool lat = s >= LCTX; const int t = s - LCTX;
        const int pos = (lane & 4) ? (t & 63) : (t >> 6);
#pragma unroll
        for (int pass = 0; pass < 2; ++pass) {
            const bf16* src = Z + (size_t)row * DIN + (pass == 0 ? ZC_AQ : ZC_AK) + hq * 64 + e0;
            float f[8]; unpack8(*(const v4u*)src, f);
            float ss = 0.f;
#pragma unroll
            for (int j = 0; j < 8; ++j) ss += f[j] * f[j];
            ss += shx(ss, 1, lane); ss += shx(ss, 2, lane); ss += shx(ss, 4, lane);
            const float rstd = rsqrtf(ss * (1.0f / 64.0f) + NORM_EPS);
            float y[8], o[8];
#pragma unroll
            for (int j = 0; j < 8; ++j) y[j] = f[j] * rstd * (pass == 0 ? gq[j] : gk[j]);
#pragma unroll
            for (int j = 0; j < 8; ++j) { const float p = shx(y[j], 2, lane);
                if (lat) { const int fi = (lane & 1) * 8 + j; const float cs = rb[(pos * 16 + fi) * 2], sn = rb[(pos * 16 + fi) * 2 + 1];
                    o[j] = ((lane & 2) == 0) ? (y[j] * cs - p * sn) : (p * sn + y[j] * cs); }
                else o[j] = y[j];
                if (pass == 0) o[j] *= C2; }
            v4u w; w.x = pk2(o[0], o[1]); w.y = pk2(o[2], o[3]); w.z = pk2(o[4], o[5]); w.w = pk2(o[6], o[7]);
            if (pass == 0) *(v4u*)(QN + (size_t)row * 512 + hq * 64 + e0) = w;
            else if (lane < 16) *(v4u*)(KN + (size_t)row * 128 + hq * 64 + e0) = w;
        }
    }
}

constexpr int RLDP = 136;
constexpr int RBUF = 128 * RLDP * 2;
__device__ __forceinline__ float log_sigmoid_f(float x) { return (x < 0.f ? x : 0.f) - log1pf(__expf(-fabsf(x))); }
template <bool TRANSPOSED, bool ROPE>
__device__ __forceinline__ void ret_stage_pair(const bf16* Z, int r0, int zc, int h, bool lat, int t0, const float* ra, float scl, float lgdec, int decmode  , LAS bf16* dst, int tid) {
#pragma unroll
    for (int it = 0; it < 2; ++it) { const int task = tid + 512 * it; const int j = task & 127, pr = task >> 7; const int c = (pr & 3) + (pr >> 2) * 8;
        const bf16* p = Z + (size_t)(r0 + j) * DIN + zc + h * 128;
        float a[8], bq[8]; unpack8(*(const v4u*)(p + 8 * c), a); unpack8(*(const v4u*)(p + 8 * (c + 4)), bq);
        float sc = scl; if (decmode == 1) sc *= __expf(lgdec * (float)(127 - j)); else if (decmode == 2) sc *= __expf(lgdec * (float)j);
        if (ROPE && lat) { const int t = t0 + j; const int pos = (c < 8) ? (t >> 6) : (t & 63);
#pragma unroll
            for (int e = 0; e < 8; ++e) { const int fi = (c & 3) * 8 + e; const float cs = ra[(pos * 32 + fi) * 2], sn = ra[(pos * 32 + fi) * 2 + 1];
                const float x1 = a[e], x2 = bq[e]; a[e] = x1 * cs - x2 * sn; bq[e] = x1 * sn + x2 * cs; } }
        if (TRANSPOSED) {
#pragma unroll
            for (int e = 0; e < 8; ++e) { dst[(8 * c + e) * RLDP + j] = (bf16)f2bf(a[e] * sc); dst[(8 * (c + 4) + e) * RLDP + j] = (bf16)f2bf(bq[e] * sc); }
        } else {
            v4u w; w.x = pk2(a[0] * sc, a[1] * sc); w.y = pk2(a[2] * sc, a[3] * sc); w.z = pk2(a[4] * sc, a[5] * sc); w.w = pk2(a[6] * sc, a[7] * sc);
            *(LAS v4u*)(dst + j * RLDP + 8 * c) = w;
            w.x = pk2(bq[0] * sc, bq[1] * sc); w.y = pk2(bq[2] * sc, bq[3] * sc); w.z = pk2(bq[4] * sc, bq[5] * sc); w.w = pk2(bq[6] * sc, bq[7] * sc);
            *(LAS v4u*)(dst + j * RLDP + 8 * (c + 4)) = w;
        } }
}
__device__ __forceinline__ void wave_mm(f32x4 (&acc)[8], const LAS bf16* Am, int row0, const LAS bf16* Bm, int lane) {
    const int r = lane & 15, g = lane >> 4;
#pragma unroll
    for (int ks = 0; ks < 4; ++ks) { const bf16x8 a = *(const LAS bf16x8*)(Am + (row0 + r) * RLDP + ks * 32 + g * 8);
#pragma unroll
        for (int nt = 0; nt < 8; ++nt) { const bf16x8 bfr = *(const LAS bf16x8*)(Bm + (nt * 16 + r) * RLDP + ks * 32 + g * 8);
            acc[nt] = __builtin_amdgcn_mfma_f32_16x16x32_bf16(a, bfr, acc[nt], 0, 0, 0); } }
}
__device__ __forceinline__ int ret_chain_pos(int d, int cidx) { return d == 0 ? cidx : (cidx == 1 ? 0 : (cidx == 0 ? 1 : 35 - cidx)); }

__device__ __forceinline__ void ret_stage_k_both(const bf16* Z, int r0, int h, bool lat, int t0, const float* ra, float scl, float lgf, float lgb, LAS bf16* dstf, LAS bf16* dstb, int tid) {
#pragma unroll
    for (int it = 0; it < 2; ++it) { const int task = tid + 512 * it; const int j = task & 127, pr = task >> 7; const int c = (pr & 3) + (pr >> 2) * 8;
        const bf16* p = Z + (size_t)(r0 + j) * DIN + ZC_RK + h * 128;
        float a[8], bq[8]; unpack8(*(const v4u*)(p + 8 * c), a); unpack8(*(const v4u*)(p + 8 * (c + 4)), bq);
        const float sf = scl * __expf(lgf * (float)(127 - j)), sb = scl * __expf(lgb * (float)j);
        if (lat) { const int t = t0 + j; const int pos = (c < 8) ? (t >> 6) : (t & 63);
#pragma unroll
            for (int e = 0; e < 8; ++e) { const int fi = (c & 3) * 8 + e; const float cs = ra[(pos * 32 + fi) * 2], sn = ra[(pos * 32 + fi) * 2 + 1];
                const float x1 = a[e], x2 = bq[e]; a[e] = x1 * cs - x2 * sn; bq[e] = x1 * sn + x2 * cs; } }
#pragma unroll
        for (int e = 0; e < 8; ++e) { dstf[(8 * c + e) * RLDP + j] = (bf16)f2bf(a[e] * sf); dstf[(8 * (c + 4) + e) * RLDP + j] = (bf16)f2bf(bq[e] * sf);
                                      dstb[(8 * c + e) * RLDP + j] = (bf16)f2bf(a[e] * sb); dstb[(8 * (c + 4) + e) * RLDP + j] = (bf16)f2bf(bq[e] * sb); } }
}
__device__ __forceinline__ void ret_u_item(const AH A, int l, int item, LAS unsigned char* lds, int tid, int wave, int lane) {
    unsigned char* ws = A.ws(); const bf16* Z = (const bf16*)(ws + WS_Z); const float* ra = (const float*)(ws + WS_ROPE);
    const int cidx = item % 34, bh = item / 34, b = bh >> 2, h = bh & 3;
    const int pf = ret_chain_pos(0, cidx), pb = ret_chain_pos(1, cidx);
    const bool lat = cidx >= 2; const int r0 = b * SROW + cidx * 128, t0 = (cidx - 2) * 128;
    const float lgf = log_sigmoid_f(A.in(I_RETLOGIT)[(l * 2 + 0) * 4 + h]), lgb = log_sigmoid_f(A.in(I_RETLOGIT)[(l * 2 + 1) * 4 + h]);
    LAS bf16* Ktf = (LAS bf16*)lds; LAS bf16* Ktb = (LAS bf16*)(lds + RBUF); LAS bf16* Vt = (LAS bf16*)(lds + 2 * RBUF);
    ret_stage_k_both(Z, r0, h, lat, t0, ra, 0.08838834764831845f, lgf, lgb, Ktf, Ktb, tid);
    ret_stage_pair<true, false>(Z, r0, ZC_RV, h, false, 0, ra, 1.0f, 0.f, 0, Vt, tid);
    __syncthreads();
    const int g = lane >> 4, c = lane & 15;
    f32x4 accf[8], accb[8];
#pragma unroll
    for (int nt = 0; nt < 8; ++nt) { accf[nt] = (f32x4){0.f, 0.f, 0.f, 0.f}; accb[nt] = (f32x4){0.f, 0.f, 0.f, 0.f}; }
    if (pf != 33) wave_mm(accf, Vt, wave * 16, Ktf, lane);
    if (pb != 33) wave_mm(accb, Vt, wave * 16, Ktb, lane);
    __syncthreads();
    LAS bf16* stg = (LAS bf16*)lds + wave * (16 * RLDP);
#pragma unroll 1
    for (int d = 0; d < 2; ++d) { const int p = d ? pb : pf;
        if (p == 33) continue;
#pragma unroll
        for (int nt = 0; nt < 8; ++nt)
#pragma unroll
            for (int jj = 0; jj < 4; ++jj) stg[(4 * g + jj) * RLDP + nt * 16 + c] = (bf16)f2bf(d ? accb[nt][jj] : accf[nt][jj]);
        LDS_WAIT(); asm volatile("" ::: "memory");
        bf16* U = (bf16*)(ws + WS_U) + ((size_t)((b * 4 + h) * 2 + d) * 34 + p) * 16384 + (size_t)(wave * 16) * 128;
#pragma unroll
        for (int it = 0; it < 4; ++it) { const int id = lane + 64 * it, rr = id >> 4, ch = id & 15;
            *(v4u*)(U + rr * 128 + ch * 8) = *(const LAS v4u*)(stg + rr * RLDP + ch * 8); }
        LDS_WAIT(); asm volatile("" ::: "memory"); }
    __syncthreads();
}
__device__ __forceinline__ void ret_scan_item(const AH A, int l, int item, int tid) {
    unsigned char* ws = A.ws();
    const int bhd = item >> 3, sl = item & 7; const int d = bhd & 1, h = (bhd >> 1) & 3;
    const float lg = log_sigmoid_f(A.in(I_RETLOGIT)[(l * 2 + d) * 4 + h]); const float sdec = __expf(128.0f * lg);
    const v2u* U = (const v2u*)((const bf16*)(ws + WS_U) + (size_t)bhd * 34 * 16384) + sl * 512 + tid;
    v2u* S = (v2u*)((bf16*)(ws + WS_SIN) + (size_t)bhd * 34 * 16384) + sl * 512 + tid;
    f32x4 s = (f32x4){0.f, 0.f, 0.f, 0.f};
#pragma unroll 1
    for (int p0 = 0; p0 < 33; p0 += 11) { v2u u[11];
#pragma unroll
        for (int i = 0; i < 11; ++i) u[i] = U[(size_t)(p0 + i) * 4096];
#pragma unroll
        for (int i = 0; i < 11; ++i) { v2u w; w.x = pk2(s.x, s.y); w.y = pk2(s.z, s.w); S[(size_t)(p0 + i) * 4096] = w;
            const f32x4 uf = (f32x4){bflo(u[i].x), bfhi(u[i].x), bflo(u[i].y), bfhi(u[i].y)}; s = s * sdec + uf; } }
    { v2u w; w.x = pk2(s.x, s.y); w.y = pk2(s.z, s.w); S[(size_t)33 * 4096] = w; }
}
__device__ __forceinline__ void ret_out_item(const AH A, int l, int item, LAS unsigned char* lds, int tid, int wave, int lane) {
    unsigned char* ws = A.ws(); const bf16* Z = (const bf16*)(ws + WS_Z); const float* ra = (const float*)(ws + WS_ROPE);
    const int cidx = item % 34, bh = item / 34, b = bh >> 2, h = bh & 3;
    const bool lat = cidx >= 2; const int r0 = b * SROW + cidx * 128, t0 = (cidx - 2) * 128;
    const float lgf = log_sigmoid_f(A.in(I_RETLOGIT)[(l * 2 + 0) * 4 + h]) * 1.4426950408889634f, lgb = log_sigmoid_f(A.in(I_RETLOGIT)[(l * 2 + 1) * 4 + h]) * 1.4426950408889634f;
    LAS bf16* Qs = (LAS bf16*)lds; LAS bf16* Ks = (LAS bf16*)(lds + RBUF); LAS bf16* Vt = (LAS bf16*)(lds + 2 * RBUF); LAS bf16* Ss = (LAS bf16*)(lds + 3 * RBUF);
    const bf16* SINf = (const bf16*)(ws + WS_SIN) + ((size_t)((b * 4 + h) * 2 + 0) * 34 + ret_chain_pos(0, cidx)) * 16384;
    const bf16* SINb = (const bf16*)(ws + WS_SIN) + ((size_t)((b * 4 + h) * 2 + 1) * 34 + ret_chain_pos(1, cidx)) * 16384;
    ret_stage_pair<false, true>(Z, r0, ZC_RQ, h, lat, t0, ra, 1.0f, 0.f, 0, Qs, tid);
    ret_stage_pair<false, true>(Z, r0, ZC_RK, h, lat, t0, ra, 0.08838834764831845f, 0.f, 0, Ks, tid);
    ret_stage_pair<true, false>(Z, r0, ZC_RV, h, false, 0, ra, 1.0f, 0.f, 0, Vt, tid);
#pragma unroll
    for (int it = 0; it < 4; ++it) { const int task = tid + 512 * it, row = task >> 4, ch = task & 15; *(LAS v4u*)(Ss + row * RLDP + ch * 8) = *(const v4u*)(SINf + row * 128 + ch * 8); }
    v4u sbv[4];
#pragma unroll
    for (int it = 0; it < 4; ++it) { const int task = tid + 512 * it, row = task >> 4, ch = task & 15; sbv[it] = *(const v4u*)(SINb + row * 128 + ch * 8); }
    __syncthreads();
    const int g = lane >> 4, c = lane & 15, i0 = wave * 16 + 4 * g;
    f32x4 accs[8], acco[8];
#pragma unroll
    for (int nt = 0; nt < 8; ++nt) { accs[nt] = (f32x4){0.f, 0.f, 0.f, 0.f}; acco[nt] = (f32x4){0.f, 0.f, 0.f, 0.f}; }
    wave_mm(accs, Qs, wave * 16, Ks, lane);
    wave_mm(acco, Qs, wave * 16, Ss, lane);
#pragma unroll
    for (int jj = 0; jj < 4; ++jj) { const float qd = __builtin_amdgcn_exp2f(lgf * (float)(i0 + jj + 1));
#pragma unroll
        for (int nt = 0; nt < 8; ++nt) acco[nt][jj] *= qd; }
    int i0w = i0; asm volatile("" : "+v"(i0w));
#pragma unroll
    for (int nt = 0; nt < 8; ++nt)
#pragma unroll
        for (int jj = 0; jj < 4; ++jj) { const int diff = (i0w + jj) - (nt * 16 + c);
            const float w = diff > 0 ? __builtin_amdgcn_exp2f(lgf * (float)diff) : (diff < 0 ? __builtin_amdgcn_exp2f(lgb * (float)(-diff)) : 2.0f);
            accs[nt][jj] *= w; }
    __syncthreads();
#pragma unroll
    for (int nt = 0; nt < 8; ++nt)
#pragma unroll
        for (int jj = 0; jj < 4; ++jj) Ks[(i0 + jj) * RLDP + nt * 16 + c] = (bf16)f2bf(accs[nt][jj]);
#pragma unroll
    for (int it = 0; it < 4; ++it) { const int task = tid + 512 * it, row = task >> 4, ch = task & 15; *(LAS v4u*)(Ss + row * RLDP + ch * 8) = sbv[it]; }
    __syncthreads();
#pragma unroll
    for (int nt = 0; nt < 8; ++nt) accs[nt] = (f32x4){0.f, 0.f, 0.f, 0.f};
    wave_mm(accs, Qs, wave * 16, Ss, lane);
#pragma unroll
    for (int jj = 0; jj < 4; ++jj) { const float qd = __builtin_amdgcn_exp2f(lgb * (float)(128 - (i0 + jj)));
#pragma unroll
        for (int nt = 0; nt < 8; ++nt) acco[nt][jj] += qd * accs[nt][jj]; }
    wave_mm(acco, Ks, wave * 16, Vt, lane);
    const float* gn = A.in(I_RETG) + (size_t)l * 512 + h * 128;
    bf16* Y = (bf16*)(ws + WS_Y);
    float gnv[8];
#pragma unroll
    for (int nt = 0; nt < 8; ++nt) gnv[nt] = gn[nt * 16 + c];
#pragma unroll
    for (int jj = 0; jj < 4; ++jj) {
        float s1 = 0.f;
#pragma unroll
        for (int nt = 0; nt < 8; ++nt) s1 += acco[nt][jj];
        s1 += shx(s1, 1, lane); s1 += shx(s1, 2, lane); s1 += shx(s1, 4, lane); s1 += shx(s1, 8, lane);
        const float mu = s1 * (1.0f / 128.0f); float s2 = 0.f;
#pragma unroll
        for (int nt = 0; nt < 8; ++nt) { const float dlt = acco[nt][jj] - mu; s2 += dlt * dlt; }
        s2 += shx(s2, 1, lane); s2 += shx(s2, 2, lane); s2 += shx(s2, 4, lane); s2 += shx(s2, 8, lane);
        const float rstd = rsqrtf(s2 * (1.0f / 128.0f) + NORM_EPS);
#pragma unroll
        for (int nt = 0; nt < 8; ++nt) Qs[(i0 + jj) * RLDP + nt * 16 + c] = (bf16)f2bf((acco[nt][jj] - mu) * rstd * gnv[nt]);
    }
    LDS_WAIT(); asm volatile("" ::: "memory");
#pragma unroll
    for (int it = 0; it < 4; ++it) { const int id = lane + 64 * it, rr = wave * 16 + (id >> 4), ch = id & 15; const size_t row = (size_t)(r0 + rr);
        float yv[8], rg[8]; unpack8(*(const LAS v4u*)(Qs + rr * RLDP + ch * 8), yv); unpack8(*(const v4u*)(Z + row * DIN + ZC_RG + h * 128 + ch * 8), rg);
#pragma unroll
        for (int e = 0; e < 8; ++e) yv[e] *= rg[e] * sigmoidf_(rg[e]);
        v4u w; w.x = pk2(yv[0], yv[1]); w.y = pk2(yv[2], yv[3]); w.z = pk2(yv[4], yv[5]); w.w = pk2(yv[6], yv[7]);
        *(v4u*)(Y + row * 512 + h * 128 + ch * 8) = w; }
    __syncthreads();
}
constexpr int XLDP = 68;
constexpr int XWAVE_BYTES = 64 * XLDP * 4;
__device__ __forceinline__ float gelu_tanh(float x) { const float u = 0.7978845608028654f * (x + 0.044715f * x * x * x); const float th = 1.0f - 2.0f * __builtin_amdgcn_rcpf(1.0f + __expf(2.0f * u)); return 0.5f * x * (1.0f + th); }
__device__ __forceinline__ int lru_chain_pos(int d, int c64) { return d == 0 ? c64 : (c64 < 4 ? 3 - c64 : 71 - c64); }

struct LruFrag { bf16x8 ba[2], bx[2]; };
__device__ __forceinline__ LruFrag lru_frag_load(const unsigned char* ws, int l, int dir, int blk, int nt, int lane) {
    const int g = lane >> 4, c = lane & 15; LruFrag f;
    const bf16* wa = (const bf16*)(ws + (size_t)(l & 1) * WS_WSET + WS_LRUW) + (size_t)((0 * 2 + dir) * 8 + blk) * 4096 + (nt * 16 + c) * 64 + g * 8;
    const bf16* wx = (const bf16*)(ws + (size_t)(l & 1) * WS_WSET + WS_LRUW) + (size_t)((1 * 2 + dir) * 8 + blk) * 4096 + (nt * 16 + c) * 64 + g * 8;
#pragma unroll
    for (int ks = 0; ks < 2; ++ks) { f.ba[ks] = *(const bf16x8*)(wa + ks * 32); f.bx[ks] = *(const bf16x8*)(wx + ks * 32); }
    return f;
}
template <int DIR, bool FINAL>
__device__ __forceinline__ void lru_dir(const AH A, int l, int b, int c64, int blk, int nt, const bf16x8 (&af)[4][2], const float (&xv)[16], float (&hs)[16], int lane,
                                        const LruFrag& fr, float b_a, float b_x, float lam, float hin) {
    unsigned char* ws = A.ws();
    const int g = lane >> 4, c = lane & 15; const int ch = blk * 64 + nt * 16 + c;
    f32x4 accr[4], acci[4];
#pragma unroll
    for (int mt = 0; mt < 4; ++mt) { accr[mt] = (f32x4){0.f, 0.f, 0.f, 0.f}; acci[mt] = (f32x4){0.f, 0.f, 0.f, 0.f};
#pragma unroll
        for (int ks = 0; ks < 2; ++ks) { accr[mt] = __builtin_amdgcn_mfma_f32_16x16x32_bf16(af[mt][ks], fr.ba[ks], accr[mt], 0, 0, 0);
                                         acci[mt] = __builtin_amdgcn_mfma_f32_16x16x32_bf16(af[mt][ks], fr.bx[ks], acci[mt], 0, 0, 0); } }
    const float sp = fmaxf(-lam, 0.f) + log1pf(__expf(-fabsf(lam)));
    float a_[16], u_[16];
#pragma unroll
    for (int q = 0; q < 16; ++q) { const int mt = q >> 2, jj = q & 3;
        const float r = sigmoidf_(accr[mt][jj] + b_a), ii = sigmoidf_(acci[mt][jj] + b_x);
        const float la = -8.0f * r * sp; a_[q] = __expf(la);
        const float x2 = 2.0f * la;
        const float em = -x2 * (1.0f + x2 * (0.5f + x2 * (0.16666667f + x2 * (0.041666668f + x2 * (0.0083333338f + x2 * 0.0013888889f)))));
        u_[q] = __builtin_amdgcn_sqrtf(em) * (ii * xv[q]); }
    float P = 1.f, H = 0.f;
#pragma unroll
    for (int qi = 0; qi < 16; ++qi) { const int q = DIR ? 15 - qi : qi; H = a_[q] * H + u_[q]; P *= a_[q]; }
    float Pg[4], Hg[4];
#pragma unroll
    for (int k = 0; k < 4; ++k) { Pg[k] = shi(P, c + 16 * k); Hg[k] = shi(H, c + 16 * k); }
    if (!FINAL) {
        const int p = lru_chain_pos(DIR, c64);
        const size_t idx = ((size_t)((b * 2 + DIR) * 68 + p)) * 512 + ch;
        float Hc, Pc = (Pg[0] * Pg[1]) * (Pg[2] * Pg[3]);
        if (DIR == 0) Hc = ((Hg[0] * Pg[1] + Hg[1]) * Pg[2] + Hg[2]) * Pg[3] + Hg[3];
        else          Hc = ((Hg[3] * Pg[2] + Hg[2]) * Pg[1] + Hg[1]) * Pg[0] + Hg[0];
        if (g == 0) { float* S = (float*)(ws + WS_SUMM); S[idx * 2] = Pc; S[idx * 2 + 1] = Hc; }
    } else {
        float s0, s1, s2, s3;
        if (DIR == 0) { s0 = hin; s1 = s0 * Pg[0] + Hg[0]; s2 = s1 * Pg[1] + Hg[1]; s3 = s2 * Pg[2] + Hg[2]; }
        else          { s3 = hin; s2 = s3 * Pg[3] + Hg[3]; s1 = s2 * Pg[2] + Hg[2]; s0 = s1 * Pg[1] + Hg[1]; }
        float h = (g == 0) ? s0 : (g == 1) ? s1 : (g == 2) ? s2 : s3;
#pragma unroll
        for (int qi = 0; qi < 16; ++qi) { const int q = DIR ? 15 - qi : qi; h = a_[q] * h + u_[q]; hs[q] += h; }
    }
}
template <bool FINAL>
__device__ __forceinline__ void lru_task(const AH A, int l, int b, int c64, int blk, LAS unsigned char* lds, int wave, int lane, int half) {
    unsigned char* ws = A.ws(); const bf16* Z = (const bf16*)(ws + WS_Z);
    LAS float* xs = (LAS float*)(lds + wave * XWAVE_BYTES);
    const int r0 = b * SROW + c64 * 64;
    const int seq_lo = (c64 < 4) ? b * SROW : b * SROW + LCTX, seq_hi = (c64 < 4) ? b * SROW + LCTX : (b + 1) * SROW;
    const int g = lane >> 4, c = lane & 15;
    const int cgx = lane & 7, tg = lane >> 3, ch0 = blk * 64 + cgx * 8;
    v4u raw[11];
#pragma unroll
    for (int q = 0; q < 11; ++q) { const int row = r0 + tg * 8 - 1 + q;
        raw[q] = (row >= seq_lo && row < seq_hi) ? *(const v4u*)(Z + (size_t)row * DIN + ZC_LX + ch0) : (v4u){0u, 0u, 0u, 0u}; }
    f32x4 cwv[4][2], cbv[2];
#pragma unroll
    for (int e2 = 0; e2 < 2; ++e2) { cbv[e2] = *(const f32x4*)(A.in(I_CONVB) + l * 512 + ch0 + 4 * e2);
#pragma unroll
        for (int j = 0; j < 4; ++j) cwv[j][e2] = *(const f32x4*)(A.in(I_CONVW) + (l * 4 + j) * 512 + ch0 + 4 * e2); }
    float pba[2][2], pbx[2][2], plam[2][2], phin[2][2];
#pragma unroll
    for (int nti = 0; nti < 2; ++nti)
#pragma unroll
        for (int d = 0; d < 2; ++d) { const int ch = blk * 64 + (2 * half + nti) * 16 + c; const int pidx = (l * 2 + d) * 512 + ch;
            pba[nti][d] = A.in(I_LBA)[pidx]; pbx[nti][d] = A.in(I_LBX)[pidx]; plam[nti][d] = A.in(I_LAM)[pidx];
            phin[nti][d] = FINAL ? ((const float*)(ws + WS_HIN))[((size_t)((b * 2 + d) * 68 + lru_chain_pos(d, c64))) * 512 + ch] : 0.f; }
    LruFrag fcur = lru_frag_load(ws, l, 0, blk, 2 * half, lane);
    {
        float xw[4][8];
#pragma unroll
        for (int q = 0; q < 3; ++q) unpack8(raw[q], xw[q]);
#pragma unroll
        for (int tt = 0; tt < 8; ++tt) { unpack8(raw[tt + 3], xw[3]);
            float y[8];
#pragma unroll
            for (int e = 0; e < 8; ++e) { float sacc = cbv[e >> 2][e & 3];
#pragma unroll
                for (int j = 0; j < 4; ++j) sacc += cwv[j][e >> 2][e & 3] * xw[j][e];
                y[e] = sacc; }
            LAS f32x4* o = (LAS f32x4*)(xs + (tg * 8 + tt) * XLDP + cgx * 8);
            o[0] = (f32x4){y[0], y[1], y[2], y[3]}; o[1] = (f32x4){y[4], y[5], y[6], y[7]};
#pragma unroll
            for (int e = 0; e < 8; ++e) { xw[0][e] = xw[1][e]; xw[1][e] = xw[2][e]; xw[2][e] = xw[3][e]; } }
    }
    LDS_WAIT(); asm volatile("" ::: "memory");
    bf16x8 af[4][2];
    { const int m = lane & 15, gq = m >> 2, jq = m & 3, kq = (lane >> 4) * 8;
#pragma unroll
      for (int mt = 0; mt < 4; ++mt) { const int tok = 16 * gq + 4 * mt + jq;
#pragma unroll
          for (int ks = 0; ks < 2; ++ks) { const LAS f32x4* s = (const LAS f32x4*)(xs + tok * XLDP + ks * 32 + kq); const f32x4 v0 = s[0], v1 = s[1];
              v4u w; w.x = pk2(v0.x, v0.y); w.y = pk2(v0.z, v0.w); w.z = pk2(v1.x, v1.y); w.w = pk2(v1.z, v1.w); af[mt][ks] = __builtin_bit_cast(bf16x8, w); } } }
#pragma unroll
    for (int nti = 0; nti < 2; ++nti) { const int nt = 2 * half + nti;
        float xv[16], hs[16];
#pragma unroll
        for (int q = 0; q < 16; ++q) { xv[q] = xs[(16 * g + q) * XLDP + nt * 16 + c]; hs[q] = 0.f; }
        const LruFrag f1 = lru_frag_load(ws, l, 1, blk, nt, lane);
        lru_dir<0, FINAL>(A, l, b, c64, blk, nt, af, xv, hs, lane, fcur, pba[nti][0], pbx[nti][0], plam[nti][0], phin[nti][0]);
        if (nti == 0) fcur = lru_frag_load(ws, l, 0, blk, nt + 1, lane);
        lru_dir<1, FINAL>(A, l, b, c64, blk, nt, af, xv, hs, lane, f1, pba[nti][1], pbx[nti][1], plam[nti][1], phin[nti][1]);
        if (FINAL) {
#pragma unroll
            for (int q = 0; q < 16; ++q) xs[(16 * g + q) * XLDP + nt * 16 + c] = hs[q]; }
    }
    if (FINAL) {
        LDS_WAIT(); asm volatile("" ::: "memory");
        bf16* Y = (bf16*)(ws + WS_Y) + (size_t)MTOK * 512;
#pragma unroll
        for (int it = 0; it < 4; ++it) { const int id = lane + 64 * it, tok = id >> 2, chn = 4 * half + (id & 3); const size_t row = (size_t)(r0 + tok);
            const LAS f32x4* sp = (const LAS f32x4*)(xs + tok * XLDP + chn * 8); const f32x4 h0 = sp[0], h1 = sp[1];
            float lz[8]; unpack8(*(const v4u*)(Z + row * DIN + ZC_LZ + blk * 64 + chn * 8), lz);
            v4u w; w.x = pk2(gelu_tanh(lz[0]) * h0.x, gelu_tanh(lz[1]) * h0.y); w.y = pk2(gelu_tanh(lz[2]) * h0.z, gelu_tanh(lz[3]) * h0.w);
            w.z = pk2(gelu_tanh(lz[4]) * h1.x, gelu_tanh(lz[5]) * h1.y); w.w = pk2(gelu_tanh(lz[6]) * h1.z, gelu_tanh(lz[7]) * h1.w);
            *(v4u*)(Y + row * 512 + blk * 64 + chn * 8) = w; }
    }
    LDS_WAIT(); asm volatile("" ::: "memory");
}
__device__ __forceinline__ void lru_scan(const AH A, int tid, int G) {
    unsigned char* ws = A.ws(); const float* S = (const float*)(ws + WS_SUMM); float* HIN = (float*)(ws + WS_HIN);
    const int cpb = (4096 + G - 1) / G;
    for (int chain = blockIdx.x * cpb + tid; tid < cpb && chain < 4096; chain += 4096) { const int bd = chain >> 9, ch = chain & 511; float h = 0.f;
        typedef float f32x2s __attribute__((ext_vector_type(2)));
#pragma unroll 1
        for (int p0 = 0; p0 < 68; p0 += 17) { f32x2s ph_[17];
#pragma unroll
            for (int i = 0; i < 17; ++i) ph_[i] = *(const f32x2s*)(S + ((size_t)(bd * 68 + p0 + i) * 512 + ch) * 2);
#pragma unroll
            for (int i = 0; i < 17; ++i) { HIN[(size_t)(bd * 68 + p0 + i) * 512 + ch] = h; h = ph_[i].x * h + ph_[i].y; } } }
}

#define EN(k) (((MASK) >> (k)) & 1)
template <int MASK> __global__ void __launch_bounds__(NWAVES * 64, 2) fwd_kernel(Args args) {
    extern __shared__ __attribute__((aligned(16))) unsigned char lds_raw[];
    LAS unsigned char* lds0 = (LAS unsigned char*)lds_raw;
    cg::grid_group grid = cg::this_grid();
    { const unsigned* aw = (const unsigned*)&args; const int tid = threadIdx.x; if (tid < 54) ((LAS unsigned*)(lds0 + ARGS_LDS_OFF))[tid] = aw[tid];
      if (tid >= 64 && tid < 66) ((LAS unsigned*)(lds0 + ARGS_LDS_OFF + 256))[tid - 64] = 0u; }
    __syncthreads();
    XcdBarrier xbar = xcd_barrier_post((unsigned*)args.ws, (volatile LAS unsigned*)(lds0 + ARGS_LDS_OFF + 256), threadIdx.x == 0);
    const int ph_lo = args.ph_lo, ph_hi = args.ph_hi;
    const int wave0 = __builtin_amdgcn_readfirstlane((int)threadIdx.x >> 6);
#ifndef PROBE_MASK
#define PROBE_MASK 0
#endif
#ifndef PROBE_SUB
#define PROBE_SUB 0
#endif
#define SUBOFF(bit) (rep && ((PROBE_SUB) & (bit)))
#define PROBE_HIT(ph) ((PROBE_MASK) != 0 && ((ph) == 0 ? (((PROBE_MASK) >> 13) & 1) : (ph) == 53 ? (((PROBE_MASK) >> 14) & 1) : (((PROBE_MASK) >> (((ph) - 1) % 13)) & 1)))
    for (int ph2 = 2 * ph_lo; ph2 < 2 * ph_hi; ++ph2) {
        const int ph = ph2 >> 1, rep = ph2 & 1;
        if (rep && !PROBE_HIT(ph)) continue;
        if (ph2 != 2 * ph_lo) {
            if (ph_lo < 0) grid.sync();
            else { int mk2_ = -1; asm volatile("" : "+s"(mk2_)); const bool t0_ = (wave0 == 0) && (__builtin_amdgcn_mbcnt_hi(mk2_, __builtin_amdgcn_mbcnt_lo(mk2_, 0)) == 0); xcd_barrier(xbar, t0_); }
        }
#define PH_PROLOG int wv_ = wave0; int mk_ = -1; asm volatile("" : "+s"(wv_), "+s"(mk_)); int tid = wv_ * 64 + (int)__builtin_amdgcn_mbcnt_hi(mk_, __builtin_amdgcn_mbcnt_lo(mk_, 0)); int G = gridDim.x, bx = blockIdx.x; asm volatile("" : "+s"(G), "+s"(bx)); \
        unsigned ldsi = (unsigned)(unsigned long long)lds0; asm volatile("" : "+s"(ldsi)); LAS unsigned char* lds = (LAS unsigned char*)(unsigned long long)ldsi; \
        const AH AHv{(const LAS unsigned*)(lds + ARGS_LDS_OFF)}; const int lane = tid & 63, wave = wv_; \
        const int gw = bx * NWAVES + wave, NGW = G * NWAVES; (void)gw; (void)NGW; (void)lane; (void)wave; (void)G; (void)bx; (void)tid;
        if (EN(13) && ph == 0) { PH_PROLOG phase_p0(AHv, lds, tid, G); __syncthreads(); convert_layer(AHv, 0, 0, CV_NIT, lds, gw, NGW, wave, lane); }
        else if (EN(14) && ph == 53) { PH_PROLOG final_rows(AHv, gw, NGW, lane); }
        else {
            const int l = (ph - 1) / 13, k = (ph - 1) - l * 13; const bool last = (l == DEPTH - 1);
#define ws (AHv.ws())
#define HN ((bf16*)(ws + WS_HN))
#define Zb ((bf16*)(ws + WS_Z))
#define X ((float*)(ws + WS_X))
#define modbuf ((const float*)(ws + WS_MOD))
            if (EN(0) && k == 0) { PH_PROLOG norm_rows(AHv, l, 0, gw, NGW, lane, l > 0 ? 11 : 0, modbuf + (size_t)(l > 0 ? l - 1 : 0) * 5 * MODW + 4 * MODW + 2 * 3072 + 2048, 0.5f); }
            else if (EN(3) && k == 3) { PH_PROLOG norm_rows(AHv, l, 1, gw, NGW, lane, 11, modbuf + (size_t)l * 5 * MODW + 4 * MODW + 0 * 3072 + 2048, 0.5f); }
            else if (EN(10) && k == 10) { PH_PROLOG norm_rows(AHv, l, 2, gw, NGW, lane, last ? 0 : 4, modbuf + (size_t)l * 5 * MODW + 4 * MODW + 1 * 3072 + 2048, 1.0f); }
            else if (EN(1) && (k == 1 || k == 11)) { PH_PROLOG const int j = (k == 1) ? 0 : 1;
                pg8::Gemm gm{HN, (const bf16*)(ws + (size_t)(l & 1) * WS_WSET + WS_WFI) + (size_t)j * 5632 * 1024, MTOK, 5632, 1024};
                pg8::EpiSwiglu E{Zb};
                if (last && k == 11) { pg8::LastLayerOrder S; S.init(5632, G, bx, 0); pg8::gemm_phase<1024, pg8::EpiSwiglu, pg8::LastLayerOrder, true, true>(lds, gm, S, E, tid); }
                else { pg8::StaticOrder S; S.init(MTOK, 5632, G, bx); pg8::gemm_phase<1024, pg8::EpiSwiglu, pg8::StaticOrder, true, true>(lds, gm, S, E, tid); } }
            else if (EN(2) && (k == 2 || k == 12)) { PH_PROLOG const int j = (k == 2) ? 0 : 1, sub = (k == 2) ? 0 : 2;
                pg8::Gemm gm{Zb, (const bf16*)(ws + (size_t)(l & 1) * WS_WSET + WS_WFO) + (size_t)j * 1024 * DFF, MTOK, 1024, DFF};
                pg8::EpiResid E{X, modbuf + (size_t)l * 5 * MODW + sub * 3072 + 2048, rep ? 0.0f : 0.5f, (float*)(ws + WS_PARTC)};
                if (last && k == 12) { pg8::LatOrder S{G, bx}; pg8::gemm_phase<DFF, pg8::EpiResid, pg8::LatOrder, true, true>(lds, gm, S, E, tid); }
                else { pg8::SplitOrder S{G, bx, 11, 4}; pg8::gemm_phase<DFF, pg8::EpiResid, pg8::SplitOrder, true, true>(lds, gm, S, E, tid); } }
            else if (EN(4) && k == 4) { PH_PROLOG
                pg8::Gemm gm{HN, (const bf16*)(ws + (size_t)(l & 1) * WS_WSET + WS_WIN), MTOK, DIN, 1024};
                pg8::EpiZ E{Zb, DIN};
                if (last) { pg8::LastLayerOrder S; S.init(DIN, G, bx, 28); pg8::gemm_phase<1024, pg8::EpiZ, pg8::LastLayerOrder, true, true>(lds, gm, S, E, tid); }
                else { pg8::StaticOrder S; S.init(MTOK, DIN, G, bx); pg8::gemm_phase<1024, pg8::EpiZ, pg8::StaticOrder, true, true>(lds, gm, S, E, tid); } }
            else if (EN(5) && k == 5) { PH_PROLOG
                if (!SUBOFF(1)) prep_qk(AHv, l, gw, NGW, lane);
                if (!SUBOFF(2)) for (int it = bx; it < 544; it += G) ret_u_item(AHv, l, it, lds, tid, wave, lane);
                __syncthreads();
                if (!SUBOFF(4)) { PH_PROLOG
                    const int H = 2 * 272, n3 = (544 > 2 * G && 544 <= 3 * G) ? 544 - 2 * G : 0, nb = G - n3;
                    for (int hi = bx; hi < H; hi += (bx < n3) ? H : nb) { const int li = hi >> 1; lru_task<false>(AHv, l, li / 68, li % 68, wave, lds, wave, lane, hi & 1); } } }
            else if (EN(6) && k == 6) { PH_PROLOG
                for (int it = bx; it < 256; it += G) ret_scan_item(AHv, l, it, tid);
                lru_scan(AHv, tid, G);
                const int nunits = last ? 512 : 544;
                for (int i = 0;; ++i) { const int u = i * G + bx; if (u >= nunits) break;
                    long qrow0, kvrow0; int hq, kvh, NT;
                    if (u < 512) { const int combo = u & 7, j = u >> 3; const int b = combo >> 1; kvh = combo & 1; hq = kvh * 4 + (j & 3); const int qb = j >> 2;
                        qrow0 = (long)b * SROW + LCTX + qb * 256; kvrow0 = (long)b * SROW; NT = 68; }
                    else { const int v = u - 512; const int b = v >> 3; hq = v & 7; kvh = hq >> 2; qrow0 = (long)b * SROW; kvrow0 = qrow0; NT = 4; }
                    attn_body::attn_unit<8>(qrow0, kvrow0, hq, kvh, NT, (const attn_body::bf16*)(ws + WS_QN), (const attn_body::bf16*)(ws + WS_KN), (const attn_body::bf16*)(Zb + ZC_AV),
                                            (attn_body::bf16*)((bf16*)(ws + WS_Y) + (size_t)2 * MTOK * 512), (char*)lds, tid); } }
            else if ((EN(7) || EN(15)) && k == 7) { PH_PROLOG
                const int nret = last ? 512 : 544, nlru = last ? 256 : 272;
                if (EN(7) && !SUBOFF(8)) for (int it = bx; it < nret; it += G) { const int item = last ? ((it >> 5) * 34 + 2 + (it & 31)) : it; ret_out_item(AHv, l, item, lds, tid, wave, lane); }
                __syncthreads();
                if (EN(15) && !SUBOFF(16)) { PH_PROLOG
                    const int H = 2 * nlru, n3 = (nret > 2 * G && nret <= 3 * G) ? nret - 2 * G : 0, nb = G - n3;
                    for (int hi = bx; hi < H; hi += (bx < n3) ? H : nb) { const int li = hi >> 1; const int b = last ? (li >> 6) : (li / 68), c64 = last ? (4 + (li & 63)) : (li % 68);
                        lru_task<true>(AHv, l, b, c64, wave, lds, wave, lane, hi & 1); } } }
            else if (EN(8) && k == 8) { PH_PROLOG
                pg8::Gemm gm{(const bf16*)(ws + WS_Y), (const bf16*)(ws + (size_t)(l & 1) * WS_WSET + WS_WB), 3 * MTOK, 3 * 1024, 512}; pg8::MergeOrder S{G, bx, last ? 1 : 0};
                pg8::EpiMerge E{Zb, HN};
                pg8::gemm_phase<512, pg8::EpiMerge, pg8::MergeOrder, true, true>(lds, gm, S, E, tid);
                if (!last) {
                    const int nsec = (272 > G) ? ((272 - G < G) ? 272 - G : 0) : 0;
                    if (bx >= nsec) convert_layer(AHv, l + 1, 0, CV_NIT, lds, (bx - nsec) * NWAVES + wave, (G - nsec) * NWAVES, wave, lane); } }
            else if (EN(9) && k == 9) { PH_PROLOG
                pg8::Gemm gm{HN, (const bf16*)(ws + (size_t)(l & 1) * WS_WSET + WS_WO), MTOK, 1024, 1024};
                pg8::EpiResid E{X, modbuf + (size_t)l * 5 * MODW + 1 * 3072 + 2048, rep ? 0.0f : 1.0f, (float*)(ws + WS_PARTC)};
                if (last) { pg8::LatOrder S{G, bx}; pg8::gemm_phase<1024, pg8::EpiResid, pg8::LatOrder, true, true>(lds, gm, S, E, tid); }
                else { pg8::SplitOrder S{G, bx, 4, 4}; pg8::gemm_phase<1024, pg8::EpiResid, pg8::SplitOrder, true, true>(lds, gm, S, E, tid); } }
        }
#undef ws
#undef HN
#undef Zb
#undef X
#undef modbuf
    }
}

#ifndef MK_N_LAUNCHES
#define MK_N_LAUNCHES 1
#endif
#if MK_N_LAUNCHES == 1
#define FULLK fwd_kernel<0xffff>
#else
template <int MASK> static void launch_one(int grid, const Args& a, hipStream_t stream) {
    static bool init = false;
    if (!init) { (void)hipFuncSetAttribute((const void*)fwd_kernel<MASK>, hipFuncAttributeMaxDynamicSharedMemorySize, LDS_BYTES); init = true; }
    hipLaunchKernelGGL(fwd_kernel<MASK>, dim3(grid), dim3(NWAVES * 64), LDS_BYTES, stream, a);
}
#endif
extern "C" void kernel_launch(void* const* d_in, const int* in_sizes, int n_in, void* d_out, int out_size, void* d_ws, size_t ws_size, hipStream_t stream) {
    static int grid = 0;
    if (grid == 0) {
        if (n_in != 24 || ws_size < WS_END) { fprintf(stderr, "kernel_launch: unexpected n_in %d / ws %zu (need %zu)\n", n_in, ws_size, (size_t)WS_END); grid = -1; return; }
        int dev = 0, cus = 0;
        (void)hipGetDevice(&dev); (void)hipDeviceGetAttribute(&cus, hipDeviceAttributeMultiprocessorCount, dev);
#if MK_N_LAUNCHES == 1
        int per_cu = 0;
        (void)hipFuncSetAttribute((const void*)FULLK, hipFuncAttributeMaxDynamicSharedMemorySize, LDS_BYTES);
        if (hipOccupancyMaxActiveBlocksPerMultiprocessor(&per_cu, (const void*)FULLK, NWAVES * 64, LDS_BYTES) != hipSuccess || per_cu < 1) per_cu = 1;
        (void)hipGetLastError();
        grid = cus * per_cu;
#else
        grid = cus;
#endif
        if (grid <= 0) grid = 256;
    }
    if (grid < 0) return;
    (void)hipMemsetAsync(d_ws, 0, 16384, stream);
    Args a{};
    for (int i = 0; i < 24; ++i) a.in[i] = (const float*)d_in[i];
    a.out = (float*)d_out; a.ws = (unsigned char*)d_ws;
#if MK_N_LAUNCHES == 1
    a.ph_lo = 0; a.ph_hi = 54;
    void* params[] = {(void*)&a};
    hipError_t e = hipLaunchCooperativeKernel((const void*)FULLK, dim3(grid), dim3(NWAVES * 64), params, LDS_BYTES, stream);
    if (e != hipSuccess) fprintf(stderr, "cooperative launch failed: %s (grid %d)\n", hipGetErrorString(e), grid);
#else
    for (int ph = 0; ph < 54; ++ph) { a.ph_lo = ph; a.ph_hi = ph + 1;
        if (ph == 0) { launch_one<1 << 13>(grid, a, stream); continue; }
        if (ph == 53) { launch_one<1 << 14>(grid, a, stream); continue; }
        const int k = (ph - 1) % 13;
        switch (k) {
            case 0: launch_one<1 << 0>(grid, a, stream); break;
            case 1: case 11: launch_one<1 << 1>(grid, a, stream); break;
            case 2: case 12: launch_one<1 << 2>(grid, a, stream); break;
            case 3: launch_one<1 << 3>(grid, a, stream); break;
            case 4: launch_one<1 << 4>(grid, a, stream); break;
            case 5: launch_one<1 << 5>(grid, a, stream); break;
            case 6: launch_one<1 << 6>(grid, a, stream); break;
            case 7: launch_one<1 << 7>(grid, a, stream); launch_one<1 << 15>(grid, a, stream); break;
            case 8: launch_one<1 << 8>(grid, a, stream); break;
            case 9: launch_one<1 << 9>(grid, a, stream); break;
            case 10: launch_one<1 << 10>(grid, a, stream); break;
        }
    }
#endif
}
```

```cpp
#include <hip/hip_runtime.h>
#include <hip/hip_cooperative_groups.h>
#include <hip/hip_bf16.h>
#include <cstdio>
#include <cstdint>
#include <cmath>
namespace cg = cooperative_groups;
namespace pg8 {
#define PG8_LAS __attribute__((address_space(3)))
typedef unsigned short bf16_t;
typedef short bf16x8 __attribute__((ext_vector_type(8)));
typedef float f32x4 __attribute__((ext_vector_type(4)));
typedef unsigned u32x4 __attribute__((ext_vector_type(4)));
constexpr int BM = 256, BK = 64, HALF = 128, HTB = HALF * BK * 2  , STAGE_BYTES = 8 * HTB, NXCD = 8, WGM = 4;

__host__ __device__ __forceinline__ int lds_byte(int r, int c) { const int st = (r >> 4) * 2 + (c >> 5), rr = r & 15, cc = c & 31, ob = rr * 64 + cc * 2; return st * 1024 + (ob ^ (((ob >> 9) & 1) << 5)); }
__host__ __device__ __forceinline__ void stage_rc(int b, int& R, int& C) { const int st = b / 1024, sb = b % 1024, swz = sb ^ (((sb >> 9) & 1) << 5); R = (st >> 1) * 16 + swz / 64; C = (st & 1) * 32 + (swz % 64) / 2; }
__host__ __device__ __forceinline__ int perm32(int rho) { const int n = rho >> 4, i = rho & 15; return 8 * (i >> 2) + 4 * n + (i & 3); }

struct Unit { int pm, pn, k0, nk; };
struct Gemm { const bf16_t* A; const bf16_t* Bt; int M, N, K; };

struct StaticOrder {
    int nM, nN, nwg, G, c;
    __host__ __device__ void init(int M, int N, int G_, int c_) { nM = M / BM; nN = N / BM; nwg = nM * nN; G = G_; c = c_; }
    __host__ __device__ bool next(int i, Unit& u) const {
        const long L = (long)i * G + c; if (L >= nwg) return false;
        int wgid = (int)L; { const int q = nwg / NXCD, r = nwg % NXCD, xcd = wgid % NXCD, off = wgid / NXCD; wgid = (xcd < r ? xcd * (q + 1) : r * (q + 1) + (xcd - r) * q) + off; }
        const int nig = WGM * nN, gid = wgid / nig, fm = gid * WGM, gsz = (nM - fm) < WGM ? (nM - fm) : WGM;
        u.pm = fm + ((wgid % nig) % gsz); u.pn = (wgid % nig) / gsz; u.k0 = 0; u.nk = 0; return true;
    }
    __device__ __forceinline__ void a_ready(const Unit&) const {}
    __device__ __forceinline__ void done(const Unit&) const {}
};

typedef unsigned u32x2 __attribute__((ext_vector_type(2)));
__device__ __forceinline__ unsigned cvt_pk_bf16(float lo, float hi) { unsigned r; asm volatile("v_cvt_pk_bf16_f32 %0, %1, %2" : "=v"(r) : "v"(lo), "v"(hi)); return r; }
__device__ __forceinline__ float fast_sigmoid(float v) { return __builtin_amdgcn_rcpf(1.0f + __expf(-v)); }
__device__ __forceinline__ float bf_lo(unsigned w) { return __uint_as_float(w << 16); }
__device__ __forceinline__ float bf_hi(unsigned w) { return __uint_as_float(w & 0xffff0000u); }
struct EpiZ {
    static constexpr bool PERM = true, AFTER_DRAIN = false, CHAIN = false;
    bf16_t* O; int ldc;
    __device__ __forceinline__ void operator()(const f32x4 (&acc)[2][2][4][2], const Unit& u, int wr, int wc, int fr, int fq) const {
        const int row0 = u.pm * BM + wr * 64 + fr; const int col0 = u.pn * BM + wc * 32 + 8 * fq;
#pragma unroll
        for (int ai = 0; ai < 2; ++ai)
#pragma unroll
            for (int m = 0; m < 4; ++m) { bf16_t* rowp = O + (size_t)(row0 + ai * HALF + m * 16) * ldc + col0;
#pragma unroll
                for (int bj = 0; bj < 2; ++bj) { const f32x4 v0 = acc[ai][bj][m][0], v1 = acc[ai][bj][m][1];
                    u32x4 w; w.x = cvt_pk_bf16(v0[0], v0[1]); w.y = cvt_pk_bf16(v0[2], v0[3]); w.z = cvt_pk_bf16(v1[0], v1[1]); w.w = cvt_pk_bf16(v1[2], v1[3]);
                    *(u32x4*)(rowp + bj * HALF) = w; } }
    }
};
struct EpiSwiglu {
    static constexpr bool PERM = true, AFTER_DRAIN = false, CHAIN = false;
    bf16_t* O;
    __device__ __forceinline__ void operator()(const f32x4 (&acc)[2][2][4][2], const Unit& u, int wr, int wc, int fr, int fq) const {
        const int row0 = u.pm * BM + wr * 64 + fr; const int col0 = u.pn * HALF + wc * 32 + 8 * fq;
#pragma unroll
        for (int ai = 0; ai < 2; ++ai)
#pragma unroll
            for (int m = 0; m < 4; ++m) { bf16_t* rowp = O + (size_t)(row0 + ai * HALF + m * 16) * 2816 + col0;
                float h[8];
#pragma unroll
                for (int n = 0; n < 2; ++n)
#pragma unroll
                    for (int j = 0; j < 4; ++j) { const float a = acc[ai][0][m][n][j], b = acc[ai][1][m][n][j]; h[n * 4 + j] = a * fast_sigmoid(a) * b; }
                u32x4 w; w.x = cvt_pk_bf16(h[0], h[1]); w.y = cvt_pk_bf16(h[2], h[3]); w.z = cvt_pk_bf16(h[4], h[5]); w.w = cvt_pk_bf16(h[6], h[7]);
                *(u32x4*)rowp = w; }
    }
};
struct EpiResid {
    static constexpr bool PERM = false, AFTER_DRAIN = false, CHAIN = false;
    float* X; const float* gate; float scale; float* PARTC;
    __device__ __forceinline__ void operator()(const f32x4 (&acc)[2][2][4][2], const Unit& u, int wr, int wc, int fr, int fq) const {
        const int bb = u.pm / 17, mrow = (u.pm - bb * 17 == 0) ? 4 : bb;
        const int col0 = u.pn * BM + wc * 32 + 4 * fq;
        if (u.nk != 0) {
            const int sp = u.k0 / (u.nk * 64); float* base = PARTC + ((size_t)sp * 1024 + (size_t)bb * 256 + wr * 64 + fr) * 1024 + col0;
#pragma unroll
            for (int ai = 0; ai < 2; ++ai)
#pragma unroll
                for (int m = 0; m < 4; ++m)
#pragma unroll
                    for (int bj = 0; bj < 2; ++bj)
#pragma unroll
                        for (int n = 0; n < 2; ++n) *(f32x4*)(base + (size_t)(ai * HALF + m * 16) * 1024 + bj * HALF + n * 16) = acc[ai][bj][m][n];
            return; }
        const float* g = gate + (size_t)mrow * 9216;
        const int row0 = u.pm * BM + wr * 64 + fr;
        f32x4 gv[2][2];
#pragma unroll
        for (int bj = 0; bj < 2; ++bj)
#pragma unroll
            for (int n = 0; n < 2; ++n) gv[bj][n] = *(const f32x4*)(g + col0 + bj * HALF + n * 16) * scale;
#pragma unroll
        for (int ai = 0; ai < 2; ++ai)
#pragma unroll
            for (int m = 0; m < 4; ++m) { float* rowp = X + (size_t)(row0 + ai * HALF + m * 16) * 1024 + col0;
#pragma unroll
                for (int bj = 0; bj < 2; ++bj)
#pragma unroll
                    for (int n = 0; n < 2; ++n) { f32x4* p = (f32x4*)(rowp + bj * HALF + n * 16); *p = *p + gv[bj][n] * acc[ai][bj][m][n]; }
                asm volatile("" ::: "memory"); }
    }
};
struct EpiMerge {
    static constexpr bool PERM = false, AFTER_DRAIN = false, CHAIN = true;
    const bf16_t* Z; bf16_t* MG;
    __device__ __forceinline__ void operator()(const f32x4 (&acc)[2][2][4][2], const Unit& u, int wr, int wc, int fr, int fq) const {}
    __device__ __forceinline__ bool chain(f32x4 (&acc)[2][2][4][2], const Unit& u, int wr, int wc, int fr, int fq) const {
        const int n = u.pm / 68, pm = u.pm - n * 68, pn = u.pn & 3;
        const int row0 = pm * BM + wr * 64 + fr; const int col0 = pn * BM + wc * 32 + 4 * fq;
#pragma unroll
        for (int ai = 0; ai < 2; ++ai)
#pragma unroll
            for (int m = 0; m < 4; ++m) { const size_t row = (size_t)(row0 + ai * HALF + m * 16);
#pragma unroll
                for (int bj = 0; bj < 2; ++bj)
#pragma unroll
                    for (int nn = 0; nn < 2; ++nn) { const int col = col0 + bj * HALF + nn * 16;
                        const bf16_t* zp = Z + row * 6912 + 3840 + n * 1024 + col;
                        const u32x2 ga = *(const u32x2*)zp;
                        const float ea0 = 1.0f + __expf(-bf_lo(ga.x)), ea1 = 1.0f + __expf(-bf_hi(ga.x)), ea2 = 1.0f + __expf(-bf_lo(ga.y)), ea3 = 1.0f + __expf(-bf_hi(ga.y));
                        f32x4 sc;
                        if (n < 2) { const u32x2 gb = *(const u32x2*)(zp + 1024);
                            sc[0] = (1.0f + __expf(-bf_lo(gb.x))) * __builtin_amdgcn_rcpf(ea0); sc[1] = (1.0f + __expf(-bf_hi(gb.x))) * __builtin_amdgcn_rcpf(ea1);
                            sc[2] = (1.0f + __expf(-bf_lo(gb.y))) * __builtin_amdgcn_rcpf(ea2); sc[3] = (1.0f + __expf(-bf_hi(gb.y))) * __builtin_amdgcn_rcpf(ea3);
                            acc[ai][bj][m][nn] = acc[ai][bj][m][nn] * sc; }
                        else { sc[0] = __builtin_amdgcn_rcpf(ea0); sc[1] = __builtin_amdgcn_rcpf(ea1); sc[2] = __builtin_amdgcn_rcpf(ea2); sc[3] = __builtin_amdgcn_rcpf(ea3);
                            const f32x4 v = acc[ai][bj][m][nn] * sc; u32x2 w; w.x = cvt_pk_bf16(v[0], v[1]); w.y = cvt_pk_bf16(v[2], v[3]); *(u32x2*)(MG + row * 1024 + col) = w; } }
                asm volatile("" ::: "memory"); }
        return n < 2;
    }
};
struct MergeOrder {
    int G, c, latonly;
    __device__ bool next(int i, Unit& u) const {
        const int ti = i / 3, n = i - ti * 3; const int L = ti * G + c; if (L >= (latonly ? 256 : 272)) return false;
        const int t = L >> 2; const int pm = latonly ? ((t >> 4) * 17 + 1 + (t & 15)) : t;
        u.pm = n * 68 + pm; u.pn = n * 4 + (L & 3); u.k0 = 0; u.nk = 0; return true;
    }
    __device__ __forceinline__ void a_ready(const Unit&) const {}
    __device__ __forceinline__ void done(const Unit&) const {}
};
struct LastLayerOrder {
    StaticOrder so; int nextra;
    __device__ void init(int N, int G, int c, int nextra_) { so.init(64 * BM, N, G, c); nextra = nextra_; }
    __device__ bool next(int i, Unit& u) const {
        if (so.next(i, u)) { const int v = u.pm; u.pm = (v >> 4) * 17 + 1 + (v & 15); return true; }
        const int L = i * so.G + so.c - so.nwg; if (L < 0 || L >= nextra) return false;
        const int t = L / 7, q = L - t * 7; u.pm = t * 17; u.pn = (q < 4) ? 2 + q : (q < 6) ? 4 + q : 14; u.k0 = 0; u.nk = 0; return true;
    }
    __device__ __forceinline__ void a_ready(const Unit&) const {}
    __device__ __forceinline__ void done(const Unit&) const {}
};
struct LatOrder {
    int G, c;
    __device__ bool next(int i, Unit& u) const {
        const int L = i * G + c; if (L >= 256) return false;
        const int t = L >> 2; u.pm = (t >> 4) * 17 + 1 + (t & 15); u.pn = L & 3; u.k0 = 0; u.nk = 0; return true;
    }
    __device__ __forceinline__ void a_ready(const Unit&) const {}
    __device__ __forceinline__ void done(const Unit&) const {}
};
struct SplitOrder {
    int G, c, nsplit, nkt;
    __device__ bool next(int i, Unit& u) const {
        int L = i * G + c;
        if (L < 256) { const int t = L >> 2; u.pm = (t >> 4) * 17 + 1 + (t & 15); u.pn = L & 3; u.k0 = 0; u.nk = 0; return true; }
        L -= 256; if (L >= 16 * nsplit) return false;
        const int t = L / nsplit, s = L - t * nsplit;
        u.pm = (t >> 2) * 17; u.pn = t & 3; u.k0 = s * nkt * 64; u.nk = nkt; return true;
    }
    __device__ __forceinline__ void a_ready(const Unit&) const {}
    __device__ __forceinline__ void done(const Unit&) const {}
};
template <int KT, class Epi, class Sched, bool ALIGN_EPI = false, bool SP2 = false>
__device__ __forceinline__ void gemm_phase(PG8_LAS unsigned char* lds, const Gemm g, const Sched& S, const Epi& E, const int tid) {
    const int wid = __builtin_amdgcn_readfirstlane(tid >> 6), lane = tid & 63, wr = wid >> 2, wc = wid & 3, fr = lane & 15, fq = lane >> 4;
    constexpr int K = KT, nt = K / BK;
    unsigned voffA[2], voffB[2];
#pragma unroll
    for (int i = 0; i < 2; ++i) { int R, C; stage_rc(tid * 16 + i * 8192, R, C); const int Rb = Epi::PERM ? ((R & ~31) + perm32(R & 31)) : R;
        voffA[i] = (unsigned)(R * K + C) * 2u; voffB[i] = (unsigned)(Rb * K + C) * 2u; }
    const size_t kstep = (size_t)(BK * 2);
    const size_t hstep = (size_t)HALF * K * 2;
    const size_t tstep = 2 * hstep;
    const unsigned ldsw = (unsigned)wid * 1024u;
    const int aoff = lds_byte(wr * 64 + fr, fq * 8), boff = lds_byte(wc * 32 + fr, fq * 8);
#define PG8_SA(b, h) (((b) * 2 + (h)) * HTB)
#define PG8_SB(b, h) ((4 + (b) * 2 + (h)) * HTB)
#define PG8_STAGE(bufoff, gbase, voff) do { _Pragma("unroll") for (int _i = 0; _i < 2; ++_i) \
        __builtin_amdgcn_global_load_lds((const unsigned*)((const char*)(gbase) + (voff)[_i]), (PG8_LAS unsigned*)(lds + (bufoff) + ldsw + _i * 8192), 16, 0, 0); } while (0)
#define PG8_LDA(dst, b, h) do { _Pragma("unroll") for (int m = 0; m < 4; ++m) _Pragma("unroll") for (int k = 0; k < 2; ++k) dst[m][k] = *(const PG8_LAS bf16x8*)(lds + PG8_SA(b, h) + aoff + m * 2048 + k * 1024); } while (0)
#define PG8_LDB(dst, b, h) do { _Pragma("unroll") for (int n = 0; n < 2; ++n) _Pragma("unroll") for (int k = 0; k < 2; ++k) dst[n][k] = *(const PG8_LAS bf16x8*)(lds + PG8_SB(b, h) + boff + n * 2048 + k * 1024); } while (0)
#define PG8_MMA(ai, bj, At, Bt) do { __builtin_amdgcn_s_setprio(1); _Pragma("unroll") for (int m = 0; m < 4; ++m) _Pragma("unroll") for (int n = 0; n < 2; ++n) _Pragma("unroll") for (int k = 0; k < 2; ++k) \
        acc[ai][bj][m][n] = __builtin_amdgcn_mfma_f32_16x16x32_bf16(Bt[n][k], At[m][k], acc[ai][bj][m][n], 0, 0, 0); __builtin_amdgcn_s_setprio(0); } while (0)
#define PG8_WAIT_V(n) asm volatile("s_waitcnt vmcnt(" #n ")" ::: "memory")
#define PG8_WAIT_L(n) asm volatile("s_waitcnt lgkmcnt(" #n ")" ::: "memory")
#define PG8_BAR __builtin_amdgcn_s_barrier()
#define PG8_SCHED __builtin_amdgcn_sched_barrier(0)
    Unit cur{0, 0, 0, 0}, nxt{0, 0, 0, 0}; int ui = 0;
    if (!S.next(0, cur)) return;
    f32x4 acc[2][2][4][2];
#pragma unroll
    for (int a = 0; a < 2; ++a)
#pragma unroll
        for (int b = 0; b < 2; ++b)
#pragma unroll
            for (int m = 0; m < 4; ++m)
#pragma unroll
                for (int n = 0; n < 2; ++n) acc[a][b][m][n] = (f32x4){0.f, 0.f, 0.f, 0.f};
    bf16x8 At[4][2], B0[2][2], B1[2][2];
    const char* cA = (const char*)g.A + (size_t)cur.pm * tstep + (size_t)cur.k0 * 2; const char* cB = (const char*)g.Bt + (size_t)cur.pn * tstep + (size_t)cur.k0 * 2;
    S.a_ready(cur);
    if constexpr (SP2) {
        PG8_STAGE(PG8_SB(0, 0), cB, voffB); PG8_STAGE(PG8_SB(0, 1), cB + hstep, voffB); PG8_STAGE(PG8_SA(0, 0), cA, voffA); PG8_STAGE(PG8_SA(0, 1), cA + hstep, voffA);
        if (wr == 1) PG8_BAR;
        PG8_WAIT_V(2); PG8_BAR;
        PG8_STAGE(PG8_SB(1, 0), cB + kstep, voffB); PG8_STAGE(PG8_SA(1, 0), cA + kstep, voffA); PG8_STAGE(PG8_SB(1, 1), cB + hstep + kstep, voffB);
        PG8_WAIT_V(6); PG8_BAR;
    } else {
        PG8_STAGE(PG8_SB(0, 0), cB, voffB); PG8_STAGE(PG8_SA(0, 0), cA, voffA); PG8_STAGE(PG8_SB(0, 1), cB + hstep, voffB); PG8_STAGE(PG8_SA(0, 1), cA + hstep, voffA);
        if (wr == 1) PG8_BAR;
        PG8_WAIT_V(4); PG8_BAR;
        PG8_STAGE(PG8_SB(1, 0), cB + kstep, voffB); PG8_STAGE(PG8_SA(1, 0), cA + kstep, voffA); PG8_STAGE(PG8_SB(1, 1), cB + hstep + kstep, voffB);
        PG8_WAIT_V(6); PG8_BAR;
    }
    for (;;) {
        const bool has_next = S.next(ui + 1, nxt);
        const char* nA = has_next ? (const char*)g.A + (size_t)nxt.pm * tstep + (size_t)nxt.k0 * 2 : cA; const char* nB = has_next ? (const char*)g.Bt + (size_t)nxt.pn * tstep + (size_t)nxt.k0 * 2 : cB;
        const int ntu = cur.nk ? cur.nk : nt;
        for (int t = 0; t < ntu; t += 2) {
            const bool last = (t == ntu - 2);
            const char* a1 = cA + (size_t)(t + 1) * kstep;
            const char* a2 = last ? nA : cA + (size_t)(t + 2) * kstep; const char* b2 = last ? nB : cB + (size_t)(t + 2) * kstep;
            const char* a3 = a2 + kstep; const char* b3 = b2 + kstep;
            if (last && has_next) S.a_ready(nxt);
            if constexpr (SP2) {
            PG8_LDB(B0, 0, 0); PG8_LDB(B1, 0, 1); PG8_SCHED; PG8_LDA(At, 0, 0); PG8_STAGE(PG8_SA(1, 1), a1 + hstep, voffA);
            PG8_WAIT_V(8); PG8_WAIT_L(0); PG8_BAR; PG8_MMA(0, 0, At, B0); PG8_MMA(0, 1, At, B1); PG8_BAR; PG8_SCHED;
            PG8_LDA(At, 0, 1); PG8_STAGE(PG8_SB(0, 0), b2, voffB); PG8_STAGE(PG8_SB(0, 1), b2 + hstep, voffB); PG8_STAGE(PG8_SA(0, 0), a2, voffA);
            PG8_WAIT_V(8); PG8_WAIT_L(0); PG8_BAR; PG8_MMA(1, 0, At, B0); PG8_MMA(1, 1, At, B1); PG8_BAR; PG8_SCHED;
            PG8_LDB(B0, 1, 0); PG8_LDB(B1, 1, 1); PG8_SCHED; PG8_LDA(At, 1, 0); PG8_STAGE(PG8_SA(0, 1), a2 + hstep, voffA);
            PG8_WAIT_V(8); PG8_WAIT_L(0); PG8_BAR; PG8_MMA(0, 0, At, B0); PG8_MMA(0, 1, At, B1); PG8_BAR; PG8_SCHED;
            PG8_LDA(At, 1, 1); PG8_STAGE(PG8_SB(1, 0), b3, voffB); PG8_STAGE(PG8_SB(1, 1), b3 + hstep, voffB); PG8_STAGE(PG8_SA(1, 0), a3, voffA);
            PG8_WAIT_V(8); PG8_WAIT_L(0); PG8_BAR; PG8_MMA(1, 0, At, B0); PG8_MMA(1, 1, At, B1); PG8_BAR; PG8_SCHED;
            } else {
            PG8_LDB(B0, 0, 0); PG8_SCHED; PG8_LDA(At, 0, 0); PG8_STAGE(PG8_SA(1, 1), a1 + hstep, voffA);
            PG8_WAIT_L(8); PG8_BAR; PG8_WAIT_L(0); PG8_MMA(0, 0, At, B0); PG8_BAR; PG8_SCHED;
            PG8_LDB(B1, 0, 1); PG8_STAGE(PG8_SB(0, 0), b2, voffB);
            PG8_BAR; PG8_WAIT_L(0); PG8_MMA(0, 1, At, B1); PG8_BAR;
            PG8_LDA(At, 0, 1); PG8_STAGE(PG8_SA(0, 0), a2, voffA);
            PG8_BAR; PG8_WAIT_L(0); PG8_MMA(1, 0, At, B0); PG8_BAR; PG8_SCHED;
            PG8_STAGE(PG8_SB(0, 1), b2 + hstep, voffB);
            PG8_WAIT_V(6); PG8_BAR; PG8_MMA(1, 1, At, B1); PG8_BAR;
            PG8_LDB(B0, 1, 0); PG8_SCHED; PG8_LDA(At, 1, 0); PG8_STAGE(PG8_SA(0, 1), a2 + hstep, voffA);
            PG8_WAIT_L(8); PG8_BAR; PG8_WAIT_L(0); PG8_MMA(0, 0, At, B0); PG8_BAR; PG8_SCHED;
            PG8_LDB(B1, 1, 1); PG8_STAGE(PG8_SB(1, 0), b3, voffB);
            PG8_BAR; PG8_WAIT_L(0); PG8_MMA(0, 1, At, B1); PG8_BAR;
            PG8_LDA(At, 1, 1); PG8_STAGE(PG8_SA(1, 0), a3, voffA);
            PG8_BAR; PG8_WAIT_L(0); PG8_MMA(1, 0, At, B0); PG8_BAR; PG8_SCHED;
            PG8_STAGE(PG8_SB(1, 1), b3 + hstep, voffB);
            PG8_WAIT_V(6); PG8_BAR; PG8_MMA(1, 1, At, B1); PG8_BAR;
            }
        }
        if constexpr (ALIGN_EPI) { if (wr == 0) PG8_BAR; }
        bool keep_acc = false;
        if constexpr (!Epi::AFTER_DRAIN) { if constexpr (Epi::CHAIN) keep_acc = E.chain(acc, cur, wr, wc, fr, fq); else E(acc, cur, wr, wc, fr, fq); S.done(cur); }
        if (!has_next) break;
        if (!keep_acc) {
#pragma unroll
        for (int a = 0; a < 2; ++a)
#pragma unroll
            for (int b = 0; b < 2; ++b)
#pragma unroll
                for (int m = 0; m < 4; ++m)
#pragma unroll
                    for (int n = 0; n < 2; ++n) acc[a][b][m][n] = (f32x4){0.f, 0.f, 0.f, 0.f};
        }
        cur = nxt; cA = nA; cB = nB; ++ui;
        if constexpr (ALIGN_EPI) { if (wr == 1) PG8_BAR; }
    }
    PG8_WAIT_V(0);
    if constexpr (!ALIGN_EPI) { if (wr == 0) PG8_BAR; }
    PG8_BAR;
    if constexpr (Epi::AFTER_DRAIN) { E.fused(acc, cur, wr, wc, fr, fq, lds, wid, lane); S.done(cur); }
#undef PG8_SA
#undef PG8_SB
#undef PG8_STAGE
#undef PG8_LDA
#undef PG8_LDB
#undef PG8_MMA
#undef PG8_WAIT_V
#undef PG8_WAIT_L
#undef PG8_BAR
#undef PG8_SCHED
}
}
namespace attn_body {
using bf16=__hip_bfloat16;
using bf16x8=__attribute__((ext_vector_type(8)))short;
using s16x4=__attribute__((ext_vector_type(4)))short;
using f32x16=__attribute__((ext_vector_type(16)))float;
using u32x4=__attribute__((ext_vector_type(4)))unsigned;
constexpr int D=64,QP=512,KP=128,VP=6912,OP=512;
constexpr int NW=8,QBLK=32,QB=QBLK*NW,KVBLK=64;
__device__ __forceinline__ int crow(int r,int hi){return (r&3)+8*(r>>2)+4*hi;}
#define SBAR() __builtin_amdgcn_sched_barrier(0)
constexpr int NSLOT=3, SLOTB=8192;
constexpr int LDS_K=0, LDS_V=NSLOT*SLOTB, LDS_WS=2*NSLOT*SLOTB, LDS_OST=LDS_WS+NW*64*4, LDS_BYTES=LDS_OST+NW*4096;
constexpr float C2=0.125f*1.4426950408889634f;
__device__ __forceinline__ void glds16(const void*gsrc,unsigned lds_dst){unsigned keep;
  asm volatile("s_mov_b32 %0, m0\n\ts_mov_b32 m0, %2\n\ts_nop 0\n\tglobal_load_lds_dwordx4 %1, off\n\ts_mov_b32 m0, %0":"=&s"(keep):"v"(gsrc),"s"(lds_dst):"memory");}
__device__ __forceinline__ float max3f(float a,float b,float c){float r;asm("v_max3_f32 %0, %1, %2, %3":"=v"(r):"v"(a),"v"(b),"v"(c));return r;}
__device__ __forceinline__ float max2f(float a,float b){float r;asm("v_max_f32_e32 %0, %1, %2":"=v"(r):"v"(a),"v"(b));return r;}
__device__ __forceinline__ float fadd_s(float a,float b){float r;asm("v_add_f32_e32 %0, %1, %2":"=v"(r):"v"(a),"v"(b));return r;}
__device__ __forceinline__ float fsub_s(float a,float b){float r;asm("v_sub_f32_e32 %0, %1, %2":"=v"(r):"v"(a),"v"(b));return r;}
typedef float f32x2_t __attribute__((ext_vector_type(2))); typedef __bf16 bf16x2_t __attribute__((ext_vector_type(2)));
__device__ __forceinline__ unsigned cvtpk_s(float lo,float hi){f32x2_t v={lo,hi};bf16x2_t b=__builtin_convertvector(v,bf16x2_t);return __builtin_bit_cast(unsigned,b);}
#define WAIT_BAR(N) asm volatile("s_waitcnt vmcnt(" #N ") lgkmcnt(0)\n\ts_barrier":::"memory")

__device__ __forceinline__ void qkt(f32x16&p0,f32x16&p1,const char*Kslot,const bf16x8*qr,const f32x16&negm,int r32,int hi){
  const char*kb=Kslot+hi*1024+r32*16;
  #pragma unroll
  for(int d0=0;d0<4;++d0){
    const bf16x8 b0=*reinterpret_cast<const bf16x8*>(kb+d0*2048);
    const bf16x8 b1=*reinterpret_cast<const bf16x8*>(kb+d0*2048+512);
    if(d0==0){p0=__builtin_amdgcn_mfma_f32_32x32x16_bf16(b0,qr[0],negm,0,0,0);p1=__builtin_amdgcn_mfma_f32_32x32x16_bf16(b1,qr[0],negm,0,0,0);}
    else{p0=__builtin_amdgcn_mfma_f32_32x32x16_bf16(b0,qr[d0],p0,0,0,0);p1=__builtin_amdgcn_mfma_f32_32x32x16_bf16(b1,qr[d0],p1,0,0,0);}}
}
typedef __attribute__((address_space(3))) const char* lds_cptr;
typedef short v4i16_t __attribute__((ext_vector_type(4)));
__device__ __forceinline__ void kload8(bf16x8*kf,lds_cptr kp){
  kf[0]=*(const __attribute__((address_space(3))) bf16x8*)(kp);      kf[1]=*(const __attribute__((address_space(3))) bf16x8*)(kp+512);
  kf[2]=*(const __attribute__((address_space(3))) bf16x8*)(kp+2048); kf[3]=*(const __attribute__((address_space(3))) bf16x8*)(kp+2560);
  kf[4]=*(const __attribute__((address_space(3))) bf16x8*)(kp+4096); kf[5]=*(const __attribute__((address_space(3))) bf16x8*)(kp+4608);
  kf[6]=*(const __attribute__((address_space(3))) bf16x8*)(kp+6144); kf[7]=*(const __attribute__((address_space(3))) bf16x8*)(kp+6656);
}
__device__ __forceinline__ void kload2(bf16x8*kf,lds_cptr kp,int j){ kf[2*j]=*(const __attribute__((address_space(3))) bf16x8*)(kp+j*2048); kf[2*j+1]=*(const __attribute__((address_space(3))) bf16x8*)(kp+j*2048+512); }
__device__ __forceinline__ s16x4 vtr(lds_cptr p){ return __builtin_bit_cast(s16x4,__builtin_amdgcn_ds_read_tr16_b64_v4i16((__attribute__((address_space(3))) v4i16_t*)p)); }
__device__ __forceinline__ float rowmax(const f32x16&p0,const f32x16&p1){
  float a=max3f(p0[0],p0[1],p1[0]),b=max3f(p0[2],p0[3],p1[1]);a=max3f(a,p1[2],p1[3]);
  #pragma unroll
  for(int r=4;r<16;r+=4){a=max3f(a,p0[r],p0[r+1]);b=max3f(b,p0[r+2],p0[r+3]);a=max3f(a,p1[r],p1[r+1]);b=max3f(b,p1[r+2],p1[r+3]);}
  const float m=max2f(a,b);
  auto rr=__builtin_amdgcn_permlane32_swap(__float_as_uint(m),__float_as_uint(m),false,false);
  return max2f(__uint_as_float(rr[0]),__uint_as_float(rr[1]));
}
__device__ __forceinline__ void pv(f32x16*o,int vb,bf16x8 pa0,bf16x8 pa1,bf16x8 pa2,bf16x8 pa3){
  #pragma unroll
  for(int d0=0;d0<2;++d0){s16x4 lo[4],hi[4];
    #pragma unroll
    for(int ks=0;ks<4;++ks){
      asm volatile("ds_read_b64_tr_b16 %0,%1 offset:%c2":"=&v"(lo[ks]):"v"(vb),"i"(d0*4096+ks*1024):"memory");
      asm volatile("ds_read_b64_tr_b16 %0,%1 offset:%c2":"=&v"(hi[ks]):"v"(vb),"i"(d0*4096+ks*1024+512):"memory");}
    asm volatile("s_waitcnt lgkmcnt(0)":::"memory");SBAR();
    #define PK(k) (bf16x8){lo[k][0],lo[k][1],lo[k][2],lo[k][3],hi[k][0],hi[k][1],hi[k][2],hi[k][3]}
    o[d0]=__builtin_amdgcn_mfma_f32_32x32x16_bf16(pa0,PK(0),o[d0],0,0,0);
    o[d0]=__builtin_amdgcn_mfma_f32_32x32x16_bf16(pa1,PK(1),o[d0],0,0,0);
    o[d0]=__builtin_amdgcn_mfma_f32_32x32x16_bf16(pa2,PK(2),o[d0],0,0,0);
    o[d0]=__builtin_amdgcn_mfma_f32_32x32x16_bf16(pa3,PK(3),o[d0],0,0,0);
    #undef PK
  }
}

#ifndef ATTN_STORE16
#define ATTN_STORE16(p,v) (*(u32x4*)(p)=(v))
#endif
template<int THRL> __device__ __forceinline__ void attn_unit(long qrow0,long kvrow0,int hq,int kvh,int NT,const bf16*Q,const bf16*__restrict__ K,const bf16*__restrict__ V,bf16*O,char*shm,const int tid){
  const int lane=tid&63,r32=lane&31,hi=lane>>5; const int wid=__builtin_amdgcn_readfirstlane(tid>>6);
  const bf16*Qw=Q+(qrow0+wid*QBLK)*QP+hq*D;
  const bf16*Kh=K+kvrow0*KP+kvh*D,*Vh=V+kvrow0*VP+kvh*D;
  const unsigned lds0=(unsigned)(uintptr_t)shm;
  float*wsf=(float*)(shm+LDS_WS)+wid*64;
  const bf16*ksrc=Kh+(long)lane*KP+wid*8;
  const bf16*vsrc=Vh+(long)(16*(wid&3)+(lane>>2))*VP+(wid>>2)*32+(lane&3)*8;
  const unsigned kdst=lds0+LDS_K+wid*1024, vdst=lds0+LDS_V+wid*1024;
  #define DMA_K(t,slot) glds16(ksrc+(long)(t)*KVBLK*KP,(unsigned)__builtin_amdgcn_readfirstlane(kdst+(slot)))
  #define DMA_V(t,slot) glds16(vsrc+(long)(t)*KVBLK*VP,(unsigned)__builtin_amdgcn_readfirstlane(vdst+(slot)))
  const int vb0=(int)(lds0+LDS_V)+((lane>>4)&1)*32+(lane&3)*8+(4*hi+((lane&15)>>2))*64;
  const char*Kbase=shm+LDS_K; bf16x8 kf[8];
  const lds_cptr shm3=(lds_cptr)shm; const lds_cptr kp0=shm3+LDS_K+hi*1024+r32*16; const lds_cptr vp0=shm3+LDS_V+((lane>>4)&1)*32+(lane&3)*8+(4*hi+((lane&15)>>2))*64;
  DMA_K(0,0);DMA_V(0,0);DMA_K(1,SLOTB);
  bf16x8 qr[4];
  #pragma unroll
  for(int d0=0;d0<4;++d0)qr[d0]=*reinterpret_cast<const bf16x8*>(&Qw[(long)r32*QP+d0*16+hi*8]);
  float mhat=0.f,l_reg=0.f;float z0_=0.f;asm volatile("":"+v"(z0_));f32x16 o[2];f32x16 negm;
  #pragma unroll
  for(int r=0;r<16;++r){o[0][r]=z0_;o[1][r]=z0_;negm[r]=z0_;}
  asm volatile("":"+v"(negm));
  #define CMASK(P0,P1,t) do{}while(0)
  bool resc=false;
  #define START(P0,P1) do{ const float rm=rowmax(P0,P1); resc=false; \
    { const float dl=rm; mhat=fadd_s(mhat,dl); \
      _Pragma("unroll") for(int r=0;r<16;++r){P0[r]=fsub_s(P0[r],dl);P1[r]=fsub_s(P1[r],dl);} \
      _Pragma("unroll") for(int r=0;r<16;++r)negm[r]=-mhat; asm volatile("":"+v"(negm)); } \
    _Pragma("unroll") for(int r=0;r<16;++r)P0[r]=__builtin_amdgcn_exp2f(P0[r]); }while(0)
  #define RESC() do{ if(resc){ asm volatile("s_waitcnt lgkmcnt(0)":::"memory"); \
      _Pragma("unroll") for(int d_=0;d_<2;++d_) _Pragma("unroll") for(int r=0;r<16;++r)o[d_][r]*=wsf[crow(r,hi)]; } }while(0)
  f32x16 pA0,pA1,pB0,pB1;
  int sl_prev=0,sl_cur=0,sl_next=SLOTB;
  #define ROT() do{sl_prev=sl_cur;sl_cur=sl_next;sl_next=(sl_next==(NSLOT-1)*SLOTB)?0:sl_next+SLOTB;}while(0)
  DMA_K(2,2*SLOTB);
  WAIT_BAR(3);
  qkt(pA0,pA1,Kbase,qr,negm,r32,hi);asm volatile("s_nop 15\n\ts_nop 7":"+v"(pA0),"+v"(pA1));CMASK(pA0,pA1,0);
  START(pA0,pA1);
  _Pragma("unroll") for(int r=0;r<16;++r)pA1[r]=__builtin_amdgcn_exp2f(pA1[r]);
  WAIT_BAR(0);
  DMA_K(3,0);DMA_V(1,SLOTB);
  ROT();
  kload8(kf,kp0+sl_cur);
  WAIT_BAR(2);
  s16x4 vlo[8],vhi[8]; u32x4 pw0,pw1,pw2,pw3;
  #define PKW(P,B) cvtpk_s(P[B],P[B+1])
  #define PAF(k) __builtin_bit_cast(bf16x8,pw##k)
  #define VFR(i) (bf16x8){vlo[i][0],vlo[i][1],vlo[i][2],vlo[i][3],vhi[i][0],vhi[i][1],vhi[i][2],vhi[i][3]}
  #define PIN(x) asm volatile("":"+v"(x))
  #define MX3(a,b,c) __builtin_fmaxf(__builtin_fmaxf((a),(b)),(c))
  #define GAPA(MF,A0,A1,A2,A3,W0,W1,PW) do{ MF; sacc+=A0; sacc+=A1; sacc+=A2; sacc+=A3; PIN(sacc); W0; W1; PIN(PW); SBAR(); }while(0)
  #define EX(v) __builtin_amdgcn_exp2f(v)
  #define GAPB(MF,X,B) do{ MF; X[B]=EX(X[B]); X[B+1]=EX(X[B+1]); X[B+2]=EX(X[B+2]); X[B+3]=EX(X[B+3]); PIN(X); SBAR(); }while(0)
  #define VRD(i) do{ vlo[i]=vtr(vp_+(((i)>>2)*4096+((i)&3)*1024)); vhi[i]=vtr(vp_+(((i)>>2)*4096+((i)&3)*1024+512)); }while(0)
  #define KRD(G,j) do{ if(G){ kload2(kf,kp0+sl_next,j); SBAR(); } }while(0)
  #define STEP(C0,C1,P0,P1,t,GK,GV,GL) do{ SBAR(); \
    const lds_cptr vp_=vp0+sl_prev; \
    VRD(0); SBAR(); float sacc=(P0[0]+P0[1]); \
    GAPA(C0=__builtin_amdgcn_mfma_f32_32x32x16_bf16(kf[0],qr[0],negm,0,0,0), P0[2],P0[3],P0[4],P0[5],     pw0[0]=PKW(P0,0), pw0[1]=PKW(P0,2), pw0); \
    VRD(4); SBAR(); GAPA(C1=__builtin_amdgcn_mfma_f32_32x32x16_bf16(kf[1],qr[0],negm,0,0,0), P0[6],P0[7],P0[8],P0[9],     pw0[2]=PKW(P0,4), pw0[3]=PKW(P0,6), pw0); \
    VRD(1); SBAR(); GAPA(C0=__builtin_amdgcn_mfma_f32_32x32x16_bf16(kf[2],qr[1],C0,0,0,0),   P0[10],P0[11],P0[12],P0[13], pw1[0]=PKW(P0,8), pw1[1]=PKW(P0,10), pw1); \
    VRD(5); SBAR(); GAPA(C1=__builtin_amdgcn_mfma_f32_32x32x16_bf16(kf[3],qr[1],C1,0,0,0),   P0[14],P0[15],P1[0],P1[1],   pw1[2]=PKW(P0,12),pw1[3]=PKW(P0,14), pw1); \
    VRD(2); SBAR(); GAPA(C0=__builtin_amdgcn_mfma_f32_32x32x16_bf16(kf[4],qr[2],C0,0,0,0),   P1[2],P1[3],P1[4],P1[5],     pw2[0]=PKW(P1,0), pw2[1]=PKW(P1,2), pw2); \
    VRD(6); SBAR(); GAPA(C1=__builtin_amdgcn_mfma_f32_32x32x16_bf16(kf[5],qr[2],C1,0,0,0),   P1[6],P1[7],P1[8],P1[9],     pw2[2]=PKW(P1,4), pw2[3]=PKW(P1,6), pw2); \
    VRD(3); SBAR(); GAPA(C0=__builtin_amdgcn_mfma_f32_32x32x16_bf16(kf[6],qr[3],C0,0,0,0),   P1[10],P1[11],P1[12],P1[13], pw3[0]=PKW(P1,8), pw3[1]=PKW(P1,10), pw3); \
    VRD(7); SBAR(); GAPA(C1=__builtin_amdgcn_mfma_f32_32x32x16_bf16(kf[7],qr[3],C1,0,0,0),   P1[14],P1[15],0.f,0.f,       pw3[2]=PKW(P1,12),pw3[3]=PKW(P1,14), pw3); \
    l_reg+=sacc; \
    if(GK){DMA_K((t)+3,sl_cur);} if(GV){DMA_V((t)+1,sl_next);} \
    CMASK(C0,C1,t); \
    { float a=MX3(C0[0],C0[1],C1[0]),b=MX3(C0[2],C0[3],C1[1]); a=MX3(a,C1[2],C1[3]); \
      _Pragma("unroll") for(int r=4;r<16;r+=4){a=MX3(a,C0[r],C0[r+1]);b=MX3(b,C0[r+2],C0[r+3]);a=MX3(a,C1[r],C1[r+1]);b=MX3(b,C1[r+2],C1[r+3]);} \
      float rm=__builtin_fmaxf(a,b); { auto rr=__builtin_amdgcn_permlane32_swap(__float_as_uint(rm),__float_as_uint(rm),false,false); rm=__builtin_fmaxf(__uint_as_float(rr[0]),__uint_as_float(rr[1])); } \
      resc=false; \
      if(__builtin_expect(__any(rm>(float)THRL),0)){ const float dl=__builtin_fmaxf(rm,0.f); mhat+=dl; \
        _Pragma("unroll") for(int r=0;r<16;++r){C0[r]-=dl;C1[r]-=dl;} \
        _Pragma("unroll") for(int r=0;r<16;++r)negm[r]=-mhat; asm volatile("":"+v"(negm)); \
        const float f=__builtin_amdgcn_exp2f(-dl); l_reg*=f; if(hi==0)wsf[r32]=f; resc=true; } } \
    SBAR(); \
    GAPB(o[0]=__builtin_amdgcn_mfma_f32_32x32x16_bf16(PAF(0),VFR(0),o[0],0,0,0), C0,0); \
    GAPB(o[1]=__builtin_amdgcn_mfma_f32_32x32x16_bf16(PAF(0),VFR(4),o[1],0,0,0), C0,4); \
    KRD(GL,0); GAPB(o[0]=__builtin_amdgcn_mfma_f32_32x32x16_bf16(PAF(1),VFR(1),o[0],0,0,0), C0,8); \
    KRD(GL,1); GAPB(o[1]=__builtin_amdgcn_mfma_f32_32x32x16_bf16(PAF(1),VFR(5),o[1],0,0,0), C0,12); \
    KRD(GL,2); GAPB(o[0]=__builtin_amdgcn_mfma_f32_32x32x16_bf16(PAF(2),VFR(2),o[0],0,0,0), C1,0); \
    KRD(GL,3); GAPB(o[1]=__builtin_amdgcn_mfma_f32_32x32x16_bf16(PAF(2),VFR(6),o[1],0,0,0), C1,4); \
    GAPB(o[0]=__builtin_amdgcn_mfma_f32_32x32x16_bf16(PAF(3),VFR(3),o[0],0,0,0), C1,8); \
    GAPB(o[1]=__builtin_amdgcn_mfma_f32_32x32x16_bf16(PAF(3),VFR(7),o[1],0,0,0), C1,12); \
    }while(0)
  int t=1;
  #undef CMASK
  #define CMASK(P0,P1,t) do{}while(0)
  for(;t+5<NT;t+=2){
    STEP(pB0,pB1,pA0,pA1,t,true,true,true);     WAIT_BAR(2); RESC(); ROT();
    STEP(pA0,pA1,pB0,pB1,t+1,true,true,true);   WAIT_BAR(2); RESC(); ROT();
  }
  #undef CMASK
  #define CMASK(P0,P1,t) do{}while(0)
  #define ENDW(tt) do{ if((tt)+3<NT){WAIT_BAR(2);} else if((tt)+2<NT){WAIT_BAR(1);} else {WAIT_BAR(0);} }while(0)
  for(;t+1<NT;t+=2){
    STEP(pB0,pB1,pA0,pA1,t,(t+3<NT),(t+1<NT),(t+1<NT));       ENDW(t);   RESC(); ROT();
    STEP(pA0,pA1,pB0,pB1,t+1,(t+4<NT),(t+2<NT),(t+2<NT));     ENDW(t+1); RESC(); ROT();
  }
  STEP(pB0,pB1,pA0,pA1,NT-1,false,false,false); RESC();
  { float sacc=pB0[0]+pB0[1]; _Pragma("unroll") for(int r=2;r<16;++r)sacc+=pB0[r]; _Pragma("unroll") for(int r=0;r<16;++r)sacc+=pB1[r]; l_reg+=sacc;
    pw0=(u32x4){PKW(pB0,0),PKW(pB0,2),PKW(pB0,4),PKW(pB0,6)};pw1=(u32x4){PKW(pB0,8),PKW(pB0,10),PKW(pB0,12),PKW(pB0,14)};pw2=(u32x4){PKW(pB1,0),PKW(pB1,2),PKW(pB1,4),PKW(pB1,6)};pw3=(u32x4){PKW(pB1,8),PKW(pB1,10),PKW(pB1,12),PKW(pB1,14)};
    SBAR(); pv(o,vb0+sl_cur,PAF(0),PAF(1),PAF(2),PAF(3)); }
  #undef PKW
  #undef PAF
  #undef VFR
  #undef PIN
  #undef MX3
  #undef GAPA
  #undef GAPB
  #undef EX
  #undef VRD
  #undef KRD
  #undef STEP
  #undef ENDW
  {auto rr=__builtin_amdgcn_permlane32_swap(__float_as_uint(l_reg),__float_as_uint(l_reg),false,false);l_reg=__uint_as_float(rr[0])+__uint_as_float(rr[1]);}
  if(hi==0)wsf[32+r32]=l_reg;asm volatile("s_waitcnt lgkmcnt(0)":::"memory");
  float rli[16];
  #pragma unroll
  for(int r=0;r<16;++r)rli[r]=__builtin_amdgcn_rcpf(wsf[32+crow(r,hi)]);
  bf16*Ow=O+(qrow0+wid*QBLK)*OP+hq*D;
  { bf16*stg=(bf16*)(shm+LDS_OST)+wid*2048;
    #pragma unroll
    for(int r=0;r<16;++r){const int orow=crow(r,hi);
      #pragma unroll
      for(int d0=0;d0<2;++d0)stg[orow*64+d0*32+r32]=__float2bfloat16(o[d0][r]*rli[r]);}
    asm volatile("s_waitcnt lgkmcnt(0)":::"memory");
    #pragma unroll
    for(int i=0;i<4;++i){const int row=i*8+(lane>>3),ch=lane&7; const u32x4 v=*(const u32x4*)(stg+row*64+ch*8); ATTN_STORE16(Ow+(long)row*OP+ch*8,v);} }
  asm volatile("s_waitcnt lgkmcnt(0)\n\ts_barrier":::"memory");
  #undef DMA_K
  #undef DMA_V
  #undef CMASK
  #undef START
  #undef RESC
  #undef ROT
}
constexpr int ATTN_LDS_BYTES=LDS_BYTES;
#undef SBAR
#undef WAIT_BAR
}
#define LAS __attribute__((address_space(3)))
typedef unsigned short bf16;
typedef unsigned v4u __attribute__((ext_vector_type(4)));
typedef unsigned v2u __attribute__((ext_vector_type(2)));
typedef float f32x4 __attribute__((ext_vector_type(4)));
typedef short bf16x8 __attribute__((ext_vector_type(8)));
constexpr int NWAVES = 8;
constexpr int NB = 4, LAT = 4096, LCTX = 256, SROW = 4352, MTOK = 17408, DMODEL = 1024, DEPTH = 4, DFF = 2816, DIN = 6912, MODW = 9216;
constexpr int ZC_RQ = 0, ZC_RK = 512, ZC_RV = 1024, ZC_RG = 1536, ZC_LX = 2048, ZC_LZ = 2560, ZC_AQ = 3072, ZC_AK = 3584, ZC_AV = 3712, ZC_GT = 3840;
constexpr float NORM_EPS = 1e-6f;
constexpr size_t MiB = 1u << 20;
constexpr size_t WS_MOD = 1 * MiB, WS_ROPE = 2 * MiB, WS_SUMM = 3 * MiB, WS_HIN = 6 * MiB;
constexpr size_t WS_WSET = 54 * MiB;
constexpr size_t WS_WFI = 8 * MiB;
constexpr size_t WS_WFO = 30 * MiB;
constexpr size_t WS_WIN = 41 * MiB;
constexpr size_t WS_WB = 55 * MiB;
constexpr size_t WS_WO = 58 * MiB;
constexpr size_t WS_LRUW = 60 * MiB;
constexpr size_t WS_X = 116 * MiB;
constexpr size_t WS_HN = 184 * MiB;
constexpr size_t WS_Z = 218 * MiB;
constexpr size_t WS_QN = 448 * MiB;
constexpr size_t WS_KN = 465 * MiB;
constexpr size_t WS_Y = 470 * MiB;
constexpr size_t WS_U = 521 * MiB;
constexpr size_t WS_SIN = 589 * MiB;
constexpr size_t WS_PARTC = 624 * MiB;
constexpr size_t WS_END = 670 * MiB;
constexpr int LDS_BYTES = 147456;

__device__ __forceinline__ unsigned f2bf(float f) { unsigned u = __builtin_bit_cast(unsigned, f); return (u + 0x7fffu + ((u >> 16) & 1u)) >> 16; }
__device__ __forceinline__ unsigned pk2(float lo, float hi) { return f2bf(lo) | (f2bf(hi) << 16); }
__device__ __forceinline__ float bflo(unsigned w) { return __uint_as_float(w << 16); }
__device__ __forceinline__ float bfhi(unsigned w) { return __uint_as_float(w & 0xffff0000u); }
__device__ __forceinline__ float bf1(bf16 h) { return __uint_as_float(((unsigned)h) << 16); }
__device__ __forceinline__ void unpack8(const v4u w, float* f) { f[0] = bflo(w.x); f[1] = bfhi(w.x); f[2] = bflo(w.y); f[3] = bfhi(w.y); f[4] = bflo(w.z); f[5] = bfhi(w.z); f[6] = bflo(w.w); f[7] = bfhi(w.w); }
__device__ __forceinline__ float sigmoidf_(float v) { return __builtin_amdgcn_rcpf(1.0f + __expf(-v)); }
__device__ __forceinline__ float shx(float v, int m, int lane) { return __builtin_bit_cast(float, __builtin_amdgcn_ds_bpermute((lane ^ m) << 2, __builtin_bit_cast(int, v))); }
__device__ __forceinline__ float shi(float v, int src) { return __builtin_bit_cast(float, __builtin_amdgcn_ds_bpermute(src << 2, __builtin_bit_cast(int, v))); }
__device__ __forceinline__ float wave_sum(float v, int lane) {
#pragma unroll
    for (int o = 1; o < 64; o <<= 1) v += shx(v, o, lane);
    return v;
}
#define LDS_WAIT() asm volatile("s_waitcnt lgkmcnt(0)" ::: "memory")

struct Args { const float* in[24]; float* out; unsigned char* ws; int ph_lo, ph_hi; };
constexpr int ARGS_LDS_OFF = 139520;
struct AH { const LAS unsigned* w;
    __device__ __forceinline__ const float* in(int i) const { const unsigned lo = __builtin_amdgcn_readfirstlane(w[2 * i]), hi = __builtin_amdgcn_readfirstlane(w[2 * i + 1]); return (const float*)(((unsigned long long)hi << 32) | lo); }
    __device__ __forceinline__ float* out() const { const unsigned lo = __builtin_amdgcn_readfirstlane(w[48]), hi = __builtin_amdgcn_readfirstlane(w[49]); return (float*)(((unsigned long long)hi << 32) | lo); }
    __device__ __forceinline__ unsigned char* ws() const { const unsigned lo = __builtin_amdgcn_readfirstlane(w[50]), hi = __builtin_amdgcn_readfirstlane(w[51]); return (unsigned char*)(((unsigned long long)hi << 32) | lo); }
};
enum { I_X = 0, I_C, I_CTX, I_CCTX, I_WMOD, I_BMOD, I_NORMG, I_FFNIN, I_FFNOUT, I_WIN, I_RETLOGIT, I_RETG, I_CONVW, I_CONVB, I_LWA, I_LBA, I_LWX, I_LBX, I_LAM, I_QG, I_KG, I_WBR, I_WOUT, I_FG };

__device__ __forceinline__ void tr_item(const float* W, int N, int k0, int n0, bf16* WT, int K, int orow0, LAS float* scr, int lane) {
    const float* src = W + (size_t)k0 * N + n0 + lane;
#pragma unroll 1
    for (int i = 0; i < 64; i += 16) { float v[16];
#pragma unroll
        for (int r = 0; r < 16; ++r) v[r] = src[(size_t)(i + r) * N];
#pragma unroll
        for (int r = 0; r < 16; ++r) scr[(i + r) * 65 + lane] = v[r]; }
    LDS_WAIT(); asm volatile("" ::: "memory");
    const int c = lane & 7;
#pragma unroll
    for (int j = 0; j < 8; ++j) { const int n = (lane >> 3) + 8 * j; const LAS float* s = scr + (8 * c) * 65 + n;
        v4u o; o.x = pk2(s[0 * 65], s[1 * 65]); o.y = pk2(s[2 * 65], s[3 * 65]); o.z = pk2(s[4 * 65], s[5 * 65]); o.w = pk2(s[6 * 65], s[7 * 65]);
        *(v4u*)(WT + (size_t)(orow0 + n) * K + k0 + 8 * c) = o; }
    LDS_WAIT(); asm volatile("" ::: "memory");
}

__device__ __forceinline__ void phase_p0(const AH A, LAS unsigned char* lds, int tid, int G) {
    unsigned char* ws = A.ws();
    constexpr int NGEMV = 144;
    const int bx = blockIdx.x;
    if (bx < NGEMV || G <= NGEMV) {
        LAS float* sv = (LAS float*)lds;
        LAS float* red = sv + 5 * 1024;
        const float* c = A.in(I_C); const float* cctx = A.in(I_CCTX);
        for (int i = tid; i < 5 * 1024; i += 512) { const int r = i >> 10, k = i & 1023; const float v = (r < 4) ? c[r * 1024 + k] : cctx[k]; sv[i] = v / (1.0f + __expf(-v)); }
        __syncthreads();
        float* modbuf = (float*)(ws + WS_MOD);
        const float* wmod = A.in(I_WMOD); const float* bmod = A.in(I_BMOD);
        for (int item = bx; item < NGEMV; item += G) {
            const int l = item / 36, n0 = (item - l * 36) * 256, c4 = tid & 63, kg = tid >> 6;
            const f32x4* W = (const f32x4*)(wmod + (size_t)l * 1024 * MODW + n0) + c4;
            f32x4 acc[5];
#pragma unroll
            for (int r = 0; r < 5; ++r) acc[r] = (f32x4){0.f, 0.f, 0.f, 0.f};
#pragma unroll 8
            for (int k = kg * 128; k < kg * 128 + 128; ++k) { const f32x4 w = W[(size_t)k * (MODW / 4)];
#pragma unroll
                for (int r = 0; r < 5; ++r) acc[r] += w * sv[r * 1024 + k]; }
#pragma unroll
            for (int r = 0; r < 5; ++r) *(LAS f32x4*)(red + (kg * 5 + r) * 256 + c4 * 4) = acc[r];
            __syncthreads();
            for (int o = tid; o < 5 * 256; o += 512) { const int r = o >> 8, cc = o & 255; float s = 0.f;
#pragma unroll
                for (int q = 0; q < 8; ++q) s += red[(q * 5 + r) * 256 + cc];
                modbuf[(size_t)(l * 5 + r) * MODW + n0 + cc] = s + bmod[(size_t)l * MODW + n0 + cc]; }
            __syncthreads();
        }
    }
    if (bx >= NGEMV || G <= NGEMV) {
        const int wb = (G > NGEMV) ? bx - NGEMV : bx, nwb = (G > NGEMV) ? G - NGEMV : G;
        const f32x4* x4 = (const f32x4*)A.in(I_X); const f32x4* c4p = (const f32x4*)A.in(I_CTX); f32x4* X4 = (f32x4*)(ws + WS_X);
        const int total = MTOK * 256, stride = nwb * 512;
        for (int i = wb * 512 + tid; i < total; i += 4 * stride) { f32x4 v[4];
#pragma unroll
            for (int q = 0; q < 4; ++q) { const int ii = i + q * stride; if (ii < total) { const int row = ii >> 8, qq = ii & 255; const int b = row / SROW, s = row - b * SROW;
                v[q] = (s < LCTX) ? c4p[(size_t)(b * LCTX + s) * 256 + qq] : x4[(size_t)(b * LAT + s - LCTX) * 256 + qq]; } }
#pragma unroll
            for (int q = 0; q < 4; ++q) { const int ii = i + q * stride; if (ii < total) X4[ii] = v[q]; } }
        float* ra = (float*)(ws + WS_ROPE); float* rb = ra + 64 * 32 * 2;
        for (int i = wb * 512 + tid; i < 64 * 32 + 64 * 16; i += nwb * 512) {
            if (i < 64 * 32) { const int pos = i >> 5, f = i & 31; const float fr = powf(10000.0f, -(float)(2 * f) / 64.0f); const float ang = (float)pos * fr; ra[2 * i] = cosf(ang); ra[2 * i + 1] = sinf(ang); }
            else { const int j = i - 64 * 32; const int pos = j >> 4, f = j & 15; const float fr = powf(10000.0f, -(float)(2 * f) / 32.0f); const float ang = (float)pos * fr; rb[2 * j] = cosf(ang); rb[2 * j + 1] = sinf(ang); } }
    }
}

constexpr int CV_FI = 16 * 88, CV_FO = 44 * 16, CV_IN = 16 * 108, CV_BR = 8 * 16, CV_OUT = 16 * 16, CV_LRU = 32;
constexpr int CV_NIT = 2 * CV_FI + 2 * CV_FO + CV_IN + 3 * CV_BR + CV_OUT + CV_LRU;
__device__ __forceinline__ void convert_layer(const AH A, int l, int it_lo, int it_hi, LAS unsigned char* lds, int gw, int NGW, int wave, int lane) {
    unsigned char* ws = A.ws() + (size_t)(l & 1) * WS_WSET;
    LAS float* scr = (LAS float*)(lds + wave * 16640);
    for (int it = it_lo + gw; it < it_hi; it += NGW) {
        int r = it; bool done = false;
#pragma unroll
        for (int j = 0; j < 2; ++j) { if (!done) { if (r < CV_FI) { const int kb = r / 88, nb = r - kb * 88, n0 = nb * 64;
                const int orow0 = (n0 < DFF) ? ((n0 >> 7) * 256 + (n0 & 127)) : (((n0 - DFF) >> 7) * 256 + 128 + ((n0 - DFF) & 127));
                tr_item(A.in(I_FFNIN) + (size_t)(l * 2 + j) * 1024 * 5632, 5632, kb * 64, n0, (bf16*)(ws + WS_WFI) + (size_t)j * 5632 * 1024, 1024, orow0, scr, lane); done = true; } else r -= CV_FI; } }
#pragma unroll
        for (int j = 0; j < 2; ++j) { if (!done) { if (r < CV_FO) { const int kb = r >> 4, nb = r & 15;
                tr_item(A.in(I_FFNOUT) + (size_t)(l * 2 + j) * DFF * 1024, 1024, kb * 64, nb * 64, (bf16*)(ws + WS_WFO) + (size_t)j * 1024 * DFF, DFF, nb * 64, scr, lane); done = true; } else r -= CV_FO; } }
        if (!done) { if (r < CV_IN) { const int kb = r / 108, nb = r - kb * 108;
                tr_item(A.in(I_WIN) + (size_t)l * 1024 * DIN, DIN, kb * 64, nb * 64, (bf16*)(ws + WS_WIN), 1024, nb * 64, scr, lane); done = true; } else r -= CV_IN; }
#pragma unroll
        for (int n = 0; n < 3; ++n) { if (!done) { if (r < CV_BR) { const int kb = r >> 4, nb = r & 15;
                tr_item(A.in(I_WBR) + (size_t)(l * 3 + n) * 512 * 1024, 1024, kb * 64, nb * 64, (bf16*)(ws + WS_WB) + (size_t)n * 1024 * 512, 512, nb * 64, scr, lane); done = true; } else r -= CV_BR; } }
        if (!done) { if (r < CV_OUT) { const int kb = r >> 4, nb = r & 15;
                tr_item(A.in(I_WOUT) + (size_t)l * 1024 * 1024, 1024, kb * 64, nb * 64, (bf16*)(ws + WS_WO), 1024, nb * 64, scr, lane); done = true; } else r -= CV_OUT; }
        if (!done) { const int mat = r; const int g = mat >> 4, d = (mat >> 3) & 1, blk = mat & 7;
                const float* src = (g ? A.in(I_LWX) : A.in(I_LWA)) + (size_t)((l * 2 + d) * 8 + blk) * 4096;
                tr_item(src, 64, 0, 0, (bf16*)(ws + WS_LRUW) + (size_t)mat * 4096, 64, 0, scr, lane); }
    }
}

__device__ __forceinline__ void norm_rows(const AH A, int l, int sub, int gw, int NGW, int lane, int pend_ns, const float* pend_gate, float pend_scale) {
    unsigned char* ws = A.ws();
    const float* X = (const float*)(ws + WS_X); bf16* HN = (bf16*)(ws + WS_HN);
    const float* g = A.in(I_NORMG) + (size_t)(l * 3 + sub) * 1024;
    const float* modl = (const float*)(ws + WS_MOD) + (size_t)l * 5 * MODW + sub * 3072;
    f32x4 gv[4];
#pragma unroll
    for (int j = 0; j < 4; ++j) gv[j] = ((const f32x4*)g)[lane + 64 * j];
    f32x4 nx[4];
    if (gw < MTOK) {
#pragma unroll
        for (int j = 0; j < 4; ++j) nx[j] = ((const f32x4*)(X + (size_t)gw * 1024))[lane + 64 * j]; }
    for (int row = gw; row < MTOK; row += NGW) {
        const int b = row / SROW, s = row - b * SROW; const int mr = (s < LCTX) ? 4 : b;
        const f32x4* sh = (const f32x4*)(modl + (size_t)mr * MODW); const f32x4* sc = (const f32x4*)(modl + (size_t)mr * MODW + 1024);
        f32x4 v[4]; float ss = 0.f;
#pragma unroll
        for (int j = 0; j < 4; ++j) v[j] = nx[j];
        if (row + NGW < MTOK) {
#pragma unroll
            for (int j = 0; j < 4; ++j) nx[j] = ((const f32x4*)(X + (size_t)(row + NGW) * 1024))[lane + 64 * j]; }
        f32x4 scv[4], shv[4];
#pragma unroll
        for (int j = 0; j < 4; ++j) { scv[j] = sc[lane + 64 * j]; shv[j] = sh[lane + 64 * j]; }
        if (pend_ns > 0 && s < LCTX) {
            const f32x4* pc = (const f32x4*)((const float*)(ws + WS_PARTC) + (size_t)(b * LCTX + s) * 1024); const f32x4* pg = (const f32x4*)pend_gate;
            f32x4 a4[4] = {(f32x4){0.f, 0.f, 0.f, 0.f}, (f32x4){0.f, 0.f, 0.f, 0.f}, (f32x4){0.f, 0.f, 0.f, 0.f}, (f32x4){0.f, 0.f, 0.f, 0.f}};
            for (int sp = 0; sp < pend_ns; ++sp) {
#pragma unroll
                for (int j = 0; j < 4; ++j) a4[j] += pc[(size_t)sp * 262144 + lane + 64 * j]; }
            f32x4* xw = (f32x4*)(ws + WS_X) + (size_t)row * 256;
#pragma unroll
            for (int j = 0; j < 4; ++j) { v[j] += (pg[lane + 64 * j] * pend_scale) * a4[j]; xw[lane + 64 * j] = v[j]; }
        }
#pragma unroll
        for (int j = 0; j < 4; ++j) ss += (v[j].x * v[j].x + v[j].y * v[j].y) + (v[j].z * v[j].z + v[j].w * v[j].w);
        const float rstd = rsqrtf(wave_sum(ss, lane) * (1.0f / 1024.0f) + NORM_EPS);
        v2u* o = (v2u*)(HN + (size_t)row * 1024);
#pragma unroll
        for (int j = 0; j < 4; ++j) { const f32x4 y = (v[j] * rstd) * gv[j] * (scv[j] + 1.0f) + shv[j];
            v2u w; w.x = pk2(y.x, y.y); w.y = pk2(y.z, y.w); o[lane + 64 * j] = w; }
    }
}
__device__ __forceinline__ void final_rows(const AH A, int gw, int NGW, int lane) {
    const float* X = (const float*)(A.ws() + WS_X); const float* g = A.in(I_FG);
    f32x4 gv[4];
#pragma unroll
    for (int j = 0; j < 4; ++j) gv[j] = ((const f32x4*)g)[lane + 64 * j];
    f32x4 nx[4];
    if (gw < NB * LAT) { const int b = gw >> 12, t = gw & 4095;
#pragma unroll
        for (int j = 0; j < 4; ++j) nx[j] = ((const f32x4*)(X + (size_t)(b * SROW + LCTX + t) * 1024))[lane + 64 * j]; }
    for (int r = gw; r < NB * LAT; r += NGW) {
        f32x4 v[4]; float ss = 0.f;
#pragma unroll
        for (int j = 0; j < 4; ++j) v[j] = nx[j];
        if (r + NGW < NB * LAT) { const int r2 = r + NGW, b = r2 >> 12, t = r2 & 4095;
#pragma unroll
            for (int j = 0; j < 4; ++j) nx[j] = ((const f32x4*)(X + (size_t)(b * SROW + LCTX + t) * 1024))[lane + 64 * j]; }
#pragma unroll
        for (int j = 0; j < 4; ++j) ss += (v[j].x * v[j].x + v[j].y * v[j].y) + (v[j].z * v[j].z + v[j].w * v[j].w);
        const float rstd = rsqrtf(wave_sum(ss, lane) * (1.0f / 1024.0f) + NORM_EPS);
        f32x4* o = (f32x4*)(A.out() + (size_t)r * 1024);
#pragma unroll
        for (int j = 0; j < 4; ++j) o[lane + 64 * j] = (v[j] * rstd) * gv[j];
    }
}
#define XB_TMO      128
#define XB_XCNT(j)  (256  + 64 * (j))
#define XB_XSUB(j)  (1280 + 64 * (j))
#define XB_XGEN(j)  (2304 + 64 * (j))
#define XB_TOP      3328
#define XB_TOPGEN   3392
#define XCD_BAR_WORDS 3456
#define XB_SPIN_CAP (1u << 22)

__device__ __forceinline__ unsigned xb_ld(unsigned* p)              { return __hip_atomic_load(p, __ATOMIC_RELAXED, __HIP_MEMORY_SCOPE_AGENT); }
__device__ __forceinline__ unsigned xb_add(unsigned* p, unsigned v) { return __hip_atomic_fetch_add(p, v, __ATOMIC_RELAXED, __HIP_MEMORY_SCOPE_AGENT); }
__device__ __forceinline__ unsigned xb_xcc_id() { return (unsigned)__builtin_amdgcn_s_getreg((3 << 11) | 20) & 0xFu; }
#define XB_SPIN(cond, bar) do { unsigned _sp = 0; while (cond) { __builtin_amdgcn_s_sleep(1); \
    if ((++_sp & 255u) == 0u) { if (xb_ld(&(bar)[XB_TMO])) break; if (_sp > XB_SPIN_CAP) { atomicAdd(&(bar)[XB_TMO], 1u); break; } } } } while (0)

struct XcdBarrier {
    unsigned* bar; unsigned x;
    volatile LAS unsigned* st;
};

__device__ __forceinline__ XcdBarrier xcd_barrier_post(unsigned* bar, volatile LAS unsigned* st, bool t0) {
    XcdBarrier b; b.bar = bar; b.x = xb_xcc_id(); b.st = st;
    if (t0) (void)xb_add(&bar[XB_XCNT(b.x)], 1u);
    return b;
}
__device__ __forceinline__ void xcd_barrier_complete(unsigned* bar, unsigned x, unsigned& nloc, unsigned& nx) {
    const unsigned G = gridDim.x * gridDim.y * gridDim.z;
    unsigned sum, cnt, mine, sp = 0u;
    for (;;) {
        sum = 0u; cnt = 0u; mine = 0u;
#pragma unroll
        for (unsigned j = 0; j < 16; ++j) { const unsigned c = xb_ld(&bar[XB_XCNT(j)]); sum += c; cnt += (c > 0u) ? 1u : 0u; mine = (j == x) ? c : mine; }
        if (sum == G) break;
        __builtin_amdgcn_s_sleep(1);
        if ((++sp & 255u) == 0u) { if (xb_ld(&bar[XB_TMO])) break; if (sp > XB_SPIN_CAP) { atomicAdd(&bar[XB_TMO], 1u); break; } }
    }
    nloc = mine > 0u ? mine : 1u; nx = cnt > 0u ? cnt : 1u;
}

__device__ __forceinline__ void xcd_barrier(const XcdBarrier& b, bool t0) {
    asm volatile("s_waitcnt vmcnt(0)" ::: "memory");
    __syncthreads();
    if (t0) {
        unsigned* bar = b.bar;
        __builtin_amdgcn_s_waitcnt(0);
        unsigned nloc = b.st[0], nx = b.st[1];
        if (nloc == 0u) { xcd_barrier_complete(bar, b.x, nloc, nx); b.st[0] = nloc; b.st[1] = nx; }
        const unsigned old = xb_add(&bar[XB_XSUB(b.x)], 1u);
        const unsigned gen = old / nloc;
        if (old + 1u == (gen + 1u) * nloc) {
            __builtin_amdgcn_fence(__ATOMIC_RELEASE, "agent");
            asm volatile("s_waitcnt vmcnt(0)" ::: "memory");
            const unsigned og = xb_add(&bar[XB_TOP], 1u);
            const unsigned tg = og / nx;
            if (og + 1u == (tg + 1u) * nx) xb_add(&bar[XB_TOPGEN], 1u);
            else XB_SPIN(xb_ld(&bar[XB_TOPGEN]) == tg, bar);
            __builtin_amdgcn_fence(__ATOMIC_ACQUIRE, "agent");
            xb_add(&bar[XB_XGEN(b.x)], 1u);
            asm volatile("s_waitcnt vmcnt(0)" ::: "memory");
        } else {
            XB_SPIN(xb_ld(&bar[XB_XGEN(b.x)]) == gen, bar);
            __builtin_amdgcn_fence(__ATOMIC_ACQUIRE, "agent");
            asm volatile("s_waitcnt vmcnt(0)" ::: "memory");
        }
    }
    __syncthreads();
}
__device__ __forceinline__ void prep_qk(const AH A, int l, int gw, int NGW, int lane) {
    unsigned char* ws = A.ws();
    const bf16* Z = (const bf16*)(ws + WS_Z); bf16* QN = (bf16*)(ws + WS_QN); bf16* KN = (bf16*)(ws + WS_KN);
    const float* rb = (const float*)(ws + WS_ROPE) + 64 * 32 * 2;
    const int e0 = (lane & 7) * 8, hq = lane >> 3;
    float gq[8], gk[8];
#pragma unroll
    for (int j = 0; j < 8; ++j) { gq[j] = A.in(I_QG)[l * 64 + e0 + j]; gk[j] = A.in(I_KG)[l * 64 + e0 + j]; }
    constexpr float C2 = 0.125f * 1.4426950408889634f;
    for (int row = gw; row < MTOK; row += NGW) {
        const int b = row / SROW, s = row - b * SROW; const bool lat = s >= LCTX; const int t = s - LCTX;
        const int pos = (lane & 4) ? (t & 63) : (t >> 6);
#pragma unroll
        for (int pass = 0; pass < 2; ++pass) {
            const bf16* src = Z + (size_t)row * DIN + (pass == 0 ? ZC_AQ : ZC_AK) + hq * 64 + e0;
            float f[8]; unpack8(*(const v4u*)src, f);
            float ss = 0.f;
#pragma unroll
            for (int j = 0; j < 8; ++j) ss += f[j] * f[j];
            ss += shx(ss, 1, lane); ss += shx(ss, 2, lane); ss += shx(ss, 4, lane);
            const float rstd = rsqrtf(ss * (1.0f / 64.0f) + NORM_EPS);
            float y[8], o[8];
#pragma unroll
            for (int j = 0; j < 8; ++j) y[j] = f[j] * rstd * (pass == 0 ? gq[j] : gk[j]);
#pragma unroll
            for (int j = 0; j < 8; ++j) { const float p = shx(y[j], 2, lane);
                if (lat) { const int fi = (lane & 1) * 8 + j; const float cs = rb[(pos * 16 + fi) * 2], sn = rb[(pos * 16 + fi) * 2 + 1];
                    o[j] = ((lane & 2) == 0) ? (y[j] * cs - p * sn) : (p * sn + y[j] * cs); }
                else o[j] = y[j];
                if (pass == 0) o[j] *= C2; }
            v4u w; w.x = pk2(o[0], o[1]); w.y = pk2(o[2], o[3]); w.z = pk2(o[4], o[5]); w.w = pk2(o[6], o[7]);
            if (pass == 0) *(v4u*)(QN + (size_t)row * 512 + hq * 64 + e0) = w;
            else if (lane < 16) *(v4u*)(KN + (size_t)row * 128 + hq * 64 + e0) = w;
        }
    }
}

constexpr int RLDP = 136;
constexpr int RBUF = 128 * RLDP * 2;
__device__ __forceinline__ float log_sigmoid_f(float x) { return (x < 0.f ? x : 0.f) - log1pf(__expf(-fabsf(x))); }
template <bool TRANSPOSED, bool ROPE>
__device__ __forceinline__ void ret_stage_pair(const bf16* Z, int r0, int zc, int h, bool lat, int t0, const float* ra, float scl, float lgdec, int decmode  , LAS bf16* dst, int tid) {
#pragma unroll
    for (int it = 0; it < 2; ++it) { const int task = tid + 512 * it; const int j = task & 127, pr = task >> 7; const int c = (pr & 3) + (pr >> 2) * 8;
        const bf16* p = Z + (size_t)(r0 + j) * DIN + zc + h * 128;
        float a[8], bq[8]; unpack8(*(const v4u*)(p + 8 * c), a); unpack8(*(const v4u*)(p + 8 * (c + 4)), bq);
        float sc = scl; if (decmode == 1) sc *= __expf(lgdec * (float)(127 - j)); else if (decmode == 2) sc *= __expf(lgdec * (float)j);
        if (ROPE && lat) { const int t = t0 + j; const int pos = (c < 8) ? (t >> 6) : (t & 63);
#pragma unroll
            for (int e = 0; e < 8; ++e) { const int fi = (c & 3) * 8 + e; const float cs = ra[(pos * 32 + fi) * 2], sn = ra[(pos * 32 + fi) * 2 + 1];
                const float x1 = a[e], x2 = bq[e]; a[e] = x1 * cs - x2 * sn; bq[e] = x1 * sn + x2 * cs; } }
        if (TRANSPOSED) {
#pragma unroll
            for (int e = 0; e < 8; ++e) { dst[(8 * c + e) * RLDP + j] = (bf16)f2bf(a[e] * sc); dst[(8 * (c + 4) + e) * RLDP + j] = (bf16)f2bf(bq[e] * sc); }
        } else {
            v4u w; w.x = pk2(a[0] * sc, a[1] * sc); w.y = pk2(a[2] * sc, a[3] * sc); w.z = pk2(a[4] * sc, a[5] * sc); w.w = pk2(a[6] * sc, a[7] * sc);
            *(LAS v4u*)(dst + j * RLDP + 8 * c) = w;
            w.x = pk2(bq[0] * sc, bq[1] * sc); w.y = pk2(bq[2] * sc, bq[3] * sc); w.z = pk2(bq[4] * sc, bq[5] * sc); w.w = pk2(bq[6] * sc, bq[7] * sc);
            *(LAS v4u*)(dst + j * RLDP + 8 * (c + 4)) = w;
        } }
}
__device__ __forceinline__ void wave_mm(f32x4 (&acc)[8], const LAS bf16* Am, int row0, const LAS bf16* Bm, int lane) {
    const int r = lane & 15, g = lane >> 4;
#pragma unroll
    for (int ks = 0; ks < 4; ++ks) { const bf16x8 a = *(const LAS bf16x8*)(Am + (row0 + r) * RLDP + ks * 32 + g * 8);
#pragma unroll
        for (int nt = 0; nt < 8; ++nt) { const bf16x8 bfr = *(const LAS bf16x8*)(Bm + (nt * 16 + r) * RLDP + ks * 32 + g * 8);
            acc[nt] = __builtin_amdgcn_mfma_f32_16x16x32_bf16(a, bfr, acc[nt], 0, 0, 0); } }
}
__device__ __forceinline__ int ret_chain_pos(int d, int cidx) { return d == 0 ? cidx : (cidx == 1 ? 0 : (cidx == 0 ? 1 : 35 - cidx)); }

__device__ __forceinline__ void ret_stage_k_both(const bf16* Z, int r0, int h, bool lat, int t0, const float* ra, float scl, float lgf, float lgb, LAS bf16* dstf, LAS bf16* dstb, int tid) {
#pragma unroll
    for (int it = 0; it < 2; ++it) { const int task = tid + 512 * it; const int j = task & 127, pr = task >> 7; const int c = (pr & 3) + (pr >> 2) * 8;
        const bf16* p = Z + (size_t)(r0 + j) * DIN + ZC_RK + h * 128;
        float a[8], bq[8]; unpack8(*(const v4u*)(p + 8 * c), a); unpack8(*(const v4u*)(p + 8 * (c + 4)), bq);
        const float sf = scl * __expf(lgf * (float)(127 - j)), sb = scl * __expf(lgb * (float)j);
        if (lat) { const int t = t0 + j; const int pos = (c < 8) ? (t >> 6) : (t & 63);
#pragma unroll
            for (int e = 0; e < 8; ++e) { const int fi = (c & 3) * 8 + e; const float cs = ra[(pos * 32 + fi) * 2], sn = ra[(pos * 32 + fi) * 2 + 1];
                const float x1 = a[e], x2 = bq[e]; a[e] = x1 * cs - x2 * sn; bq[e] = x1 * sn + x2 * cs; } }
#pragma unroll
        for (int e = 0; e < 8; ++e) { dstf[(8 * c + e) * RLDP + j] = (bf16)f2bf(a[e] * sf); dstf[(8 * (c + 4) + e) * RLDP + j] = (bf16)f2bf(bq[e] * sf);
                                      dstb[(8 * c + e) * RLDP + j] = (bf16)f2bf(a[e] * sb); dstb[(8 * (c + 4) + e) * RLDP + j] = (bf16)f2bf(bq[e] * sb); } }
}
__device__ __forceinline__ void ret_u_item(const AH A, int l, int item, LAS unsigned char* lds, int tid, int wave, int lane) {
    unsigned char* ws = A.ws(); const bf16* Z = (const bf16*)(ws + WS_Z); const float* ra = (const float*)(ws + WS_ROPE);
    const int cidx = item % 34, bh = item / 34, b = bh >> 2, h = bh & 3;
    const int pf = ret_chain_pos(0, cidx), pb = ret_chain_pos(1, cidx);
    const bool lat = cidx >= 2; const int r0 = b * SROW + cidx * 128, t0 = (cidx - 2) * 128;
    const float lgf = log_sigmoid_f(A.in(I_RETLOGIT)[(l * 2 + 0) * 4 + h]), lgb = log_sigmoid_f(A.in(I_RETLOGIT)[(l * 2 + 1) * 4 + h]);
    LAS bf16* Ktf = (LAS bf16*)lds; LAS bf16* Ktb = (LAS bf16*)(lds + RBUF); LAS bf16* Vt = (LAS bf16*)(lds + 2 * RBUF);
    ret_stage_k_both(Z, r0, h, lat, t0, ra, 0.08838834764831845f, lgf, lgb, Ktf, Ktb, tid);
    ret_stage_pair<true, false>(Z, r0, ZC_RV, h, false, 0, ra, 1.0f, 0.f, 0, Vt, tid);
    __syncthreads();
    const int g = lane >> 4, c = lane & 15;
#pragma unroll 1
    for (int d = 0; d < 2; ++d) { const int p = d ? pb : pf;
        if (p == 33) continue;
        f32x4 acc[8];
#pragma unroll
        for (int nt = 0; nt < 8; ++nt) acc[nt] = (f32x4){0.f, 0.f, 0.f, 0.f};
        wave_mm(acc, Vt, wave * 16, d ? Ktb : Ktf, lane);
        float* U = (float*)(ws + WS_U) + ((size_t)((b * 4 + h) * 2 + d) * 34 + p) * 16384;
#pragma unroll
        for (int nt = 0; nt < 8; ++nt)
#pragma unroll
            for (int jj = 0; jj < 4; ++jj) U[(wave * 16 + 4 * g + jj) * 128 + nt * 16 + c] = acc[nt][jj]; }
    __syncthreads();
}
__device__ __forceinline__ void ret_scan_item(const AH A, int l, int item, int tid) {
    unsigned char* ws = A.ws();
    const int bhd = item >> 3, sl = item & 7; const int d = bhd & 1, h = (bhd >> 1) & 3;
    const float lg = log_sigmoid_f(A.in(I_RETLOGIT)[(l * 2 + d) * 4 + h]); const float sdec = __expf(128.0f * lg);
    const f32x4* U = (const f32x4*)((const float*)(ws + WS_U) + (size_t)bhd * 34 * 16384) + sl * 512 + tid;
    v2u* S = (v2u*)((bf16*)(ws + WS_SIN) + (size_t)bhd * 34 * 16384) + sl * 512 + tid;
    f32x4 s = (f32x4){0.f, 0.f, 0.f, 0.f};
#pragma unroll 1
    for (int p0 = 0; p0 < 33; p0 += 11) { f32x4 u[11];
#pragma unroll
        for (int i = 0; i < 11; ++i) u[i] = U[(size_t)(p0 + i) * 4096];
#pragma unroll
        for (int i = 0; i < 11; ++i) { v2u w; w.x = pk2(s.x, s.y); w.y = pk2(s.z, s.w); S[(size_t)(p0 + i) * 4096] = w; s = s * sdec + u[i]; } }
    { v2u w; w.x = pk2(s.x, s.y); w.y = pk2(s.z, s.w); S[(size_t)33 * 4096] = w; }
}
__device__ __forceinline__ void ret_out_item(const AH A, int l, int item, LAS unsigned char* lds, int tid, int wave, int lane) {
    unsigned char* ws = A.ws(); const bf16* Z = (const bf16*)(ws + WS_Z); const float* ra = (const float*)(ws + WS_ROPE);
    const int cidx = item % 34, bh = item / 34, b = bh >> 2, h = bh & 3;
    const bool lat = cidx >= 2; const int r0 = b * SROW + cidx * 128, t0 = (cidx - 2) * 128;
    const float lgf = log_sigmoid_f(A.in(I_RETLOGIT)[(l * 2 + 0) * 4 + h]) * 1.4426950408889634f, lgb = log_sigmoid_f(A.in(I_RETLOGIT)[(l * 2 + 1) * 4 + h]) * 1.4426950408889634f;
    LAS bf16* Qs = (LAS bf16*)lds; LAS bf16* Ks = (LAS bf16*)(lds + RBUF); LAS bf16* Vt = (LAS bf16*)(lds + 2 * RBUF); LAS bf16* Ss = (LAS bf16*)(lds + 3 * RBUF);
    const bf16* SINf = (const bf16*)(ws + WS_SIN) + ((size_t)((b * 4 + h) * 2 + 0) * 34 + ret_chain_pos(0, cidx)) * 16384;
    const bf16* SINb = (const bf16*)(ws + WS_SIN) + ((size_t)((b * 4 + h) * 2 + 1) * 34 + ret_chain_pos(1, cidx)) * 16384;
    ret_stage_pair<false, true>(Z, r0, ZC_RQ, h, lat, t0, ra, 1.0f, 0.f, 0, Qs, tid);
    ret_stage_pair<false, true>(Z, r0, ZC_RK, h, lat, t0, ra, 0.08838834764831845f, 0.f, 0, Ks, tid);
    ret_stage_pair<true, false>(Z, r0, ZC_RV, h, false, 0, ra, 1.0f, 0.f, 0, Vt, tid);
#pragma unroll
    for (int it = 0; it < 4; ++it) { const int task = tid + 512 * it, row = task >> 4, ch = task & 15; *(LAS v4u*)(Ss + row * RLDP + ch * 8) = *(const v4u*)(SINf + row * 128 + ch * 8); }
    v4u sbv[4];
#pragma unroll
    for (int it = 0; it < 4; ++it) { const int task = tid + 512 * it, row = task >> 4, ch = task & 15; sbv[it] = *(const v4u*)(SINb + row * 128 + ch * 8); }
    __syncthreads();
    const int g = lane >> 4, c = lane & 15, i0 = wave * 16 + 4 * g;
    f32x4 accs[8], acco[8];
#pragma unroll
    for (int nt = 0; nt < 8; ++nt) { accs[nt] = (f32x4){0.f, 0.f, 0.f, 0.f}; acco[nt] = (f32x4){0.f, 0.f, 0.f, 0.f}; }
    wave_mm(accs, Qs, wave * 16, Ks, lane);
    wave_mm(acco, Qs, wave * 16, Ss, lane);
#pragma unroll
    for (int jj = 0; jj < 4; ++jj) { const float qd = __builtin_amdgcn_exp2f(lgf * (float)(i0 + jj + 1));
#pragma unroll
        for (int nt = 0; nt < 8; ++nt) acco[nt][jj] *= qd; }
    int i0w = i0; asm volatile("" : "+v"(i0w));
#pragma unroll
    for (int nt = 0; nt < 8; ++nt)
#pragma unroll
        for (int jj = 0; jj < 4; ++jj) { const int diff = (i0w + jj) - (nt * 16 + c);
            const float w = diff > 0 ? __builtin_amdgcn_exp2f(lgf * (float)diff) : (diff < 0 ? __builtin_amdgcn_exp2f(lgb * (float)(-diff)) : 2.0f);
            accs[nt][jj] *= w; }
    __syncthreads();
#pragma unroll
    for (int nt = 0; nt < 8; ++nt)
#pragma unroll
        for (int jj = 0; jj < 4; ++jj) Ks[(i0 + jj) * RLDP + nt * 16 + c] = (bf16)f2bf(accs[nt][jj]);
#pragma unroll
    for (int it = 0; it < 4; ++it) { const int task = tid + 512 * it, row = task >> 4, ch = task & 15; *(LAS v4u*)(Ss + row * RLDP + ch * 8) = sbv[it]; }
    __syncthreads();
#pragma unroll
    for (int nt = 0; nt < 8; ++nt) accs[nt] = (f32x4){0.f, 0.f, 0.f, 0.f};
    wave_mm(accs, Qs, wave * 16, Ss, lane);
#pragma unroll
    for (int jj = 0; jj < 4; ++jj) { const float qd = __builtin_amdgcn_exp2f(lgb * (float)(128 - (i0 + jj)));
#pragma unroll
        for (int nt = 0; nt < 8; ++nt) acco[nt][jj] += qd * accs[nt][jj]; }
    wave_mm(acco, Ks, wave * 16, Vt, lane);
    const float* gn = A.in(I_RETG) + (size_t)l * 512 + h * 128;
    bf16* Y = (bf16*)(ws + WS_Y);
    float gnv[8];
#pragma unroll
    for (int nt = 0; nt < 8; ++nt) gnv[nt] = gn[nt * 16 + c];
#pragma unroll
    for (int jj = 0; jj < 4; ++jj) {
        float s1 = 0.f;
#pragma unroll
        for (int nt = 0; nt < 8; ++nt) s1 += acco[nt][jj];
        s1 += shx(s1, 1, lane); s1 += shx(s1, 2, lane); s1 += shx(s1, 4, lane); s1 += shx(s1, 8, lane);
        const float mu = s1 * (1.0f / 128.0f); float s2 = 0.f;
#pragma unroll
        for (int nt = 0; nt < 8; ++nt) { const float dlt = acco[nt][jj] - mu; s2 += dlt * dlt; }
        s2 += shx(s2, 1, lane); s2 += shx(s2, 2, lane); s2 += shx(s2, 4, lane); s2 += shx(s2, 8, lane);
        const float rstd = rsqrtf(s2 * (1.0f / 128.0f) + NORM_EPS);
#pragma unroll
        for (int nt = 0; nt < 8; ++nt) Qs[(i0 + jj) * RLDP + nt * 16 + c] = (bf16)f2bf((acco[nt][jj] - mu) * rstd * gnv[nt]);
    }
    LDS_WAIT(); asm volatile("" ::: "memory");
#pragma unroll
    for (int it = 0; it < 4; ++it) { const int id = lane + 64 * it, rr = wave * 16 + (id >> 4), ch = id & 15; const size_t row = (size_t)(r0 + rr);
        float yv[8], rg[8]; unpack8(*(const LAS v4u*)(Qs + rr * RLDP + ch * 8), yv); unpack8(*(const v4u*)(Z + row * DIN + ZC_RG + h * 128 + ch * 8), rg);
#pragma unroll
        for (int e = 0; e < 8; ++e) yv[e] *= rg[e] * sigmoidf_(rg[e]);
        v4u w; w.x = pk2(yv[0], yv[1]); w.y = pk2(yv[2], yv[3]); w.z = pk2(yv[4], yv[5]); w.w = pk2(yv[6], yv[7]);
        *(v4u*)(Y + row * 512 + h * 128 + ch * 8) = w; }
    __syncthreads();
}
constexpr int XLDP = 68;
constexpr int XWAVE_BYTES = 64 * XLDP * 4;
__device__ __forceinline__ float gelu_tanh(float x) { const float u = 0.7978845608028654f * (x + 0.044715f * x * x * x); const float th = 1.0f - 2.0f * __builtin_amdgcn_rcpf(1.0f + __expf(2.0f * u)); return 0.5f * x * (1.0f + th); }
__device__ __forceinline__ int lru_chain_pos(int d, int c64) { return d == 0 ? c64 : (c64 < 4 ? 3 - c64 : 71 - c64); }

struct LruFrag { bf16x8 ba[2], bx[2]; };
__device__ __forceinline__ LruFrag lru_frag_load(const unsigned char* ws, int l, int dir, int blk, int nt, int lane) {
    const int g = lane >> 4, c = lane & 15; LruFrag f;
    const bf16* wa = (const bf16*)(ws + (size_t)(l & 1) * WS_WSET + WS_LRUW) + (size_t)((0 * 2 + dir) * 8 + blk) * 4096 + (nt * 16 + c) * 64 + g * 8;
    const bf16* wx = (const bf16*)(ws + (size_t)(l & 1) * WS_WSET + WS_LRUW) + (size_t)((1 * 2 + dir) * 8 + blk) * 4096 + (nt * 16 + c) * 64 + g * 8;
#pragma unroll
    for (int ks = 0; ks < 2; ++ks) { f.ba[ks] = *(const bf16x8*)(wa + ks * 32); f.bx[ks] = *(const bf16x8*)(wx + ks * 32); }
    return f;
}
template <int DIR, bool FINAL>
__device__ __forceinline__ void lru_dir(const AH A, int l, int b, int c64, int blk, int nt, const bf16x8 (&af)[4][2], const float (&xv)[16], float (&hs)[16], int lane,
                                        const LruFrag& fr, float b_a, float b_x, float lam, float hin) {
    unsigned char* ws = A.ws();
    const int g = lane >> 4, c = lane & 15; const int ch = blk * 64 + nt * 16 + c;
    f32x4 accr[4], acci[4];
#pragma unroll
    for (int mt = 0; mt < 4; ++mt) { accr[mt] = (f32x4){0.f, 0.f, 0.f, 0.f}; acci[mt] = (f32x4){0.f, 0.f, 0.f, 0.f};
#pragma unroll
        for (int ks = 0; ks < 2; ++ks) { accr[mt] = __builtin_amdgcn_mfma_f32_16x16x32_bf16(af[mt][ks], fr.ba[ks], accr[mt], 0, 0, 0);
                                         acci[mt] = __builtin_amdgcn_mfma_f32_16x16x32_bf16(af[mt][ks], fr.bx[ks], acci[mt], 0, 0, 0); } }
    const float sp = fmaxf(-lam, 0.f) + log1pf(__expf(-fabsf(lam)));
    float a_[16], u_[16], la_[16];
#pragma unroll
    for (int q = 0; q < 16; ++q) { const int mt = q >> 2, jj = q & 3;
        const float r = sigmoidf_(accr[mt][jj] + b_a), ii = sigmoidf_(acci[mt][jj] + b_x);
        const float la = -8.0f * r * sp; a_[q] = __expf(la); la_[q] = la;
        const float x2 = 2.0f * la;
        const float em = -x2 * (1.0f + x2 * (0.5f + x2 * (0.16666667f + x2 * (0.041666668f + x2 * (0.0083333338f + x2 * 0.0013888889f)))));
        u_[q] = __builtin_amdgcn_sqrtf(em) * (ii * xv[q]); }
    float P = 1.f, H = 0.f;
#pragma unroll
    for (int qi = 0; qi < 16; ++qi) { const int q = DIR ? 15 - qi : qi; H = a_[q] * H + u_[q]; P *= a_[q]; }
    float Pg[4], Hg[4];
#pragma unroll
    for (int k = 0; k < 4; ++k) { Pg[k] = shi(P, c + 16 * k); Hg[k] = shi(H, c + 16 * k); }
    if (!FINAL) {
        const int p = lru_chain_pos(DIR, c64);
        const size_t idx = ((size_t)((b * 2 + DIR) * 68 + p)) * 512 + ch;
        float Hc, Pc = (Pg[0] * Pg[1]) * (Pg[2] * Pg[3]);
        if (DIR == 0) Hc = ((Hg[0] * Pg[1] + Hg[1]) * Pg[2] + Hg[2]) * Pg[3] + Hg[3];
        else          Hc = ((Hg[3] * Pg[2] + Hg[2]) * Pg[1] + Hg[1]) * Pg[0] + Hg[0];
        if (g == 0) { float* S = (float*)(ws + WS_SUMM); S[idx * 2] = Pc; S[idx * 2 + 1] = Hc; }
        const size_t e0 = ((((size_t)((b * 68 + c64) * 8 + blk) * 4 + nt) * 2 + DIR) * 64 + lane) * 16;
        bf16* LA = (bf16*)(ws + WS_HN) + e0; bf16* LU = (bf16*)(ws + WS_PARTC) + e0;
        v4u w;
        w.x = pk2(la_[0], la_[1]); w.y = pk2(la_[2], la_[3]); w.z = pk2(la_[4], la_[5]); w.w = pk2(la_[6], la_[7]); *(v4u*)LA = w;
        w.x = pk2(la_[8], la_[9]); w.y = pk2(la_[10], la_[11]); w.z = pk2(la_[12], la_[13]); w.w = pk2(la_[14], la_[15]); *(v4u*)(LA + 8) = w;
        w.x = pk2(u_[0], u_[1]); w.y = pk2(u_[2], u_[3]); w.z = pk2(u_[4], u_[5]); w.w = pk2(u_[6], u_[7]); *(v4u*)LU = w;
        w.x = pk2(u_[8], u_[9]); w.y = pk2(u_[10], u_[11]); w.z = pk2(u_[12], u_[13]); w.w = pk2(u_[14], u_[15]); *(v4u*)(LU + 8) = w;
    } else {
        float s0, s1, s2, s3;
        if (DIR == 0) { s0 = hin; s1 = s0 * Pg[0] + Hg[0]; s2 = s1 * Pg[1] + Hg[1]; s3 = s2 * Pg[2] + Hg[2]; }
        else          { s3 = hin; s2 = s3 * Pg[3] + Hg[3]; s1 = s2 * Pg[2] + Hg[2]; s0 = s1 * Pg[1] + Hg[1]; }
        float h = (g == 0) ? s0 : (g == 1) ? s1 : (g == 2) ? s2 : s3;
#pragma unroll
        for (int qi = 0; qi < 16; ++qi) { const int q = DIR ? 15 - qi : qi; h = a_[q] * h + u_[q]; hs[q] += h; }
    }
}
template <bool FINAL>
__device__ __forceinline__ void lru_task(const AH A, int l, int b, int c64, int blk, LAS unsigned char* lds, int wave, int lane, int half) {
    unsigned char* ws = A.ws(); const bf16* Z = (const bf16*)(ws + WS_Z);
    LAS float* xs = (LAS float*)(lds + wave * XWAVE_BYTES);
    const int r0 = b * SROW + c64 * 64;
    const int seq_lo = (c64 < 4) ? b * SROW : b * SROW + LCTX, seq_hi = (c64 < 4) ? b * SROW + LCTX : (b + 1) * SROW;
    const int g = lane >> 4, c = lane & 15;
    const int cgx = lane & 7, tg = lane >> 3, ch0 = blk * 64 + cgx * 8;
    v4u raw[11];
#pragma unroll
    for (int q = 0; q < 11; ++q) { const int row = r0 + tg * 8 - 1 + q;
        raw[q] = (row >= seq_lo && row < seq_hi) ? *(const v4u*)(Z + (size_t)row * DIN + ZC_LX + ch0) : (v4u){0u, 0u, 0u, 0u}; }
    f32x4 cwv[4][2], cbv[2];
#pragma unroll
    for (int e2 = 0; e2 < 2; ++e2) { cbv[e2] = *(const f32x4*)(A.in(I_CONVB) + l * 512 + ch0 + 4 * e2);
#pragma unroll
        for (int j = 0; j < 4; ++j) cwv[j][e2] = *(const f32x4*)(A.in(I_CONVW) + (l * 4 + j) * 512 + ch0 + 4 * e2); }
    float pba[2][2], pbx[2][2], plam[2][2], phin[2][2];
#pragma unroll
    for (int nti = 0; nti < 2; ++nti)
#pragma unroll
        for (int d = 0; d < 2; ++d) { const int ch = blk * 64 + (2 * half + nti) * 16 + c; const int pidx = (l * 2 + d) * 512 + ch;
            pba[nti][d] = A.in(I_LBA)[pidx]; pbx[nti][d] = A.in(I_LBX)[pidx]; plam[nti][d] = A.in(I_LAM)[pidx];
            phin[nti][d] = FINAL ? ((const float*)(ws + WS_HIN))[((size_t)((b * 2 + d) * 68 + lru_chain_pos(d, c64))) * 512 + ch] : 0.f; }
    LruFrag fcur = lru_frag_load(ws, l, 0, blk, 2 * half, lane);
    {
        float xw[4][8];
#pragma unroll
        for (int q = 0; q < 3; ++q) unpack8(raw[q], xw[q]);
#pragma unroll
        for (int tt = 0; tt < 8; ++tt) { unpack8(raw[tt + 3], xw[3]);
            float y[8];
#pragma unroll
            for (int e = 0; e < 8; ++e) { float sacc = cbv[e >> 2][e & 3];
#pragma unroll
                for (int j = 0; j < 4; ++j) sacc += cwv[j][e >> 2][e & 3] * xw[j][e];
                y[e] = sacc; }
            LAS f32x4* o = (LAS f32x4*)(xs + (tg * 8 + tt) * XLDP + cgx * 8);
            o[0] = (f32x4){y[0], y[1], y[2], y[3]}; o[1] = (f32x4){y[4], y[5], y[6], y[7]};
#pragma unroll
            for (int e = 0; e < 8; ++e) { xw[0][e] = xw[1][e]; xw[1][e] = xw[2][e]; xw[2][e] = xw[3][e]; } }
    }
    LDS_WAIT(); asm volatile("" ::: "memory");
    bf16x8 af[4][2];
    { const int m = lane & 15, gq = m >> 2, jq = m & 3, kq = (lane >> 4) * 8;
#pragma unroll
      for (int mt = 0; mt < 4; ++mt) { const int tok = 16 * gq + 4 * mt + jq;
#pragma unroll
          for (int ks = 0; ks < 2; ++ks) { const LAS f32x4* s = (const LAS f32x4*)(xs + tok * XLDP + ks * 32 + kq); const f32x4 v0 = s[0], v1 = s[1];
              v4u w; w.x = pk2(v0.x, v0.y); w.y = pk2(v0.z, v0.w); w.z = pk2(v1.x, v1.y); w.w = pk2(v1.z, v1.w); af[mt][ks] = __builtin_bit_cast(bf16x8, w); } } }
#pragma unroll
    for (int nti = 0; nti < 2; ++nti) { const int nt = 2 * half + nti;
        float xv[16], hs[16];
#pragma unroll
        for (int q = 0; q < 16; ++q) { xv[q] = xs[(16 * g + q) * XLDP + nt * 16 + c]; hs[q] = 0.f; }
        const LruFrag f1 = lru_frag_load(ws, l, 1, blk, nt, lane);
        lru_dir<0, FINAL>(A, l, b, c64, blk, nt, af, xv, hs, lane, fcur, pba[nti][0], pbx[nti][0], plam[nti][0], phin[nti][0]);
        if (nti == 0) fcur = lru_frag_load(ws, l, 0, blk, nt + 1, lane);
        lru_dir<1, FINAL>(A, l, b, c64, blk, nt, af, xv, hs, lane, f1, pba[nti][1], pbx[nti][1], plam[nti][1], phin[nti][1]);
        if (FINAL) {
#pragma unroll
            for (int q = 0; q < 16; ++q) xs[(16 * g + q) * XLDP + nt * 16 + c] = hs[q]; }
    }
    if (FINAL) {
        LDS_WAIT(); asm volatile("" ::: "memory");
        bf16* Y = (bf16*)(ws + WS_Y) + (size_t)MTOK * 512;
#pragma unroll
        for (int it = 0; it < 4; ++it) { const int id = lane + 64 * it, tok = id >> 2, chn = 4 * half + (id & 3); const size_t row = (size_t)(r0 + tok);
            const LAS f32x4* sp = (const LAS f32x4*)(xs + tok * XLDP + chn * 8); const f32x4 h0 = sp[0], h1 = sp[1];
            float lz[8]; unpack8(*(const v4u*)(Z + row * DIN + ZC_LZ + blk * 64 + chn * 8), lz);
            v4u w; w.x = pk2(gelu_tanh(lz[0]) * h0.x, gelu_tanh(lz[1]) * h0.y); w.y = pk2(gelu_tanh(lz[2]) * h0.z, gelu_tanh(lz[3]) * h0.w);
            w.z = pk2(gelu_tanh(lz[4]) * h1.x, gelu_tanh(lz[5]) * h1.y); w.w = pk2(gelu_tanh(lz[6]) * h1.z, gelu_tanh(lz[7]) * h1.w);
            *(v4u*)(Y + row * 512 + blk * 64 + chn * 8) = w; }
    }
    LDS_WAIT(); asm volatile("" ::: "memory");
}
template <int DIR>
__device__ __forceinline__ void lru_apply(const float (&a_)[16], const float (&u_)[16], float hin, float (&hs)[16], int lane) {
    const int g = lane >> 4, c = lane & 15;
    float P = 1.f, H = 0.f;
#pragma unroll
    for (int qi = 0; qi < 16; ++qi) { const int q = DIR ? 15 - qi : qi; H = a_[q] * H + u_[q]; P *= a_[q]; }
    float Pg[4], Hg[4];
#pragma unroll
    for (int k = 0; k < 4; ++k) { Pg[k] = shi(P, c + 16 * k); Hg[k] = shi(H, c + 16 * k); }
    float s0, s1, s2, s3;
    if (DIR == 0) { s0 = hin; s1 = s0 * Pg[0] + Hg[0]; s2 = s1 * Pg[1] + Hg[1]; s3 = s2 * Pg[2] + Hg[2]; }
    else          { s3 = hin; s2 = s3 * Pg[3] + Hg[3]; s1 = s2 * Pg[2] + Hg[2]; s0 = s1 * Pg[1] + Hg[1]; }
    float h = (g == 0) ? s0 : (g == 1) ? s1 : (g == 2) ? s2 : s3;
#pragma unroll
    for (int qi = 0; qi < 16; ++qi) { const int q = DIR ? 15 - qi : qi; h = a_[q] * h + u_[q]; hs[q] += h; }
}
__device__ __forceinline__ void lru_final(const AH A, int l, int b, int c64, int blk, LAS unsigned char* lds, int wave, int lane, int half) {
    unsigned char* ws = A.ws(); const bf16* Z = (const bf16*)(ws + WS_Z);
    LAS float* xs = (LAS float*)(lds + wave * XWAVE_BYTES);
    const int r0 = b * SROW + c64 * 64;
    const int g = lane >> 4, c = lane & 15;
    float phin[2][2];
#pragma unroll
    for (int nti = 0; nti < 2; ++nti)
#pragma unroll
        for (int d = 0; d < 2; ++d) { const int ch = blk * 64 + (2 * half + nti) * 16 + c;
            phin[nti][d] = ((const float*)(ws + WS_HIN))[((size_t)((b * 2 + d) * 68 + lru_chain_pos(d, c64))) * 512 + ch]; }
    v4u wl[2][2][2], wu[2][2][2];
#pragma unroll
    for (int nti = 0; nti < 2; ++nti)
#pragma unroll
        for (int d = 0; d < 2; ++d) { const size_t e0 = ((((size_t)((b * 68 + c64) * 8 + blk) * 4 + (2 * half + nti)) * 2 + d) * 64 + lane) * 16;
            const bf16* LA = (const bf16*)(ws + WS_HN) + e0; const bf16* LU = (const bf16*)(ws + WS_PARTC) + e0;
            wl[nti][d][0] = *(const v4u*)LA; wl[nti][d][1] = *(const v4u*)(LA + 8); wu[nti][d][0] = *(const v4u*)LU; wu[nti][d][1] = *(const v4u*)(LU + 8); }
#pragma unroll
    for (int nti = 0; nti < 2; ++nti) { const int nt = 2 * half + nti;
        float hs[16];
#pragma unroll
        for (int q = 0; q < 16; ++q) hs[q] = 0.f;
#pragma unroll
        for (int d = 0; d < 2; ++d) { float a_[16], u_[16];
            unpack8(wl[nti][d][0], a_); unpack8(wl[nti][d][1], a_ + 8); unpack8(wu[nti][d][0], u_); unpack8(wu[nti][d][1], u_ + 8);
#pragma unroll
            for (int q = 0; q < 16; ++q) a_[q] = __expf(a_[q]);
            if (d == 0) lru_apply<0>(a_, u_, phin[nti][0], hs, lane); else lru_apply<1>(a_, u_, phin[nti][1], hs, lane); }
#pragma unroll
        for (int q = 0; q < 16; ++q) xs[(16 * g + q) * XLDP + nt * 16 + c] = hs[q];
    }
    LDS_WAIT(); asm volatile("" ::: "memory");
    bf16* Y = (bf16*)(ws + WS_Y) + (size_t)MTOK * 512;
#pragma unroll
    for (int it = 0; it < 4; ++it) { const int id = lane + 64 * it, tok = id >> 2, chn = 4 * half + (id & 3); const size_t row = (size_t)(r0 + tok);
        const LAS f32x4* sp = (const LAS f32x4*)(xs + tok * XLDP + chn * 8); const f32x4 h0 = sp[0], h1 = sp[1];
        float lz[8]; unpack8(*(const v4u*)(Z + row * DIN + ZC_LZ + blk * 64 + chn * 8), lz);
        v4u w; w.x = pk2(gelu_tanh(lz[0]) * h0.x, gelu_tanh(lz[1]) * h0.y); w.y = pk2(gelu_tanh(lz[2]) * h0.z, gelu_tanh(lz[3]) * h0.w);
        w.z = pk2(gelu_tanh(lz[4]) * h1.x, gelu_tanh(lz[5]) * h1.y); w.w = pk2(gelu_tanh(lz[6]) * h1.z, gelu_tanh(lz[7]) * h1.w);
        *(v4u*)(Y + row * 512 + blk * 64 + chn * 8) = w; }
    LDS_WAIT(); asm volatile("" ::: "memory");
}
__device__ __forceinline__ void lru_scan(const AH A, int tid, int G) {
    unsigned char* ws = A.ws(); const float* S = (const float*)(ws + WS_SUMM); float* HIN = (float*)(ws + WS_HIN);
    const int cpb = (4096 + G - 1) / G;
    for (int chain = blockIdx.x * cpb + tid; tid < cpb && chain < 4096; chain += 4096) { const int bd = chain >> 9, ch = chain & 511; float h = 0.f;
        typedef float f32x2s __attribute__((ext_vector_type(2)));
#pragma unroll 1
        for (int p0 = 0; p0 < 68; p0 += 17) { f32x2s ph_[17];
#pragma unroll
            for (int i = 0; i < 17; ++i) ph_[i] = *(const f32x2s*)(S + ((size_t)(bd * 68 + p0 + i) * 512 + ch) * 2);
#pragma unroll
            for (int i = 0; i < 17; ++i) { HIN[(size_t)(bd * 68 + p0 + i) * 512 + ch] = h; h = ph_[i].x * h + ph_[i].y; } } }
}

#define EN(k) (((MASK) >> (k)) & 1)
template <int MASK> __global__ void __launch_bounds__(NWAVES * 64, 2) fwd_kernel(Args args) {
    extern __shared__ __attribute__((aligned(16))) unsigned char lds_raw[];
    LAS unsigned char* lds0 = (LAS unsigned char*)lds_raw;
    cg::grid_group grid = cg::this_grid();
    { const unsigned* aw = (const unsigned*)&args; const int tid = threadIdx.x; if (tid < 54) ((LAS unsigned*)(lds0 + ARGS_LDS_OFF))[tid] = aw[tid];
      if (tid >= 64 && tid < 66) ((LAS unsigned*)(lds0 + ARGS_LDS_OFF + 256))[tid - 64] = 0u; }
    __syncthreads();
    XcdBarrier xbar = xcd_barrier_post((unsigned*)args.ws, (volatile LAS unsigned*)(lds0 + ARGS_LDS_OFF + 256), threadIdx.x == 0);
    const int ph_lo = args.ph_lo, ph_hi = args.ph_hi;
    const int wave0 = __builtin_amdgcn_readfirstlane((int)threadIdx.x >> 6);
#ifndef PROBE_MASK
#define PROBE_MASK 0
#endif
#ifndef PROBE_SUB
#define PROBE_SUB 0
#endif
#define SUBOFF(bit) (rep && ((PROBE_SUB) & (bit)))
#define PROBE_HIT(ph) ((PROBE_MASK) != 0 && ((ph) == 0 ? (((PROBE_MASK) >> 13) & 1) : (ph) == 53 ? (((PROBE_MASK) >> 14) & 1) : (((PROBE_MASK) >> (((ph) - 1) % 13)) & 1)))
    for (int ph2 = 2 * ph_lo; ph2 < 2 * ph_hi; ++ph2) {
        const int ph = ph2 >> 1, rep = ph2 & 1;
        if (rep && !PROBE_HIT(ph)) continue;
        if (ph2 != 2 * ph_lo) {
            if (ph_lo < 0) grid.sync();
            else { int mk2_ = -1; asm volatile("" : "+s"(mk2_)); const bool t0_ = (wave0 == 0) && (__builtin_amdgcn_mbcnt_hi(mk2_, __builtin_amdgcn_mbcnt_lo(mk2_, 0)) == 0); xcd_barrier(xbar, t0_); }
        }
#define PH_PROLOG int wv_ = wave0; int mk_ = -1; asm volatile("" : "+s"(wv_), "+s"(mk_)); int tid = wv_ * 64 + (int)__builtin_amdgcn_mbcnt_hi(mk_, __builtin_amdgcn_mbcnt_lo(mk_, 0)); int G = gridDim.x, bx = blockIdx.x; asm volatile("" : "+s"(G), "+s"(bx)); \
        unsigned ldsi = (unsigned)(unsigned long long)lds0; asm volatile("" : "+s"(ldsi)); LAS unsigned char* lds = (LAS unsigned char*)(unsigned long long)ldsi; \
        const AH AHv{(const LAS unsigned*)(lds + ARGS_LDS_OFF)}; const int lane = tid & 63, wave = wv_; \
        const int gw = bx * NWAVES + wave, NGW = G * NWAVES; (void)gw; (void)NGW; (void)lane; (void)wave; (void)G; (void)bx; (void)tid;
        if (EN(13) && ph == 0) { PH_PROLOG phase_p0(AHv, lds, tid, G); __syncthreads(); convert_layer(AHv, 0, 0, CV_NIT, lds, gw, NGW, wave, lane); }
        else if (EN(14) && ph == 53) { PH_PROLOG final_rows(AHv, gw, NGW, lane); }
        else {
            const int l = (ph - 1) / 13, k = (ph - 1) - l * 13; const bool last = (l == DEPTH - 1);
#define ws (AHv.ws())
#define HN ((bf16*)(ws + WS_HN))
#define Zb ((bf16*)(ws + WS_Z))
#define X ((float*)(ws + WS_X))
#define modbuf ((const float*)(ws + WS_MOD))
            if (EN(0) && k == 0) { PH_PROLOG norm_rows(AHv, l, 0, gw, NGW, lane, l > 0 ? 11 : 0, modbuf + (size_t)(l > 0 ? l - 1 : 0) * 5 * MODW + 4 * MODW + 2 * 3072 + 2048, 0.5f); }
            else if (EN(3) && k == 3) { PH_PROLOG norm_rows(AHv, l, 1, gw, NGW, lane, 11, modbuf + (size_t)l * 5 * MODW + 4 * MODW + 0 * 3072 + 2048, 0.5f); }
            else if (EN(10) && k == 10) { PH_PROLOG norm_rows(AHv, l, 2, gw, NGW, lane, last ? 0 : 4, modbuf + (size_t)l * 5 * MODW + 4 * MODW + 1 * 3072 + 2048, 1.0f); }
            else if (EN(1) && (k == 1 || k == 11)) { PH_PROLOG const int j = (k == 1) ? 0 : 1;
                pg8::Gemm gm{HN, (const bf16*)(ws + (size_t)(l & 1) * WS_WSET + WS_WFI) + (size_t)j * 5632 * 1024, MTOK, 5632, 1024};
                pg8::EpiSwiglu E{Zb};
                if (last && k == 11) { pg8::LastLayerOrder S; S.init(5632, G, bx, 0); pg8::gemm_phase<1024, pg8::EpiSwiglu, pg8::LastLayerOrder, true, true>(lds, gm, S, E, tid); }
                else { pg8::StaticOrder S; S.init(MTOK, 5632, G, bx); pg8::gemm_phase<1024, pg8::EpiSwiglu, pg8::StaticOrder, true, true>(lds, gm, S, E, tid); } }
            else if (EN(2) && (k == 2 || k == 12)) { PH_PROLOG const int j = (k == 2) ? 0 : 1, sub = (k == 2) ? 0 : 2;
                pg8::Gemm gm{Zb, (const bf16*)(ws + (size_t)(l & 1) * WS_WSET + WS_WFO) + (size_t)j * 1024 * DFF, MTOK, 1024, DFF};
                pg8::EpiResid E{X, modbuf + (size_t)l * 5 * MODW + sub * 3072 + 2048, rep ? 0.0f : 0.5f, (float*)(ws + WS_PARTC)};
                if (last && k == 12) { pg8::LatOrder S{G, bx}; pg8::gemm_phase<DFF, pg8::EpiResid, pg8::LatOrder, true, true>(lds, gm, S, E, tid); }
                else { pg8::SplitOrder S{G, bx, 11, 4}; pg8::gemm_phase<DFF, pg8::EpiResid, pg8::SplitOrder, true, true>(lds, gm, S, E, tid); } }
            else if (EN(4) && k == 4) { PH_PROLOG
                pg8::Gemm gm{HN, (const bf16*)(ws + (size_t)(l & 1) * WS_WSET + WS_WIN), MTOK, DIN, 1024};
                pg8::EpiZ E{Zb, DIN};
                if (last) { pg8::LastLayerOrder S; S.init(DIN, G, bx, 28); pg8::gemm_phase<1024, pg8::EpiZ, pg8::LastLayerOrder, true, true>(lds, gm, S, E, tid); }
                else { pg8::StaticOrder S; S.init(MTOK, DIN, G, bx); pg8::gemm_phase<1024, pg8::EpiZ, pg8::StaticOrder, true, true>(lds, gm, S, E, tid); } }
            else if (EN(5) && k == 5) { PH_PROLOG
                if (!SUBOFF(1)) prep_qk(AHv, l, gw, NGW, lane);
                if (!SUBOFF(2)) for (int it = bx; it < 544; it += G) ret_u_item(AHv, l, it, lds, tid, wave, lane);
                __syncthreads();
                if (!SUBOFF(4)) { PH_PROLOG
                    const int H = 2 * 272, n3 = (544 > 2 * G && 544 <= 3 * G) ? 544 - 2 * G : 0, nb = G - n3;
                    for (int hi = bx; hi < H; hi += (bx < n3) ? H : nb) { const int li = hi >> 1; lru_task<false>(AHv, l, li / 68, li % 68, wave, lds, wave, lane, hi & 1); } } }
            else if (EN(6) && k == 6) { PH_PROLOG
                for (int it = bx; it < 256; it += G) ret_scan_item(AHv, l, it, tid);
                lru_scan(AHv, tid, G);
                const int nunits = last ? 512 : 544;
                for (int i = 0;; ++i) { const int u = i * G + bx; if (u >= nunits) break;
                    long qrow0, kvrow0; int hq, kvh, NT;
                    if (u < 512) { const int combo = u & 7, j = u >> 3; const int b = combo >> 1; kvh = combo & 1; hq = kvh * 4 + (j & 3); const int qb = j >> 2;
                        qrow0 = (long)b * SROW + LCTX + qb * 256; kvrow0 = (long)b * SROW; NT = 68; }
                    else { const int v = u - 512; const int b = v >> 3; hq = v & 7; kvh = hq >> 2; qrow0 = (long)b * SROW; kvrow0 = qrow0; NT = 4; }
                    attn_body::attn_unit<8>(qrow0, kvrow0, hq, kvh, NT, (const attn_body::bf16*)(ws + WS_QN), (const attn_body::bf16*)(ws + WS_KN), (const attn_body::bf16*)(Zb + ZC_AV),
                                            (attn_body::bf16*)((bf16*)(ws + WS_Y) + (size_t)2 * MTOK * 512), (char*)lds, tid); } }
            else if ((EN(7) || EN(15)) && k == 7) { PH_PROLOG
                const int nret = last ? 512 : 544, nlru = last ? 256 : 272;
                if (EN(7) && !SUBOFF(8)) for (int it = bx; it < nret; it += G) { const int item = last ? ((it >> 5) * 34 + 2 + (it & 31)) : it; ret_out_item(AHv, l, item, lds, tid, wave, lane); }
                __syncthreads();
                if (EN(15) && !SUBOFF(16)) { PH_PROLOG
                    const int H = 2 * nlru, n3 = (nret > 2 * G && nret <= 3 * G) ? nret - 2 * G : 0, nb = G - n3;
                    for (int hi = bx; hi < H; hi += (bx < n3) ? H : nb) { const int li = hi >> 1; const int b = last ? (li >> 6) : (li / 68), c64 = last ? (4 + (li & 63)) : (li % 68);
                        lru_final(AHv, l, b, c64, wave, lds, wave, lane, hi & 1); } } }
            else if (EN(8) && k == 8) { PH_PROLOG
                pg8::Gemm gm{(const bf16*)(ws + WS_Y), (const bf16*)(ws + (size_t)(l & 1) * WS_WSET + WS_WB), 3 * MTOK, 3 * 1024, 512}; pg8::MergeOrder S{G, bx, last ? 1 : 0};
                pg8::EpiMerge E{Zb, HN};
                pg8::gemm_phase<512, pg8::EpiMerge, pg8::MergeOrder, true, true>(lds, gm, S, E, tid);
                if (!last) {
                    const int nsec = (272 > G) ? ((272 - G < G) ? 272 - G : 0) : 0;
                    if (bx >= nsec) convert_layer(AHv, l + 1, 0, CV_NIT, lds, (bx - nsec) * NWAVES + wave, (G - nsec) * NWAVES, wave, lane); } }
            else if (EN(9) && k == 9) { PH_PROLOG
                pg8::Gemm gm{HN, (const bf16*)(ws + (size_t)(l & 1) * WS_WSET + WS_WO), MTOK, 1024, 1024};
                pg8::EpiResid E{X, modbuf + (size_t)l * 5 * MODW + 1 * 3072 + 2048, rep ? 0.0f : 1.0f, (float*)(ws + WS_PARTC)};
                if (last) { pg8::LatOrder S{G, bx}; pg8::gemm_phase<1024, pg8::EpiResid, pg8::LatOrder, true, true>(lds, gm, S, E, tid); }
                else { pg8::SplitOrder S{G, bx, 4, 4}; pg8::gemm_phase<1024, pg8::EpiResid, pg8::SplitOrder, true, true>(lds, gm, S, E, tid); } }
        }
#undef ws
#undef HN
#undef Zb
#undef X
#undef modbuf
    }
}

#ifndef MK_N_LAUNCHES
#define MK_N_LAUNCHES 1
#endif
#if MK_N_LAUNCHES == 1
#define FULLK fwd_kernel<0xffff>
#else
template <int MASK> static void launch_one(int grid, const Args& a, hipStream_t stream) {
    static bool init = false;
    if (!init) { (void)hipFuncSetAttribute((const void*)fwd_kernel<MASK>, hipFuncAttributeMaxDynamicSharedMemorySize, LDS_BYTES); init = true; }
    hipLaunchKernelGGL(fwd_kernel<MASK>, dim3(grid), dim3(NWAVES * 64), LDS_BYTES, stream, a);
}
#endif
extern "C" void kernel_launch(void* const* d_in, const int* in_sizes, int n_in, void* d_out, int out_size, void* d_ws, size_t ws_size, hipStream_t stream) {
    static int grid = 0;
    if (grid == 0) {
        if (n_in != 24 || ws_size < WS_END) { fprintf(stderr, "kernel_launch: unexpected n_in %d / ws %zu (need %zu)\n", n_in, ws_size, (size_t)WS_END); grid = -1; return; }
        int dev = 0, cus = 0;
        (void)hipGetDevice(&dev); (void)hipDeviceGetAttribute(&cus, hipDeviceAttributeMultiprocessorCount, dev);
#if MK_N_LAUNCHES == 1
        int per_cu = 0;
        (void)hipFuncSetAttribute((const void*)FULLK, hipFuncAttributeMaxDynamicSharedMemorySize, LDS_BYTES);
        if (hipOccupancyMaxActiveBlocksPerMultiprocessor(&per_cu, (const void*)FULLK, NWAVES * 64, LDS_BYTES) != hipSuccess || per_cu < 1) per_cu = 1;
        (void)hipGetLastError();
        grid = cus * per_cu;
#else
        grid = cus;
#endif
        if (grid <= 0) grid = 256;
    }
    if (grid < 0) return;
    (void)hipMemsetAsync(d_ws, 0, 16384, stream);
    Args a{};
    for (int i = 0; i < 24; ++i) a.in[i] = (const float*)d_in[i];
    a.out = (float*)d_out; a.ws = (unsigned char*)d_ws;
#if MK_N_LAUNCHES == 1
    a.ph_lo = 0; a.ph_hi = 54;
    void* params[] = {(void*)&a};
    hipError_t e = hipLaunchCooperativeKernel((const void*)FULLK, dim3(grid), dim3(NWAVES * 64), params, LDS_BYTES, stream);
    if (e != hipSuccess) fprintf(stderr, "cooperative launch failed: %s (grid %d)\n", hipGetErrorString(e), grid);
#else
    for (int ph = 0; ph < 54; ++ph) { a.ph_lo = ph; a.ph_hi = ph + 1;
        if (ph == 0) { launch_one<1 << 13>(grid, a, stream); continue; }
        if (ph == 53) { launch_one<1 << 14>(grid, a, stream); continue; }
        const int k = (ph - 1) % 13;
        switch (k) {
            case 0: launch_one<1 << 0>(grid, a, stream); break;
            case 1: case 11: launch_one<1 << 1>(grid, a, stream); break;
            case 2: case 12: launch_one<1 << 2>(grid, a, stream); break;
            case 3: launch_one<1 << 3>(grid, a, stream); break;
            case 4: launch_one<1 << 4>(grid, a, stream); break;
            case 5: launch_one<1 << 5>(grid, a, stream); break;
            case 6: launch_one<1 << 6>(grid, a, stream); break;
            case 7: launch_one<1 << 7>(grid, a, stream); launch_one<1 << 15>(grid, a, stream); break;
            case 8: launch_one<1 << 8>(grid, a, stream); break;
            case 9: launch_one<1 << 9>(grid, a, stream); break;
            case 10: launch_one<1 << 10>(grid, a, stream); break;
        }
    }
#endif
}
```

```cpp
#include <hip/hip_runtime.h>
#include <hip/hip_cooperative_groups.h>
#include <hip/hip_bf16.h>
#include <cstdio>
#include <cstdint>
#include <cmath>
namespace cg = cooperative_groups;
namespace pg8 {
#define PG8_LAS __attribute__((address_space(3)))
typedef unsigned short bf16_t;
typedef short bf16x8 __attribute__((ext_vector_type(8)));
typedef float f32x4 __attribute__((ext_vector_type(4)));
typedef unsigned u32x4 __attribute__((ext_vector_type(4)));
constexpr int BM = 256, BK = 64, HALF = 128, HTB = HALF * BK * 2  , STAGE_BYTES = 8 * HTB, NXCD = 8, WGM = 4;

__host__ __device__ __forceinline__ int lds_byte(int r, int c) { const int st = (r >> 4) * 2 + (c >> 5), rr = r & 15, cc = c & 31, ob = rr * 64 + cc * 2; return st * 1024 + (ob ^ (((ob >> 9) & 1) << 5)); }
__host__ __device__ __forceinline__ void stage_rc(int b, int& R, int& C) { const int st = b / 1024, sb = b % 1024, swz = sb ^ (((sb >> 9) & 1) << 5); R = (st >> 1) * 16 + swz / 64; C = (st & 1) * 32 + (swz % 64) / 2; }
__host__ __device__ __forceinline__ int perm32(int rho) { const int n = rho >> 4, i = rho & 15; return 8 * (i >> 2) + 4 * n + (i & 3); }

struct Unit { int pm, pn, k0, nk; };
struct Gemm { const bf16_t* A; const bf16_t* Bt; int M, N, K; };

struct StaticOrder {
    int nM, nN, nwg, G, c;
    __host__ __device__ void init(int M, int N, int G_, int c_) { nM = M / BM; nN = N / BM; nwg = nM * nN; G = G_; c = c_; }
    __host__ __device__ bool next(int i, Unit& u) const {
        const long L = (long)i * G + c; if (L >= nwg) return false;
        int wgid = (int)L; { const int q = nwg / NXCD, r = nwg % NXCD, xcd = wgid % NXCD, off = wgid / NXCD; wgid = (xcd < r ? xcd * (q + 1) : r * (q + 1) + (xcd - r) * q) + off; }
        const int nig = WGM * nN, gid = wgid / nig, fm = gid * WGM, gsz = (nM - fm) < WGM ? (nM - fm) : WGM;
        u.pm = fm + ((wgid % nig) % gsz); u.pn = (wgid % nig) / gsz; u.k0 = 0; u.nk = 0; return true;
    }
    __device__ __forceinline__ void a_ready(const Unit&) const {}
    __device__ __forceinline__ void done(const Unit&) const {}
};

typedef unsigned u32x2 __attribute__((ext_vector_type(2)));
__device__ __forceinline__ unsigned cvt_pk_bf16(float lo, float hi) { unsigned r; asm volatile("v_cvt_pk_bf16_f32 %0, %1, %2" : "=v"(r) : "v"(lo), "v"(hi)); return r; }
__device__ __forceinline__ float fast_sigmoid(float v) { return __builtin_amdgcn_rcpf(1.0f + __expf(-v)); }
__device__ __forceinline__ float bf_lo(unsigned w) { return __uint_as_float(w << 16); }
__device__ __forceinline__ float bf_hi(unsigned w) { return __uint_as_float(w & 0xffff0000u); }
struct EpiZ {
    static constexpr bool PERM = true, AFTER_DRAIN = false, CHAIN = false;
    bf16_t* O; int ldc;
    __device__ __forceinline__ void operator()(const f32x4 (&acc)[2][2][4][2], const Unit& u, int wr, int wc, int fr, int fq) const {
        const int row0 = u.pm * BM + wr * 64 + fr; const int col0 = u.pn * BM + wc * 32 + 8 * fq;
#pragma unroll
        for (int ai = 0; ai < 2; ++ai)
#pragma unroll
            for (int m = 0; m < 4; ++m) { bf16_t* rowp = O + (size_t)(row0 + ai * HALF + m * 16) * ldc + col0;
#pragma unroll
                for (int bj = 0; bj < 2; ++bj) { const f32x4 v0 = acc[ai][bj][m][0], v1 = acc[ai][bj][m][1];
                    u32x4 w; w.x = cvt_pk_bf16(v0[0], v0[1]); w.y = cvt_pk_bf16(v0[2], v0[3]); w.z = cvt_pk_bf16(v1[0], v1[1]); w.w = cvt_pk_bf16(v1[2], v1[3]);
                    *(u32x4*)(rowp + bj * HALF) = w; } }
    }
};
struct EpiSwiglu {
    static constexpr bool PERM = true, AFTER_DRAIN = false, CHAIN = false;
    bf16_t* O;
    __device__ __forceinline__ void operator()(const f32x4 (&acc)[2][2][4][2], const Unit& u, int wr, int wc, int fr, int fq) const {
        const int row0 = u.pm * BM + wr * 64 + fr; const int col0 = u.pn * HALF + wc * 32 + 8 * fq;
#pragma unroll
        for (int ai = 0; ai < 2; ++ai)
#pragma unroll
            for (int m = 0; m < 4; ++m) { bf16_t* rowp = O + (size_t)(row0 + ai * HALF + m * 16) * 2816 + col0;
                float h[8];
#pragma unroll
                for (int n = 0; n < 2; ++n)
#pragma unroll
                    for (int j = 0; j < 4; ++j) { const float a = acc[ai][0][m][n][j], b = acc[ai][1][m][n][j]; h[n * 4 + j] = a * fast_sigmoid(a) * b; }
                u32x4 w; w.x = cvt_pk_bf16(h[0], h[1]); w.y = cvt_pk_bf16(h[2], h[3]); w.z = cvt_pk_bf16(h[4], h[5]); w.w = cvt_pk_bf16(h[6], h[7]);
                *(u32x4*)rowp = w; }
    }
};
struct EpiResid {
    static constexpr bool PERM = false, AFTER_DRAIN = false, CHAIN = false;
    float* X; const float* gate; float scale; float* PARTC;
    __device__ __forceinline__ void operator()(const f32x4 (&acc)[2][2][4][2], const Unit& u, int wr, int wc, int fr, int fq) const {
        const int bb = u.pm / 17, mrow = (u.pm - bb * 17 == 0) ? 4 : bb;
        const int col0 = u.pn * BM + wc * 32 + 4 * fq;
        if (u.nk != 0) {
            const int sp = u.k0 / (u.nk * 64); float* base = PARTC + ((size_t)sp * 1024 + (size_t)bb * 256 + wr * 64 + fr) * 1024 + col0;
#pragma unroll
            for (int ai = 0; ai < 2; ++ai)
#pragma unroll
                for (int m = 0; m < 4; ++m)
#pragma unroll
                    for (int bj = 0; bj < 2; ++bj)
#pragma unroll
                        for (int n = 0; n < 2; ++n) *(f32x4*)(base + (size_t)(ai * HALF + m * 16) * 1024 + bj * HALF + n * 16) = acc[ai][bj][m][n];
            return; }
        const float* g = gate + (size_t)mrow * 9216;
        const int row0 = u.pm * BM + wr * 64 + fr;
        f32x4 gv[2][2];
#pragma unroll
        for (int bj = 0; bj < 2; ++bj)
#pragma unroll
            for (int n = 0; n < 2; ++n) gv[bj][n] = *(const f32x4*)(g + col0 + bj * HALF + n * 16) * scale;
#pragma unroll
        for (int ai = 0; ai < 2; ++ai)
#pragma unroll
            for (int m = 0; m < 4; ++m) { float* rowp = X + (size_t)(row0 + ai * HALF + m * 16) * 1024 + col0;
#pragma unroll
                for (int bj = 0; bj < 2; ++bj)
#pragma unroll
                    for (int n = 0; n < 2; ++n) { f32x4* p = (f32x4*)(rowp + bj * HALF + n * 16); *p = *p + gv[bj][n] * acc[ai][bj][m][n]; }
                asm volatile("" ::: "memory"); }
    }
};
struct EpiMerge {
    static constexpr bool PERM = false, AFTER_DRAIN = false, CHAIN = true;
    const bf16_t* Z; bf16_t* MG;
    __device__ __forceinline__ void operator()(const f32x4 (&acc)[2][2][4][2], const Unit& u, int wr, int wc, int fr, int fq) const {}
    __device__ __forceinline__ bool chain(f32x4 (&acc)[2][2][4][2], const Unit& u, int wr, int wc, int fr, int fq) const {
        const int n = u.pm / 68, pm = u.pm - n * 68, pn = u.pn & 3;
        const int row0 = pm * BM + wr * 64 + fr; const int col0 = pn * BM + wc * 32 + 4 * fq;
#pragma unroll
        for (int ai = 0; ai < 2; ++ai)
#pragma unroll
            for (int m = 0; m < 4; ++m) { const size_t row = (size_t)(row0 + ai * HALF + m * 16);
#pragma unroll
                for (int bj = 0; bj < 2; ++bj)
#pragma unroll
                    for (int nn = 0; nn < 2; ++nn) { const int col = col0 + bj * HALF + nn * 16;
                        const bf16_t* zp = Z + row * 6912 + 3840 + n * 1024 + col;
                        const u32x2 ga = *(const u32x2*)zp;
                        const float ea0 = 1.0f + __expf(-bf_lo(ga.x)), ea1 = 1.0f + __expf(-bf_hi(ga.x)), ea2 = 1.0f + __expf(-bf_lo(ga.y)), ea3 = 1.0f + __expf(-bf_hi(ga.y));
                        f32x4 sc;
                        if (n < 2) { const u32x2 gb = *(const u32x2*)(zp + 1024);
                            sc[0] = (1.0f + __expf(-bf_lo(gb.x))) * __builtin_amdgcn_rcpf(ea0); sc[1] = (1.0f + __expf(-bf_hi(gb.x))) * __builtin_amdgcn_rcpf(ea1);
                            sc[2] = (1.0f + __expf(-bf_lo(gb.y))) * __builtin_amdgcn_rcpf(ea2); sc[3] = (1.0f + __expf(-bf_hi(gb.y))) * __builtin_amdgcn_rcpf(ea3);
                            acc[ai][bj][m][nn] = acc[ai][bj][m][nn] * sc; }
                        else { sc[0] = __builtin_amdgcn_rcpf(ea0); sc[1] = __builtin_amdgcn_rcpf(ea1); sc[2] = __builtin_amdgcn_rcpf(ea2); sc[3] = __builtin_amdgcn_rcpf(ea3);
                            const f32x4 v = acc[ai][bj][m][nn] * sc; u32x2 w; w.x = cvt_pk_bf16(v[0], v[1]); w.y = cvt_pk_bf16(v[2], v[3]); *(u32x2*)(MG + row * 1024 + col) = w; } }
                asm volatile("" ::: "memory"); }
        return n < 2;
    }
};
struct MergeOrder {
    int G, c, latonly;
    __device__ bool next(int i, Unit& u) const {
        const int ti = i / 3, n = i - ti * 3; const int L = ti * G + c; if (L >= (latonly ? 256 : 272)) return false;
        const int t = L >> 2; const int pm = latonly ? ((t >> 4) * 17 + 1 + (t & 15)) : t;
        u.pm = n * 68 + pm; u.pn = n * 4 + (L & 3); u.k0 = 0; u.nk = 0; return true;
    }
    __device__ __forceinline__ void a_ready(const Unit&) const {}
    __device__ __forceinline__ void done(const Unit&) const {}
};
struct LastLayerOrder {
    StaticOrder so; int nextra;
    __device__ void init(int N, int G, int c, int nextra_) { so.init(64 * BM, N, G, c); nextra = nextra_; }
    __device__ bool next(int i, Unit& u) const {
        if (so.next(i, u)) { const int v = u.pm; u.pm = (v >> 4) * 17 + 1 + (v & 15); return true; }
        const int L = i * so.G + so.c - so.nwg; if (L < 0 || L >= nextra) return false;
        const int t = L / 7, q = L - t * 7; u.pm = t * 17; u.pn = (q < 4) ? 2 + q : (q < 6) ? 4 + q : 14; u.k0 = 0; u.nk = 0; return true;
    }
    __device__ __forceinline__ void a_ready(const Unit&) const {}
    __device__ __forceinline__ void done(const Unit&) const {}
};
struct LatOrder {
    int G, c;
    __device__ bool next(int i, Unit& u) const {
        const int L = i * G + c; if (L >= 256) return false;
        const int t = L >> 2; u.pm = (t >> 4) * 17 + 1 + (t & 15); u.pn = L & 3; u.k0 = 0; u.nk = 0; return true;
    }
    __device__ __forceinline__ void a_ready(const Unit&) const {}
    __device__ __forceinline__ void done(const Unit&) const {}
};
struct SplitOrder {
    int G, c, nsplit, nkt;
    __device__ bool next(int i, Unit& u) const {
        int L = i * G + c;
        if (L < 256) { const int t = L >> 2; u.pm = (t >> 4) * 17 + 1 + (t & 15); u.pn = L & 3; u.k0 = 0; u.nk = 0; return true; }
        L -= 256; if (L >= 16 * nsplit) return false;
        const int t = L / nsplit, s = L - t * nsplit;
        u.pm = (t >> 2) * 17; u.pn = t & 3; u.k0 = s * nkt * 64; u.nk = nkt; return true;
    }
    __device__ __forceinline__ void a_ready(const Unit&) const {}
    __device__ __forceinline__ void done(const Unit&) const {}
};
template <int KT, class Epi, class Sched, bool ALIGN_EPI = false, bool SP2 = false>
__device__ __forceinline__ void gemm_phase(PG8_LAS unsigned char* lds, const Gemm g, const Sched& S, const Epi& E, const int tid) {
    const int wid = __builtin_amdgcn_readfirstlane(tid >> 6), lane = tid & 63, wr = wid >> 2, wc = wid & 3, fr = lane & 15, fq = lane >> 4;
    constexpr int K = KT, nt = K / BK;
    unsigned voffA[2], voffB[2];
#pragma unroll
    for (int i = 0; i < 2; ++i) { int R, C; stage_rc(tid * 16 + i * 8192, R, C); const int Rb = Epi::PERM ? ((R & ~31) + perm32(R & 31)) : R;
        voffA[i] = (unsigned)(R * K + C) * 2u; voffB[i] = (unsigned)(Rb * K + C) * 2u; }
    const size_t kstep = (size_t)(BK * 2);
    const size_t hstep = (size_t)HALF * K * 2;
    const size_t tstep = 2 * hstep;
    const unsigned ldsw = (unsigned)wid * 1024u;
    const int aoff = lds_byte(wr * 64 + fr, fq * 8), boff = lds_byte(wc * 32 + fr, fq * 8);
#define PG8_SA(b, h) (((b) * 2 + (h)) * HTB)
#define PG8_SB(b, h) ((4 + (b) * 2 + (h)) * HTB)
#define PG8_STAGE(bufoff, gbase, voff) do { _Pragma("unroll") for (int _i = 0; _i < 2; ++_i) \
        __builtin_amdgcn_global_load_lds((const unsigned*)((const char*)(gbase) + (voff)[_i]), (PG8_LAS unsigned*)(lds + (bufoff) + ldsw + _i * 8192), 16, 0, 0); } while (0)
#define PG8_LDA(dst, b, h) do { _Pragma("unroll") for (int m = 0; m < 4; ++m) _Pragma("unroll") for (int k = 0; k < 2; ++k) dst[m][k] = *(const PG8_LAS bf16x8*)(lds + PG8_SA(b, h) + aoff + m * 2048 + k * 1024); } while (0)
#define PG8_LDB(dst, b, h) do { _Pragma("unroll") for (int n = 0; n < 2; ++n) _Pragma("unroll") for (int k = 0; k < 2; ++k) dst[n][k] = *(const PG8_LAS bf16x8*)(lds + PG8_SB(b, h) + boff + n * 2048 + k * 1024); } while (0)
#define PG8_MMA(ai, bj, At, Bt) do { __builtin_amdgcn_s_setprio(1); _Pragma("unroll") for (int m = 0; m < 4; ++m) _Pragma("unroll") for (int n = 0; n < 2; ++n) _Pragma("unroll") for (int k = 0; k < 2; ++k) \
        acc[ai][bj][m][n] = __builtin_amdgcn_mfma_f32_16x16x32_bf16(Bt[n][k], At[m][k], acc[ai][bj][m][n], 0, 0, 0); __builtin_amdgcn_s_setprio(0); } while (0)
#define PG8_WAIT_V(n) asm volatile("s_waitcnt vmcnt(" #n ")" ::: "memory")
#define PG8_WAIT_L(n) asm volatile("s_waitcnt lgkmcnt(" #n ")" ::: "memory")
#define PG8_BAR __builtin_amdgcn_s_barrier()
#define PG8_SCHED __builtin_amdgcn_sched_barrier(0)
    Unit cur{0, 0, 0, 0}, nxt{0, 0, 0, 0}; int ui = 0;
    if (!S.next(0, cur)) return;
    f32x4 acc[2][2][4][2];
#pragma unroll
    for (int a = 0; a < 2; ++a)
#pragma unroll
        for (int b = 0; b < 2; ++b)
#pragma unroll
            for (int m = 0; m < 4; ++m)
#pragma unroll
                for (int n = 0; n < 2; ++n) acc[a][b][m][n] = (f32x4){0.f, 0.f, 0.f, 0.f};
    bf16x8 At[4][2], B0[2][2], B1[2][2];
    const char* cA = (const char*)g.A + (size_t)cur.pm * tstep + (size_t)cur.k0 * 2; const char* cB = (const char*)g.Bt + (size_t)cur.pn * tstep + (size_t)cur.k0 * 2;
    S.a_ready(cur);
    if constexpr (SP2) {
        PG8_STAGE(PG8_SB(0, 0), cB, voffB); PG8_STAGE(PG8_SB(0, 1), cB + hstep, voffB); PG8_STAGE(PG8_SA(0, 0), cA, voffA); PG8_STAGE(PG8_SA(0, 1), cA + hstep, voffA);
        if (wr == 1) PG8_BAR;
        PG8_WAIT_V(2); PG8_BAR;
        PG8_STAGE(PG8_SB(1, 0), cB + kstep, voffB); PG8_STAGE(PG8_SA(1, 0), cA + kstep, voffA); PG8_STAGE(PG8_SB(1, 1), cB + hstep + kstep, voffB);
        PG8_WAIT_V(6); PG8_BAR;
    } else {
        PG8_STAGE(PG8_SB(0, 0), cB, voffB); PG8_STAGE(PG8_SA(0, 0), cA, voffA); PG8_STAGE(PG8_SB(0, 1), cB + hstep, voffB); PG8_STAGE(PG8_SA(0, 1), cA + hstep, voffA);
        if (wr == 1) PG8_BAR;
        PG8_WAIT_V(4); PG8_BAR;
        PG8_STAGE(PG8_SB(1, 0), cB + kstep, voffB); PG8_STAGE(PG8_SA(1, 0), cA + kstep, voffA); PG8_STAGE(PG8_SB(1, 1), cB + hstep + kstep, voffB);
        PG8_WAIT_V(6); PG8_BAR;
    }
    for (;;) {
        const bool has_next = S.next(ui + 1, nxt);
        const char* nA = has_next ? (const char*)g.A + (size_t)nxt.pm * tstep + (size_t)nxt.k0 * 2 : cA; const char* nB = has_next ? (const char*)g.Bt + (size_t)nxt.pn * tstep + (size_t)nxt.k0 * 2 : cB;
        const int ntu = cur.nk ? cur.nk : nt;
        for (int t = 0; t < ntu; t += 2) {
            const bool last = (t == ntu - 2);
            const char* a1 = cA + (size_t)(t + 1) * kstep;
            const char* a2 = last ? nA : cA + (size_t)(t + 2) * kstep; const char* b2 = last ? nB : cB + (size_t)(t + 2) * kstep;
            const char* a3 = a2 + kstep; const char* b3 = b2 + kstep;
            if (last && has_next) S.a_ready(nxt);
            if constexpr (SP2) {
            PG8_LDB(B0, 0, 0); PG8_LDB(B1, 0, 1); PG8_SCHED; PG8_LDA(At, 0, 0); PG8_STAGE(PG8_SA(1, 1), a1 + hstep, voffA);
            PG8_WAIT_V(8); PG8_WAIT_L(0); PG8_BAR; PG8_MMA(0, 0, At, B0); PG8_MMA(0, 1, At, B1); PG8_BAR; PG8_SCHED;
            PG8_LDA(At, 0, 1); PG8_STAGE(PG8_SB(0, 0), b2, voffB); PG8_STAGE(PG8_SB(0, 1), b2 + hstep, voffB); PG8_STAGE(PG8_SA(0, 0), a2, voffA);
            PG8_WAIT_V(8); PG8_WAIT_L(0); PG8_BAR; PG8_MMA(1, 0, At, B0); PG8_MMA(1, 1, At, B1); PG8_BAR; PG8_SCHED;
            PG8_LDB(B0, 1, 0); PG8_LDB(B1, 1, 1); PG8_SCHED; PG8_LDA(At, 1, 0); PG8_STAGE(PG8_SA(0, 1), a2 + hstep, voffA);
            PG8_WAIT_V(8); PG8_WAIT_L(0); PG8_BAR; PG8_MMA(0, 0, At, B0); PG8_MMA(0, 1, At, B1); PG8_BAR; PG8_SCHED;
            PG8_LDA(At, 1, 1); PG8_STAGE(PG8_SB(1, 0), b3, voffB); PG8_STAGE(PG8_SB(1, 1), b3 + hstep, voffB); PG8_STAGE(PG8_SA(1, 0), a3, voffA);
            PG8_WAIT_V(8); PG8_WAIT_L(0); PG8_BAR; PG8_MMA(1, 0, At, B0); PG8_MMA(1, 1, At, B1); PG8_BAR; PG8_SCHED;
            } else {
            PG8_LDB(B0, 0, 0); PG8_SCHED; PG8_LDA(At, 0, 0); PG8_STAGE(PG8_SA(1, 1), a1 + hstep, voffA);
            PG8_WAIT_L(8); PG8_BAR; PG8_WAIT_L(0); PG8_MMA(0, 0, At, B0); PG8_BAR; PG8_SCHED;
            PG8_LDB(B1, 0, 1); PG8_STAGE(PG8_SB(0, 0), b2, voffB);
            PG8_BAR; PG8_WAIT_L(0); PG8_MMA(0, 1, At, B1); PG8_BAR;
            PG8_LDA(At, 0, 1); PG8_STAGE(PG8_SA(0, 0), a2, voffA);
            PG8_BAR; PG8_WAIT_L(0); PG8_MMA(1, 0, At, B0); PG8_BAR; PG8_SCHED;
            PG8_STAGE(PG8_SB(0, 1), b2 + hstep, voffB);
            PG8_WAIT_V(6); PG8_BAR; PG8_MMA(1, 1, At, B1); PG8_BAR;
            PG8_LDB(B0, 1, 0); PG8_SCHED; PG8_LDA(At, 1, 0); PG8_STAGE(PG8_SA(0, 1), a2 + hstep, voffA);
            PG8_WAIT_L(8); PG8_BAR; PG8_WAIT_L(0); PG8_MMA(0, 0, At, B0); PG8_BAR; PG8_SCHED;
            PG8_LDB(B1, 1, 1); PG8_STAGE(PG8_SB(1, 0), b3, voffB);
            PG8_BAR; PG8_WAIT_L(0); PG8_MMA(0, 1, At, B1); PG8_BAR;
            PG8_LDA(At, 1, 1); PG8_STAGE(PG8_SA(1, 0), a3, voffA);
            PG8_BAR; PG8_WAIT_L(0); PG8_MMA(1, 0, At, B0); PG8_BAR; PG8_SCHED;
            PG8_STAGE(PG8_SB(1, 1), b3 + hstep, voffB);
            PG8_WAIT_V(6); PG8_BAR; PG8_MMA(1, 1, At, B1); PG8_BAR;
            }
        }
        if constexpr (ALIGN_EPI) { if (wr == 0) PG8_BAR; }
        bool keep_acc = false;
        if constexpr (!Epi::AFTER_DRAIN) { if constexpr (Epi::CHAIN) keep_acc = E.chain(acc, cur, wr, wc, fr, fq); else E(acc, cur, wr, wc, fr, fq); S.done(cur); }
        if (!has_next) break;
        if (!keep_acc) {
#pragma unroll
        for (int a = 0; a < 2; ++a)
#pragma unroll
            for (int b = 0; b < 2; ++b)
#pragma unroll
                for (int m = 0; m < 4; ++m)
#pragma unroll
                    for (int n = 0; n < 2; ++n) acc[a][b][m][n] = (f32x4){0.f, 0.f, 0.f, 0.f};
        }
        cur = nxt; cA = nA; cB = nB; ++ui;
        if constexpr (ALIGN_EPI) { if (wr == 1) PG8_BAR; }
    }
    PG8_WAIT_V(0);
    if constexpr (!ALIGN_EPI) { if (wr == 0) PG8_BAR; }
    PG8_BAR;
    if constexpr (Epi::AFTER_DRAIN) { E.fused(acc, cur, wr, wc, fr, fq, lds, wid, lane); S.done(cur); }
#undef PG8_SA
#undef PG8_SB
#undef PG8_STAGE
#undef PG8_LDA
#undef PG8_LDB
#undef PG8_MMA
#undef PG8_WAIT_V
#undef PG8_WAIT_L
#undef PG8_BAR
#undef PG8_SCHED
}
}
namespace attn_body {
using bf16=__hip_bfloat16;
using bf16x8=__attribute__((ext_vector_type(8)))short;
using s16x4=__attribute__((ext_vector_type(4)))short;
using f32x16=__attribute__((ext_vector_type(16)))float;
using u32x4=__attribute__((ext_vector_type(4)))unsigned;
constexpr int D=64,QP=512,KP=128,VP=6912,OP=512;
constexpr int NW=8,QBLK=32,QB=QBLK*NW,KVBLK=64;
__device__ __forceinline__ int crow(int r,int hi){return (r&3)+8*(r>>2)+4*hi;}
#define SBAR() __builtin_amdgcn_sched_barrier(0)
constexpr int NSLOT=3, SLOTB=8192;
constexpr int LDS_K=0, LDS_V=NSLOT*SLOTB, LDS_WS=2*NSLOT*SLOTB, LDS_OST=LDS_WS+NW*64*4, LDS_BYTES=LDS_OST+NW*4096;
constexpr float C2=0.125f*1.4426950408889634f;
__device__ __forceinline__ void glds16(const void*gsrc,unsigned lds_dst){unsigned keep;
  asm volatile("s_mov_b32 %0, m0\n\ts_mov_b32 m0, %2\n\ts_nop 0\n\tglobal_load_lds_dwordx4 %1, off\n\ts_mov_b32 m0, %0":"=&s"(keep):"v"(gsrc),"s"(lds_dst):"memory");}
__device__ __forceinline__ float max3f(float a,float b,float c){float r;asm("v_max3_f32 %0, %1, %2, %3":"=v"(r):"v"(a),"v"(b),"v"(c));return r;}
__device__ __forceinline__ float max2f(float a,float b){float r;asm("v_max_f32_e32 %0, %1, %2":"=v"(r):"v"(a),"v"(b));return r;}
__device__ __forceinline__ float fadd_s(float a,float b){float r;asm("v_add_f32_e32 %0, %1, %2":"=v"(r):"v"(a),"v"(b));return r;}
__device__ __forceinline__ float fsub_s(float a,float b){float r;asm("v_sub_f32_e32 %0, %1, %2":"=v"(r):"v"(a),"v"(b));return r;}
typedef float f32x2_t __attribute__((ext_vector_type(2))); typedef __bf16 bf16x2_t __attribute__((ext_vector_type(2)));
__device__ __forceinline__ unsigned cvtpk_s(float lo,float hi){f32x2_t v={lo,hi};bf16x2_t b=__builtin_convertvector(v,bf16x2_t);return __builtin_bit_cast(unsigned,b);}
#define WAIT_BAR(N) asm volatile("s_waitcnt vmcnt(" #N ") lgkmcnt(0)\n\ts_barrier":::"memory")

__device__ __forceinline__ void qkt(f32x16&p0,f32x16&p1,const char*Kslot,const bf16x8*qr,const f32x16&negm,int r32,int hi){
  const char*kb=Kslot+hi*1024+r32*16;
  #pragma unroll
  for(int d0=0;d0<4;++d0){
    const bf16x8 b0=*reinterpret_cast<const bf16x8*>(kb+d0*2048);
    const bf16x8 b1=*reinterpret_cast<const bf16x8*>(kb+d0*2048+512);
    if(d0==0){p0=__builtin_amdgcn_mfma_f32_32x32x16_bf16(b0,qr[0],negm,0,0,0);p1=__builtin_amdgcn_mfma_f32_32x32x16_bf16(b1,qr[0],negm,0,0,0);}
    else{p0=__builtin_amdgcn_mfma_f32_32x32x16_bf16(b0,qr[d0],p0,0,0,0);p1=__builtin_amdgcn_mfma_f32_32x32x16_bf16(b1,qr[d0],p1,0,0,0);}}
}
typedef __attribute__((address_space(3))) const char* lds_cptr;
typedef short v4i16_t __attribute__((ext_vector_type(4)));
__device__ __forceinline__ void kload8(bf16x8*kf,lds_cptr kp){
  kf[0]=*(const __attribute__((address_space(3))) bf16x8*)(kp);      kf[1]=*(const __attribute__((address_space(3))) bf16x8*)(kp+512);
  kf[2]=*(const __attribute__((address_space(3))) bf16x8*)(kp+2048); kf[3]=*(const __attribute__((address_space(3))) bf16x8*)(kp+2560);
  kf[4]=*(const __attribute__((address_space(3))) bf16x8*)(kp+4096); kf[5]=*(const __attribute__((address_space(3))) bf16x8*)(kp+4608);
  kf[6]=*(const __attribute__((address_space(3))) bf16x8*)(kp+6144); kf[7]=*(const __attribute__((address_space(3))) bf16x8*)(kp+6656);
}
__device__ __forceinline__ void kload2(bf16x8*kf,lds_cptr kp,int j){ kf[2*j]=*(const __attribute__((address_space(3))) bf16x8*)(kp+j*2048); kf[2*j+1]=*(const __attribute__((address_space(3))) bf16x8*)(kp+j*2048+512); }
__device__ __forceinline__ s16x4 vtr(lds_cptr p){ return __builtin_bit_cast(s16x4,__builtin_amdgcn_ds_read_tr16_b64_v4i16((__attribute__((address_space(3))) v4i16_t*)p)); }
__device__ __forceinline__ float rowmax(const f32x16&p0,const f32x16&p1){
  float a=max3f(p0[0],p0[1],p1[0]),b=max3f(p0[2],p0[3],p1[1]);a=max3f(a,p1[2],p1[3]);
  #pragma unroll
  for(int r=4;r<16;r+=4){a=max3f(a,p0[r],p0[r+1]);b=max3f(b,p0[r+2],p0[r+3]);a=max3f(a,p1[r],p1[r+1]);b=max3f(b,p1[r+2],p1[r+3]);}
  const float m=max2f(a,b);
  auto rr=__builtin_amdgcn_permlane32_swap(__float_as_uint(m),__float_as_uint(m),false,false);
  return max2f(__uint_as_float(rr[0]),__uint_as_float(rr[1]));
}
__device__ __forceinline__ void pv(f32x16*o,int vb,bf16x8 pa0,bf16x8 pa1,bf16x8 pa2,bf16x8 pa3){
  #pragma unroll
  for(int d0=0;d0<2;++d0){s16x4 lo[4],hi[4];
    #pragma unroll
    for(int ks=0;ks<4;++ks){
      asm volatile("ds_read_b64_tr_b16 %0,%1 offset:%c2":"=&v"(lo[ks]):"v"(vb),"i"(d0*4096+ks*1024):"memory");
      asm volatile("ds_read_b64_tr_b16 %0,%1 offset:%c2":"=&v"(hi[ks]):"v"(vb),"i"(d0*4096+ks*1024+512):"memory");}
    asm volatile("s_waitcnt lgkmcnt(0)":::"memory");SBAR();
    #define PK(k) (bf16x8){lo[k][0],lo[k][1],lo[k][2],lo[k][3],hi[k][0],hi[k][1],hi[k][2],hi[k][3]}
    o[d0]=__builtin_amdgcn_mfma_f32_32x32x16_bf16(pa0,PK(0),o[d0],0,0,0);
    o[d0]=__builtin_amdgcn_mfma_f32_32x32x16_bf16(pa1,PK(1),o[d0],0,0,0);
    o[d0]=__builtin_amdgcn_mfma_f32_32x32x16_bf16(pa2,PK(2),o[d0],0,0,0);
    o[d0]=__builtin_amdgcn_mfma_f32_32x32x16_bf16(pa3,PK(3),o[d0],0,0,0);
    #undef PK
  }
}

#ifndef ATTN_STORE16
#define ATTN_STORE16(p,v) (*(u32x4*)(p)=(v))
#endif
template<int THRL> __device__ __forceinline__ void attn_unit(long qrow0,long kvrow0,int hq,int kvh,int NT,const bf16*Q,const bf16*__restrict__ K,const bf16*__restrict__ V,bf16*O,char*shm,const int tid){
  const int lane=tid&63,r32=lane&31,hi=lane>>5; const int wid=__builtin_amdgcn_readfirstlane(tid>>6);
  const bf16*Qw=Q+(qrow0+wid*QBLK)*QP+hq*D;
  const bf16*Kh=K+kvrow0*KP+kvh*D,*Vh=V+kvrow0*VP+kvh*D;
  const unsigned lds0=(unsigned)(uintptr_t)shm;
  float*wsf=(float*)(shm+LDS_WS)+wid*64;
  const bf16*ksrc=Kh+(long)lane*KP+wid*8;
  const bf16*vsrc=Vh+(long)(16*(wid&3)+(lane>>2))*VP+(wid>>2)*32+(lane&3)*8;
  const unsigned kdst=lds0+LDS_K+wid*1024, vdst=lds0+LDS_V+wid*1024;
  #define DMA_K(t,slot) glds16(ksrc+(long)(t)*KVBLK*KP,(unsigned)__builtin_amdgcn_readfirstlane(kdst+(slot)))
  #define DMA_V(t,slot) glds16(vsrc+(long)(t)*KVBLK*VP,(unsigned)__builtin_amdgcn_readfirstlane(vdst+(slot)))
  const int vb0=(int)(lds0+LDS_V)+((lane>>4)&1)*32+(lane&3)*8+(4*hi+((lane&15)>>2))*64;
  const char*Kbase=shm+LDS_K; bf16x8 kf[8];
  const lds_cptr shm3=(lds_cptr)shm; const lds_cptr kp0=shm3+LDS_K+hi*1024+r32*16; const lds_cptr vp0=shm3+LDS_V+((lane>>4)&1)*32+(lane&3)*8+(4*hi+((lane&15)>>2))*64;
  DMA_K(0,0);DMA_V(0,0);DMA_K(1,SLOTB);
  bf16x8 qr[4];
  #pragma unroll
  for(int d0=0;d0<4;++d0)qr[d0]=*reinterpret_cast<const bf16x8*>(&Qw[(long)r32*QP+d0*16+hi*8]);
  float mhat=0.f,l_reg=0.f;float z0_=0.f;asm volatile("":"+v"(z0_));f32x16 o[2];f32x16 negm;
  #pragma unroll
  for(int r=0;r<16;++r){o[0][r]=z0_;o[1][r]=z0_;negm[r]=z0_;}
  asm volatile("":"+v"(negm));
  #define CMASK(P0,P1,t) do{}while(0)
  bool resc=false;
  #define START(P0,P1) do{ const float rm=rowmax(P0,P1); resc=false; \
    { const float dl=rm; mhat=fadd_s(mhat,dl); \
      _Pragma("unroll") for(int r=0;r<16;++r){P0[r]=fsub_s(P0[r],dl);P1[r]=fsub_s(P1[r],dl);} \
      _Pragma("unroll") for(int r=0;r<16;++r)negm[r]=-mhat; asm volatile("":"+v"(negm)); } \
    _Pragma("unroll") for(int r=0;r<16;++r)P0[r]=__builtin_amdgcn_exp2f(P0[r]); }while(0)
  #define RESC() do{ if(resc){ asm volatile("s_waitcnt lgkmcnt(0)":::"memory"); \
      _Pragma("unroll") for(int d_=0;d_<2;++d_) _Pragma("unroll") for(int r=0;r<16;++r)o[d_][r]*=wsf[crow(r,hi)]; } }while(0)
  f32x16 pA0,pA1,pB0,pB1;
  int sl_prev=0,sl_cur=0,sl_next=SLOTB;
  #define ROT() do{sl_prev=sl_cur;sl_cur=sl_next;sl_next=(sl_next==(NSLOT-1)*SLOTB)?0:sl_next+SLOTB;}while(0)
  DMA_K(2,2*SLOTB);
  WAIT_BAR(3);
  qkt(pA0,pA1,Kbase,qr,negm,r32,hi);asm volatile("s_nop 15\n\ts_nop 7":"+v"(pA0),"+v"(pA1));CMASK(pA0,pA1,0);
  START(pA0,pA1);
  _Pragma("unroll") for(int r=0;r<16;++r)pA1[r]=__builtin_amdgcn_exp2f(pA1[r]);
  WAIT_BAR(0);
  DMA_K(3,0);DMA_V(1,SLOTB);
  ROT();
  kload8(kf,kp0+sl_cur);
  WAIT_BAR(2);
  s16x4 vlo[8],vhi[8]; u32x4 pw0,pw1,pw2,pw3;
  #define PKW(P,B) cvtpk_s(P[B],P[B+1])
  #define PAF(k) __builtin_bit_cast(bf16x8,pw##k)
  #define VFR(i) (bf16x8){vlo[i][0],vlo[i][1],vlo[i][2],vlo[i][3],vhi[i][0],vhi[i][1],vhi[i][2],vhi[i][3]}
  #define PIN(x) asm volatile("":"+v"(x))
  #define MX3(a,b,c) __builtin_fmaxf(__builtin_fmaxf((a),(b)),(c))
  #define GAPA(MF,A0,A1,A2,A3,W0,W1,PW) do{ MF; sacc+=A0; sacc+=A1; sacc+=A2; sacc+=A3; PIN(sacc); W0; W1; PIN(PW); SBAR(); }while(0)
  #define EX(v) __builtin_amdgcn_exp2f(v)
  #define GAPB(MF,X,B) do{ MF; X[B]=EX(X[B]); X[B+1]=EX(X[B+1]); X[B+2]=EX(X[B+2]); X[B+3]=EX(X[B+3]); PIN(X); SBAR(); }while(0)
  #define VRD(i) do{ vlo[i]=vtr(vp_+(((i)>>2)*4096+((i)&3)*1024)); vhi[i]=vtr(vp_+(((i)>>2)*4096+((i)&3)*1024+512)); }while(0)
  #define KRD(G,j) do{ if(G){ kload2(kf,kp0+sl_next,j); SBAR(); } }while(0)
  #define STEP(C0,C1,P0,P1,t,GK,GV,GL) do{ SBAR(); \
    const lds_cptr vp_=vp0+sl_prev; \
    VRD(0); SBAR(); float sacc=(P0[0]+P0[1]); \
    GAPA(C0=__builtin_amdgcn_mfma_f32_32x32x16_bf16(kf[0],qr[0],negm,0,0,0), P0[2],P0[3],P0[4],P0[5],     pw0[0]=PKW(P0,0), pw0[1]=PKW(P0,2), pw0); \
    VRD(4); SBAR(); GAPA(C1=__builtin_amdgcn_mfma_f32_32x32x16_bf16(kf[1],qr[0],negm,0,0,0), P0[6],P0[7],P0[8],P0[9],     pw0[2]=PKW(P0,4), pw0[3]=PKW(P0,6), pw0); \
    VRD(1); SBAR(); GAPA(C0=__builtin_amdgcn_mfma_f32_32x32x16_bf16(kf[2],qr[1],C0,0,0,0),   P0[10],P0[11],P0[12],P0[13], pw1[0]=PKW(P0,8), pw1[1]=PKW(P0,10), pw1); \
    VRD(5); SBAR(); GAPA(C1=__builtin_amdgcn_mfma_f32_32x32x16_bf16(kf[3],qr[1],C1,0,0,0),   P0[14],P0[15],P1[0],P1[1],   pw1[2]=PKW(P0,12),pw1[3]=PKW(P0,14), pw1); \
    VRD(2); SBAR(); GAPA(C0=__builtin_amdgcn_mfma_f32_32x32x16_bf16(kf[4],qr[2],C0,0,0,0),   P1[2],P1[3],P1[4],P1[5],     pw2[0]=PKW(P1,0), pw2[1]=PKW(P1,2), pw2); \
    VRD(6); SBAR(); GAPA(C1=__builtin_amdgcn_mfma_f32_32x32x16_bf16(kf[5],qr[2],C1,0,0,0),   P1[6],P1[7],P1[8],P1[9],     pw2[2]=PKW(P1,4), pw2[3]=PKW(P1,6), pw2); \
    VRD(3); SBAR(); GAPA(C0=__builtin_amdgcn_mfma_f32_32x32x16_bf16(kf[6],qr[3],C0,0,0,0),   P1[10],P1[11],P1[12],P1[13], pw3[0]=PKW(P1,8), pw3[1]=PKW(P1,10), pw3); \
    VRD(7); SBAR(); GAPA(C1=__builtin_amdgcn_mfma_f32_32x32x16_bf16(kf[7],qr[3],C1,0,0,0),   P1[14],P1[15],0.f,0.f,       pw3[2]=PKW(P1,12),pw3[3]=PKW(P1,14), pw3); \
    l_reg+=sacc; \
    if(GK){DMA_K((t)+3,sl_cur);} if(GV){DMA_V((t)+1,sl_next);} \
    CMASK(C0,C1,t); \
    { float a=MX3(C0[0],C0[1],C1[0]),b=MX3(C0[2],C0[3],C1[1]); a=MX3(a,C1[2],C1[3]); \
      _Pragma("unroll") for(int r=4;r<16;r+=4){a=MX3(a,C0[r],C0[r+1]);b=MX3(b,C0[r+2],C0[r+3]);a=MX3(a,C1[r],C1[r+1]);b=MX3(b,C1[r+2],C1[r+3]);} \
      float rm=__builtin_fmaxf(a,b); { auto rr=__builtin_amdgcn_permlane32_swap(__float_as_uint(rm),__float_as_uint(rm),false,false); rm=__builtin_fmaxf(__uint_as_float(rr[0]),__uint_as_float(rr[1])); } \
      resc=false; \
      if(__builtin_expect(__any(rm>(float)THRL),0)){ const float dl=__builtin_fmaxf(rm,0.f); mhat+=dl; \
        _Pragma("unroll") for(int r=0;r<16;++r){C0[r]-=dl;C1[r]-=dl;} \
        _Pragma("unroll") for(int r=0;r<16;++r)negm[r]=-mhat; asm volatile("":"+v"(negm)); \
        const float f=__builtin_amdgcn_exp2f(-dl); l_reg*=f; if(hi==0)wsf[r32]=f; resc=true; } } \
    SBAR(); \
    GAPB(o[0]=__builtin_amdgcn_mfma_f32_32x32x16_bf16(PAF(0),VFR(0),o[0],0,0,0), C0,0); \
    GAPB(o[1]=__builtin_amdgcn_mfma_f32_32x32x16_bf16(PAF(0),VFR(4),o[1],0,0,0), C0,4); \
    KRD(GL,0); GAPB(o[0]=__builtin_amdgcn_mfma_f32_32x32x16_bf16(PAF(1),VFR(1),o[0],0,0,0), C0,8); \
    KRD(GL,1); GAPB(o[1]=__builtin_amdgcn_mfma_f32_32x32x16_bf16(PAF(1),VFR(5),o[1],0,0,0), C0,12); \
    KRD(GL,2); GAPB(o[0]=__builtin_amdgcn_mfma_f32_32x32x16_bf16(PAF(2),VFR(2),o[0],0,0,0), C1,0); \
    KRD(GL,3); GAPB(o[1]=__builtin_amdgcn_mfma_f32_32x32x16_bf16(PAF(2),VFR(6),o[1],0,0,0), C1,4); \
    GAPB(o[0]=__builtin_amdgcn_mfma_f32_32x32x16_bf16(PAF(3),VFR(3),o[0],0,0,0), C1,8); \
    GAPB(o[1]=__builtin_amdgcn_mfma_f32_32x32x16_bf16(PAF(3),VFR(7),o[1],0,0,0), C1,12); \
    }while(0)
  int t=1;
  #undef CMASK
  #define CMASK(P0,P1,t) do{}while(0)
  for(;t+5<NT;t+=2){
    STEP(pB0,pB1,pA0,pA1,t,true,true,true);     WAIT_BAR(2); RESC(); ROT();
    STEP(pA0,pA1,pB0,pB1,t+1,true,true,true);   WAIT_BAR(2); RESC(); ROT();
  }
  #undef CMASK
  #define CMASK(P0,P1,t) do{}while(0)
  #define ENDW(tt) do{ if((tt)+3<NT){WAIT_BAR(2);} else if((tt)+2<NT){WAIT_BAR(1);} else {WAIT_BAR(0);} }while(0)
  for(;t+1<NT;t+=2){
    STEP(pB0,pB1,pA0,pA1,t,(t+3<NT),(t+1<NT),(t+1<NT));       ENDW(t);   RESC(); ROT();
    STEP(pA0,pA1,pB0,pB1,t+1,(t+4<NT),(t+2<NT),(t+2<NT));     ENDW(t+1); RESC(); ROT();
  }
  STEP(pB0,pB1,pA0,pA1,NT-1,false,false,false); RESC();
  { float sacc=pB0[0]+pB0[1]; _Pragma("unroll") for(int r=2;r<16;++r)sacc+=pB0[r]; _Pragma("unroll") for(int r=0;r<16;++r)sacc+=pB1[r]; l_reg+=sacc;
    pw0=(u32x4){PKW(pB0,0),PKW(pB0,2),PKW(pB0,4),PKW(pB0,6)};pw1=(u32x4){PKW(pB0,8),PKW(pB0,10),PKW(pB0,12),PKW(pB0,14)};pw2=(u32x4){PKW(pB1,0),PKW(pB1,2),PKW(pB1,4),PKW(pB1,6)};pw3=(u32x4){PKW(pB1,8),PKW(pB1,10),PKW(pB1,12),PKW(pB1,14)};
    SBAR(); pv(o,vb0+sl_cur,PAF(0),PAF(1),PAF(2),PAF(3)); }
  #undef PKW
  #undef PAF
  #undef VFR
  #undef PIN
  #undef MX3
  #undef GAPA
  #undef GAPB
  #undef EX
  #undef VRD
  #undef KRD
  #undef STEP
  #undef ENDW
  {auto rr=__builtin_amdgcn_permlane32_swap(__float_as_uint(l_reg),__float_as_uint(l_reg),false,false);l_reg=__uint_as_float(rr[0])+__uint_as_float(rr[1]);}
  if(hi==0)wsf[32+r32]=l_reg;asm volatile("s_waitcnt lgkmcnt(0)":::"memory");
  float rli[16];
  #pragma unroll
  for(int r=0;r<16;++r)rli[r]=__builtin_amdgcn_rcpf(wsf[32+crow(r,hi)]);
  bf16*Ow=O+(qrow0+wid*QBLK)*OP+hq*D;
  { bf16*stg=(bf16*)(shm+LDS_OST)+wid*2048;
    #pragma unroll
    for(int r=0;r<16;++r){const int orow=crow(r,hi);
      #pragma unroll
      for(int d0=0;d0<2;++d0)stg[orow*64+d0*32+r32]=__float2bfloat16(o[d0][r]*rli[r]);}
    asm volatile("s_waitcnt lgkmcnt(0)":::"memory");
    #pragma unroll
    for(int i=0;i<4;++i){const int row=i*8+(lane>>3),ch=lane&7; const u32x4 v=*(const u32x4*)(stg+row*64+ch*8); ATTN_STORE16(Ow+(long)row*OP+ch*8,v);} }
  asm volatile("s_waitcnt lgkmcnt(0)\n\ts_barrier":::"memory");
  #undef DMA_K
  #undef DMA_V
  #undef CMASK
  #undef START
  #undef RESC
  #undef ROT
}
constexpr int ATTN_LDS_BYTES=LDS_BYTES;
#undef SBAR
#undef WAIT_BAR
}
#define LAS __attribute__((address_space(3)))
typedef unsigned short bf16;
typedef unsigned v4u __attribute__((ext_vector_type(4)));
typedef unsigned v2u __attribute__((ext_vector_type(2)));
typedef float f32x4 __attribute__((ext_vector_type(4)));
typedef short bf16x8 __attribute__((ext_vector_type(8)));
constexpr int NWAVES = 8;
constexpr int NB = 4, LAT = 4096, LCTX = 256, SROW = 4352, MTOK = 17408, DMODEL = 1024, DEPTH = 4, DFF = 2816, DIN = 6912, MODW = 9216;
constexpr int ZC_RQ = 0, ZC_RK = 512, ZC_RV = 1024, ZC_RG = 1536, ZC_LX = 2048, ZC_LZ = 2560, ZC_AQ = 3072, ZC_AK = 3584, ZC_AV = 3712, ZC_GT = 3840;
constexpr float NORM_EPS = 1e-6f;
constexpr size_t MiB = 1u << 20;
constexpr size_t WS_MOD = 1 * MiB, WS_ROPE = 2 * MiB, WS_SUMM = 3 * MiB, WS_HIN = 6 * MiB;
constexpr size_t WS_WSET = 54 * MiB;
constexpr size_t WS_WFI = 8 * MiB;
constexpr size_t WS_WFO = 30 * MiB;
constexpr size_t WS_WIN = 41 * MiB;
constexpr size_t WS_WB = 55 * MiB;
constexpr size_t WS_WO = 58 * MiB;
constexpr size_t WS_LRUW = 60 * MiB;
constexpr size_t WS_X = 116 * MiB;
constexpr size_t WS_HN = 184 * MiB;
constexpr size_t WS_Z = 218 * MiB;
constexpr size_t WS_QN = 448 * MiB;
constexpr size_t WS_KN = 465 * MiB;
constexpr size_t WS_Y = 470 * MiB;
constexpr size_t WS_U = 521 * MiB;
constexpr size_t WS_SIN = 589 * MiB;
constexpr size_t WS_PARTC = 624 * MiB;
constexpr size_t WS_END = 670 * MiB;
constexpr int LDS_BYTES = 147456;

__device__ __forceinline__ unsigned f2bf(float f) { unsigned u = __builtin_bit_cast(unsigned, f); return (u + 0x7fffu + ((u >> 16) & 1u)) >> 16; }
__device__ __forceinline__ unsigned pk2(float lo, float hi) { return f2bf(lo) | (f2bf(hi) << 16); }
__device__ __forceinline__ float bflo(unsigned w) { return __uint_as_float(w << 16); }
__device__ __forceinline__ float bfhi(unsigned w) { return __uint_as_float(w & 0xffff0000u); }
__device__ __forceinline__ float bf1(bf16 h) { return __uint_as_float(((unsigned)h) << 16); }
__device__ __forceinline__ void unpack8(const v4u w, float* f) { f[0] = bflo(w.x); f[1] = bfhi(w.x); f[2] = bflo(w.y); f[3] = bfhi(w.y); f[4] = bflo(w.z); f[5] = bfhi(w.z); f[6] = bflo(w.w); f[7] = bfhi(w.w); }
__device__ __forceinline__ float sigmoidf_(float v) { return __builtin_amdgcn_rcpf(1.0f + __expf(-v)); }
__device__ __forceinline__ float shx(float v, int m, int lane) { return __builtin_bit_cast(float, __builtin_amdgcn_ds_bpermute((lane ^ m) << 2, __builtin_bit_cast(int, v))); }
__device__ __forceinline__ float shi(float v, int src) { return __builtin_bit_cast(float, __builtin_amdgcn_ds_bpermute(src << 2, __builtin_bit_cast(int, v))); }
__device__ __forceinline__ float wave_sum(float v, int lane) {
#pragma unroll
    for (int o = 1; o < 64; o <<= 1) v += shx(v, o, lane);
    return v;
}
#define LDS_WAIT() asm volatile("s_waitcnt lgkmcnt(0)" ::: "memory")

struct Args { const float* in[24]; float* out; unsigned char* ws; int ph_lo, ph_hi; };
constexpr int ARGS_LDS_OFF = 139520;
struct AH { const LAS unsigned* w;
    __device__ __forceinline__ const float* in(int i) const { const unsigned lo = __builtin_amdgcn_readfirstlane(w[2 * i]), hi = __builtin_amdgcn_readfirstlane(w[2 * i + 1]); return (const float*)(((unsigned long long)hi << 32) | lo); }
    __device__ __forceinline__ float* out() const { const unsigned lo = __builtin_amdgcn_readfirstlane(w[48]), hi = __builtin_amdgcn_readfirstlane(w[49]); return (float*)(((unsigned long long)hi << 32) | lo); }
    __device__ __forceinline__ unsigned char* ws() const { const unsigned lo = __builtin_amdgcn_readfirstlane(w[50]), hi = __builtin_amdgcn_readfirstlane(w[51]); return (unsigned char*)(((unsigned long long)hi << 32) | lo); }
};
enum { I_X = 0, I_C, I_CTX, I_CCTX, I_WMOD, I_BMOD, I_NORMG, I_FFNIN, I_FFNOUT, I_WIN, I_RETLOGIT, I_RETG, I_CONVW, I_CONVB, I_LWA, I_LBA, I_LWX, I_LBX, I_LAM, I_QG, I_KG, I_WBR, I_WOUT, I_FG };

__device__ __forceinline__ void tr_item(const float* W, int N, int k0, int n0, bf16* WT, int K, int orow0, LAS float* scr, int lane) {
    const float* src = W + (size_t)k0 * N + n0 + lane;
#pragma unroll 1
    for (int i = 0; i < 64; i += 16) { float v[16];
#pragma unroll
        for (int r = 0; r < 16; ++r) v[r] = src[(size_t)(i + r) * N];
#pragma unroll
        for (int r = 0; r < 16; ++r) scr[(i + r) * 65 + lane] = v[r]; }
    LDS_WAIT(); asm volatile("" ::: "memory");
    const int c = lane & 7;
#pragma unroll
    for (int j = 0; j < 8; ++j) { const int n = (lane >> 3) + 8 * j; const LAS float* s = scr + (8 * c) * 65 + n;
        v4u o; o.x = pk2(s[0 * 65], s[1 * 65]); o.y = pk2(s[2 * 65], s[3 * 65]); o.z = pk2(s[4 * 65], s[5 * 65]); o.w = pk2(s[6 * 65], s[7 * 65]);
        *(v4u*)(WT + (size_t)(orow0 + n) * K + k0 + 8 * c) = o; }
    LDS_WAIT(); asm volatile("" ::: "memory");
}

__device__ __forceinline__ void phase_p0(const AH A, LAS unsigned char* lds, int tid, int G) {
    unsigned char* ws = A.ws();
    constexpr int NGEMV = 144;
    const int bx = blockIdx.x;
    if (bx < NGEMV || G <= NGEMV) {
        LAS float* sv = (LAS float*)lds;
        LAS float* red = sv + 5 * 1024;
        const float* c = A.in(I_C); const float* cctx = A.in(I_CCTX);
        for (int i = tid; i < 5 * 1024; i += 512) { const int r = i >> 10, k = i & 1023; const float v = (r < 4) ? c[r * 1024 + k] : cctx[k]; sv[i] = v / (1.0f + __expf(-v)); }
        __syncthreads();
        float* modbuf = (float*)(ws + WS_MOD);
        const float* wmod = A.in(I_WMOD); const float* bmod = A.in(I_BMOD);
        for (int item = bx; item < NGEMV; item += G) {
            const int l = item / 36, n0 = (item - l * 36) * 256, c4 = tid & 63, kg = tid >> 6;
            const f32x4* W = (const f32x4*)(wmod + (size_t)l * 1024 * MODW + n0) + c4;
            f32x4 acc[5];
#pragma unroll
            for (int r = 0; r < 5; ++r) acc[r] = (f32x4){0.f, 0.f, 0.f, 0.f};
#pragma unroll 8
            for (int k = kg * 128; k < kg * 128 + 128; ++k) { const f32x4 w = W[(size_t)k * (MODW / 4)];
#pragma unroll
                for (int r = 0; r < 5; ++r) acc[r] += w * sv[r * 1024 + k]; }
#pragma unroll
            for (int r = 0; r < 5; ++r) *(LAS f32x4*)(red + (kg * 5 + r) * 256 + c4 * 4) = acc[r];
            __syncthreads();
            for (int o = tid; o < 5 * 256; o += 512) { const int r = o >> 8, cc = o & 255; float s = 0.f;
#pragma unroll
                for (int q = 0; q < 8; ++q) s += red[(q * 5 + r) * 256 + cc];
                modbuf[(size_t)(l * 5 + r) * MODW + n0 + cc] = s + bmod[(size_t)l * MODW + n0 + cc]; }
            __syncthreads();
        }
    }
    if (bx >= NGEMV || G <= NGEMV) {
        const int wb = (G > NGEMV) ? bx - NGEMV : bx, nwb = (G > NGEMV) ? G - NGEMV : G;
        const f32x4* x4 = (const f32x4*)A.in(I_X); const f32x4* c4p = (const f32x4*)A.in(I_CTX); f32x4* X4 = (f32x4*)(ws + WS_X);
        const int total = MTOK * 256, stride = nwb * 512;
        for (int i = wb * 512 + tid; i < total; i += 4 * stride) { f32x4 v[4];
#pragma unroll
            for (int q = 0; q < 4; ++q) { const int ii = i + q * stride; if (ii < total) { const int row = ii >> 8, qq = ii & 255; const int b = row / SROW, s = row - b * SROW;
                v[q] = (s < LCTX) ? c4p[(size_t)(b * LCTX + s) * 256 + qq] : x4[(size_t)(b * LAT + s - LCTX) * 256 + qq]; } }
#pragma unroll
            for (int q = 0; q < 4; ++q) { const int ii = i + q * stride; if (ii < total) X4[ii] = v[q]; } }
        float* ra = (float*)(ws + WS_ROPE); float* rb = ra + 64 * 32 * 2;
        for (int i = wb * 512 + tid; i < 64 * 32 + 64 * 16; i += nwb * 512) {
            if (i < 64 * 32) { const int pos = i >> 5, f = i & 31; const float fr = powf(10000.0f, -(float)(2 * f) / 64.0f); const float ang = (float)pos * fr; ra[2 * i] = cosf(ang); ra[2 * i + 1] = sinf(ang); }
            else { const int j = i - 64 * 32; const int pos = j >> 4, f = j & 15; const float fr = powf(10000.0f, -(float)(2 * f) / 32.0f); const float ang = (float)pos * fr; rb[2 * j] = cosf(ang); rb[2 * j + 1] = sinf(ang); } }
    }
}

constexpr int CV_FI = 16 * 88, CV_FO = 44 * 16, CV_IN = 16 * 108, CV_BR = 8 * 16, CV_OUT = 16 * 16, CV_LRU = 32;
constexpr int CV_NIT = 2 * CV_FI + 2 * CV_FO + CV_IN + 3 * CV_BR + CV_OUT + CV_LRU;
__device__ __forceinline__ void convert_layer(const AH A, int l, int it_lo, int it_hi, LAS unsigned char* lds, int gw, int NGW, int wave, int lane) {
    unsigned char* ws = A.ws() + (size_t)(l & 1) * WS_WSET;
    LAS float* scr = (LAS float*)(lds + wave * 16640);
    for (int it = it_lo + gw; it < it_hi; it += NGW) {
        int r = it; bool done = false;
#pragma unroll
        for (int j = 0; j < 2; ++j) { if (!done) { if (r < CV_FI) { const int kb = r / 88, nb = r - kb * 88, n0 = nb * 64;
                const int orow0 = (n0 < DFF) ? ((n0 >> 7) * 256 + (n0 & 127)) : (((n0 - DFF) >> 7) * 256 + 128 + ((n0 - DFF) & 127));
                tr_item(A.in(I_FFNIN) + (size_t)(l * 2 + j) * 1024 * 5632, 5632, kb * 64, n0, (bf16*)(ws + WS_WFI) + (size_t)j * 5632 * 1024, 1024, orow0, scr, lane); done = true; } else r -= CV_FI; } }
#pragma unroll
        for (int j = 0; j < 2; ++j) { if (!done) { if (r < CV_FO) { const int kb = r >> 4, nb = r & 15;
                tr_item(A.in(I_FFNOUT) + (size_t)(l * 2 + j) * DFF * 1024, 1024, kb * 64, nb * 64, (bf16*)(ws + WS_WFO) + (size_t)j * 1024 * DFF, DFF, nb * 64, scr, lane); done = true; } else r -= CV_FO; } }
        if (!done) { if (r < CV_IN) { const int kb = r / 108, nb = r - kb * 108;
                tr_item(A.in(I_WIN) + (size_t)l * 1024 * DIN, DIN, kb * 64, nb * 64, (bf16*)(ws + WS_WIN), 1024, nb * 64, scr, lane); done = true; } else r -= CV_IN; }
#pragma unroll
        for (int n = 0; n < 3; ++n) { if (!done) { if (r < CV_BR) { const int kb = r >> 4, nb = r & 15;
                tr_item(A.in(I_WBR) + (size_t)(l * 3 + n) * 512 * 1024, 1024, kb * 64, nb * 64, (bf16*)(ws + WS_WB) + (size_t)n * 1024 * 512, 512, nb * 64, scr, lane); done = true; } else r -= CV_BR; } }
        if (!done) { if (r < CV_OUT) { const int kb = r >> 4, nb = r & 15;
                tr_item(A.in(I_WOUT) + (size_t)l * 1024 * 1024, 1024, kb * 64, nb * 64, (bf16*)(ws + WS_WO), 1024, nb * 64, scr, lane); done = true; } else r -= CV_OUT; }
        if (!done) { const int mat = r; const int g = mat >> 4, d = (mat >> 3) & 1, blk = mat & 7;
                const float* src = (g ? A.in(I_LWX) : A.in(I_LWA)) + (size_t)((l * 2 + d) * 8 + blk) * 4096;
                tr_item(src, 64, 0, 0, (bf16*)(ws + WS_LRUW) + (size_t)mat * 4096, 64, 0, scr, lane); }
    }
}

__device__ __forceinline__ void norm_rows(const AH A, int l, int sub, int gw, int NGW, int lane, int pend_ns, const float* pend_gate, float pend_scale) {
    unsigned char* ws = A.ws();
    const float* X = (const float*)(ws + WS_X); bf16* HN = (bf16*)(ws + WS_HN);
    const float* g = A.in(I_NORMG) + (size_t)(l * 3 + sub) * 1024;
    const float* modl = (const float*)(ws + WS_MOD) + (size_t)l * 5 * MODW + sub * 3072;
    f32x4 gv[4];
#pragma unroll
    for (int j = 0; j < 4; ++j) gv[j] = ((const f32x4*)g)[lane + 64 * j];
    f32x4 nx[4];
    if (gw < MTOK) {
#pragma unroll
        for (int j = 0; j < 4; ++j) nx[j] = ((const f32x4*)(X + (size_t)gw * 1024))[lane + 64 * j]; }
    for (int row = gw; row < MTOK; row += NGW) {
        const int b = row / SROW, s = row - b * SROW; const int mr = (s < LCTX) ? 4 : b;
        const f32x4* sh = (const f32x4*)(modl + (size_t)mr * MODW); const f32x4* sc = (const f32x4*)(modl + (size_t)mr * MODW + 1024);
        f32x4 v[4]; float ss = 0.f;
#pragma unroll
        for (int j = 0; j < 4; ++j) v[j] = nx[j];
        if (row + NGW < MTOK) {
#pragma unroll
            for (int j = 0; j < 4; ++j) nx[j] = ((const f32x4*)(X + (size_t)(row + NGW) * 1024))[lane + 64 * j]; }
        f32x4 scv[4], shv[4];
#pragma unroll
        for (int j = 0; j < 4; ++j) { scv[j] = sc[lane + 64 * j]; shv[j] = sh[lane + 64 * j]; }
        if (pend_ns > 0 && s < LCTX) {
            const f32x4* pc = (const f32x4*)((const float*)(ws + WS_PARTC) + (size_t)(b * LCTX + s) * 1024); const f32x4* pg = (const f32x4*)pend_gate;
            f32x4 a4[4] = {(f32x4){0.f, 0.f, 0.f, 0.f}, (f32x4){0.f, 0.f, 0.f, 0.f}, (f32x4){0.f, 0.f, 0.f, 0.f}, (f32x4){0.f, 0.f, 0.f, 0.f}};
            for (int sp = 0; sp < pend_ns; ++sp) {
#pragma unroll
                for (int j = 0; j < 4; ++j) a4[j] += pc[(size_t)sp * 262144 + lane + 64 * j]; }
            f32x4* xw = (f32x4*)(ws + WS_X) + (size_t)row * 256;
#pragma unroll
            for (int j = 0; j < 4; ++j) { v[j] += (pg[lane + 64 * j] * pend_scale) * a4[j]; xw[lane + 64 * j] = v[j]; }
        }
#pragma unroll
        for (int j = 0; j < 4; ++j) ss += (v[j].x * v[j].x + v[j].y * v[j].y) + (v[j].z * v[j].z + v[j].w * v[j].w);
        const float rstd = rsqrtf(wave_sum(ss, lane) * (1.0f / 1024.0f) + NORM_EPS);
        v2u* o = (v2u*)(HN + (size_t)row * 1024);
#pragma unroll
        for (int j = 0; j < 4; ++j) { const f32x4 y = (v[j] * rstd) * gv[j] * (scv[j] + 1.0f) + shv[j];
            v2u w; w.x = pk2(y.x, y.y); w.y = pk2(y.z, y.w); o[lane + 64 * j] = w; }
    }
}
__device__ __forceinline__ void final_rows(const AH A, int gw, int NGW, int lane) {
    const float* X = (const float*)(A.ws() + WS_X); const float* g = A.in(I_FG);
    f32x4 gv[4];
#pragma unroll
    for (int j = 0; j < 4; ++j) gv[j] = ((const f32x4*)g)[lane + 64 * j];
    f32x4 nx[4];
    if (gw < NB * LAT) { const int b = gw >> 12, t = gw & 4095;
#pragma unroll
        for (int j = 0; j < 4; ++j) nx[j] = ((const f32x4*)(X + (size_t)(b * SROW + LCTX + t) * 1024))[lane + 64 * j]; }
    for (int r = gw; r < NB * LAT; r += NGW) {
        f32x4 v[4]; float ss = 0.f;
#pragma unroll
        for (int j = 0; j < 4; ++j) v[j] = nx[j];
        if (r + NGW < NB * LAT) { const int r2 = r + NGW, b = r2 >> 12, t = r2 & 4095;
#pragma unroll
            for (int j = 0; j < 4; ++j) nx[j] = ((const f32x4*)(X + (size_t)(b * SROW + LCTX + t) * 1024))[lane + 64 * j]; }
#pragma unroll
        for (int j = 0; j < 4; ++j) ss += (v[j].x * v[j].x + v[j].y * v[j].y) + (v[j].z * v[j].z + v[j].w * v[j].w);
        const float rstd = rsqrtf(wave_sum(ss, lane) * (1.0f / 1024.0f) + NORM_EPS);
        f32x4* o = (f32x4*)(A.out() + (size_t)r * 1024);
#pragma unroll
        for (int j = 0; j < 4; ++j) o[lane + 64 * j] = (v[j] * rstd) * gv[j];
    }
}
#define XB_TMO      128
#define XB_XCNT(j)  (256  + 64 * (j))
#define XB_XSUB(j)  (1280 + 64 * (j))
#define XB_XGEN(j)  (2304 + 64 * (j))
#define XB_TOP      3328
#define XB_TOPGEN   3392
#define XCD_BAR_WORDS 3456
#define XB_SPIN_CAP (1u << 22)

__device__ __forceinline__ unsigned xb_ld(unsigned* p)              { return __hip_atomic_load(p, __ATOMIC_RELAXED, __HIP_MEMORY_SCOPE_AGENT); }
__device__ __forceinline__ unsigned xb_add(unsigned* p, unsigned v) { return __hip_atomic_fetch_add(p, v, __ATOMIC_RELAXED, __HIP_MEMORY_SCOPE_AGENT); }
__device__ __forceinline__ unsigned xb_xcc_id() { return (unsigned)__builtin_amdgcn_s_getreg((3 << 11) | 20) & 0xFu; }
#define XB_SPIN(cond, bar) do { unsigned _sp = 0; while (cond) { __builtin_amdgcn_s_sleep(1); \
    if ((++_sp & 255u) == 0u) { if (xb_ld(&(bar)[XB_TMO])) break; if (_sp > XB_SPIN_CAP) { atomicAdd(&(bar)[XB_TMO], 1u); break; } } } } while (0)

struct XcdBarrier {
    unsigned* bar; unsigned x;
    volatile LAS unsigned* st;
};

__device__ __forceinline__ XcdBarrier xcd_barrier_post(unsigned* bar, volatile LAS unsigned* st, bool t0) {
    XcdBarrier b; b.bar = bar; b.x = xb_xcc_id(); b.st = st;
    if (t0) (void)xb_add(&bar[XB_XCNT(b.x)], 1u);
    return b;
}
__device__ __forceinline__ void xcd_barrier_complete(unsigned* bar, unsigned x, unsigned& nloc, unsigned& nx) {
    const unsigned G = gridDim.x * gridDim.y * gridDim.z;
    unsigned sum, cnt, mine, sp = 0u;
    for (;;) {
        sum = 0u; cnt = 0u; mine = 0u;
#pragma unroll
        for (unsigned j = 0; j < 16; ++j) { const unsigned c = xb_ld(&bar[XB_XCNT(j)]); sum += c; cnt += (c > 0u) ? 1u : 0u; mine = (j == x) ? c : mine; }
        if (sum == G) break;
        __builtin_amdgcn_s_sleep(1);
        if ((++sp & 255u) == 0u) { if (xb_ld(&bar[XB_TMO])) break; if (sp > XB_SPIN_CAP) { atomicAdd(&bar[XB_TMO], 1u); break; } }
    }
    nloc = mine > 0u ? mine : 1u; nx = cnt > 0u ? cnt : 1u;
}

__device__ __forceinline__ void xcd_barrier(const XcdBarrier& b, bool t0) {
    asm volatile("s_waitcnt vmcnt(0)" ::: "memory");
    __syncthreads();
    if (t0) {
        unsigned* bar = b.bar;
        __builtin_amdgcn_s_waitcnt(0);
        unsigned nloc = b.st[0], nx = b.st[1];
        if (nloc == 0u) { xcd_barrier_complete(bar, b.x, nloc, nx); b.st[0] = nloc; b.st[1] = nx; }
        const unsigned old = xb_add(&bar[XB_XSUB(b.x)], 1u);
        const unsigned gen = old / nloc;
        if (old + 1u == (gen + 1u) * nloc) {
            __builtin_amdgcn_fence(__ATOMIC_RELEASE, "agent");
            asm volatile("s_waitcnt vmcnt(0)" ::: "memory");
            const unsigned og = xb_add(&bar[XB_TOP], 1u);
            const unsigned tg = og / nx;
            if (og + 1u == (tg + 1u) * nx) xb_add(&bar[XB_TOPGEN], 1u);
            else XB_SPIN(xb_ld(&bar[XB_TOPGEN]) == tg, bar);
            __builtin_amdgcn_fence(__ATOMIC_ACQUIRE, "agent");
            xb_add(&bar[XB_XGEN(b.x)], 1u);
            asm volatile("s_waitcnt vmcnt(0)" ::: "memory");
        } else {
            XB_SPIN(xb_ld(&bar[XB_XGEN(b.x)]) == gen, bar);
            __builtin_amdgcn_fence(__ATOMIC_ACQUIRE, "agent");
            asm volatile("s_waitcnt vmcnt(0)" ::: "memory");
        }
    }
    __syncthreads();
}
__device__ __forceinline__ void prep_qk(const AH A, int l, int gw, int NGW, int lane) {
    unsigned char* ws = A.ws();
    const bf16* Z = (const bf16*)(ws + WS_Z); bf16* QN = (bf16*)(ws + WS_QN); bf16* KN = (bf16*)(ws + WS_KN);
    const float* rb = (const float*)(ws + WS_ROPE) + 64 * 32 * 2;
    const int e0 = (lane & 7) * 8, hq = lane >> 3;
    float gq[8], gk[8];
#pragma unroll
    for (int j = 0; j < 8; ++j) { gq[j] = A.in(I_QG)[l * 64 + e0 + j]; gk[j] = A.in(I_KG)[l * 64 + e0 + j]; }
    constexpr float C2 = 0.125f * 1.4426950408889634f;
    for (int row = gw; row < MTOK; row += NGW) {
        const int b = row / SROW, s = row - b * SROW; const bool lat = s >= LCTX; const int t = s - LCTX;
        const int pos = (lane & 4) ? (t & 63) : (t >> 6);
#pragma unroll
        for (int pass = 0; pass < 2; ++pass) {
            const bf16* src = Z + (size_t)row * DIN + (pass == 0 ? ZC_AQ : ZC_AK) + hq * 64 + e0;
            float f[8]; unpack8(*(const v4u*)src, f);
            float ss = 0.f;
#pragma unroll
            for (int j = 0; j < 8; ++j) ss += f[j] * f[j];
            ss += shx(ss, 1, lane); ss += shx(ss, 2, lane); ss += shx(ss, 4, lane);
            const float rstd = rsqrtf(ss * (1.0f / 64.0f) + NORM_EPS);
            float y[8], o[8];
#pragma unroll
            for (int j = 0; j < 8; ++j) y[j] = f[j] * rstd * (pass == 0 ? gq[j] : gk[j]);
#pragma unroll
            for (int j = 0; j < 8; ++j) { const float p = shx(y[j], 2, lane);
                if (lat) { const int fi = (lane & 1) * 8 + j; const float cs = rb[(pos * 16 + fi) * 2], sn = rb[(pos * 16 + fi) * 2 + 1];
                    o[j] = ((lane & 2) == 0) ? (y[j] * cs - p * sn) : (p * sn + y[j] * cs); }
                else o[j] = y[j];
                if (pass == 0) o[j] *= C2; }
            v4u w; w.x = pk2(o[0], o[1]); w.y = pk2(o[2], o[3]); w.z = pk2(o[4], o[5]); w.w = pk2(o[6], o[7]);
            if (pass == 0) *(v4u*)(QN + (size_t)row * 512 + hq * 64 + e0) = w;
            else if (lane < 16) *(v4u*)(KN + (size_t)row * 128 + hq * 64 + e0) = w;
        }
    }
}

constexpr int RLDP = 136;
constexpr int RBUF = 128 * RLDP * 2;
__device__ __forceinline__ float log_sigmoid_f(float x) { return (x < 0.f ? x : 0.f) - log1pf(__expf(-fabsf(x))); }
template <bool TRANSPOSED, bool ROPE>
__device__ __forceinline__ void ret_stage_pair(const bf16* Z, int r0, int zc, int h, bool lat, int t0, const float* ra, float scl, float lgdec, int decmode  , LAS bf16* dst, int tid) {
#pragma unroll
    for (int it = 0; it < 2; ++it) { const int task = tid + 512 * it; const int j = task & 127, pr = task >> 7; const int c = (pr & 3) + (pr >> 2) * 8;
        const bf16* p = Z + (size_t)(r0 + j) * DIN + zc + h * 128;
        float a[8], bq[8]; unpack8(*(const v4u*)(p + 8 * c), a); unpack8(*(const v4u*)(p + 8 * (c + 4)), bq);
        float sc = scl; if (decmode == 1) sc *= __expf(lgdec * (float)(127 - j)); else if (decmode == 2) sc *= __expf(lgdec * (float)j);
        if (ROPE && lat) { const int t = t0 + j; const int pos = (c < 8) ? (t >> 6) : (t & 63);
#pragma unroll
            for (int e = 0; e < 8; ++e) { const int fi = (c & 3) * 8 + e; const float cs = ra[(pos * 32 + fi) * 2], sn = ra[(pos * 32 + fi) * 2 + 1];
                const float x1 = a[e], x2 = bq[e]; a[e] = x1 * cs - x2 * sn; bq[e] = x1 * sn + x2 * cs; } }
        if (TRANSPOSED) {
#pragma unroll
            for (int e = 0; e < 8; ++e) { dst[(8 * c + e) * RLDP + j] = (bf16)f2bf(a[e] * sc); dst[(8 * (c + 4) + e) * RLDP + j] = (bf16)f2bf(bq[e] * sc); }
        } else {
            v4u w; w.x = pk2(a[0] * sc, a[1] * sc); w.y = pk2(a[2] * sc, a[3] * sc); w.z = pk2(a[4] * sc, a[5] * sc); w.w = pk2(a[6] * sc, a[7] * sc);
            *(LAS v4u*)(dst + j * RLDP + 8 * c) = w;
            w.x = pk2(bq[0] * sc, bq[1] * sc); w.y = pk2(bq[2] * sc, bq[3] * sc); w.z = pk2(bq[4] * sc, bq[5] * sc); w.w = pk2(bq[6] * sc, bq[7] * sc);
            *(LAS v4u*)(dst + j * RLDP + 8 * (c + 4)) = w;
        } }
}
__device__ __forceinline__ void wave_mm(f32x4 (&acc)[8], const LAS bf16* Am, int row0, const LAS bf16* Bm, int lane) {
    const int r = lane & 15, g = lane >> 4;
#pragma unroll
    for (int ks = 0; ks < 4; ++ks) { const bf16x8 a = *(const LAS bf16x8*)(Am + (row0 + r) * RLDP + ks * 32 + g * 8);
#pragma unroll
        for (int nt = 0; nt < 8; ++nt) { const bf16x8 bfr = *(const LAS bf16x8*)(Bm + (nt * 16 + r) * RLDP + ks * 32 + g * 8);
            acc[nt] = __builtin_amdgcn_mfma_f32_16x16x32_bf16(a, bfr, acc[nt], 0, 0, 0); } }
}
__device__ __forceinline__ int ret_chain_pos(int d, int cidx) { return d == 0 ? cidx : (cidx == 1 ? 0 : (cidx == 0 ? 1 : 35 - cidx)); }

__device__ __forceinline__ void ret_stage_k_both(const bf16* Z, int r0, int h, bool lat, int t0, const float* ra, float scl, float lgf, float lgb, LAS bf16* dstf, LAS bf16* dstb, int tid) {
#pragma unroll
    for (int it = 0; it < 2; ++it) { const int task = tid + 512 * it; const int j = task & 127, pr = task >> 7; const int c = (pr & 3) + (pr >> 2) * 8;
        const bf16* p = Z + (size_t)(r0 + j) * DIN + ZC_RK + h * 128;
        float a[8], bq[8]; unpack8(*(const v4u*)(p + 8 * c), a); unpack8(*(const v4u*)(p + 8 * (c + 4)), bq);
        const float sf = scl * __expf(lgf * (float)(127 - j)), sb = scl * __expf(lgb * (float)j);
        if (lat) { const int t = t0 + j; const int pos = (c < 8) ? (t >> 6) : (t & 63);
#pragma unroll
            for (int e = 0; e < 8; ++e) { const int fi = (c & 3) * 8 + e; const float cs = ra[(pos * 32 + fi) * 2], sn = ra[(pos * 32 + fi) * 2 + 1];
                const float x1 = a[e], x2 = bq[e]; a[e] = x1 * cs - x2 * sn; bq[e] = x1 * sn + x2 * cs; } }
#pragma unroll
        for (int e = 0; e < 8; ++e) { dstf[(8 * c + e) * RLDP + j] = (bf16)f2bf(a[e] * sf); dstf[(8 * (c + 4) + e) * RLDP + j] = (bf16)f2bf(bq[e] * sf);
                                      dstb[(8 * c + e) * RLDP + j] = (bf16)f2bf(a[e] * sb); dstb[(8 * (c + 4) + e) * RLDP + j] = (bf16)f2bf(bq[e] * sb); } }
}
__device__ __forceinline__ void ret_u_item(const AH A, int l, int item, LAS unsigned char* lds, int tid, int wave, int lane) {
    unsigned char* ws = A.ws(); const bf16* Z = (const bf16*)(ws + WS_Z); const float* ra = (const float*)(ws + WS_ROPE);
    const int cidx = item % 34, bh = item / 34, b = bh >> 2, h = bh & 3;
    const int pf = ret_chain_pos(0, cidx), pb = ret_chain_pos(1, cidx);
    const bool lat = cidx >= 2; const int r0 = b * SROW + cidx * 128, t0 = (cidx - 2) * 128;
    const float lgf = log_sigmoid_f(A.in(I_RETLOGIT)[(l * 2 + 0) * 4 + h]), lgb = log_sigmoid_f(A.in(I_RETLOGIT)[(l * 2 + 1) * 4 + h]);
    LAS bf16* Ktf = (LAS bf16*)lds; LAS bf16* Ktb = (LAS bf16*)(lds + RBUF); LAS bf16* Vt = (LAS bf16*)(lds + 2 * RBUF);
    ret_stage_k_both(Z, r0, h, lat, t0, ra, 0.08838834764831845f, lgf, lgb, Ktf, Ktb, tid);
    ret_stage_pair<true, false>(Z, r0, ZC_RV, h, false, 0, ra, 1.0f, 0.f, 0, Vt, tid);
    __syncthreads();
    const int g = lane >> 4, c = lane & 15;
    f32x4 accf[8], accb[8];
#pragma unroll
    for (int nt = 0; nt < 8; ++nt) { accf[nt] = (f32x4){0.f, 0.f, 0.f, 0.f}; accb[nt] = (f32x4){0.f, 0.f, 0.f, 0.f}; }
    if (pf != 33) wave_mm(accf, Vt, wave * 16, Ktf, lane);
    if (pb != 33) wave_mm(accb, Vt, wave * 16, Ktb, lane);
    __syncthreads();
    LAS bf16* stg = (LAS bf16*)lds + wave * (16 * RLDP);
#pragma unroll 1
    for (int d = 0; d < 2; ++d) { const int p = d ? pb : pf;
        if (p == 33) continue;
#pragma unroll
        for (int nt = 0; nt < 8; ++nt)
#pragma unroll
            for (int jj = 0; jj < 4; ++jj) stg[(4 * g + jj) * RLDP + nt * 16 + c] = (bf16)f2bf(d ? accb[nt][jj] : accf[nt][jj]);
        LDS_WAIT(); asm volatile("" ::: "memory");
        bf16* U = (bf16*)(ws + WS_U) + ((size_t)((b * 4 + h) * 2 + d) * 34 + p) * 16384 + (size_t)(wave * 16) * 128;
#pragma unroll
        for (int it = 0; it < 4; ++it) { const int id = lane + 64 * it, rr = id >> 4, ch = id & 15;
            *(v4u*)(U + rr * 128 + ch * 8) = *(const LAS v4u*)(stg + rr * RLDP + ch * 8); }
        LDS_WAIT(); asm volatile("" ::: "memory"); }
    __syncthreads();
}
__device__ __forceinline__ void ret_scan_item(const AH A, int l, int item, int tid) {
    unsigned char* ws = A.ws();
    const int bhd = item >> 3, sl = item & 7; const int d = bhd & 1, h = (bhd >> 1) & 3;
    const float lg = log_sigmoid_f(A.in(I_RETLOGIT)[(l * 2 + d) * 4 + h]); const float sdec = __expf(128.0f * lg);
    const v2u* U = (const v2u*)((const bf16*)(ws + WS_U) + (size_t)bhd * 34 * 16384) + sl * 512 + tid;
    v2u* S = (v2u*)((bf16*)(ws + WS_SIN) + (size_t)bhd * 34 * 16384) + sl * 512 + tid;
    f32x4 s = (f32x4){0.f, 0.f, 0.f, 0.f};
#pragma unroll 1
    for (int p0 = 0; p0 < 33; p0 += 11) { v2u u[11];
#pragma unroll
        for (int i = 0; i < 11; ++i) u[i] = U[(size_t)(p0 + i) * 4096];
#pragma unroll
        for (int i = 0; i < 11; ++i) { v2u w; w.x = pk2(s.x, s.y); w.y = pk2(s.z, s.w); S[(size_t)(p0 + i) * 4096] = w;
            const f32x4 uf = (f32x4){bflo(u[i].x), bfhi(u[i].x), bflo(u[i].y), bfhi(u[i].y)}; s = s * sdec + uf; } }
    { v2u w; w.x = pk2(s.x, s.y); w.y = pk2(s.z, s.w); S[(size_t)33 * 4096] = w; }
}
__device__ __forceinline__ void ret_out_item(const AH A, int l, int item, LAS unsigned char* lds, int tid, int wave, int lane) {
    unsigned char* ws = A.ws(); const bf16* Z = (const bf16*)(ws + WS_Z); const float* ra = (const float*)(ws + WS_ROPE);
    const int cidx = item % 34, bh = item / 34, b = bh >> 2, h = bh & 3;
    const bool lat = cidx >= 2; const int r0 = b * SROW + cidx * 128, t0 = (cidx - 2) * 128;
    const float lgf = log_sigmoid_f(A.in(I_RETLOGIT)[(l * 2 + 0) * 4 + h]) * 1.4426950408889634f, lgb = log_sigmoid_f(A.in(I_RETLOGIT)[(l * 2 + 1) * 4 + h]) * 1.4426950408889634f;
    LAS bf16* Qs = (LAS bf16*)lds; LAS bf16* Ks = (LAS bf16*)(lds + RBUF); LAS bf16* Vt = (LAS bf16*)(lds + 2 * RBUF); LAS bf16* Ss = (LAS bf16*)(lds + 3 * RBUF);
    const bf16* SINf = (const bf16*)(ws + WS_SIN) + ((size_t)((b * 4 + h) * 2 + 0) * 34 + ret_chain_pos(0, cidx)) * 16384;
    const bf16* SINb = (const bf16*)(ws + WS_SIN) + ((size_t)((b * 4 + h) * 2 + 1) * 34 + ret_chain_pos(1, cidx)) * 16384;
    ret_stage_pair<false, true>(Z, r0, ZC_RQ, h, lat, t0, ra, 1.0f, 0.f, 0, Qs, tid);
    ret_stage_pair<false, true>(Z, r0, ZC_RK, h, lat, t0, ra, 0.08838834764831845f, 0.f, 0, Ks, tid);
    ret_stage_pair<true, false>(Z, r0, ZC_RV, h, false, 0, ra, 1.0f, 0.f, 0, Vt, tid);
#pragma unroll
    for (int it = 0; it < 4; ++it) { const int task = tid + 512 * it, row = task >> 4, ch = task & 15; *(LAS v4u*)(Ss + row * RLDP + ch * 8) = *(const v4u*)(SINf + row * 128 + ch * 8); }
    v4u sbv[4];
#pragma unroll
    for (int it = 0; it < 4; ++it) { const int task = tid + 512 * it, row = task >> 4, ch = task & 15; sbv[it] = *(const v4u*)(SINb + row * 128 + ch * 8); }
    __syncthreads();
    const int g = lane >> 4, c = lane & 15, i0 = wave * 16 + 4 * g;
    f32x4 accs[8], acco[8];
#pragma unroll
    for (int nt = 0; nt < 8; ++nt) { accs[nt] = (f32x4){0.f, 0.f, 0.f, 0.f}; acco[nt] = (f32x4){0.f, 0.f, 0.f, 0.f}; }
    wave_mm(accs, Qs, wave * 16, Ks, lane);
    wave_mm(acco, Qs, wave * 16, Ss, lane);
#pragma unroll
    for (int jj = 0; jj < 4; ++jj) { const float qd = __builtin_amdgcn_exp2f(lgf * (float)(i0 + jj + 1));
#pragma unroll
        for (int nt = 0; nt < 8; ++nt) acco[nt][jj] *= qd; }
    int i0w = i0; asm volatile("" : "+v"(i0w));
#pragma unroll
    for (int nt = 0; nt < 8; ++nt)
#pragma unroll
        for (int jj = 0; jj < 4; ++jj) { const int diff = (i0w + jj) - (nt * 16 + c);
            const float w = diff > 0 ? __builtin_amdgcn_exp2f(lgf * (float)diff) : (diff < 0 ? __builtin_amdgcn_exp2f(lgb * (float)(-diff)) : 2.0f);
            accs[nt][jj] *= w; }
    __syncthreads();
#pragma unroll
    for (int nt = 0; nt < 8; ++nt)
#pragma unroll
        for (int jj = 0; jj < 4; ++jj) Ks[(i0 + jj) * RLDP + nt * 16 + c] = (bf16)f2bf(accs[nt][jj]);
#pragma unroll
    for (int it = 0; it < 4; ++it) { const int task = tid + 512 * it, row = task >> 4, ch = task & 15; *(LAS v4u*)(Ss + row * RLDP + ch * 8) = sbv[it]; }
    __syncthreads();
#pragma unroll
    for (int nt = 0; nt < 8; ++nt) accs[nt] = (f32x4){0.f, 0.f, 0.f, 0.f};
    wave_mm(accs, Qs, wave * 16, Ss, lane);
#pragma unroll
    for (int jj = 0; jj < 4; ++jj) { const float qd = __builtin_amdgcn_exp2f(lgb * (float)(128 - (i0 + jj)));
#pragma unroll
        for (int nt = 0; nt < 8; ++nt) acco[nt][jj] += qd * accs[nt][jj]; }
    wave_mm(acco, Ks, wave * 16, Vt, lane);
    const float* gn = A.in(I_RETG) + (size_t)l * 512 + h * 128;
    bf16* Y = (bf16*)(ws + WS_Y);
    float gnv[8];
#pragma unroll
    for (int nt = 0; nt < 8; ++nt) gnv[nt] = gn[nt * 16 + c];
#pragma unroll
    for (int jj = 0; jj < 4; ++jj) {
        float s1 = 0.f;
#pragma unroll
        for (int nt = 0; nt < 8; ++nt) s1 += acco[nt][jj];
        s1 += shx(s1, 1, lane); s1 += shx(s1, 2, lane); s1 += shx(s1, 4, lane); s1 += shx(s1, 8, lane);
        const float mu = s1 * (1.0f / 128.0f); float s2 = 0.f;
#pragma unroll
        for (int nt = 0; nt < 8; ++nt) { const float dlt = acco[nt][jj] - mu; s2 += dlt * dlt; }
        s2 += shx(s2, 1, lane); s2 += shx(s2, 2, lane); s2 += shx(s2, 4, lane); s2 += shx(s2, 8, lane);
        const float rstd = rsqrtf(s2 * (1.0f / 128.0f) + NORM_EPS);
#pragma unroll
        for (int nt = 0; nt < 8; ++nt) Qs[(i0 + jj) * RLDP + nt * 16 + c] = (bf16)f2bf((acco[nt][jj] - mu) * rstd * gnv[nt]);
    }
    LDS_WAIT(); asm volatile("" ::: "memory");
#pragma unroll
    for (int it = 0; it < 4; ++it) { const int id = lane + 64 * it, rr = wave * 16 + (id >> 4), ch = id & 15; const size_t row = (size_t)(r0 + rr);
        float yv[8], rg[8]; unpack8(*(const LAS v4u*)(Qs + rr * RLDP + ch * 8), yv); unpack8(*(const v4u*)(Z + row * DIN + ZC_RG + h * 128 + ch * 8), rg);
#pragma unroll
        for (int e = 0; e < 8; ++e) yv[e] *= rg[e] * sigmoidf_(rg[e]);
        v4u w; w.x = pk2(yv[0], yv[1]); w.y = pk2(yv[2], yv[3]); w.z = pk2(yv[4], yv[5]); w.w = pk2(yv[6], yv[7]);
        *(v4u*)(Y + row * 512 + h * 128 + ch * 8) = w; }
    __syncthreads();
}
constexpr int XLDP = 68;
constexpr int XWAVE_BYTES = 64 * XLDP * 4;
__device__ __forceinline__ float gelu_tanh(float x) { const float u = 0.7978845608028654f * (x + 0.044715f * x * x * x); const float th = 1.0f - 2.0f * __builtin_amdgcn_rcpf(1.0f + __expf(2.0f * u)); return 0.5f * x * (1.0f + th); }
__device__ __forceinline__ int lru_chain_pos(int d, int c64) { return d == 0 ? c64 : (c64 < 4 ? 3 - c64 : 71 - c64); }

struct LruFrag { bf16x8 ba[2], bx[2]; };
__device__ __forceinline__ LruFrag lru_frag_load(const unsigned char* ws, int l, int dir, int blk, int nt, int lane) {
    const int g = lane >> 4, c = lane & 15; LruFrag f;
    const bf16* wa = (const bf16*)(ws + (size_t)(l & 1) * WS_WSET + WS_LRUW) + (size_t)((0 * 2 + dir) * 8 + blk) * 4096 + (nt * 16 + c) * 64 + g * 8;
    const bf16* wx = (const bf16*)(ws + (size_t)(l & 1) * WS_WSET + WS_LRUW) + (size_t)((1 * 2 + dir) * 8 + blk) * 4096 + (nt * 16 + c) * 64 + g * 8;
#pragma unroll
    for (int ks = 0; ks < 2; ++ks) { f.ba[ks] = *(const bf16x8*)(wa + ks * 32); f.bx[ks] = *(const bf16x8*)(wx + ks * 32); }
    return f;
}
template <int DIR, bool FINAL>
__device__ __forceinline__ void lru_dir(const AH A, int l, int b, int c64, int blk, int nt, const bf16x8 (&af)[4][2], const float (&xv)[16], float (&hs)[16], int lane,
                                        const LruFrag& fr, float b_a, float b_x, float lam, float hin) {
    unsigned char* ws = A.ws();
    const int g = lane >> 4, c = lane & 15; const int ch = blk * 64 + nt * 16 + c;
    f32x4 accr[4], acci[4];
#pragma unroll
    for (int mt = 0; mt < 4; ++mt) { accr[mt] = (f32x4){0.f, 0.f, 0.f, 0.f}; acci[mt] = (f32x4){0.f, 0.f, 0.f, 0.f};
#pragma unroll
        for (int ks = 0; ks < 2; ++ks) { accr[mt] = __builtin_amdgcn_mfma_f32_16x16x32_bf16(af[mt][ks], fr.ba[ks], accr[mt], 0, 0, 0);
                                         acci[mt] = __builtin_amdgcn_mfma_f32_16x16x32_bf16(af[mt][ks], fr.bx[ks], acci[mt], 0, 0, 0); } }
    const float sp = fmaxf(-lam, 0.f) + log1pf(__expf(-fabsf(lam)));
    float a_[16], u_[16], la_[16];
#pragma unroll
    for (int q = 0; q < 16; ++q) { const int mt = q >> 2, jj = q & 3;
        const float r = sigmoidf_(accr[mt][jj] + b_a), ii = sigmoidf_(acci[mt][jj] + b_x);
        const float la = -8.0f * r * sp; a_[q] = __expf(la); la_[q] = la;
        const float x2 = 2.0f * la;
        const float em = -x2 * (1.0f + x2 * (0.5f + x2 * (0.16666667f + x2 * (0.041666668f + x2 * (0.0083333338f + x2 * 0.0013888889f)))));
        u_[q] = __builtin_amdgcn_sqrtf(em) * (ii * xv[q]); }
    float P = 1.f, H = 0.f;
#pragma unroll
    for (int qi = 0; qi < 16; ++qi) { const int q = DIR ? 15 - qi : qi; H = a_[q] * H + u_[q]; P *= a_[q]; }
    float Pg[4], Hg[4];
#pragma unroll
    for (int k = 0; k < 4; ++k) { Pg[k] = shi(P, c + 16 * k); Hg[k] = shi(H, c + 16 * k); }
    if (!FINAL) {
        const int p = lru_chain_pos(DIR, c64);
        const size_t idx = ((size_t)((b * 2 + DIR) * 68 + p)) * 512 + ch;
        float Hc, Pc = (Pg[0] * Pg[1]) * (Pg[2] * Pg[3]);
        if (DIR == 0) Hc = ((Hg[0] * Pg[1] + Hg[1]) * Pg[2] + Hg[2]) * Pg[3] + Hg[3];
        else          Hc = ((Hg[3] * Pg[2] + Hg[2]) * Pg[1] + Hg[1]) * Pg[0] + Hg[0];
        if (g == 0) { float* S = (float*)(ws + WS_SUMM); S[idx * 2] = Pc; S[idx * 2 + 1] = Hc; }
        const size_t e0 = ((((size_t)((b * 68 + c64) * 8 + blk) * 4 + nt) * 2 + DIR) * 64 + lane) * 16;
        bf16* LA = (bf16*)(ws + WS_HN) + e0; bf16* LU = (bf16*)(ws + WS_PARTC) + e0;
        v4u w;
        w.x = pk2(la_[0], la_[1]); w.y = pk2(la_[2], la_[3]); w.z = pk2(la_[4], la_[5]); w.w = pk2(la_[6], la_[7]); *(v4u*)LA = w;
        w.x = pk2(la_[8], la_[9]); w.y = pk2(la_[10], la_[11]); w.z = pk2(la_[12], la_[13]); w.w = pk2(la_[14], la_[15]); *(v4u*)(LA + 8) = w;
        w.x = pk2(u_[0], u_[1]); w.y = pk2(u_[2], u_[3]); w.z = pk2(u_[4], u_[5]); w.w = pk2(u_[6], u_[7]); *(v4u*)LU = w;
        w.x = pk2(u_[8], u_[9]); w.y = pk2(u_[10], u_[11]); w.z = pk2(u_[12], u_[13]); w.w = pk2(u_[14], u_[15]); *(v4u*)(LU + 8) = w;
    } else {
        float s0, s1, s2, s3;
        if (DIR == 0) { s0 = hin; s1 = s0 * Pg[0] + Hg[0]; s2 = s1 * Pg[1] + Hg[1]; s3 = s2 * Pg[2] + Hg[2]; }
        else          { s3 = hin; s2 = s3 * Pg[3] + Hg[3]; s1 = s2 * Pg[2] + Hg[2]; s0 = s1 * Pg[1] + Hg[1]; }
        float h = (g == 0) ? s0 : (g == 1) ? s1 : (g == 2) ? s2 : s3;
#pragma unroll
        for (int qi = 0; qi < 16; ++qi) { const int q = DIR ? 15 - qi : qi; h = a_[q] * h + u_[q]; hs[q] += h; }
    }
}
template <bool FINAL>
__device__ __forceinline__ void lru_task(const AH A, int l, int b, int c64, int blk, LAS unsigned char* lds, int wave, int lane, int half) {
    unsigned char* ws = A.ws(); const bf16* Z = (const bf16*)(ws + WS_Z);
    LAS float* xs = (LAS float*)(lds + wave * XWAVE_BYTES);
    const int r0 = b * SROW + c64 * 64;
    const int seq_lo = (c64 < 4) ? b * SROW : b * SROW + LCTX, seq_hi = (c64 < 4) ? b * SROW + LCTX : (b + 1) * SROW;
    const int g = lane >> 4, c = lane & 15;
    const int cgx = lane & 7, tg = lane >> 3, ch0 = blk * 64 + cgx * 8;
    v4u raw[11];
#pragma unroll
    for (int q = 0; q < 11; ++q) { const int row = r0 + tg * 8 - 1 + q;
        raw[q] = (row >= seq_lo && row < seq_hi) ? *(const v4u*)(Z + (size_t)row * DIN + ZC_LX + ch0) : (v4u){0u, 0u, 0u, 0u}; }
    f32x4 cwv[4][2], cbv[2];
#pragma unroll
    for (int e2 = 0; e2 < 2; ++e2) { cbv[e2] = *(const f32x4*)(A.in(I_CONVB) + l * 512 + ch0 + 4 * e2);
#pragma unroll
        for (int j = 0; j < 4; ++j) cwv[j][e2] = *(const f32x4*)(A.in(I_CONVW) + (l * 4 + j) * 512 + ch0 + 4 * e2); }
    float pba[2][2], pbx[2][2], plam[2][2], phin[2][2];
#pragma unroll
    for (int nti = 0; nti < 2; ++nti)
#pragma unroll
        for (int d = 0; d < 2; ++d) { const int ch = blk * 64 + (2 * half + nti) * 16 + c; const int pidx = (l * 2 + d) * 512 + ch;
            pba[nti][d] = A.in(I_LBA)[pidx]; pbx[nti][d] = A.in(I_LBX)[pidx]; plam[nti][d] = A.in(I_LAM)[pidx];
            phin[nti][d] = FINAL ? ((const float*)(ws + WS_HIN))[((size_t)((b * 2 + d) * 68 + lru_chain_pos(d, c64))) * 512 + ch] : 0.f; }
    LruFrag fcur = lru_frag_load(ws, l, 0, blk, 2 * half, lane);
    {
        float xw[4][8];
#pragma unroll
        for (int q = 0; q < 3; ++q) unpack8(raw[q], xw[q]);
#pragma unroll
        for (int tt = 0; tt < 8; ++tt) { unpack8(raw[tt + 3], xw[3]);
            float y[8];
#pragma unroll
            for (int e = 0; e < 8; ++e) { float sacc = cbv[e >> 2][e & 3];
#pragma unroll
                for (int j = 0; j < 4; ++j) sacc += cwv[j][e >> 2][e & 3] * xw[j][e];
                y[e] = sacc; }
            LAS f32x4* o = (LAS f32x4*)(xs + (tg * 8 + tt) * XLDP + cgx * 8);
            o[0] = (f32x4){y[0], y[1], y[2], y[3]}; o[1] = (f32x4){y[4], y[5], y[6], y[7]};
#pragma unroll
            for (int e = 0; e < 8; ++e) { xw[0][e] = xw[1][e]; xw[1][e] = xw[2][e]; xw[2][e] = xw[3][e]; } }
    }
    LDS_WAIT(); asm volatile("" ::: "memory");
    bf16x8 af[4][2];
    { const int m = lane & 15, gq = m >> 2, jq = m & 3, kq = (lane >> 4) * 8;
#pragma unroll
      for (int mt = 0; mt < 4; ++mt) { const int tok = 16 * gq + 4 * mt + jq;
#pragma unroll
          for (int ks = 0; ks < 2; ++ks) { const LAS f32x4* s = (const LAS f32x4*)(xs + tok * XLDP + ks * 32 + kq); const f32x4 v0 = s[0], v1 = s[1];
              v4u w; w.x = pk2(v0.x, v0.y); w.y = pk2(v0.z, v0.w); w.z = pk2(v1.x, v1.y); w.w = pk2(v1.z, v1.w); af[mt][ks] = __builtin_bit_cast(bf16x8, w); } } }
#pragma unroll
    for (int nti = 0; nti < 2; ++nti) { const int nt = 2 * half + nti;
        float xv[16], hs[16];
#pragma unroll
        for (int q = 0; q < 16; ++q) { xv[q] = xs[(16 * g + q) * XLDP + nt * 16 + c]; hs[q] = 0.f; }
        const LruFrag f1 = lru_frag_load(ws, l, 1, blk, nt, lane);
        lru_dir<0, FINAL>(A, l, b, c64, blk, nt, af, xv, hs, lane, fcur, pba[nti][0], pbx[nti][0], plam[nti][0], phin[nti][0]);
        if (nti == 0) fcur = lru_frag_load(ws, l, 0, blk, nt + 1, lane);
        lru_dir<1, FINAL>(A, l, b, c64, blk, nt, af, xv, hs, lane, f1, pba[nti][1], pbx[nti][1], plam[nti][1], phin[nti][1]);
        if (FINAL) {
#pragma unroll
            for (int q = 0; q < 16; ++q) xs[(16 * g + q) * XLDP + nt * 16 + c] = hs[q]; }
    }
    if (FINAL) {
        LDS_WAIT(); asm volatile("" ::: "memory");
        bf16* Y = (bf16*)(ws + WS_Y) + (size_t)MTOK * 512;
#pragma unroll
        for (int it = 0; it < 4; ++it) { const int id = lane + 64 * it, tok = id >> 2, chn = 4 * half + (id & 3); const size_t row = (size_t)(r0 + tok);
            const LAS f32x4* sp = (const LAS f32x4*)(xs + tok * XLDP + chn * 8); const f32x4 h0 = sp[0], h1 = sp[1];
            float lz[8]; unpack8(*(const v4u*)(Z + row * DIN + ZC_LZ + blk * 64 + chn * 8), lz);
            v4u w; w.x = pk2(gelu_tanh(lz[0]) * h0.x, gelu_tanh(lz[1]) * h0.y); w.y = pk2(gelu_tanh(lz[2]) * h0.z, gelu_tanh(lz[3]) * h0.w);
            w.z = pk2(gelu_tanh(lz[4]) * h1.x, gelu_tanh(lz[5]) * h1.y); w.w = pk2(gelu_tanh(lz[6]) * h1.z, gelu_tanh(lz[7]) * h1.w);
            *(v4u*)(Y + row * 512 + blk * 64 + chn * 8) = w; }
    }
    LDS_WAIT(); asm volatile("" ::: "memory");
}
template <int DIR>
__device__ __forceinline__ void lru_apply(const float (&a_)[16], const float (&u_)[16], float hin, float (&hs)[16], int lane) {
    const int g = lane >> 4, c = lane & 15;
    float P = 1.f, H = 0.f;
#pragma unroll
    for (int qi = 0; qi < 16; ++qi) { const int q = DIR ? 15 - qi : qi; H = a_[q] * H + u_[q]; P *= a_[q]; }
    float Pg[4], Hg[4];
#pragma unroll
    for (int k = 0; k < 4; ++k) { Pg[k] = shi(P, c + 16 * k); Hg[k] = shi(H, c + 16 * k); }
    float s0, s1, s2, s3;
    if (DIR == 0) { s0 = hin; s1 = s0 * Pg[0] + Hg[0]; s2 = s1 * Pg[1] + Hg[1]; s3 = s2 * Pg[2] + Hg[2]; }
    else          { s3 = hin; s2 = s3 * Pg[3] + Hg[3]; s1 = s2 * Pg[2] + Hg[2]; s0 = s1 * Pg[1] + Hg[1]; }
    float h = (g == 0) ? s0 : (g == 1) ? s1 : (g == 2) ? s2 : s3;
#pragma unroll
    for (int qi = 0; qi < 16; ++qi) { const int q = DIR ? 15 - qi : qi; h = a_[q] * h + u_[q]; hs[q] += h; }
}
__device__ __forceinline__ void lru_final(const AH A, int l, int b, int c64, int blk, LAS unsigned char* lds, int wave, int lane, int half) {
    unsigned char* ws = A.ws(); const bf16* Z = (const bf16*)(ws + WS_Z);
    LAS float* xs = (LAS float*)(lds + wave * XWAVE_BYTES);
    const int r0 = b * SROW + c64 * 64;
    const int g = lane >> 4, c = lane & 15;
    float phin[2][2];
#pragma unroll
    for (int nti = 0; nti < 2; ++nti)
#pragma unroll
        for (int d = 0; d < 2; ++d) { const int ch = blk * 64 + (2 * half + nti) * 16 + c;
            phin[nti][d] = ((const float*)(ws + WS_HIN))[((size_t)((b * 2 + d) * 68 + lru_chain_pos(d, c64))) * 512 + ch]; }
    v4u wl[2][2][2], wu[2][2][2];
#pragma unroll
    for (int nti = 0; nti < 2; ++nti)
#pragma unroll
        for (int d = 0; d < 2; ++d) { const size_t e0 = ((((size_t)((b * 68 + c64) * 8 + blk) * 4 + (2 * half + nti)) * 2 + d) * 64 + lane) * 16;
            const bf16* LA = (const bf16*)(ws + WS_HN) + e0; const bf16* LU = (const bf16*)(ws + WS_PARTC) + e0;
            wl[nti][d][0] = *(const v4u*)LA; wl[nti][d][1] = *(const v4u*)(LA + 8); wu[nti][d][0] = *(const v4u*)LU; wu[nti][d][1] = *(const v4u*)(LU + 8); }
#pragma unroll
    for (int nti = 0; nti < 2; ++nti) { const int nt = 2 * half + nti;
        float hs[16];
#pragma unroll
        for (int q = 0; q < 16; ++q) hs[q] = 0.f;
#pragma unroll
        for (int d = 0; d < 2; ++d) { float a_[16], u_[16];
            unpack8(wl[nti][d][0], a_); unpack8(wl[nti][d][1], a_ + 8); unpack8(wu[nti][d][0], u_); unpack8(wu[nti][d][1], u_ + 8);
#pragma unroll
            for (int q = 0; q < 16; ++q) a_[q] = __expf(a_[q]);
            if (d == 0) lru_apply<0>(a_, u_, phin[nti][0], hs, lane); else lru_apply<1>(a_, u_, phin[nti][1], hs, lane); }
#pragma unroll
        for (int q = 0; q < 16; ++q) xs[(16 * g + q) * XLDP + nt * 16 + c] = hs[q];
    }
    LDS_WAIT(); asm volatile("" ::: "memory");
    bf16* Y = (bf16*)(ws + WS_Y) + (size_t)MTOK * 512;
#pragma unroll
    for (int it = 0; it < 4; ++it) { const int id = lane + 64 * it, tok = id >> 2, chn = 4 * half + (id & 3); const size_t row = (size_t)(r0 + tok);
        const LAS f32x4* sp = (const LAS f32x4*)(xs + tok * XLDP + chn * 8); const f32x4 h0 = sp[0], h1 = sp[1];
        float lz[8]; unpack8(*(const v4u*)(Z + row * DIN + ZC_LZ + blk * 64 + chn * 8), lz);
        v4u w; w.x = pk2(gelu_tanh(lz[0]) * h0.x, gelu_tanh(lz[1]) * h0.y); w.y = pk2(gelu_tanh(lz[2]) * h0.z, gelu_tanh(lz[3]) * h0.w);
        w.z = pk2(gelu_tanh(lz[4]) * h1.x, gelu_tanh(lz[5]) * h1.y); w.w = pk2(gelu_tanh(lz[6]) * h1.z, gelu_tanh(lz[7]) * h1.w);
        *(v4u*)(Y + row * 512 + blk * 64 + chn * 8) = w; }
    LDS_WAIT(); asm volatile("" ::: "memory");
}
__device__ __forceinline__ void lru_scan(const AH A, int tid, int G) {
    unsigned char* ws = A.ws(); const float* S = (const float*)(ws + WS_SUMM); float* HIN = (float*)(ws + WS_HIN);
    const int cpb = (4096 + G - 1) / G;
    for (int chain = blockIdx.x * cpb + tid; tid < cpb && chain < 4096; chain += 4096) { const int bd = chain >> 9, ch = chain & 511; float h = 0.f;
        typedef float f32x2s __attribute__((ext_vector_type(2)));
#pragma unroll 1
        for (int p0 = 0; p0 < 68; p0 += 17) { f32x2s ph_[17];
#pragma unroll
            for (int i = 0; i < 17; ++i) ph_[i] = *(const f32x2s*)(S + ((size_t)(bd * 68 + p0 + i) * 512 + ch) * 2);
#pragma unroll
            for (int i = 0; i < 17; ++i) { HIN[(size_t)(bd * 68 + p0 + i) * 512 + ch] = h; h = ph_[i].x * h + ph_[i].y; } } }
}

#define EN(k) (((MASK) >> (k)) & 1)
template <int MASK> __global__ void __launch_bounds__(NWAVES * 64, 2) fwd_kernel(Args args) {
    extern __shared__ __attribute__((aligned(16))) unsigned char lds_raw[];
    LAS unsigned char* lds0 = (LAS unsigned char*)lds_raw;
    cg::grid_group grid = cg::this_grid();
    { const unsigned* aw = (const unsigned*)&args; const int tid = threadIdx.x; if (tid < 54) ((LAS unsigned*)(lds0 + ARGS_LDS_OFF))[tid] = aw[tid];
      if (tid >= 64 && tid < 66) ((LAS unsigned*)(lds0 + ARGS_LDS_OFF + 256))[tid - 64] = 0u; }
    __syncthreads();
    XcdBarrier xbar = xcd_barrier_post((unsigned*)args.ws, (volatile LAS unsigned*)(lds0 + ARGS_LDS_OFF + 256), threadIdx.x == 0);
    const int ph_lo = args.ph_lo, ph_hi = args.ph_hi;
    const int wave0 = __builtin_amdgcn_readfirstlane((int)threadIdx.x >> 6);
#ifndef PROBE_MASK
#define PROBE_MASK 0
#endif
#ifndef PROBE_SUB
#define PROBE_SUB 0
#endif
#define SUBOFF(bit) (rep && ((PROBE_SUB) & (bit)))
#define PROBE_HIT(ph) ((PROBE_MASK) != 0 && ((ph) == 0 ? (((PROBE_MASK) >> 13) & 1) : (ph) == 53 ? (((PROBE_MASK) >> 14) & 1) : (((PROBE_MASK) >> (((ph) - 1) % 13)) & 1)))
    for (int ph2 = 2 * ph_lo; ph2 < 2 * ph_hi; ++ph2) {
        const int ph = ph2 >> 1, rep = ph2 & 1;
        if (rep && !PROBE_HIT(ph)) continue;
        if (ph2 != 2 * ph_lo) {
            if (ph_lo < 0) grid.sync();
            else { int mk2_ = -1; asm volatile("" : "+s"(mk2_)); const bool t0_ = (wave0 == 0) && (__builtin_amdgcn_mbcnt_hi(mk2_, __builtin_amdgcn_mbcnt_lo(mk2_, 0)) == 0); xcd_barrier(xbar, t0_); }
        }
#define PH_PROLOG int wv_ = wave0; int mk_ = -1; asm volatile("" : "+s"(wv_), "+s"(mk_)); int tid = wv_ * 64 + (int)__builtin_amdgcn_mbcnt_hi(mk_, __builtin_amdgcn_mbcnt_lo(mk_, 0)); int G = gridDim.x, bx = blockIdx.x; asm volatile("" : "+s"(G), "+s"(bx)); \
        unsigned ldsi = (unsigned)(unsigned long long)lds0; asm volatile("" : "+s"(ldsi)); LAS unsigned char* lds = (LAS unsigned char*)(unsigned long long)ldsi; \
        const AH AHv{(const LAS unsigned*)(lds + ARGS_LDS_OFF)}; const int lane = tid & 63, wave = wv_; \
        const int gw = bx * NWAVES + wave, NGW = G * NWAVES; (void)gw; (void)NGW; (void)lane; (void)wave; (void)G; (void)bx; (void)tid;
        if (EN(13) && ph == 0) { PH_PROLOG phase_p0(AHv, lds, tid, G); __syncthreads(); convert_layer(AHv, 0, 0, CV_NIT, lds, gw, NGW, wave, lane); }
        else if (EN(14) && ph == 53) { PH_PROLOG final_rows(AHv, gw, NGW, lane); }
        else {
            const int l = (ph - 1) / 13, k = (ph - 1) - l * 13; const bool last = (l == DEPTH - 1);
#define ws (AHv.ws())
#define HN ((bf16*)(ws + WS_HN))
#define Zb ((bf16*)(ws + WS_Z))
#define X ((float*)(ws + WS_X))
#define modbuf ((const float*)(ws + WS_MOD))
            if (EN(0) && k == 0) { PH_PROLOG norm_rows(AHv, l, 0, gw, NGW, lane, l > 0 ? 11 : 0, modbuf + (size_t)(l > 0 ? l - 1 : 0) * 5 * MODW + 4 * MODW + 2 * 3072 + 2048, 0.5f); }
            else if (EN(3) && k == 3) { PH_PROLOG norm_rows(AHv, l, 1, gw, NGW, lane, 11, modbuf + (size_t)l * 5 * MODW + 4 * MODW + 0 * 3072 + 2048, 0.5f); }
            else if (EN(10) && k == 10) { PH_PROLOG norm_rows(AHv, l, 2, gw, NGW, lane, last ? 0 : 4, modbuf + (size_t)l * 5 * MODW + 4 * MODW + 1 * 3072 + 2048, 1.0f); }
            else if (EN(1) && (k == 1 || k == 11)) { PH_PROLOG const int j = (k == 1) ? 0 : 1;
                pg8::Gemm gm{HN, (const bf16*)(ws + (size_t)(l & 1) * WS_WSET + WS_WFI) + (size_t)j * 5632 * 1024, MTOK, 5632, 1024};
                pg8::EpiSwiglu E{Zb};
                if (last && k == 11) { pg8::LastLayerOrder S; S.init(5632, G, bx, 0); pg8::gemm_phase<1024, pg8::EpiSwiglu, pg8::LastLayerOrder, true, true>(lds, gm, S, E, tid); }
                else { pg8::StaticOrder S; S.init(MTOK, 5632, G, bx); pg8::gemm_phase<1024, pg8::EpiSwiglu, pg8::StaticOrder, true, true>(lds, gm, S, E, tid); } }
            else if (EN(2) && (k == 2 || k == 12)) { PH_PROLOG const int j = (k == 2) ? 0 : 1, sub = (k == 2) ? 0 : 2;
                pg8::Gemm gm{Zb, (const bf16*)(ws + (size_t)(l & 1) * WS_WSET + WS_WFO) + (size_t)j * 1024 * DFF, MTOK, 1024, DFF};
                pg8::EpiResid E{X, modbuf + (size_t)l * 5 * MODW + sub * 3072 + 2048, rep ? 0.0f : 0.5f, (float*)(ws + WS_PARTC)};
                if (last && k == 12) { pg8::LatOrder S{G, bx}; pg8::gemm_phase<DFF, pg8::EpiResid, pg8::LatOrder, true, true>(lds, gm, S, E, tid); }
                else { pg8::SplitOrder S{G, bx, 11, 4}; pg8::gemm_phase<DFF, pg8::EpiResid, pg8::SplitOrder, true, true>(lds, gm, S, E, tid); } }
            else if (EN(4) && k == 4) { PH_PROLOG
                pg8::Gemm gm{HN, (const bf16*)(ws + (size_t)(l & 1) * WS_WSET + WS_WIN), MTOK, DIN, 1024};
                pg8::EpiZ E{Zb, DIN};
                if (last) { pg8::LastLayerOrder S; S.init(DIN, G, bx, 28); pg8::gemm_phase<1024, pg8::EpiZ, pg8::LastLayerOrder, true, true>(lds, gm, S, E, tid); }
                else { pg8::StaticOrder S; S.init(MTOK, DIN, G, bx); pg8::gemm_phase<1024, pg8::EpiZ, pg8::StaticOrder, true, true>(lds, gm, S, E, tid); } }
            else if (EN(5) && k == 5) { PH_PROLOG
                if (!SUBOFF(1)) prep_qk(AHv, l, gw, NGW, lane);
                if (!SUBOFF(2)) for (int it = bx; it < 544; it += G) ret_u_item(AHv, l, it, lds, tid, wave, lane);
                __syncthreads();
                if (!SUBOFF(4)) { PH_PROLOG
                    const int H = 2 * 272, n3 = (544 > 2 * G && 544 <= 3 * G) ? 544 - 2 * G : 0, nb = G - n3;
                    for (int hi = bx; hi < H; hi += (bx < n3) ? H : nb) { const int li = hi >> 1; lru_task<false>(AHv, l, li / 68, li % 68, wave, lds, wave, lane, hi & 1); } } }
            else if (EN(6) && k == 6) { PH_PROLOG
                for (int it = bx; it < 256; it += G) ret_scan_item(AHv, l, it, tid);
                lru_scan(AHv, tid, G);
                const int nunits = last ? 512 : 544;
                for (int i = 0;; ++i) { const int u = i * G + bx; if (u >= nunits) break;
                    long qrow0, kvrow0; int hq, kvh, NT;
                    if (u < 512) { const int combo = u & 7, j = u >> 3; const int b = combo >> 1; kvh = combo & 1; hq = kvh * 4 + (j & 3); const int qb = j >> 2;
                        qrow0 = (long)b * SROW + LCTX + qb * 256; kvrow0 = (long)b * SROW; NT = 68; }
                    else { const int v = u - 512; const int b = v >> 3; hq = v & 7; kvh = hq >> 2; qrow0 = (long)b * SROW; kvrow0 = qrow0; NT = 4; }
                    attn_body::attn_unit<8>(qrow0, kvrow0, hq, kvh, NT, (const attn_body::bf16*)(ws + WS_QN), (const attn_body::bf16*)(ws + WS_KN), (const attn_body::bf16*)(Zb + ZC_AV),
                                            (attn_body::bf16*)((bf16*)(ws + WS_Y) + (size_t)2 * MTOK * 512), (char*)lds, tid); } }
            else if ((EN(7) || EN(15)) && k == 7) { PH_PROLOG
                const int nret = last ? 512 : 544, nlru = last ? 256 : 272;
                if (EN(7) && !SUBOFF(8)) for (int it = bx; it < nret; it += G) { const int item = last ? ((it >> 5) * 34 + 2 + (it & 31)) : it; ret_out_item(AHv, l, item, lds, tid, wave, lane); }
                __syncthreads();
                if (EN(15) && !SUBOFF(16)) { PH_PROLOG
                    const int H = 2 * nlru, n3 = (nret > 2 * G && nret <= 3 * G) ? nret - 2 * G : 0, nb = G - n3;
                    for (int hi = bx; hi < H; hi += (bx < n3) ? H : nb) { const int li = hi >> 1; const int b = last ? (li >> 6) : (li / 68), c64 = last ? (4 + (li & 63)) : (li % 68);
                        lru_final(AHv, l, b, c64, wave, lds, wave, lane, hi & 1); } } }
            else if (EN(8) && k == 8) { PH_PROLOG
                pg8::Gemm gm{(const bf16*)(ws + WS_Y), (const bf16*)(ws + (size_t)(l & 1) * WS_WSET + WS_WB), 3 * MTOK, 3 * 1024, 512}; pg8::MergeOrder S{G, bx, last ? 1 : 0};
                pg8::EpiMerge E{Zb, HN};
                pg8::gemm_phase<512, pg8::EpiMerge, pg8::MergeOrder, true, true>(lds, gm, S, E, tid);
                if (!last) {
                    const int nsec = (272 > G) ? ((272 - G < G) ? 272 - G : 0) : 0;
                    if (bx >= nsec) convert_layer(AHv, l + 1, 0, CV_NIT, lds, (bx - nsec) * NWAVES + wave, (G - nsec) * NWAVES, wave, lane); } }
            else if (EN(9) && k == 9) { PH_PROLOG
                pg8::Gemm gm{HN, (const bf16*)(ws + (size_t)(l & 1) * WS_WSET + WS_WO), MTOK, 1024, 1024};
                pg8::EpiResid E{X, modbuf + (size_t)l * 5 * MODW + 1 * 3072 + 2048, rep ? 0.0f : 1.0f, (float*)(ws + WS_PARTC)};
                if (last) { pg8::LatOrder S{G, bx}; pg8::gemm_phase<1024, pg8::EpiResid, pg8::LatOrder, true, true>(lds, gm, S, E, tid); }
                else { pg8::SplitOrder S{G, bx, 4, 4}; pg8::gemm_phase<1024, pg8::EpiResid, pg8::SplitOrder, true, true>(lds, gm, S, E, tid); } }
        }
#undef ws
#undef HN
#undef Zb
#undef X
#undef modbuf
    }
}

#ifndef MK_N_LAUNCHES
#define MK_N_LAUNCHES 1
#endif
#if MK_N_LAUNCHES == 1
#define FULLK fwd_kernel<0xffff>
#else
template <int MASK> static void launch_one(int grid, const Args& a, hipStream_t stream) {
    static bool init = false;
    if (!init) { (void)hipFuncSetAttribute((const void*)fwd_kernel<MASK>, hipFuncAttributeMaxDynamicSharedMemorySize, LDS_BYTES); init = true; }
    hipLaunchKernelGGL(fwd_kernel<MASK>, dim3(grid), dim3(NWAVES * 64), LDS_BYTES, stream, a);
}
#endif
extern "C" void kernel_launch(void* const* d_in, const int* in_sizes, int n_in, void* d_out, int out_size, void* d_ws, size_t ws_size, hipStream_t stream) {
    static int grid = 0;
    if (grid == 0) {
        if (n_in != 24 || ws_size < WS_END) { fprintf(stderr, "kernel_launch: unexpected n_in %d / ws %zu (need %zu)\n", n_in, ws_size, (size_t)WS_END); grid = -1; return; }
        int dev = 0, cus = 0;
        (void)hipGetDevice(&dev); (void)hipDeviceGetAttribute(&cus, hipDeviceAttributeMultiprocessorCount, dev);
#if MK_N_LAUNCHES == 1
        int per_cu = 0;
        (void)hipFuncSetAttribute((const void*)FULLK, hipFuncAttributeMaxDynamicSharedMemorySize, LDS_BYTES);
        if (hipOccupancyMaxActiveBlocksPerMultiprocessor(&per_cu, (const void*)FULLK, NWAVES * 64, LDS_BYTES) != hipSuccess || per_cu < 1) per_cu = 1;
        (void)hipGetLastError();
        grid = cus * per_cu;
#else
        grid = cus;
#endif
        if (grid <= 0) grid = 256;
    }
    if (grid < 0) return;
    (void)hipMemsetAsync(d_ws, 0, 16384, stream);
    Args a{};
    for (int i = 0; i < 24; ++i) a.in[i] = (const float*)d_in[i];
    a.out = (float*)d_out; a.ws = (unsigned char*)d_ws;
#if MK_N_LAUNCHES == 1
    a.ph_lo = 0; a.ph_hi = 54;
    void* params[] = {(void*)&a};
    hipError_t e = hipLaunchCooperativeKernel((const void*)FULLK, dim3(grid), dim3(NWAVES * 64), params, LDS_BYTES, stream);
    if (e != hipSuccess) fprintf(stderr, "cooperative launch failed: %s (grid %d)\n", hipGetErrorString(e), grid);
#else
    for (int ph = 0; ph < 54; ++ph) { a.ph_lo = ph; a.ph_hi = ph + 1;
        if (ph == 0) { launch_one<1 << 13>(grid, a, stream); continue; }
        if (ph == 53) { launch_one<1 << 14>(grid, a, stream); continue; }
        const int k = (ph - 1) % 13;
        switch (k) {
            case 0: launch_one<1 << 0>(grid, a, stream); break;
            case 1: case 11: launch_one<1 << 1>(grid, a, stream); break;
            case 2: case 12: launch_one<1 << 2>(grid, a, stream); break;
            case 3: launch_one<1 << 3>(grid, a, stream); break;
            case 4: launch_one<1 << 4>(grid, a, stream); break;
            case 5: launch_one<1 << 5>(grid, a, stream); break;
            case 6: launch_one<1 << 6>(grid, a, stream); break;
            case 7: launch_one<1 << 7>(grid, a, stream); launch_one<1 << 15>(grid, a, stream); break;
            case 8: launch_one<1 << 8>(grid, a, stream); break;
            case 9: launch_one<1 << 9>(grid, a, stream); break;
            case 10: launch_one<1 << 10>(grid, a, stream); break;
        }
    }
#endif
}
```

```cpp
#include <hip/hip_runtime.h>
#include <hip/hip_cooperative_groups.h>
#include <hip/hip_bf16.h>
#include <cstdio>
#include <cstdint>
#include <cmath>
namespace cg = cooperative_groups;
namespace pg8 {
#define PG8_LAS __attribute__((address_space(3)))
typedef unsigned short bf16_t;
typedef short bf16x8 __attribute__((ext_vector_type(8)));
typedef float f32x4 __attribute__((ext_vector_type(4)));
typedef unsigned u32x4 __attribute__((ext_vector_type(4)));
constexpr int BM = 256, BK = 64, HALF = 128, HTB = HALF * BK * 2  , STAGE_BYTES = 8 * HTB, NXCD = 8, WGM = 4;

__host__ __device__ __forceinline__ int lds_byte(int r, int c) { const int st = (r >> 4) * 2 + (c >> 5), rr = r & 15, cc = c & 31, ob = rr * 64 + cc * 2; return st * 1024 + (ob ^ (((ob >> 9) & 1) << 5)); }
__host__ __device__ __forceinline__ void stage_rc(int b, int& R, int& C) { const int st = b / 1024, sb = b % 1024, swz = sb ^ (((sb >> 9) & 1) << 5); R = (st >> 1) * 16 + swz / 64; C = (st & 1) * 32 + (swz % 64) / 2; }
__host__ __device__ __forceinline__ int perm32(int rho) { const int n = rho >> 4, i = rho & 15; return 8 * (i >> 2) + 4 * n + (i & 3); }

struct Unit { int pm, pn, k0, nk; };
struct Gemm { const bf16_t* A; const bf16_t* Bt; int M, N, K; };

struct StaticOrder {
    int nM, nN, nwg, G, c;
    __host__ __device__ void init(int M, int N, int G_, int c_) { nM = M / BM; nN = N / BM; nwg = nM * nN; G = G_; c = c_; }
    __host__ __device__ bool next(int i, Unit& u) const {
        const long L = (long)i * G + c; if (L >= nwg) return false;
        int wgid = (int)L; { const int q = nwg / NXCD, r = nwg % NXCD, xcd = wgid % NXCD, off = wgid / NXCD; wgid = (xcd < r ? xcd * (q + 1) : r * (q + 1) + (xcd - r) * q) + off; }
        const int nig = WGM * nN, gid = wgid / nig, fm = gid * WGM, gsz = (nM - fm) < WGM ? (nM - fm) : WGM;
        u.pm = fm + ((wgid % nig) % gsz); u.pn = (wgid % nig) / gsz; u.k0 = 0; u.nk = 0; return true;
    }
    __device__ __forceinline__ void a_ready(const Unit&) const {}
    __device__ __forceinline__ void done(const Unit&) const {}
};

typedef unsigned u32x2 __attribute__((ext_vector_type(2)));
__device__ __forceinline__ unsigned cvt_pk_bf16(float lo, float hi) { unsigned r; asm volatile("v_cvt_pk_bf16_f32 %0, %1, %2" : "=v"(r) : "v"(lo), "v"(hi)); return r; }
__device__ __forceinline__ float fast_sigmoid(float v) { return __builtin_amdgcn_rcpf(1.0f + __expf(-v)); }
__device__ __forceinline__ float bf_lo(unsigned w) { return __uint_as_float(w << 16); }
__device__ __forceinline__ float bf_hi(unsigned w) { return __uint_as_float(w & 0xffff0000u); }
struct EpiZ {
    static constexpr bool PERM = true, AFTER_DRAIN = false, CHAIN = false;
    bf16_t* O; int ldc;
    __device__ __forceinline__ void operator()(const f32x4 (&acc)[2][2][4][2], const Unit& u, int wr, int wc, int fr, int fq) const {
        const int row0 = u.pm * BM + wr * 64 + fr; const int col0 = u.pn * BM + wc * 32 + 8 * fq;
#pragma unroll
        for (int ai = 0; ai < 2; ++ai)
#pragma unroll
            for (int m = 0; m < 4; ++m) { bf16_t* rowp = O + (size_t)(row0 + ai * HALF + m * 16) * ldc + col0;
#pragma unroll
                for (int bj = 0; bj < 2; ++bj) { const f32x4 v0 = acc[ai][bj][m][0], v1 = acc[ai][bj][m][1];
                    u32x4 w; w.x = cvt_pk_bf16(v0[0], v0[1]); w.y = cvt_pk_bf16(v0[2], v0[3]); w.z = cvt_pk_bf16(v1[0], v1[1]); w.w = cvt_pk_bf16(v1[2], v1[3]);
                    *(u32x4*)(rowp + bj * HALF) = w; } }
    }
};
struct EpiSwiglu {
    static constexpr bool PERM = true, AFTER_DRAIN = false, CHAIN = false;
    bf16_t* O;
    __device__ __forceinline__ void operator()(const f32x4 (&acc)[2][2][4][2], const Unit& u, int wr, int wc, int fr, int fq) const {
        const int row0 = u.pm * BM + wr * 64 + fr; const int col0 = u.pn * HALF + wc * 32 + 8 * fq;
#pragma unroll
        for (int ai = 0; ai < 2; ++ai)
#pragma unroll
            for (int m = 0; m < 4; ++m) { bf16_t* rowp = O + (size_t)(row0 + ai * HALF + m * 16) * 2816 + col0;
                float h[8];
#pragma unroll
                for (int n = 0; n < 2; ++n)
#pragma unroll
                    for (int j = 0; j < 4; ++j) { const float a = acc[ai][0][m][n][j], b = acc[ai][1][m][n][j]; h[n * 4 + j] = a * fast_sigmoid(a) * b; }
                u32x4 w; w.x = cvt_pk_bf16(h[0], h[1]); w.y = cvt_pk_bf16(h[2], h[3]); w.z = cvt_pk_bf16(h[4], h[5]); w.w = cvt_pk_bf16(h[6], h[7]);
                *(u32x4*)rowp = w; }
    }
};
struct EpiResid {
    static constexpr bool PERM = false, AFTER_DRAIN = false, CHAIN = false;
    float* X; const float* gate; float scale; float* PARTC;
    __device__ __forceinline__ void operator()(const f32x4 (&acc)[2][2][4][2], const Unit& u, int wr, int wc, int fr, int fq) const {
        const int bb = u.pm / 17, mrow = (u.pm - bb * 17 == 0) ? 4 : bb;
        const int col0 = u.pn * BM + wc * 32 + 4 * fq;
        if (u.nk != 0) {
            const int sp = u.k0 / (u.nk * 64); bf16_t* base = (bf16_t*)PARTC + ((size_t)sp * 1024 + (size_t)bb * 256 + wr * 64 + fr) * 1024 + col0;
#pragma unroll
            for (int ai = 0; ai < 2; ++ai)
#pragma unroll
                for (int m = 0; m < 4; ++m)
#pragma unroll
                    for (int bj = 0; bj < 2; ++bj)
#pragma unroll
                        for (int n = 0; n < 2; ++n) { const f32x4 v = acc[ai][bj][m][n]; u32x2 w; w.x = cvt_pk_bf16(v[0], v[1]); w.y = cvt_pk_bf16(v[2], v[3]);
                            *(u32x2*)(base + (size_t)(ai * HALF + m * 16) * 1024 + bj * HALF + n * 16) = w; }
            return; }
        const float* g = gate + (size_t)mrow * 9216;
        const int row0 = u.pm * BM + wr * 64 + fr;
        f32x4 gv[2][2];
#pragma unroll
        for (int bj = 0; bj < 2; ++bj)
#pragma unroll
            for (int n = 0; n < 2; ++n) gv[bj][n] = *(const f32x4*)(g + col0 + bj * HALF + n * 16) * scale;
#pragma unroll
        for (int ai = 0; ai < 2; ++ai)
#pragma unroll
            for (int m = 0; m < 4; ++m) { float* rowp = X + (size_t)(row0 + ai * HALF + m * 16) * 1024 + col0;
#pragma unroll
                for (int bj = 0; bj < 2; ++bj)
#pragma unroll
                    for (int n = 0; n < 2; ++n) { f32x4* p = (f32x4*)(rowp + bj * HALF + n * 16); *p = *p + gv[bj][n] * acc[ai][bj][m][n]; }
                asm volatile("" ::: "memory"); }
    }
};
struct EpiMerge {
    static constexpr bool PERM = false, AFTER_DRAIN = false, CHAIN = true;
    const bf16_t* Z; bf16_t* MG;
    __device__ __forceinline__ void operator()(const f32x4 (&acc)[2][2][4][2], const Unit& u, int wr, int wc, int fr, int fq) const {}
    __device__ __forceinline__ bool chain(f32x4 (&acc)[2][2][4][2], const Unit& u, int wr, int wc, int fr, int fq) const {
        const int n = u.pm / 68, pm = u.pm - n * 68, pn = u.pn & 3;
        const int row0 = pm * BM + wr * 64 + fr; const int col0 = pn * BM + wc * 32 + 4 * fq;
#pragma unroll
        for (int ai = 0; ai < 2; ++ai)
#pragma unroll
            for (int m = 0; m < 4; ++m) { const size_t row = (size_t)(row0 + ai * HALF + m * 16);
#pragma unroll
                for (int bj = 0; bj < 2; ++bj)
#pragma unroll
                    for (int nn = 0; nn < 2; ++nn) { const int col = col0 + bj * HALF + nn * 16;
                        const bf16_t* zp = Z + row * 6912 + 3840 + n * 1024 + col;
                        const u32x2 ga = *(const u32x2*)zp;
                        const float ea0 = 1.0f + __expf(-bf_lo(ga.x)), ea1 = 1.0f + __expf(-bf_hi(ga.x)), ea2 = 1.0f + __expf(-bf_lo(ga.y)), ea3 = 1.0f + __expf(-bf_hi(ga.y));
                        f32x4 sc;
                        if (n < 2) { const u32x2 gb = *(const u32x2*)(zp + 1024);
                            sc[0] = (1.0f + __expf(-bf_lo(gb.x))) * __builtin_amdgcn_rcpf(ea0); sc[1] = (1.0f + __expf(-bf_hi(gb.x))) * __builtin_amdgcn_rcpf(ea1);
                            sc[2] = (1.0f + __expf(-bf_lo(gb.y))) * __builtin_amdgcn_rcpf(ea2); sc[3] = (1.0f + __expf(-bf_hi(gb.y))) * __builtin_amdgcn_rcpf(ea3);
                            acc[ai][bj][m][nn] = acc[ai][bj][m][nn] * sc; }
                        else { sc[0] = __builtin_amdgcn_rcpf(ea0); sc[1] = __builtin_amdgcn_rcpf(ea1); sc[2] = __builtin_amdgcn_rcpf(ea2); sc[3] = __builtin_amdgcn_rcpf(ea3);
                            const f32x4 v = acc[ai][bj][m][nn] * sc; u32x2 w; w.x = cvt_pk_bf16(v[0], v[1]); w.y = cvt_pk_bf16(v[2], v[3]); *(u32x2*)(MG + row * 1024 + col) = w; } }
                asm volatile("" ::: "memory"); }
        return n < 2;
    }
};
struct MergeOrder {
    int G, c, latonly;
    __device__ bool next(int i, Unit& u) const {
        const int ti = i / 3, n = i - ti * 3; const int L = ti * G + c; if (L >= (latonly ? 256 : 272)) return false;
        const int t = L >> 2; const int pm = latonly ? ((t >> 4) * 17 + 1 + (t & 15)) : t;
        u.pm = n * 68 + pm; u.pn = n * 4 + (L & 3); u.k0 = 0; u.nk = 0; return true;
    }
    __device__ __forceinline__ void a_ready(const Unit&) const {}
    __device__ __forceinline__ void done(const Unit&) const {}
};
struct LastLayerOrder {
    StaticOrder so; int nextra;
    __device__ void init(int N, int G, int c, int nextra_) { so.init(64 * BM, N, G, c); nextra = nextra_; }
    __device__ bool next(int i, Unit& u) const {
        if (so.next(i, u)) { const int v = u.pm; u.pm = (v >> 4) * 17 + 1 + (v & 15); return true; }
        const int L = i * so.G + so.c - so.nwg; if (L < 0 || L >= nextra) return false;
        const int t = L / 7, q = L - t * 7; u.pm = t * 17; u.pn = (q < 4) ? 2 + q : (q < 6) ? 4 + q : 14; u.k0 = 0; u.nk = 0; return true;
    }
    __device__ __forceinline__ void a_ready(const Unit&) const {}
    __device__ __forceinline__ void done(const Unit&) const {}
};
struct LatOrder {
    int G, c;
    __device__ bool next(int i, Unit& u) const {
        const int L = i * G + c; if (L >= 256) return false;
        const int t = L >> 2; u.pm = (t >> 4) * 17 + 1 + (t & 15); u.pn = L & 3; u.k0 = 0; u.nk = 0; return true;
    }
    __device__ __forceinline__ void a_ready(const Unit&) const {}
    __device__ __forceinline__ void done(const Unit&) const {}
};
struct SplitOrder {
    int G, c, nsplit, nkt;
    __device__ bool next(int i, Unit& u) const {
        int L = i * G + c;
        if (L < 256) { const int t = L >> 2; u.pm = (t >> 4) * 17 + 1 + (t & 15); u.pn = L & 3; u.k0 = 0; u.nk = 0; return true; }
        L -= 256; if (L >= 16 * nsplit) return false;
        const int t = L / nsplit, s = L - t * nsplit;
        u.pm = (t >> 2) * 17; u.pn = t & 3; u.k0 = s * nkt * 64; u.nk = nkt; return true;
    }
    __device__ __forceinline__ void a_ready(const Unit&) const {}
    __device__ __forceinline__ void done(const Unit&) const {}
};
template <int KT, class Epi, class Sched, bool ALIGN_EPI = false, bool SP2 = false>
__device__ __forceinline__ void gemm_phase(PG8_LAS unsigned char* lds, const Gemm g, const Sched& S, const Epi& E, const int tid) {
    const int wid = __builtin_amdgcn_readfirstlane(tid >> 6), lane = tid & 63, wr = wid >> 2, wc = wid & 3, fr = lane & 15, fq = lane >> 4;
    constexpr int K = KT, nt = K / BK;
    unsigned voffA[2], voffB[2];
#pragma unroll
    for (int i = 0; i < 2; ++i) { int R, C; stage_rc(tid * 16 + i * 8192, R, C); const int Rb = Epi::PERM ? ((R & ~31) + perm32(R & 31)) : R;
        voffA[i] = (unsigned)(R * K + C) * 2u; voffB[i] = (unsigned)(Rb * K + C) * 2u; }
    const size_t kstep = (size_t)(BK * 2);
    const size_t hstep = (size_t)HALF * K * 2;
    const size_t tstep = 2 * hstep;
    const unsigned ldsw = (unsigned)wid * 1024u;
    const int aoff = lds_byte(wr * 64 + fr, fq * 8), boff = lds_byte(wc * 32 + fr, fq * 8);
#define PG8_SA(b, h) (((b) * 2 + (h)) * HTB)
#define PG8_SB(b, h) ((4 + (b) * 2 + (h)) * HTB)
#define PG8_STAGE(bufoff, gbase, voff) do { _Pragma("unroll") for (int _i = 0; _i < 2; ++_i) \
        __builtin_amdgcn_global_load_lds((const unsigned*)((const char*)(gbase) + (voff)[_i]), (PG8_LAS unsigned*)(lds + (bufoff) + ldsw + _i * 8192), 16, 0, 0); } while (0)
#define PG8_LDA(dst, b, h) do { _Pragma("unroll") for (int m = 0; m < 4; ++m) _Pragma("unroll") for (int k = 0; k < 2; ++k) dst[m][k] = *(const PG8_LAS bf16x8*)(lds + PG8_SA(b, h) + aoff + m * 2048 + k * 1024); } while (0)
#define PG8_LDB(dst, b, h) do { _Pragma("unroll") for (int n = 0; n < 2; ++n) _Pragma("unroll") for (int k = 0; k < 2; ++k) dst[n][k] = *(const PG8_LAS bf16x8*)(lds + PG8_SB(b, h) + boff + n * 2048 + k * 1024); } while (0)
#define PG8_MMA(ai, bj, At, Bt) do { __builtin_amdgcn_s_setprio(1); _Pragma("unroll") for (int m = 0; m < 4; ++m) _Pragma("unroll") for (int n = 0; n < 2; ++n) _Pragma("unroll") for (int k = 0; k < 2; ++k) \
        acc[ai][bj][m][n] = __builtin_amdgcn_mfma_f32_16x16x32_bf16(Bt[n][k], At[m][k], acc[ai][bj][m][n], 0, 0, 0); __builtin_amdgcn_s_setprio(0); } while (0)
#define PG8_WAIT_V(n) asm volatile("s_waitcnt vmcnt(" #n ")" ::: "memory")
#define PG8_WAIT_L(n) asm volatile("s_waitcnt lgkmcnt(" #n ")" ::: "memory")
#define PG8_BAR __builtin_amdgcn_s_barrier()
#define PG8_SCHED __builtin_amdgcn_sched_barrier(0)
    Unit cur{0, 0, 0, 0}, nxt{0, 0, 0, 0}; int ui = 0;
    if (!S.next(0, cur)) return;
    f32x4 acc[2][2][4][2];
#pragma unroll
    for (int a = 0; a < 2; ++a)
#pragma unroll
        for (int b = 0; b < 2; ++b)
#pragma unroll
            for (int m = 0; m < 4; ++m)
#pragma unroll
                for (int n = 0; n < 2; ++n) acc[a][b][m][n] = (f32x4){0.f, 0.f, 0.f, 0.f};
    bf16x8 At[4][2], B0[2][2], B1[2][2];
    const char* cA = (const char*)g.A + (size_t)cur.pm * tstep + (size_t)cur.k0 * 2; const char* cB = (const char*)g.Bt + (size_t)cur.pn * tstep + (size_t)cur.k0 * 2;
    S.a_ready(cur);
    if constexpr (SP2) {
        PG8_STAGE(PG8_SB(0, 0), cB, voffB); PG8_STAGE(PG8_SB(0, 1), cB + hstep, voffB); PG8_STAGE(PG8_SA(0, 0), cA, voffA); PG8_STAGE(PG8_SA(0, 1), cA + hstep, voffA);
        if (wr == 1) PG8_BAR;
        PG8_WAIT_V(2); PG8_BAR;
        PG8_STAGE(PG8_SB(1, 0), cB + kstep, voffB); PG8_STAGE(PG8_SA(1, 0), cA + kstep, voffA); PG8_STAGE(PG8_SB(1, 1), cB + hstep + kstep, voffB);
        PG8_WAIT_V(6); PG8_BAR;
    } else {
        PG8_STAGE(PG8_SB(0, 0), cB, voffB); PG8_STAGE(PG8_SA(0, 0), cA, voffA); PG8_STAGE(PG8_SB(0, 1), cB + hstep, voffB); PG8_STAGE(PG8_SA(0, 1), cA + hstep, voffA);
        if (wr == 1) PG8_BAR;
        PG8_WAIT_V(4); PG8_BAR;
        PG8_STAGE(PG8_SB(1, 0), cB + kstep, voffB); PG8_STAGE(PG8_SA(1, 0), cA + kstep, voffA); PG8_STAGE(PG8_SB(1, 1), cB + hstep + kstep, voffB);
        PG8_WAIT_V(6); PG8_BAR;
    }
    for (;;) {
        const bool has_next = S.next(ui + 1, nxt);
        const char* nA = has_next ? (const char*)g.A + (size_t)nxt.pm * tstep + (size_t)nxt.k0 * 2 : cA; const char* nB = has_next ? (const char*)g.Bt + (size_t)nxt.pn * tstep + (size_t)nxt.k0 * 2 : cB;
        const int ntu = cur.nk ? cur.nk : nt;
        for (int t = 0; t < ntu; t += 2) {
            const bool last = (t == ntu - 2);
            const char* a1 = cA + (size_t)(t + 1) * kstep;
            const char* a2 = last ? nA : cA + (size_t)(t + 2) * kstep; const char* b2 = last ? nB : cB + (size_t)(t + 2) * kstep;
            const char* a3 = a2 + kstep; const char* b3 = b2 + kstep;
            if (last && has_next) S.a_ready(nxt);
            if constexpr (SP2) {
            PG8_LDB(B0, 0, 0); PG8_LDB(B1, 0, 1); PG8_SCHED; PG8_LDA(At, 0, 0); PG8_STAGE(PG8_SA(1, 1), a1 + hstep, voffA);
            PG8_WAIT_V(8); PG8_WAIT_L(0); PG8_BAR; PG8_MMA(0, 0, At, B0); PG8_MMA(0, 1, At, B1); PG8_BAR; PG8_SCHED;
            PG8_LDA(At, 0, 1); PG8_STAGE(PG8_SB(0, 0), b2, voffB); PG8_STAGE(PG8_SB(0, 1), b2 + hstep, voffB); PG8_STAGE(PG8_SA(0, 0), a2, voffA);
            PG8_WAIT_V(8); PG8_WAIT_L(0); PG8_BAR; PG8_MMA(1, 0, At, B0); PG8_MMA(1, 1, At, B1); PG8_BAR; PG8_SCHED;
            PG8_LDB(B0, 1, 0); PG8_LDB(B1, 1, 1); PG8_SCHED; PG8_LDA(At, 1, 0); PG8_STAGE(PG8_SA(0, 1), a2 + hstep, voffA);
            PG8_WAIT_V(8); PG8_WAIT_L(0); PG8_BAR; PG8_MMA(0, 0, At, B0); PG8_MMA(0, 1, At, B1); PG8_BAR; PG8_SCHED;
            PG8_LDA(At, 1, 1); PG8_STAGE(PG8_SB(1, 0), b3, voffB); PG8_STAGE(PG8_SB(1, 1), b3 + hstep, voffB); PG8_STAGE(PG8_SA(1, 0), a3, voffA);
            PG8_WAIT_V(8); PG8_WAIT_L(0); PG8_BAR; PG8_MMA(1, 0, At, B0); PG8_MMA(1, 1, At, B1); PG8_BAR; PG8_SCHED;
            } else {
            PG8_LDB(B0, 0, 0); PG8_SCHED; PG8_LDA(At, 0, 0); PG8_STAGE(PG8_SA(1, 1), a1 + hstep, voffA);
            PG8_WAIT_L(8); PG8_BAR; PG8_WAIT_L(0); PG8_MMA(0, 0, At, B0); PG8_BAR; PG8_SCHED;
            PG8_LDB(B1, 0, 1); PG8_STAGE(PG8_SB(0, 0), b2, voffB);
            PG8_BAR; PG8_WAIT_L(0); PG8_MMA(0, 1, At, B1); PG8_BAR;
            PG8_LDA(At, 0, 1); PG8_STAGE(PG8_SA(0, 0), a2, voffA);
            PG8_BAR; PG8_WAIT_L(0); PG8_MMA(1, 0, At, B0); PG8_BAR; PG8_SCHED;
            PG8_STAGE(PG8_SB(0, 1), b2 + hstep, voffB);
            PG8_WAIT_V(6); PG8_BAR; PG8_MMA(1, 1, At, B1); PG8_BAR;
            PG8_LDB(B0, 1, 0); PG8_SCHED; PG8_LDA(At, 1, 0); PG8_STAGE(PG8_SA(0, 1), a2 + hstep, voffA);
            PG8_WAIT_L(8); PG8_BAR; PG8_WAIT_L(0); PG8_MMA(0, 0, At, B0); PG8_BAR; PG8_SCHED;
            PG8_LDB(B1, 1, 1); PG8_STAGE(PG8_SB(1, 0), b3, voffB);
            PG8_BAR; PG8_WAIT_L(0); PG8_MMA(0, 1, At, B1); PG8_BAR;
            PG8_LDA(At, 1, 1); PG8_STAGE(PG8_SA(1, 0), a3, voffA);
            PG8_BAR; PG8_WAIT_L(0); PG8_MMA(1, 0, At, B0); PG8_BAR; PG8_SCHED;
            PG8_STAGE(PG8_SB(1, 1), b3 + hstep, voffB);
            PG8_WAIT_V(6); PG8_BAR; PG8_MMA(1, 1, At, B1); PG8_BAR;
            }
        }
        if constexpr (ALIGN_EPI) { if (wr == 0) PG8_BAR; }
        bool keep_acc = false;
        if constexpr (!Epi::AFTER_DRAIN) { if constexpr (Epi::CHAIN) keep_acc = E.chain(acc, cur, wr, wc, fr, fq); else E(acc, cur, wr, wc, fr, fq); S.done(cur); }
        if (!has_next) break;
        if (!keep_acc) {
#pragma unroll
        for (int a = 0; a < 2; ++a)
#pragma unroll
            for (int b = 0; b < 2; ++b)
#pragma unroll
                for (int m = 0; m < 4; ++m)
#pragma unroll
                    for (int n = 0; n < 2; ++n) acc[a][b][m][n] = (f32x4){0.f, 0.f, 0.f, 0.f};
        }
        cur = nxt; cA = nA; cB = nB; ++ui;
        if constexpr (ALIGN_EPI) { if (wr == 1) PG8_BAR; }
    }
    PG8_WAIT_V(0);
    if constexpr (!ALIGN_EPI) { if (wr == 0) PG8_BAR; }
    PG8_BAR;
    if constexpr (Epi::AFTER_DRAIN) { E.fused(acc, cur, wr, wc, fr, fq, lds, wid, lane); S.done(cur); }
#undef PG8_SA
#undef PG8_SB
#undef PG8_STAGE
#undef PG8_LDA
#undef PG8_LDB
#undef PG8_MMA
#undef PG8_WAIT_V
#undef PG8_WAIT_L
#undef PG8_BAR
#undef PG8_SCHED
}
}
namespace attn_body {
using bf16=__hip_bfloat16;
using bf16x8=__attribute__((ext_vector_type(8)))short;
using s16x4=__attribute__((ext_vector_type(4)))short;
using f32x16=__attribute__((ext_vector_type(16)))float;
using u32x4=__attribute__((ext_vector_type(4)))unsigned;
constexpr int D=64,QP=512,KP=128,VP=6912,OP=512;
constexpr int NW=8,QBLK=32,QB=QBLK*NW,KVBLK=64;
__device__ __forceinline__ int crow(int r,int hi){return (r&3)+8*(r>>2)+4*hi;}
#define SBAR() __builtin_amdgcn_sched_barrier(0)
constexpr int NSLOT=3, SLOTB=8192;
constexpr int LDS_K=0, LDS_V=NSLOT*SLOTB, LDS_WS=2*NSLOT*SLOTB, LDS_OST=LDS_WS+NW*64*4, LDS_BYTES=LDS_OST+NW*4096;
constexpr float C2=0.125f*1.4426950408889634f;
__device__ __forceinline__ void glds16(const void*gsrc,unsigned lds_dst){unsigned keep;
  asm volatile("s_mov_b32 %0, m0\n\ts_mov_b32 m0, %2\n\ts_nop 0\n\tglobal_load_lds_dwordx4 %1, off\n\ts_mov_b32 m0, %0":"=&s"(keep):"v"(gsrc),"s"(lds_dst):"memory");}
__device__ __forceinline__ float max3f(float a,float b,float c){float r;asm("v_max3_f32 %0, %1, %2, %3":"=v"(r):"v"(a),"v"(b),"v"(c));return r;}
__device__ __forceinline__ float max2f(float a,float b){float r;asm("v_max_f32_e32 %0, %1, %2":"=v"(r):"v"(a),"v"(b));return r;}
__device__ __forceinline__ float fadd_s(float a,float b){float r;asm("v_add_f32_e32 %0, %1, %2":"=v"(r):"v"(a),"v"(b));return r;}
__device__ __forceinline__ float fsub_s(float a,float b){float r;asm("v_sub_f32_e32 %0, %1, %2":"=v"(r):"v"(a),"v"(b));return r;}
typedef float f32x2_t __attribute__((ext_vector_type(2))); typedef __bf16 bf16x2_t __attribute__((ext_vector_type(2)));
__device__ __forceinline__ unsigned cvtpk_s(float lo,float hi){f32x2_t v={lo,hi};bf16x2_t b=__builtin_convertvector(v,bf16x2_t);return __builtin_bit_cast(unsigned,b);}
#define WAIT_BAR(N) asm volatile("s_waitcnt vmcnt(" #N ") lgkmcnt(0)\n\ts_barrier":::"memory")

__device__ __forceinline__ void qkt(f32x16&p0,f32x16&p1,const char*Kslot,const bf16x8*qr,const f32x16&negm,int r32,int hi){
  const char*kb=Kslot+hi*1024+r32*16;
  #pragma unroll
  for(int d0=0;d0<4;++d0){
    const bf16x8 b0=*reinterpret_cast<const bf16x8*>(kb+d0*2048);
    const bf16x8 b1=*reinterpret_cast<const bf16x8*>(kb+d0*2048+512);
    if(d0==0){p0=__builtin_amdgcn_mfma_f32_32x32x16_bf16(b0,qr[0],negm,0,0,0);p1=__builtin_amdgcn_mfma_f32_32x32x16_bf16(b1,qr[0],negm,0,0,0);}
    else{p0=__builtin_amdgcn_mfma_f32_32x32x16_bf16(b0,qr[d0],p0,0,0,0);p1=__builtin_amdgcn_mfma_f32_32x32x16_bf16(b1,qr[d0],p1,0,0,0);}}
}
typedef __attribute__((address_space(3))) const char* lds_cptr;
typedef short v4i16_t __attribute__((ext_vector_type(4)));
__device__ __forceinline__ void kload8(bf16x8*kf,lds_cptr kp){
  kf[0]=*(const __attribute__((address_space(3))) bf16x8*)(kp);      kf[1]=*(const __attribute__((address_space(3))) bf16x8*)(kp+512);
  kf[2]=*(const __attribute__((address_space(3))) bf16x8*)(kp+2048); kf[3]=*(const __attribute__((address_space(3))) bf16x8*)(kp+2560);
  kf[4]=*(const __attribute__((address_space(3))) bf16x8*)(kp+4096); kf[5]=*(const __attribute__((address_space(3))) bf16x8*)(kp+4608);
  kf[6]=*(const __attribute__((address_space(3))) bf16x8*)(kp+6144); kf[7]=*(const __attribute__((address_space(3))) bf16x8*)(kp+6656);
}
__device__ __forceinline__ void kload2(bf16x8*kf,lds_cptr kp,int j){ kf[2*j]=*(const __attribute__((address_space(3))) bf16x8*)(kp+j*2048); kf[2*j+1]=*(const __attribute__((address_space(3))) bf16x8*)(kp+j*2048+512); }
__device__ __forceinline__ s16x4 vtr(lds_cptr p){ return __builtin_bit_cast(s16x4,__builtin_amdgcn_ds_read_tr16_b64_v4i16((__attribute__((address_space(3))) v4i16_t*)p)); }
__device__ __forceinline__ float rowmax(const f32x16&p0,const f32x16&p1){
  float a=max3f(p0[0],p0[1],p1[0]),b=max3f(p0[2],p0[3],p1[1]);a=max3f(a,p1[2],p1[3]);
  #pragma unroll
  for(int r=4;r<16;r+=4){a=max3f(a,p0[r],p0[r+1]);b=max3f(b,p0[r+2],p0[r+3]);a=max3f(a,p1[r],p1[r+1]);b=max3f(b,p1[r+2],p1[r+3]);}
  const float m=max2f(a,b);
  auto rr=__builtin_amdgcn_permlane32_swap(__float_as_uint(m),__float_as_uint(m),false,false);
  return max2f(__uint_as_float(rr[0]),__uint_as_float(rr[1]));
}
__device__ __forceinline__ void pv(f32x16*o,int vb,bf16x8 pa0,bf16x8 pa1,bf16x8 pa2,bf16x8 pa3){
  #pragma unroll
  for(int d0=0;d0<2;++d0){s16x4 lo[4],hi[4];
    #pragma unroll
    for(int ks=0;ks<4;++ks){
      asm volatile("ds_read_b64_tr_b16 %0,%1 offset:%c2":"=&v"(lo[ks]):"v"(vb),"i"(d0*4096+ks*1024):"memory");
      asm volatile("ds_read_b64_tr_b16 %0,%1 offset:%c2":"=&v"(hi[ks]):"v"(vb),"i"(d0*4096+ks*1024+512):"memory");}
    asm volatile("s_waitcnt lgkmcnt(0)":::"memory");SBAR();
    #define PK(k) (bf16x8){lo[k][0],lo[k][1],lo[k][2],lo[k][3],hi[k][0],hi[k][1],hi[k][2],hi[k][3]}
    o[d0]=__builtin_amdgcn_mfma_f32_32x32x16_bf16(pa0,PK(0),o[d0],0,0,0);
    o[d0]=__builtin_amdgcn_mfma_f32_32x32x16_bf16(pa1,PK(1),o[d0],0,0,0);
    o[d0]=__builtin_amdgcn_mfma_f32_32x32x16_bf16(pa2,PK(2),o[d0],0,0,0);
    o[d0]=__builtin_amdgcn_mfma_f32_32x32x16_bf16(pa3,PK(3),o[d0],0,0,0);
    #undef PK
  }
}

#ifndef ATTN_STORE16
#define ATTN_STORE16(p,v) (*(u32x4*)(p)=(v))
#endif
template<int THRL> __device__ __forceinline__ void attn_unit(long qrow0,long kvrow0,int hq,int kvh,int NT,const bf16*Q,const bf16*__restrict__ K,const bf16*__restrict__ V,bf16*O,char*shm,const int tid){
  const int lane=tid&63,r32=lane&31,hi=lane>>5; const int wid=__builtin_amdgcn_readfirstlane(tid>>6);
  const bf16*Qw=Q+(qrow0+wid*QBLK)*QP+hq*D;
  const bf16*Kh=K+kvrow0*KP+kvh*D,*Vh=V+kvrow0*VP+kvh*D;
  const unsigned lds0=(unsigned)(uintptr_t)shm;
  float*wsf=(float*)(shm+LDS_WS)+wid*64;
  const bf16*ksrc=Kh+(long)lane*KP+wid*8;
  const bf16*vsrc=Vh+(long)(16*(wid&3)+(lane>>2))*VP+(wid>>2)*32+(lane&3)*8;
  const unsigned kdst=lds0+LDS_K+wid*1024, vdst=lds0+LDS_V+wid*1024;
  #define DMA_K(t,slot) glds16(ksrc+(long)(t)*KVBLK*KP,(unsigned)__builtin_amdgcn_readfirstlane(kdst+(slot)))
  #define DMA_V(t,slot) glds16(vsrc+(long)(t)*KVBLK*VP,(unsigned)__builtin_amdgcn_readfirstlane(vdst+(slot)))
  const int vb0=(int)(lds0+LDS_V)+((lane>>4)&1)*32+(lane&3)*8+(4*hi+((lane&15)>>2))*64;
  const char*Kbase=shm+LDS_K; bf16x8 kf[8];
  const lds_cptr shm3=(lds_cptr)shm; const lds_cptr kp0=shm3+LDS_K+hi*1024+r32*16; const lds_cptr vp0=shm3+LDS_V+((lane>>4)&1)*32+(lane&3)*8+(4*hi+((lane&15)>>2))*64;
  DMA_K(0,0);DMA_V(0,0);DMA_K(1,SLOTB);
  bf16x8 qr[4];
  #pragma unroll
  for(int d0=0;d0<4;++d0)qr[d0]=*reinterpret_cast<const bf16x8*>(&Qw[(long)r32*QP+d0*16+hi*8]);
  float mhat=0.f,l_reg=0.f;float z0_=0.f;asm volatile("":"+v"(z0_));f32x16 o[2];f32x16 negm;
  #pragma unroll
  for(int r=0;r<16;++r){o[0][r]=z0_;o[1][r]=z0_;negm[r]=z0_;}
  asm volatile("":"+v"(negm));
  #define CMASK(P0,P1,t) do{}while(0)
  bool resc=false;
  #define START(P0,P1) do{ const float rm=rowmax(P0,P1); resc=false; \
    { const float dl=rm; mhat=fadd_s(mhat,dl); \
      _Pragma("unroll") for(int r=0;r<16;++r){P0[r]=fsub_s(P0[r],dl);P1[r]=fsub_s(P1[r],dl);} \
      _Pragma("unroll") for(int r=0;r<16;++r)negm[r]=-mhat; asm volatile("":"+v"(negm)); } \
    _Pragma("unroll") for(int r=0;r<16;++r)P0[r]=__builtin_amdgcn_exp2f(P0[r]); }while(0)
  #define RESC() do{ if(resc){ asm volatile("s_waitcnt lgkmcnt(0)":::"memory"); \
      _Pragma("unroll") for(int d_=0;d_<2;++d_) _Pragma("unroll") for(int r=0;r<16;++r)o[d_][r]*=wsf[crow(r,hi)]; } }while(0)
  f32x16 pA0,pA1,pB0,pB1;
  int sl_prev=0,sl_cur=0,sl_next=SLOTB;
  #define ROT() do{sl_prev=sl_cur;sl_cur=sl_next;sl_next=(sl_next==(NSLOT-1)*SLOTB)?0:sl_next+SLOTB;}while(0)
  DMA_K(2,2*SLOTB);
  WAIT_BAR(3);
  qkt(pA0,pA1,Kbase,qr,negm,r32,hi);asm volatile("s_nop 15\n\ts_nop 7":"+v"(pA0),"+v"(pA1));CMASK(pA0,pA1,0);
  START(pA0,pA1);
  _Pragma("unroll") for(int r=0;r<16;++r)pA1[r]=__builtin_amdgcn_exp2f(pA1[r]);
  WAIT_BAR(0);
  DMA_K(3,0);DMA_V(1,SLOTB);
  ROT();
  kload8(kf,kp0+sl_cur);
  WAIT_BAR(2);
  s16x4 vlo[8],vhi[8]; u32x4 pw0,pw1,pw2,pw3;
  #define PKW(P,B) cvtpk_s(P[B],P[B+1])
  #define PAF(k) __builtin_bit_cast(bf16x8,pw##k)
  #define VFR(i) (bf16x8){vlo[i][0],vlo[i][1],vlo[i][2],vlo[i][3],vhi[i][0],vhi[i][1],vhi[i][2],vhi[i][3]}
  #define PIN(x) asm volatile("":"+v"(x))
  #define MX3(a,b,c) __builtin_fmaxf(__builtin_fmaxf((a),(b)),(c))
  #define GAPA(MF,A0,A1,A2,A3,W0,W1,PW) do{ MF; sacc+=A0; sacc+=A1; sacc+=A2; sacc+=A3; PIN(sacc); W0; W1; PIN(PW); SBAR(); }while(0)
  #define EX(v) __builtin_amdgcn_exp2f(v)
  #define GAPB(MF,X,B) do{ MF; X[B]=EX(X[B]); X[B+1]=EX(X[B+1]); X[B+2]=EX(X[B+2]); X[B+3]=EX(X[B+3]); PIN(X); SBAR(); }while(0)
  #define VRD(i) do{ vlo[i]=vtr(vp_+(((i)>>2)*4096+((i)&3)*1024)); vhi[i]=vtr(vp_+(((i)>>2)*4096+((i)&3)*1024+512)); }while(0)
  #define KRD(G,j) do{ if(G){ kload2(kf,kp0+sl_next,j); SBAR(); } }while(0)
  #define STEP(C0,C1,P0,P1,t,GK,GV,GL) do{ SBAR(); \
    const lds_cptr vp_=vp0+sl_prev; \
    VRD(0); SBAR(); float sacc=(P0[0]+P0[1]); \
    GAPA(C0=__builtin_amdgcn_mfma_f32_32x32x16_bf16(kf[0],qr[0],negm,0,0,0), P0[2],P0[3],P0[4],P0[5],     pw0[0]=PKW(P0,0), pw0[1]=PKW(P0,2), pw0); \
    VRD(4); SBAR(); GAPA(C1=__builtin_amdgcn_mfma_f32_32x32x16_bf16(kf[1],qr[0],negm,0,0,0), P0[6],P0[7],P0[8],P0[9],     pw0[2]=PKW(P0,4), pw0[3]=PKW(P0,6), pw0); \
    VRD(1); SBAR(); GAPA(C0=__builtin_amdgcn_mfma_f32_32x32x16_bf16(kf[2],qr[1],C0,0,0,0),   P0[10],P0[11],P0[12],P0[13], pw1[0]=PKW(P0,8), pw1[1]=PKW(P0,10), pw1); \
    VRD(5); SBAR(); GAPA(C1=__builtin_amdgcn_mfma_f32_32x32x16_bf16(kf[3],qr[1],C1,0,0,0),   P0[14],P0[15],P1[0],P1[1],   pw1[2]=PKW(P0,12),pw1[3]=PKW(P0,14), pw1); \
    VRD(2); SBAR(); GAPA(C0=__builtin_amdgcn_mfma_f32_32x32x16_bf16(kf[4],qr[2],C0,0,0,0),   P1[2],P1[3],P1[4],P1[5],     pw2[0]=PKW(P1,0), pw2[1]=PKW(P1,2), pw2); \
    VRD(6); SBAR(); GAPA(C1=__builtin_amdgcn_mfma_f32_32x32x16_bf16(kf[5],qr[2],C1,0,0,0),   P1[6],P1[7],P1[8],P1[9],     pw2[2]=PKW(P1,4), pw2[3]=PKW(P1,6), pw2); \
    VRD(3); SBAR(); GAPA(C0=__builtin_amdgcn_mfma_f32_32x32x16_bf16(kf[6],qr[3],C0,0,0,0),   P1[10],P1[11],P1[12],P1[13], pw3[0]=PKW(P1,8), pw3[1]=PKW(P1,10), pw3); \
    VRD(7); SBAR(); GAPA(C1=__builtin_amdgcn_mfma_f32_32x32x16_bf16(kf[7],qr[3],C1,0,0,0),   P1[14],P1[15],0.f,0.f,       pw3[2]=PKW(P1,12),pw3[3]=PKW(P1,14), pw3); \
    l_reg+=sacc; \
    if(GK){DMA_K((t)+3,sl_cur);} if(GV){DMA_V((t)+1,sl_next);} \
    CMASK(C0,C1,t); \
    { float a=MX3(C0[0],C0[1],C1[0]),b=MX3(C0[2],C0[3],C1[1]); a=MX3(a,C1[2],C1[3]); \
      _Pragma("unroll") for(int r=4;r<16;r+=4){a=MX3(a,C0[r],C0[r+1]);b=MX3(b,C0[r+2],C0[r+3]);a=MX3(a,C1[r],C1[r+1]);b=MX3(b,C1[r+2],C1[r+3]);} \
      float rm=__builtin_fmaxf(a,b); { auto rr=__builtin_amdgcn_permlane32_swap(__float_as_uint(rm),__float_as_uint(rm),false,false); rm=__builtin_fmaxf(__uint_as_float(rr[0]),__uint_as_float(rr[1])); } \
      resc=false; \
      if(__builtin_expect(__any(rm>(float)THRL),0)){ const float dl=__builtin_fmaxf(rm,0.f); mhat+=dl; \
        _Pragma("unroll") for(int r=0;r<16;++r){C0[r]-=dl;C1[r]-=dl;} \
        _Pragma("unroll") for(int r=0;r<16;++r)negm[r]=-mhat; asm volatile("":"+v"(negm)); \
        const float f=__builtin_amdgcn_exp2f(-dl); l_reg*=f; if(hi==0)wsf[r32]=f; resc=true; } } \
    SBAR(); \
    GAPB(o[0]=__builtin_amdgcn_mfma_f32_32x32x16_bf16(PAF(0),VFR(0),o[0],0,0,0), C0,0); \
    GAPB(o[1]=__builtin_amdgcn_mfma_f32_32x32x16_bf16(PAF(0),VFR(4),o[1],0,0,0), C0,4); \
    KRD(GL,0); GAPB(o[0]=__builtin_amdgcn_mfma_f32_32x32x16_bf16(PAF(1),VFR(1),o[0],0,0,0), C0,8); \
    KRD(GL,1); GAPB(o[1]=__builtin_amdgcn_mfma_f32_32x32x16_bf16(PAF(1),VFR(5),o[1],0,0,0), C0,12); \
    KRD(GL,2); GAPB(o[0]=__builtin_amdgcn_mfma_f32_32x32x16_bf16(PAF(2),VFR(2),o[0],0,0,0), C1,0); \
    KRD(GL,3); GAPB(o[1]=__builtin_amdgcn_mfma_f32_32x32x16_bf16(PAF(2),VFR(6),o[1],0,0,0), C1,4); \
    GAPB(o[0]=__builtin_amdgcn_mfma_f32_32x32x16_bf16(PAF(3),VFR(3),o[0],0,0,0), C1,8); \
    GAPB(o[1]=__builtin_amdgcn_mfma_f32_32x32x16_bf16(PAF(3),VFR(7),o[1],0,0,0), C1,12); \
    }while(0)
  int t=1;
  #undef CMASK
  #define CMASK(P0,P1,t) do{}while(0)
  for(;t+5<NT;t+=2){
    STEP(pB0,pB1,pA0,pA1,t,true,true,true);     WAIT_BAR(2); RESC(); ROT();
    STEP(pA0,pA1,pB0,pB1,t+1,true,true,true);   WAIT_BAR(2); RESC(); ROT();
  }
  #undef CMASK
  #define CMASK(P0,P1,t) do{}while(0)
  #define ENDW(tt) do{ if((tt)+3<NT){WAIT_BAR(2);} else if((tt)+2<NT){WAIT_BAR(1);} else {WAIT_BAR(0);} }while(0)
  for(;t+1<NT;t+=2){
    STEP(pB0,pB1,pA0,pA1,t,(t+3<NT),(t+1<NT),(t+1<NT));       ENDW(t);   RESC(); ROT();
    STEP(pA0,pA1,pB0,pB1,t+1,(t+4<NT),(t+2<NT),(t+2<NT));     ENDW(t+1); RESC(); ROT();
  }
  STEP(pB0,pB1,pA0,pA1,NT-1,false,false,false); RESC();
  { float sacc=pB0[0]+pB0[1]; _Pragma("unroll") for(int r=2;r<16;++r)sacc+=pB0[r]; _Pragma("unroll") for(int r=0;r<16;++r)sacc+=pB1[r]; l_reg+=sacc;
    pw0=(u32x4){PKW(pB0,0),PKW(pB0,2),PKW(pB0,4),PKW(pB0,6)};pw1=(u32x4){PKW(pB0,8),PKW(pB0,10),PKW(pB0,12),PKW(pB0,14)};pw2=(u32x4){PKW(pB1,0),PKW(pB1,2),PKW(pB1,4),PKW(pB1,6)};pw3=(u32x4){PKW(pB1,8),PKW(pB1,10),PKW(pB1,12),PKW(pB1,14)};
    SBAR(); pv(o,vb0+sl_cur,PAF(0),PAF(1),PAF(2),PAF(3)); }
  #undef PKW
  #undef PAF
  #undef VFR
  #undef PIN
  #undef MX3
  #undef GAPA
  #undef GAPB
  #undef EX
  #undef VRD
  #undef KRD
  #undef STEP
  #undef ENDW
  {auto rr=__builtin_amdgcn_permlane32_swap(__float_as_uint(l_reg),__float_as_uint(l_reg),false,false);l_reg=__uint_as_float(rr[0])+__uint_as_float(rr[1]);}
  if(hi==0)wsf[32+r32]=l_reg;asm volatile("s_waitcnt lgkmcnt(0)":::"memory");
  float rli[16];
  #pragma unroll
  for(int r=0;r<16;++r)rli[r]=__builtin_amdgcn_rcpf(wsf[32+crow(r,hi)]);
  bf16*Ow=O+(qrow0+wid*QBLK)*OP+hq*D;
  { bf16*stg=(bf16*)(shm+LDS_OST)+wid*2048;
    #pragma unroll
    for(int r=0;r<16;++r){const int orow=crow(r,hi);
      #pragma unroll
      for(int d0=0;d0<2;++d0)stg[orow*64+d0*32+r32]=__float2bfloat16(o[d0][r]*rli[r]);}
    asm volatile("s_waitcnt lgkmcnt(0)":::"memory");
    #pragma unroll
    for(int i=0;i<4;++i){const int row=i*8+(lane>>3),ch=lane&7; const u32x4 v=*(const u32x4*)(stg+row*64+ch*8); ATTN_STORE16(Ow+(long)row*OP+ch*8,v);} }
  asm volatile("s_waitcnt lgkmcnt(0)\n\ts_barrier":::"memory");
  #undef DMA_K
  #undef DMA_V
  #undef CMASK
  #undef START
  #undef RESC
  #undef ROT
}
constexpr int ATTN_LDS_BYTES=LDS_BYTES;
#undef SBAR
#undef WAIT_BAR
}
#define LAS __attribute__((address_space(3)))
typedef unsigned short bf16;
typedef unsigned v4u __attribute__((ext_vector_type(4)));
typedef unsigned v2u __attribute__((ext_vector_type(2)));
typedef float f32x4 __attribute__((ext_vector_type(4)));
typedef short bf16x8 __attribute__((ext_vector_type(8)));
constexpr int NWAVES = 8;
constexpr int NB = 4, LAT = 4096, LCTX = 256, SROW = 4352, MTOK = 17408, DMODEL = 1024, DEPTH = 4, DFF = 2816, DIN = 6912, MODW = 9216;
constexpr int ZC_RQ = 0, ZC_RK = 512, ZC_RV = 1024, ZC_RG = 1536, ZC_LX = 2048, ZC_LZ = 2560, ZC_AQ = 3072, ZC_AK = 3584, ZC_AV = 3712, ZC_GT = 3840;
constexpr float NORM_EPS = 1e-6f;
constexpr size_t MiB = 1u << 20;
constexpr size_t WS_MOD = 1 * MiB, WS_ROPE = 2 * MiB, WS_SUMM = 3 * MiB, WS_HIN = 6 * MiB;
constexpr size_t WS_WSET = 54 * MiB;
constexpr size_t WS_WFI = 8 * MiB;
constexpr size_t WS_WFO = 30 * MiB;
constexpr size_t WS_WIN = 41 * MiB;
constexpr size_t WS_WB = 55 * MiB;
constexpr size_t WS_WO = 58 * MiB;
constexpr size_t WS_LRUW = 60 * MiB;
constexpr size_t WS_X = 116 * MiB;
constexpr size_t WS_HN = 184 * MiB;
constexpr size_t WS_Z = 218 * MiB;
constexpr size_t WS_QN = 448 * MiB;
constexpr size_t WS_KN = 465 * MiB;
constexpr size_t WS_Y = 470 * MiB;
constexpr size_t WS_U = 521 * MiB;
constexpr size_t WS_SIN = 589 * MiB;
constexpr size_t WS_PARTC = 624 * MiB;
constexpr size_t WS_END = 670 * MiB;
constexpr int LDS_BYTES = 147456;

__device__ __forceinline__ unsigned f2bf(float f) { unsigned u = __builtin_bit_cast(unsigned, f); return (u + 0x7fffu + ((u >> 16) & 1u)) >> 16; }
__device__ __forceinline__ unsigned pk2(float lo, float hi) { return f2bf(lo) | (f2bf(hi) << 16); }
__device__ __forceinline__ float bflo(unsigned w) { return __uint_as_float(w << 16); }
__device__ __forceinline__ float bfhi(unsigned w) { return __uint_as_float(w & 0xffff0000u); }
__device__ __forceinline__ float bf1(bf16 h) { return __uint_as_float(((unsigned)h) << 16); }
__device__ __forceinline__ void unpack8(const v4u w, float* f) { f[0] = bflo(w.x); f[1] = bfhi(w.x); f[2] = bflo(w.y); f[3] = bfhi(w.y); f[4] = bflo(w.z); f[5] = bfhi(w.z); f[6] = bflo(w.w); f[7] = bfhi(w.w); }
__device__ __forceinline__ float sigmoidf_(float v) { return __builtin_amdgcn_rcpf(1.0f + __expf(-v)); }
__device__ __forceinline__ float shx(float v, int m, int lane) { return __builtin_bit_cast(float, __builtin_amdgcn_ds_bpermute((lane ^ m) << 2, __builtin_bit_cast(int, v))); }
__device__ __forceinline__ float shi(float v, int src) { return __builtin_bit_cast(float, __builtin_amdgcn_ds_bpermute(src << 2, __builtin_bit_cast(int, v))); }
__device__ __forceinline__ float wave_sum(float v, int lane) {
#pragma unroll
    for (int o = 1; o < 64; o <<= 1) v += shx(v, o, lane);
    return v;
}
#define LDS_WAIT() asm volatile("s_waitcnt lgkmcnt(0)" ::: "memory")

struct Args { const float* in[24]; float* out; unsigned char* ws; int ph_lo, ph_hi; };
constexpr int ARGS_LDS_OFF = 139520;
struct AH { const LAS unsigned* w;
    __device__ __forceinline__ const float* in(int i) const { const unsigned lo = __builtin_amdgcn_readfirstlane(w[2 * i]), hi = __builtin_amdgcn_readfirstlane(w[2 * i + 1]); return (const float*)(((unsigned long long)hi << 32) | lo); }
    __device__ __forceinline__ float* out() const { const unsigned lo = __builtin_amdgcn_readfirstlane(w[48]), hi = __builtin_amdgcn_readfirstlane(w[49]); return (float*)(((unsigned long long)hi << 32) | lo); }
    __device__ __forceinline__ unsigned char* ws() const { const unsigned lo = __builtin_amdgcn_readfirstlane(w[50]), hi = __builtin_amdgcn_readfirstlane(w[51]); return (unsigned char*)(((unsigned long long)hi << 32) | lo); }
};
enum { I_X = 0, I_C, I_CTX, I_CCTX, I_WMOD, I_BMOD, I_NORMG, I_FFNIN, I_FFNOUT, I_WIN, I_RETLOGIT, I_RETG, I_CONVW, I_CONVB, I_LWA, I_LBA, I_LWX, I_LBX, I_LAM, I_QG, I_KG, I_WBR, I_WOUT, I_FG };

__device__ __forceinline__ void tr_item(const float* W, int N, int k0, int n0, bf16* WT, int K, int orow0, LAS float* scr, int lane) {
    const float* src = W + (size_t)k0 * N + n0 + lane;
#pragma unroll 1
    for (int i = 0; i < 64; i += 16) { float v[16];
#pragma unroll
        for (int r = 0; r < 16; ++r) v[r] = src[(size_t)(i + r) * N];
#pragma unroll
        for (int r = 0; r < 16; ++r) scr[(i + r) * 65 + lane] = v[r]; }
    LDS_WAIT(); asm volatile("" ::: "memory");
    const int c = lane & 7;
#pragma unroll
    for (int j = 0; j < 8; ++j) { const int n = (lane >> 3) + 8 * j; const LAS float* s = scr + (8 * c) * 65 + n;
        v4u o; o.x = pk2(s[0 * 65], s[1 * 65]); o.y = pk2(s[2 * 65], s[3 * 65]); o.z = pk2(s[4 * 65], s[5 * 65]); o.w = pk2(s[6 * 65], s[7 * 65]);
        *(v4u*)(WT + (size_t)(orow0 + n) * K + k0 + 8 * c) = o; }
    LDS_WAIT(); asm volatile("" ::: "memory");
}

__device__ __forceinline__ void phase_p0(const AH A, LAS unsigned char* lds, int tid, int G) {
    unsigned char* ws = A.ws();
    constexpr int NGEMV = 144;
    const int bx = blockIdx.x;
    if (bx < NGEMV || G <= NGEMV) {
        LAS float* sv = (LAS float*)lds;
        LAS float* red = sv + 5 * 1024;
        const float* c = A.in(I_C); const float* cctx = A.in(I_CCTX);
        for (int i = tid; i < 5 * 1024; i += 512) { const int r = i >> 10, k = i & 1023; const float v = (r < 4) ? c[r * 1024 + k] : cctx[k]; sv[i] = v / (1.0f + __expf(-v)); }
        __syncthreads();
        float* modbuf = (float*)(ws + WS_MOD);
        const float* wmod = A.in(I_WMOD); const float* bmod = A.in(I_BMOD);
        for (int item = bx; item < NGEMV; item += G) {
            const int l = item / 36, n0 = (item - l * 36) * 256, c4 = tid & 63, kg = tid >> 6;
            const f32x4* W = (const f32x4*)(wmod + (size_t)l * 1024 * MODW + n0) + c4;
            f32x4 acc[5];
#pragma unroll
            for (int r = 0; r < 5; ++r) acc[r] = (f32x4){0.f, 0.f, 0.f, 0.f};
#pragma unroll 8
            for (int k = kg * 128; k < kg * 128 + 128; ++k) { const f32x4 w = W[(size_t)k * (MODW / 4)];
#pragma unroll
                for (int r = 0; r < 5; ++r) acc[r] += w * sv[r * 1024 + k]; }
#pragma unroll
            for (int r = 0; r < 5; ++r) *(LAS f32x4*)(red + (kg * 5 + r) * 256 + c4 * 4) = acc[r];
            __syncthreads();
            for (int o = tid; o < 5 * 256; o += 512) { const int r = o >> 8, cc = o & 255; float s = 0.f;
#pragma unroll
                for (int q = 0; q < 8; ++q) s += red[(q * 5 + r) * 256 + cc];
                modbuf[(size_t)(l * 5 + r) * MODW + n0 + cc] = s + bmod[(size_t)l * MODW + n0 + cc]; }
            __syncthreads();
        }
    }
    if (bx >= NGEMV || G <= NGEMV) {
        const int wb = (G > NGEMV) ? bx - NGEMV : bx, nwb = (G > NGEMV) ? G - NGEMV : G;
        const f32x4* x4 = (const f32x4*)A.in(I_X); const f32x4* c4p = (const f32x4*)A.in(I_CTX); f32x4* X4 = (f32x4*)(ws + WS_X);
        const int total = MTOK * 256, stride = nwb * 512;
        for (int i = wb * 512 + tid; i < total; i += 4 * stride) { f32x4 v[4];
#pragma unroll
            for (int q = 0; q < 4; ++q) { const int ii = i + q * stride; if (ii < total) { const int row = ii >> 8, qq = ii & 255; const int b = row / SROW, s = row - b * SROW;
                v[q] = (s < LCTX) ? c4p[(size_t)(b * LCTX + s) * 256 + qq] : x4[(size_t)(b * LAT + s - LCTX) * 256 + qq]; } }
#pragma unroll
            for (int q = 0; q < 4; ++q) { const int ii = i + q * stride; if (ii < total) X4[ii] = v[q]; } }
        float* ra = (float*)(ws + WS_ROPE); float* rb = ra + 64 * 32 * 2;
        for (int i = wb * 512 + tid; i < 64 * 32 + 64 * 16; i += nwb * 512) {
            if (i < 64 * 32) { const int pos = i >> 5, f = i & 31; const float fr = powf(10000.0f, -(float)(2 * f) / 64.0f); const float ang = (float)pos * fr; ra[2 * i] = cosf(ang); ra[2 * i + 1] = sinf(ang); }
            else { const int j = i - 64 * 32; const int pos = j >> 4, f = j & 15; const float fr = powf(10000.0f, -(float)(2 * f) / 32.0f); const float ang = (float)pos * fr; rb[2 * j] = cosf(ang); rb[2 * j + 1] = sinf(ang); } }
    }
}

constexpr int CV_FI = 16 * 88, CV_FO = 44 * 16, CV_IN = 16 * 108, CV_BR = 8 * 16, CV_OUT = 16 * 16, CV_LRU = 32;
constexpr int CV_NIT = 2 * CV_FI + 2 * CV_FO + CV_IN + 3 * CV_BR + CV_OUT + CV_LRU;
__device__ __forceinline__ void convert_layer(const AH A, int l, int it_lo, int it_hi, LAS unsigned char* lds, int gw, int NGW, int wave, int lane) {
    unsigned char* ws = A.ws() + (size_t)(l & 1) * WS_WSET;
    LAS float* scr = (LAS float*)(lds + wave * 16640);
    for (int it = it_lo + gw; it < it_hi; it += NGW) {
        int r = it; bool done = false;
#pragma unroll
        for (int j = 0; j < 2; ++j) { if (!done) { if (r < CV_FI) { const int kb = r / 88, nb = r - kb * 88, n0 = nb * 64;
                const int orow0 = (n0 < DFF) ? ((n0 >> 7) * 256 + (n0 & 127)) : (((n0 - DFF) >> 7) * 256 + 128 + ((n0 - DFF) & 127));
                tr_item(A.in(I_FFNIN) + (size_t)(l * 2 + j) * 1024 * 5632, 5632, kb * 64, n0, (bf16*)(ws + WS_WFI) + (size_t)j * 5632 * 1024, 1024, orow0, scr, lane); done = true; } else r -= CV_FI; } }
#pragma unroll
        for (int j = 0; j < 2; ++j) { if (!done) { if (r < CV_FO) { const int kb = r >> 4, nb = r & 15;
                tr_item(A.in(I_FFNOUT) + (size_t)(l * 2 + j) * DFF * 1024, 1024, kb * 64, nb * 64, (bf16*)(ws + WS_WFO) + (size_t)j * 1024 * DFF, DFF, nb * 64, scr, lane); done = true; } else r -= CV_FO; } }
        if (!done) { if (r < CV_IN) { const int kb = r / 108, nb = r - kb * 108;
                tr_item(A.in(I_WIN) + (size_t)l * 1024 * DIN, DIN, kb * 64, nb * 64, (bf16*)(ws + WS_WIN), 1024, nb * 64, scr, lane); done = true; } else r -= CV_IN; }
#pragma unroll
        for (int n = 0; n < 3; ++n) { if (!done) { if (r < CV_BR) { const int kb = r >> 4, nb = r & 15;
                tr_item(A.in(I_WBR) + (size_t)(l * 3 + n) * 512 * 1024, 1024, kb * 64, nb * 64, (bf16*)(ws + WS_WB) + (size_t)n * 1024 * 512, 512, nb * 64, scr, lane); done = true; } else r -= CV_BR; } }
        if (!done) { if (r < CV_OUT) { const int kb = r >> 4, nb = r & 15;
                tr_item(A.in(I_WOUT) + (size_t)l * 1024 * 1024, 1024, kb * 64, nb * 64, (bf16*)(ws + WS_WO), 1024, nb * 64, scr, lane); done = true; } else r -= CV_OUT; }
        if (!done) { const int mat = r; const int g = mat >> 4, d = (mat >> 3) & 1, blk = mat & 7;
                const float* src = (g ? A.in(I_LWX) : A.in(I_LWA)) + (size_t)((l * 2 + d) * 8 + blk) * 4096;
                tr_item(src, 64, 0, 0, (bf16*)(ws + WS_LRUW) + (size_t)mat * 4096, 64, 0, scr, lane); }
    }
}

__device__ __forceinline__ void norm_rows(const AH A, int l, int sub, int gw, int NGW, int lane, int pend_ns, const float* pend_gate, float pend_scale) {
    unsigned char* ws = A.ws();
    const float* X = (const float*)(ws + WS_X); bf16* HN = (bf16*)(ws + WS_HN);
    const float* g = A.in(I_NORMG) + (size_t)(l * 3 + sub) * 1024;
    const float* modl = (const float*)(ws + WS_MOD) + (size_t)l * 5 * MODW + sub * 3072;
    f32x4 gv[4];
#pragma unroll
    for (int j = 0; j < 4; ++j) gv[j] = ((const f32x4*)g)[lane + 64 * j];
    f32x4 nx[4];
    if (gw < MTOK) {
#pragma unroll
        for (int j = 0; j < 4; ++j) nx[j] = ((const f32x4*)(X + (size_t)gw * 1024))[lane + 64 * j]; }
    for (int row = gw; row < MTOK; row += NGW) {
        const int b = row / SROW, s = row - b * SROW; const int mr = (s < LCTX) ? 4 : b;
        const f32x4* sh = (const f32x4*)(modl + (size_t)mr * MODW); const f32x4* sc = (const f32x4*)(modl + (size_t)mr * MODW + 1024);
        f32x4 v[4]; float ss = 0.f;
#pragma unroll
        for (int j = 0; j < 4; ++j) v[j] = nx[j];
        if (row + NGW < MTOK) {
#pragma unroll
            for (int j = 0; j < 4; ++j) nx[j] = ((const f32x4*)(X + (size_t)(row + NGW) * 1024))[lane + 64 * j]; }
        f32x4 scv[4], shv[4];
#pragma unroll
        for (int j = 0; j < 4; ++j) { scv[j] = sc[lane + 64 * j]; shv[j] = sh[lane + 64 * j]; }
        if (pend_ns > 0 && s < LCTX) {
            const v2u* pc = (const v2u*)((const bf16*)(ws + WS_PARTC) + (size_t)(b * LCTX + s) * 1024); const f32x4* pg = (const f32x4*)pend_gate;
            f32x4 a4[4] = {(f32x4){0.f, 0.f, 0.f, 0.f}, (f32x4){0.f, 0.f, 0.f, 0.f}, (f32x4){0.f, 0.f, 0.f, 0.f}, (f32x4){0.f, 0.f, 0.f, 0.f}};
            for (int sp = 0; sp < pend_ns; ++sp) {
#pragma unroll
                for (int j = 0; j < 4; ++j) { const v2u w = pc[(size_t)sp * 262144 + lane + 64 * j]; a4[j] += (f32x4){bflo(w.x), bfhi(w.x), bflo(w.y), bfhi(w.y)}; } }
            f32x4* xw = (f32x4*)(ws + WS_X) + (size_t)row * 256;
#pragma unroll
            for (int j = 0; j < 4; ++j) { v[j] += (pg[lane + 64 * j] * pend_scale) * a4[j]; xw[lane + 64 * j] = v[j]; }
        }
#pragma unroll
        for (int j = 0; j < 4; ++j) ss += (v[j].x * v[j].x + v[j].y * v[j].y) + (v[j].z * v[j].z + v[j].w * v[j].w);
        const float rstd = rsqrtf(wave_sum(ss, lane) * (1.0f / 1024.0f) + NORM_EPS);
        v2u* o = (v2u*)(HN + (size_t)row * 1024);
#pragma unroll
        for (int j = 0; j < 4; ++j) { const f32x4 y = (v[j] * rstd) * gv[j] * (scv[j] + 1.0f) + shv[j];
            v2u w; w.x = pk2(y.x, y.y); w.y = pk2(y.z, y.w); o[lane + 64 * j] = w; }
    }
}
__device__ __forceinline__ void final_rows(const AH A, int gw, int NGW, int lane) {
    const float* X = (const float*)(A.ws() + WS_X); const float* g = A.in(I_FG);
    f32x4 gv[4];
#pragma unroll
    for (int j = 0; j < 4; ++j) gv[j] = ((const f32x4*)g)[lane + 64 * j];
    f32x4 nx[4];
    if (gw < NB * LAT) { const int b = gw >> 12, t = gw & 4095;
#pragma unroll
        for (int j = 0; j < 4; ++j) nx[j] = ((const f32x4*)(X + (size_t)(b * SROW + LCTX + t) * 1024))[lane + 64 * j]; }
    for (int r = gw; r < NB * LAT; r += NGW) {
        f32x4 v[4]; float ss = 0.f;
#pragma unroll
        for (int j = 0; j < 4; ++j) v[j] = nx[j];
        if (r + NGW < NB * LAT) { const int r2 = r + NGW, b = r2 >> 12, t = r2 & 4095;
#pragma unroll
            for (int j = 0; j < 4; ++j) nx[j] = ((const f32x4*)(X + (size_t)(b * SROW + LCTX + t) * 1024))[lane + 64 * j]; }
#pragma unroll
        for (int j = 0; j < 4; ++j) ss += (v[j].x * v[j].x + v[j].y * v[j].y) + (v[j].z * v[j].z + v[j].w * v[j].w);
        const float rstd = rsqrtf(wave_sum(ss, lane) * (1.0f / 1024.0f) + NORM_EPS);
        f32x4* o = (f32x4*)(A.out() + (size_t)r * 1024);
#pragma unroll
        for (int j = 0; j < 4; ++j) o[lane + 64 * j] = (v[j] * rstd) * gv[j];
    }
}
#define XB_TMO      128
#define XB_XCNT(j)  (256  + 64 * (j))
#define XB_XSUB(j)  (1280 + 64 * (j))
#define XB_XGEN(j)  (2304 + 64 * (j))
#define XB_TOP      3328
#define XB_TOPGEN   3392
#define XCD_BAR_WORDS 3456
#define XB_SPIN_CAP (1u << 22)

__device__ __forceinline__ unsigned xb_ld(unsigned* p)              { return __hip_atomic_load(p, __ATOMIC_RELAXED, __HIP_MEMORY_SCOPE_AGENT); }
__device__ __forceinline__ unsigned xb_add(unsigned* p, unsigned v) { return __hip_atomic_fetch_add(p, v, __ATOMIC_RELAXED, __HIP_MEMORY_SCOPE_AGENT); }
__device__ __forceinline__ unsigned xb_xcc_id() { return (unsigned)__builtin_amdgcn_s_getreg((3 << 11) | 20) & 0xFu; }
#define XB_SPIN(cond, bar) do { unsigned _sp = 0; while (cond) { __builtin_amdgcn_s_sleep(1); \
    if ((++_sp & 255u) == 0u) { if (xb_ld(&(bar)[XB_TMO])) break; if (_sp > XB_SPIN_CAP) { atomicAdd(&(bar)[XB_TMO], 1u); break; } } } } while (0)

struct XcdBarrier {
    unsigned* bar; unsigned x;
    volatile LAS unsigned* st;
};

__device__ __forceinline__ XcdBarrier xcd_barrier_post(unsigned* bar, volatile LAS unsigned* st, bool t0) {
    XcdBarrier b; b.bar = bar; b.x = xb_xcc_id(); b.st = st;
    if (t0) (void)xb_add(&bar[XB_XCNT(b.x)], 1u);
    return b;
}
__device__ __forceinline__ void xcd_barrier_complete(unsigned* bar, unsigned x, unsigned& nloc, unsigned& nx) {
    const unsigned G = gridDim.x * gridDim.y * gridDim.z;
    unsigned sum, cnt, mine, sp = 0u;
    for (;;) {
        sum = 0u; cnt = 0u; mine = 0u;
#pragma unroll
        for (unsigned j = 0; j < 16; ++j) { const unsigned c = xb_ld(&bar[XB_XCNT(j)]); sum += c; cnt += (c > 0u) ? 1u : 0u; mine = (j == x) ? c : mine; }
        if (sum == G) break;
        __builtin_amdgcn_s_sleep(1);
        if ((++sp & 255u) == 0u) { if (xb_ld(&bar[XB_TMO])) break; if (sp > XB_SPIN_CAP) { atomicAdd(&bar[XB_TMO], 1u); break; } }
    }
    nloc = mine > 0u ? mine : 1u; nx = cnt > 0u ? cnt : 1u;
}

__device__ __forceinline__ void xcd_barrier(const XcdBarrier& b, bool t0) {
    asm volatile("s_waitcnt vmcnt(0)" ::: "memory");
    __syncthreads();
    if (t0) {
        unsigned* bar = b.bar;
        __builtin_amdgcn_s_waitcnt(0);
        unsigned nloc = b.st[0], nx = b.st[1];
        if (nloc == 0u) { xcd_barrier_complete(bar, b.x, nloc, nx); b.st[0] = nloc; b.st[1] = nx; }
        const unsigned old = xb_add(&bar[XB_XSUB(b.x)], 1u);
        const unsigned gen = old / nloc;
        if (old + 1u == (gen + 1u) * nloc) {
            __builtin_amdgcn_fence(__ATOMIC_RELEASE, "agent");
            asm volatile("s_waitcnt vmcnt(0)" ::: "memory");
            const unsigned og = xb_add(&bar[XB_TOP], 1u);
            const unsigned tg = og / nx;
            if (og + 1u == (tg + 1u) * nx) xb_add(&bar[XB_TOPGEN], 1u);
            else XB_SPIN(xb_ld(&bar[XB_TOPGEN]) == tg, bar);
            __builtin_amdgcn_fence(__ATOMIC_ACQUIRE, "agent");
            xb_add(&bar[XB_XGEN(b.x)], 1u);
            asm volatile("s_waitcnt vmcnt(0)" ::: "memory");
        } else {
            XB_SPIN(xb_ld(&bar[XB_XGEN(b.x)]) == gen, bar);
            __builtin_amdgcn_fence(__ATOMIC_ACQUIRE, "agent");
            asm volatile("s_waitcnt vmcnt(0)" ::: "memory");
        }
    }
    __syncthreads();
}
__device__ __forceinline__ void prep_qk(const AH A, int l, int gw, int NGW, int lane) {
    unsigned char* ws = A.ws();
    const bf16* Z = (const bf16*)(ws + WS_Z); bf16* QN = (bf16*)(ws + WS_QN); bf16* KN = (bf16*)(ws + WS_KN);
    const float* rb = (const float*)(ws + WS_ROPE) + 64 * 32 * 2;
    const int e0 = (lane & 7) * 8, hq = lane >> 3;
    float gq[8], gk[8];
#pragma unroll
    for (int j = 0; j < 8; ++j) { gq[j] = A.in(I_QG)[l * 64 + e0 + j]; gk[j] = A.in(I_KG)[l * 64 + e0 + j]; }
    constexpr float C2 = 0.125f * 1.4426950408889634f;
    for (int row = gw; row < MTOK; row += NGW) {
        const int b = row / SROW, s = row - b * SROW; const bool lat = s >= LCTX; const int t = s - LCTX;
        const int pos = (lane & 4) ? (t & 63) : (t >> 6);
#pragma unroll
        for (int pass = 0; pass < 2; ++pass) {
            const bf16* src = Z + (size_t)row * DIN + (pass == 0 ? ZC_AQ : ZC_AK) + hq * 64 + e0;
            float f[8]; unpack8(*(const v4u*)src, f);
            float ss = 0.f;
#pragma unroll
            for (int j = 0; j < 8; ++j) ss += f[j] * f[j];
            ss += shx(ss, 1, lane); ss += shx(ss, 2, lane); ss += shx(ss, 4, lane);
            const float rstd = rsqrtf(ss * (1.0f / 64.0f) + NORM_EPS);
            float y[8], o[8];
#pragma unroll
            for (int j = 0; j < 8; ++j) y[j] = f[j] * rstd * (pass == 0 ? gq[j] : gk[j]);
#pragma unroll
            for (int j = 0; j < 8; ++j) { const float p = shx(y[j], 2, lane);
                if (lat) { const int fi = (lane & 1) * 8 + j; const float cs = rb[(pos * 16 + fi) * 2], sn = rb[(pos * 16 + fi) * 2 + 1];
                    o[j] = ((lane & 2) == 0) ? (y[j] * cs - p * sn) : (p * sn + y[j] * cs); }
                else o[j] = y[j];
                if (pass == 0) o[j] *= C2; }
            v4u w; w.x = pk2(o[0], o[1]); w.y = pk2(o[2], o[3]); w.z = pk2(o[4], o[5]); w.w = pk2(o[6], o[7]);
            if (pass == 0) *(v4u*)(QN + (size_t)row * 512 + hq * 64 + e0) = w;
            else if (lane < 16) *(v4u*)(KN + (size_t)row * 128 + hq * 64 + e0) = w;
        }
    }
}

constexpr int RLDP = 136;
constexpr int RBUF = 128 * RLDP * 2;
__device__ __forceinline__ float log_sigmoid_f(float x) { return (x < 0.f ? x : 0.f) - log1pf(__expf(-fabsf(x))); }
template <bool TRANSPOSED, bool ROPE>
__device__ __forceinline__ void ret_stage_pair(const bf16* Z, int r0, int zc, int h, bool lat, int t0, const float* ra, float scl, float lgdec, int decmode  , LAS bf16* dst, int tid) {
#pragma unroll
    for (int it = 0; it < 2; ++it) { const int task = tid + 512 * it; const int j = task & 127, pr = task >> 7; const int c = (pr & 3) + (pr >> 2) * 8;
        const bf16* p = Z + (size_t)(r0 + j) * DIN + zc + h * 128;
        float a[8], bq[8]; unpack8(*(const v4u*)(p + 8 * c), a); unpack8(*(const v4u*)(p + 8 * (c + 4)), bq);
        float sc = scl; if (decmode == 1) sc *= __expf(lgdec * (float)(127 - j)); else if (decmode == 2) sc *= __expf(lgdec * (float)j);
        if (ROPE && lat) { const int t = t0 + j; const int pos = (c < 8) ? (t >> 6) : (t & 63);
#pragma unroll
            for (int e = 0; e < 8; ++e) { const int fi = (c & 3) * 8 + e; const float cs = ra[(pos * 32 + fi) * 2], sn = ra[(pos * 32 + fi) * 2 + 1];
                const float x1 = a[e], x2 = bq[e]; a[e] = x1 * cs - x2 * sn; bq[e] = x1 * sn + x2 * cs; } }
        if (TRANSPOSED) {
#pragma unroll
            for (int e = 0; e < 8; ++e) { dst[(8 * c + e) * RLDP + j] = (bf16)f2bf(a[e] * sc); dst[(8 * (c + 4) + e) * RLDP + j] = (bf16)f2bf(bq[e] * sc); }
        } else {
            v4u w; w.x = pk2(a[0] * sc, a[1] * sc); w.y = pk2(a[2] * sc, a[3] * sc); w.z = pk2(a[4] * sc, a[5] * sc); w.w = pk2(a[6] * sc, a[7] * sc);
            *(LAS v4u*)(dst + j * RLDP + 8 * c) = w;
            w.x = pk2(bq[0] * sc, bq[1] * sc); w.y = pk2(bq[2] * sc, bq[3] * sc); w.z = pk2(bq[4] * sc, bq[5] * sc); w.w = pk2(bq[6] * sc, bq[7] * sc);
            *(LAS v4u*)(dst + j * RLDP + 8 * (c + 4)) = w;
        } }
}
__device__ __forceinline__ void wave_mm(f32x4 (&acc)[8], const LAS bf16* Am, int row0, const LAS bf16* Bm, int lane) {
    const int r = lane & 15, g = lane >> 4;
#pragma unroll
    for (int ks = 0; ks < 4; ++ks) { const bf16x8 a = *(const LAS bf16x8*)(Am + (row0 + r) * RLDP + ks * 32 + g * 8);
#pragma unroll
        for (int nt = 0; nt < 8; ++nt) { const bf16x8 bfr = *(const LAS bf16x8*)(Bm + (nt * 16 + r) * RLDP + ks * 32 + g * 8);
            acc[nt] = __builtin_amdgcn_mfma_f32_16x16x32_bf16(a, bfr, acc[nt], 0, 0, 0); } }
}
__device__ __forceinline__ int ret_chain_pos(int d, int cidx) { return d == 0 ? cidx : (cidx == 1 ? 0 : (cidx == 0 ? 1 : 35 - cidx)); }

__device__ __forceinline__ void ret_stage_k_both(const bf16* Z, int r0, int h, bool lat, int t0, const float* ra, float scl, float lgf, float lgb, LAS bf16* dstf, LAS bf16* dstb, int tid) {
#pragma unroll
    for (int it = 0; it < 2; ++it) { const int task = tid + 512 * it; const int j = task & 127, pr = task >> 7; const int c = (pr & 3) + (pr >> 2) * 8;
        const bf16* p = Z + (size_t)(r0 + j) * DIN + ZC_RK + h * 128;
        float a[8], bq[8]; unpack8(*(const v4u*)(p + 8 * c), a); unpack8(*(const v4u*)(p + 8 * (c + 4)), bq);
        const float sf = scl * __expf(lgf * (float)(127 - j)), sb = scl * __expf(lgb * (float)j);
        if (lat) { const int t = t0 + j; const int pos = (c < 8) ? (t >> 6) : (t & 63);
#pragma unroll
            for (int e = 0; e < 8; ++e) { const int fi = (c & 3) * 8 + e; const float cs = ra[(pos * 32 + fi) * 2], sn = ra[(pos * 32 + fi) * 2 + 1];
                const float x1 = a[e], x2 = bq[e]; a[e] = x1 * cs - x2 * sn; bq[e] = x1 * sn + x2 * cs; } }
#pragma unroll
        for (int e = 0; e < 8; ++e) { dstf[(8 * c + e) * RLDP + j] = (bf16)f2bf(a[e] * sf); dstf[(8 * (c + 4) + e) * RLDP + j] = (bf16)f2bf(bq[e] * sf);
                                      dstb[(8 * c + e) * RLDP + j] = (bf16)f2bf(a[e] * sb); dstb[(8 * (c + 4) + e) * RLDP + j] = (bf16)f2bf(bq[e] * sb); } }
}
__device__ __forceinline__ void ret_u_item(const AH A, int l, int item, LAS unsigned char* lds, int tid, int wave, int lane) {
    unsigned char* ws = A.ws(); const bf16* Z = (const bf16*)(ws + WS_Z); const float* ra = (const float*)(ws + WS_ROPE);
    const int cidx = item % 34, bh = item / 34, b = bh >> 2, h = bh & 3;
    const int pf = ret_chain_pos(0, cidx), pb = ret_chain_pos(1, cidx);
    const bool lat = cidx >= 2; const int r0 = b * SROW + cidx * 128, t0 = (cidx - 2) * 128;
    const float lgf = log_sigmoid_f(A.in(I_RETLOGIT)[(l * 2 + 0) * 4 + h]), lgb = log_sigmoid_f(A.in(I_RETLOGIT)[(l * 2 + 1) * 4 + h]);
    LAS bf16* Ktf = (LAS bf16*)lds; LAS bf16* Ktb = (LAS bf16*)(lds + RBUF); LAS bf16* Vt = (LAS bf16*)(lds + 2 * RBUF);
    ret_stage_k_both(Z, r0, h, lat, t0, ra, 0.08838834764831845f, lgf, lgb, Ktf, Ktb, tid);
    ret_stage_pair<true, false>(Z, r0, ZC_RV, h, false, 0, ra, 1.0f, 0.f, 0, Vt, tid);
    __syncthreads();
    const int g = lane >> 4, c = lane & 15;
    f32x4 accf[8], accb[8];
#pragma unroll
    for (int nt = 0; nt < 8; ++nt) { accf[nt] = (f32x4){0.f, 0.f, 0.f, 0.f}; accb[nt] = (f32x4){0.f, 0.f, 0.f, 0.f}; }
    if (pf != 33) wave_mm(accf, Vt, wave * 16, Ktf, lane);
    if (pb != 33) wave_mm(accb, Vt, wave * 16, Ktb, lane);
    __syncthreads();
    LAS bf16* stg = (LAS bf16*)lds + wave * (16 * RLDP);
#pragma unroll 1
    for (int d = 0; d < 2; ++d) { const int p = d ? pb : pf;
        if (p == 33) continue;
#pragma unroll
        for (int nt = 0; nt < 8; ++nt)
#pragma unroll
            for (int jj = 0; jj < 4; ++jj) stg[(4 * g + jj) * RLDP + nt * 16 + c] = (bf16)f2bf(d ? accb[nt][jj] : accf[nt][jj]);
        LDS_WAIT(); asm volatile("" ::: "memory");
        bf16* U = (bf16*)(ws + WS_U) + ((size_t)((b * 4 + h) * 2 + d) * 34 + p) * 16384 + (size_t)(wave * 16) * 128;
#pragma unroll
        for (int it = 0; it < 4; ++it) { const int id = lane + 64 * it, rr = id >> 4, ch = id & 15;
            *(v4u*)(U + rr * 128 + ch * 8) = *(const LAS v4u*)(stg + rr * RLDP + ch * 8); }
        LDS_WAIT(); asm volatile("" ::: "memory"); }
    __syncthreads();
}
__device__ __forceinline__ void ret_scan_item(const AH A, int l, int item, int tid) {
    unsigned char* ws = A.ws();
    const int bhd = item >> 3, sl = item & 7; const int d = bhd & 1, h = (bhd >> 1) & 3;
    const float lg = log_sigmoid_f(A.in(I_RETLOGIT)[(l * 2 + d) * 4 + h]); const float sdec = __expf(128.0f * lg);
    const v2u* U = (const v2u*)((const bf16*)(ws + WS_U) + (size_t)bhd * 34 * 16384) + sl * 512 + tid;
    v2u* S = (v2u*)((bf16*)(ws + WS_SIN) + (size_t)bhd * 34 * 16384) + sl * 512 + tid;
    f32x4 s = (f32x4){0.f, 0.f, 0.f, 0.f};
#pragma unroll 1
    for (int p0 = 0; p0 < 33; p0 += 11) { v2u u[11];
#pragma unroll
        for (int i = 0; i < 11; ++i) u[i] = U[(size_t)(p0 + i) * 4096];
#pragma unroll
        for (int i = 0; i < 11; ++i) { v2u w; w.x = pk2(s.x, s.y); w.y = pk2(s.z, s.w); S[(size_t)(p0 + i) * 4096] = w;
            const f32x4 uf = (f32x4){bflo(u[i].x), bfhi(u[i].x), bflo(u[i].y), bfhi(u[i].y)}; s = s * sdec + uf; } }
    { v2u w; w.x = pk2(s.x, s.y); w.y = pk2(s.z, s.w); S[(size_t)33 * 4096] = w; }
}
__device__ __forceinline__ void ret_out_item(const AH A, int l, int item, LAS unsigned char* lds, int tid, int wave, int lane) {
    unsigned char* ws = A.ws(); const bf16* Z = (const bf16*)(ws + WS_Z); const float* ra = (const float*)(ws + WS_ROPE);
    const int cidx = item % 34, bh = item / 34, b = bh >> 2, h = bh & 3;
    const bool lat = cidx >= 2; const int r0 = b * SROW + cidx * 128, t0 = (cidx - 2) * 128;
    const float lgf = log_sigmoid_f(A.in(I_RETLOGIT)[(l * 2 + 0) * 4 + h]) * 1.4426950408889634f, lgb = log_sigmoid_f(A.in(I_RETLOGIT)[(l * 2 + 1) * 4 + h]) * 1.4426950408889634f;
    LAS bf16* Qs = (LAS bf16*)lds; LAS bf16* Ks = (LAS bf16*)(lds + RBUF); LAS bf16* Vt = (LAS bf16*)(lds + 2 * RBUF); LAS bf16* Ss = (LAS bf16*)(lds + 3 * RBUF);
    const bf16* SINf = (const bf16*)(ws + WS_SIN) + ((size_t)((b * 4 + h) * 2 + 0) * 34 + ret_chain_pos(0, cidx)) * 16384;
    const bf16* SINb = (const bf16*)(ws + WS_SIN) + ((size_t)((b * 4 + h) * 2 + 1) * 34 + ret_chain_pos(1, cidx)) * 16384;
    ret_stage_pair<false, true>(Z, r0, ZC_RQ, h, lat, t0, ra, 1.0f, 0.f, 0, Qs, tid);
    ret_stage_pair<false, true>(Z, r0, ZC_RK, h, lat, t0, ra, 0.08838834764831845f, 0.f, 0, Ks, tid);
    ret_stage_pair<true, false>(Z, r0, ZC_RV, h, false, 0, ra, 1.0f, 0.f, 0, Vt, tid);
#pragma unroll
    for (int it = 0; it < 4; ++it) { const int task = tid + 512 * it, row = task >> 4, ch = task & 15; *(LAS v4u*)(Ss + row * RLDP + ch * 8) = *(const v4u*)(SINf + row * 128 + ch * 8); }
    v4u sbv[4];
#pragma unroll
    for (int it = 0; it < 4; ++it) { const int task = tid + 512 * it, row = task >> 4, ch = task & 15; sbv[it] = *(const v4u*)(SINb + row * 128 + ch * 8); }
    __syncthreads();
    const int g = lane >> 4, c = lane & 15, i0 = wave * 16 + 4 * g;
    f32x4 accs[8], acco[8];
#pragma unroll
    for (int nt = 0; nt < 8; ++nt) { accs[nt] = (f32x4){0.f, 0.f, 0.f, 0.f}; acco[nt] = (f32x4){0.f, 0.f, 0.f, 0.f}; }
    wave_mm(accs, Qs, wave * 16, Ks, lane);
    wave_mm(acco, Qs, wave * 16, Ss, lane);
#pragma unroll
    for (int jj = 0; jj < 4; ++jj) { const float qd = __builtin_amdgcn_exp2f(lgf * (float)(i0 + jj + 1));
#pragma unroll
        for (int nt = 0; nt < 8; ++nt) acco[nt][jj] *= qd; }
    int i0w = i0; asm volatile("" : "+v"(i0w));
#pragma unroll
    for (int nt = 0; nt < 8; ++nt)
#pragma unroll
        for (int jj = 0; jj < 4; ++jj) { const int diff = (i0w + jj) - (nt * 16 + c);
            const float w = diff > 0 ? __builtin_amdgcn_exp2f(lgf * (float)diff) : (diff < 0 ? __builtin_amdgcn_exp2f(lgb * (float)(-diff)) : 2.0f);
            accs[nt][jj] *= w; }
    __syncthreads();
#pragma unroll
    for (int nt = 0; nt < 8; ++nt)
#pragma unroll
        for (int jj = 0; jj < 4; ++jj) Ks[(i0 + jj) * RLDP + nt * 16 + c] = (bf16)f2bf(accs[nt][jj]);
#pragma unroll
    for (int it = 0; it < 4; ++it) { const int task = tid + 512 * it, row = task >> 4, ch = task & 15; *(LAS v4u*)(Ss + row * RLDP + ch * 8) = sbv[it]; }
    __syncthreads();
#pragma unroll
    for (int nt = 0; nt < 8; ++nt) accs[nt] = (f32x4){0.f, 0.f, 0.f, 0.f};
    wave_mm(accs, Qs, wave * 16, Ss, lane);
#pragma unroll
    for (int jj = 0; jj < 4; ++jj) { const float qd = __builtin_amdgcn_exp2f(lgb * (float)(128 - (i0 + jj)));
#pragma unroll
        for (int nt = 0; nt < 8; ++nt) acco[nt][jj] += qd * accs[nt][jj]; }
    wave_mm(acco, Ks, wave * 16, Vt, lane);
    const float* gn = A.in(I_RETG) + (size_t)l * 512 + h * 128;
    bf16* Y = (bf16*)(ws + WS_Y);
    float gnv[8];
#pragma unroll
    for (int nt = 0; nt < 8; ++nt) gnv[nt] = gn[nt * 16 + c];
#pragma unroll
    for (int jj = 0; jj < 4; ++jj) {
        float s1 = 0.f;
#pragma unroll
        for (int nt = 0; nt < 8; ++nt) s1 += acco[nt][jj];
        s1 += shx(s1, 1, lane); s1 += shx(s1, 2, lane); s1 += shx(s1, 4, lane); s1 += shx(s1, 8, lane);
        const float mu = s1 * (1.0f / 128.0f); float s2 = 0.f;
#pragma unroll
        for (int nt = 0; nt < 8; ++nt) { const float dlt = acco[nt][jj] - mu; s2 += dlt * dlt; }
        s2 += shx(s2, 1, lane); s2 += shx(s2, 2, lane); s2 += shx(s2, 4, lane); s2 += shx(s2, 8, lane);
        const float rstd = rsqrtf(s2 * (1.0f / 128.0f) + NORM_EPS);
#pragma unroll
        for (int nt = 0; nt < 8; ++nt) Qs[(i0 + jj) * RLDP + nt * 16 + c] = (bf16)f2bf((acco[nt][jj] - mu) * rstd * gnv[nt]);
    }
    LDS_WAIT(); asm volatile("" ::: "memory");
#pragma unroll
    for (int it = 0; it < 4; ++it) { const int id = lane + 64 * it, rr = wave * 16 + (id >> 4), ch = id & 15; const size_t row = (size_t)(r0 + rr);
        float yv[8], rg[8]; unpack8(*(const LAS v4u*)(Qs + rr * RLDP + ch * 8), yv); unpack8(*(const v4u*)(Z + row * DIN + ZC_RG + h * 128 + ch * 8), rg);
#pragma unroll
        for (int e = 0; e < 8; ++e) yv[e] *= rg[e] * sigmoidf_(rg[e]);
        v4u w; w.x = pk2(yv[0], yv[1]); w.y = pk2(yv[2], yv[3]); w.z = pk2(yv[4], yv[5]); w.w = pk2(yv[6], yv[7]);
        *(v4u*)(Y + row * 512 + h * 128 + ch * 8) = w; }
    __syncthreads();
}
constexpr int XLDP = 68;
constexpr int XWAVE_BYTES = 64 * XLDP * 4;
__device__ __forceinline__ float gelu_tanh(float x) { const float u = 0.7978845608028654f * (x + 0.044715f * x * x * x); const float th = 1.0f - 2.0f * __builtin_amdgcn_rcpf(1.0f + __expf(2.0f * u)); return 0.5f * x * (1.0f + th); }
__device__ __forceinline__ int lru_chain_pos(int d, int c64) { return d == 0 ? c64 : (c64 < 4 ? 3 - c64 : 71 - c64); }

struct LruFrag { bf16x8 ba[2], bx[2]; };
__device__ __forceinline__ LruFrag lru_frag_load(const unsigned char* ws, int l, int dir, int blk, int nt, int lane) {
    const int g = lane >> 4, c = lane & 15; LruFrag f;
    const bf16* wa = (const bf16*)(ws + (size_t)(l & 1) * WS_WSET + WS_LRUW) + (size_t)((0 * 2 + dir) * 8 + blk) * 4096 + (nt * 16 + c) * 64 + g * 8;
    const bf16* wx = (const bf16*)(ws + (size_t)(l & 1) * WS_WSET + WS_LRUW) + (size_t)((1 * 2 + dir) * 8 + blk) * 4096 + (nt * 16 + c) * 64 + g * 8;
#pragma unroll
    for (int ks = 0; ks < 2; ++ks) { f.ba[ks] = *(const bf16x8*)(wa + ks * 32); f.bx[ks] = *(const bf16x8*)(wx + ks * 32); }
    return f;
}
template <int DIR, bool FINAL>
__device__ __forceinline__ void lru_dir(const AH A, int l, int b, int c64, int blk, int nt, const bf16x8 (&af)[4][2], const float (&xv)[16], float (&hs)[16], int lane,
                                        const LruFrag& fr, float b_a, float b_x, float lam, float hin) {
    unsigned char* ws = A.ws();
    const int g = lane >> 4, c = lane & 15; const int ch = blk * 64 + nt * 16 + c;
    f32x4 accr[4], acci[4];
#pragma unroll
    for (int mt = 0; mt < 4; ++mt) { accr[mt] = (f32x4){0.f, 0.f, 0.f, 0.f}; acci[mt] = (f32x4){0.f, 0.f, 0.f, 0.f};
#pragma unroll
        for (int ks = 0; ks < 2; ++ks) { accr[mt] = __builtin_amdgcn_mfma_f32_16x16x32_bf16(af[mt][ks], fr.ba[ks], accr[mt], 0, 0, 0);
                                         acci[mt] = __builtin_amdgcn_mfma_f32_16x16x32_bf16(af[mt][ks], fr.bx[ks], acci[mt], 0, 0, 0); } }
    const float sp = fmaxf(-lam, 0.f) + log1pf(__expf(-fabsf(lam)));
    float a_[16], u_[16], la_[16];
#pragma unroll
    for (int q = 0; q < 16; ++q) { const int mt = q >> 2, jj = q & 3;
        const float r = sigmoidf_(accr[mt][jj] + b_a), ii = sigmoidf_(acci[mt][jj] + b_x);
        const float la = -8.0f * r * sp; a_[q] = __expf(la); la_[q] = la;
        const float x2 = 2.0f * la;
        const float em = -x2 * (1.0f + x2 * (0.5f + x2 * (0.16666667f + x2 * (0.041666668f + x2 * (0.0083333338f + x2 * 0.0013888889f)))));
        u_[q] = __builtin_amdgcn_sqrtf(em) * (ii * xv[q]); }
    float P = 1.f, H = 0.f;
#pragma unroll
    for (int qi = 0; qi < 16; ++qi) { const int q = DIR ? 15 - qi : qi; H = a_[q] * H + u_[q]; P *= a_[q]; }
    float Pg[4], Hg[4];
#pragma unroll
    for (int k = 0; k < 4; ++k) { Pg[k] = shi(P, c + 16 * k); Hg[k] = shi(H, c + 16 * k); }
    if (!FINAL) {
        const int p = lru_chain_pos(DIR, c64);
        const size_t idx = ((size_t)((b * 2 + DIR) * 68 + p)) * 512 + ch;
        float Hc, Pc = (Pg[0] * Pg[1]) * (Pg[2] * Pg[3]);
        if (DIR == 0) Hc = ((Hg[0] * Pg[1] + Hg[1]) * Pg[2] + Hg[2]) * Pg[3] + Hg[3];
        else          Hc = ((Hg[3] * Pg[2] + Hg[2]) * Pg[1] + Hg[1]) * Pg[0] + Hg[0];
        if (g == 0) { float* S = (float*)(ws + WS_SUMM); S[idx * 2] = Pc; S[idx * 2 + 1] = Hc; }
        const size_t e0 = ((((size_t)((b * 68 + c64) * 8 + blk) * 4 + nt) * 2 + DIR) * 64 + lane) * 16;
        bf16* LA = (bf16*)(ws + WS_HN) + e0; bf16* LU = (bf16*)(ws + WS_PARTC) + e0;
        v4u w;
        w.x = pk2(la_[0], la_[1]); w.y = pk2(la_[2], la_[3]); w.z = pk2(la_[4], la_[5]); w.w = pk2(la_[6], la_[7]); *(v4u*)LA = w;
        w.x = pk2(la_[8], la_[9]); w.y = pk2(la_[10], la_[11]); w.z = pk2(la_[12], la_[13]); w.w = pk2(la_[14], la_[15]); *(v4u*)(LA + 8) = w;
        w.x = pk2(u_[0], u_[1]); w.y = pk2(u_[2], u_[3]); w.z = pk2(u_[4], u_[5]); w.w = pk2(u_[6], u_[7]); *(v4u*)LU = w;
        w.x = pk2(u_[8], u_[9]); w.y = pk2(u_[10], u_[11]); w.z = pk2(u_[12], u_[13]); w.w = pk2(u_[14], u_[15]); *(v4u*)(LU + 8) = w;
    } else {
        float s0, s1, s2, s3;
        if (DIR == 0) { s0 = hin; s1 = s0 * Pg[0] + Hg[0]; s2 = s1 * Pg[1] + Hg[1]; s3 = s2 * Pg[2] + Hg[2]; }
        else          { s3 = hin; s2 = s3 * Pg[3] + Hg[3]; s1 = s2 * Pg[2] + Hg[2]; s0 = s1 * Pg[1] + Hg[1]; }
        float h = (g == 0) ? s0 : (g == 1) ? s1 : (g == 2) ? s2 : s3;
#pragma unroll
        for (int qi = 0; qi < 16; ++qi) { const int q = DIR ? 15 - qi : qi; h = a_[q] * h + u_[q]; hs[q] += h; }
    }
}
template <bool FINAL>
__device__ __forceinline__ void lru_task(const AH A, int l, int b, int c64, int blk, LAS unsigned char* lds, int wave, int lane, int half) {
    unsigned char* ws = A.ws(); const bf16* Z = (const bf16*)(ws + WS_Z);
    LAS float* xs = (LAS float*)(lds + wave * XWAVE_BYTES);
    const int r0 = b * SROW + c64 * 64;
    const int seq_lo = (c64 < 4) ? b * SROW : b * SROW + LCTX, seq_hi = (c64 < 4) ? b * SROW + LCTX : (b + 1) * SROW;
    const int g = lane >> 4, c = lane & 15;
    const int cgx = lane & 7, tg = lane >> 3, ch0 = blk * 64 + cgx * 8;
    v4u raw[11];
#pragma unroll
    for (int q = 0; q < 11; ++q) { const int row = r0 + tg * 8 - 1 + q;
        raw[q] = (row >= seq_lo && row < seq_hi) ? *(const v4u*)(Z + (size_t)row * DIN + ZC_LX + ch0) : (v4u){0u, 0u, 0u, 0u}; }
    f32x4 cwv[4][2], cbv[2];
#pragma unroll
    for (int e2 = 0; e2 < 2; ++e2) { cbv[e2] = *(const f32x4*)(A.in(I_CONVB) + l * 512 + ch0 + 4 * e2);
#pragma unroll
        for (int j = 0; j < 4; ++j) cwv[j][e2] = *(const f32x4*)(A.in(I_CONVW) + (l * 4 + j) * 512 + ch0 + 4 * e2); }
    float pba[2][2], pbx[2][2], plam[2][2], phin[2][2];
#pragma unroll
    for (int nti = 0; nti < 2; ++nti)
#pragma unroll
        for (int d = 0; d < 2; ++d) { const int ch = blk * 64 + (2 * half + nti) * 16 + c; const int pidx = (l * 2 + d) * 512 + ch;
            pba[nti][d] = A.in(I_LBA)[pidx]; pbx[nti][d] = A.in(I_LBX)[pidx]; plam[nti][d] = A.in(I_LAM)[pidx];
            phin[nti][d] = FINAL ? ((const float*)(ws + WS_HIN))[((size_t)((b * 2 + d) * 68 + lru_chain_pos(d, c64))) * 512 + ch] : 0.f; }
    LruFrag fcur = lru_frag_load(ws, l, 0, blk, 2 * half, lane);
    {
        float xw[4][8];
#pragma unroll
        for (int q = 0; q < 3; ++q) unpack8(raw[q], xw[q]);
#pragma unroll
        for (int tt = 0; tt < 8; ++tt) { unpack8(raw[tt + 3], xw[3]);
            float y[8];
#pragma unroll
            for (int e = 0; e < 8; ++e) { float sacc = cbv[e >> 2][e & 3];
#pragma unroll
                for (int j = 0; j < 4; ++j) sacc += cwv[j][e >> 2][e & 3] * xw[j][e];
                y[e] = sacc; }
            LAS f32x4* o = (LAS f32x4*)(xs + (tg * 8 + tt) * XLDP + cgx * 8);
            o[0] = (f32x4){y[0], y[1], y[2], y[3]}; o[1] = (f32x4){y[4], y[5], y[6], y[7]};
#pragma unroll
            for (int e = 0; e < 8; ++e) { xw[0][e] = xw[1][e]; xw[1][e] = xw[2][e]; xw[2][e] = xw[3][e]; } }
    }
    LDS_WAIT(); asm volatile("" ::: "memory");
    bf16x8 af[4][2];
    { const int m = lane & 15, gq = m >> 2, jq = m & 3, kq = (lane >> 4) * 8;
#pragma unroll
      for (int mt = 0; mt < 4; ++mt) { const int tok = 16 * gq + 4 * mt + jq;
#pragma unroll
          for (int ks = 0; ks < 2; ++ks) { const LAS f32x4* s = (const LAS f32x4*)(xs + tok * XLDP + ks * 32 + kq); const f32x4 v0 = s[0], v1 = s[1];
              v4u w; w.x = pk2(v0.x, v0.y); w.y = pk2(v0.z, v0.w); w.z = pk2(v1.x, v1.y); w.w = pk2(v1.z, v1.w); af[mt][ks] = __builtin_bit_cast(bf16x8, w); } } }
#pragma unroll
    for (int nti = 0; nti < 2; ++nti) { const int nt = 2 * half + nti;
        float xv[16], hs[16];
#pragma unroll
        for (int q = 0; q < 16; ++q) { xv[q] = xs[(16 * g + q) * XLDP + nt * 16 + c]; hs[q] = 0.f; }
        const LruFrag f1 = lru_frag_load(ws, l, 1, blk, nt, lane);
        lru_dir<0, FINAL>(A, l, b, c64, blk, nt, af, xv, hs, lane, fcur, pba[nti][0], pbx[nti][0], plam[nti][0], phin[nti][0]);
        if (nti == 0) fcur = lru_frag_load(ws, l, 0, blk, nt + 1, lane);
        lru_dir<1, FINAL>(A, l, b, c64, blk, nt, af, xv, hs, lane, f1, pba[nti][1], pbx[nti][1], plam[nti][1], phin[nti][1]);
        if (FINAL) {
#pragma unroll
            for (int q = 0; q < 16; ++q) xs[(16 * g + q) * XLDP + nt * 16 + c] = hs[q]; }
    }
    if (FINAL) {
        LDS_WAIT(); asm volatile("" ::: "memory");
        bf16* Y = (bf16*)(ws + WS_Y) + (size_t)MTOK * 512;
#pragma unroll
        for (int it = 0; it < 4; ++it) { const int id = lane + 64 * it, tok = id >> 2, chn = 4 * half + (id & 3); const size_t row = (size_t)(r0 + tok);
            const LAS f32x4* sp = (const LAS f32x4*)(xs + tok * XLDP + chn * 8); const f32x4 h0 = sp[0], h1 = sp[1];
            float lz[8]; unpack8(*(const v4u*)(Z + row * DIN + ZC_LZ + blk * 64 + chn * 8), lz);
            v4u w; w.x = pk2(gelu_tanh(lz[0]) * h0.x, gelu_tanh(lz[1]) * h0.y); w.y = pk2(gelu_tanh(lz[2]) * h0.z, gelu_tanh(lz[3]) * h0.w);
            w.z = pk2(gelu_tanh(lz[4]) * h1.x, gelu_tanh(lz[5]) * h1.y); w.w = pk2(gelu_tanh(lz[6]) * h1.z, gelu_tanh(lz[7]) * h1.w);
            *(v4u*)(Y + row * 512 + blk * 64 + chn * 8) = w; }
    }
    LDS_WAIT(); asm volatile("" ::: "memory");
}
template <int DIR>
__device__ __forceinline__ void lru_apply(const float (&a_)[16], const float (&u_)[16], float hin, float (&hs)[16], int lane) {
    const int g = lane >> 4, c = lane & 15;
    float P = 1.f, H = 0.f;
#pragma unroll
    for (int qi = 0; qi < 16; ++qi) { const int q = DIR ? 15 - qi : qi; H = a_[q] * H + u_[q]; P *= a_[q]; }
    float Pg[4], Hg[4];
#pragma unroll
    for (int k = 0; k < 4; ++k) { Pg[k] = shi(P, c + 16 * k); Hg[k] = shi(H, c + 16 * k); }
    float s0, s1, s2, s3;
    if (DIR == 0) { s0 = hin; s1 = s0 * Pg[0] + Hg[0]; s2 = s1 * Pg[1] + Hg[1]; s3 = s2 * Pg[2] + Hg[2]; }
    else          { s3 = hin; s2 = s3 * Pg[3] + Hg[3]; s1 = s2 * Pg[2] + Hg[2]; s0 = s1 * Pg[1] + Hg[1]; }
    float h = (g == 0) ? s0 : (g == 1) ? s1 : (g == 2) ? s2 : s3;
#pragma unroll
    for (int qi = 0; qi < 16; ++qi) { const int q = DIR ? 15 - qi : qi; h = a_[q] * h + u_[q]; hs[q] += h; }
}
__device__ __forceinline__ void lru_final(const AH A, int l, int b, int c64, int blk, LAS unsigned char* lds, int wave, int lane, int half) {
    unsigned char* ws = A.ws(); const bf16* Z = (const bf16*)(ws + WS_Z);
    LAS float* xs = (LAS float*)(lds + wave * XWAVE_BYTES);
    const int r0 = b * SROW + c64 * 64;
    const int g = lane >> 4, c = lane & 15;
    float phin[2][2];
#pragma unroll
    for (int nti = 0; nti < 2; ++nti)
#pragma unroll
        for (int d = 0; d < 2; ++d) { const int ch = blk * 64 + (2 * half + nti) * 16 + c;
            phin[nti][d] = ((const float*)(ws + WS_HIN))[((size_t)((b * 2 + d) * 68 + lru_chain_pos(d, c64))) * 512 + ch]; }
    v4u wl[2][2][2], wu[2][2][2];
#pragma unroll
    for (int nti = 0; nti < 2; ++nti)
#pragma unroll
        for (int d = 0; d < 2; ++d) { const size_t e0 = ((((size_t)((b * 68 + c64) * 8 + blk) * 4 + (2 * half + nti)) * 2 + d) * 64 + lane) * 16;
            const bf16* LA = (const bf16*)(ws + WS_HN) + e0; const bf16* LU = (const bf16*)(ws + WS_PARTC) + e0;
            wl[nti][d][0] = *(const v4u*)LA; wl[nti][d][1] = *(const v4u*)(LA + 8); wu[nti][d][0] = *(const v4u*)LU; wu[nti][d][1] = *(const v4u*)(LU + 8); }
#pragma unroll
    for (int nti = 0; nti < 2; ++nti) { const int nt = 2 * half + nti;
        float hs[16];
#pragma unroll
        for (int q = 0; q < 16; ++q) hs[q] = 0.f;
#pragma unroll
        for (int d = 0; d < 2; ++d) { float a_[16], u_[16];
            unpack8(wl[nti][d][0], a_); unpack8(wl[nti][d][1], a_ + 8); unpack8(wu[nti][d][0], u_); unpack8(wu[nti][d][1], u_ + 8);
#pragma unroll
            for (int q = 0; q < 16; ++q) a_[q] = __expf(a_[q]);
            if (d == 0) lru_apply<0>(a_, u_, phin[nti][0], hs, lane); else lru_apply<1>(a_, u_, phin[nti][1], hs, lane); }
#pragma unroll
        for (int q = 0; q < 16; ++q) xs[(16 * g + q) * XLDP + nt * 16 + c] = hs[q];
    }
    LDS_WAIT(); asm volatile("" ::: "memory");
    bf16* Y = (bf16*)(ws + WS_Y) + (size_t)MTOK * 512;
#pragma unroll
    for (int it = 0; it < 4; ++it) { const int id = lane + 64 * it, tok = id >> 2, chn = 4 * half + (id & 3); const size_t row = (size_t)(r0 + tok);
        const LAS f32x4* sp = (const LAS f32x4*)(xs + tok * XLDP + chn * 8); const f32x4 h0 = sp[0], h1 = sp[1];
        float lz[8]; unpack8(*(const v4u*)(Z + row * DIN + ZC_LZ + blk * 64 + chn * 8), lz);
        v4u w; w.x = pk2(gelu_tanh(lz[0]) * h0.x, gelu_tanh(lz[1]) * h0.y); w.y = pk2(gelu_tanh(lz[2]) * h0.z, gelu_tanh(lz[3]) * h0.w);
        w.z = pk2(gelu_tanh(lz[4]) * h1.x, gelu_tanh(lz[5]) * h1.y); w.w = pk2(gelu_tanh(lz[6]) * h1.z, gelu_tanh(lz[7]) * h1.w);
        *(v4u*)(Y + row * 512 + blk * 64 + chn * 8) = w; }
    LDS_WAIT(); asm volatile("" ::: "memory");
}
__device__ __forceinline__ void lru_scan(const AH A, int tid, int G) {
    unsigned char* ws = A.ws(); const float* S = (const float*)(ws + WS_SUMM); float* HIN = (float*)(ws + WS_HIN);
    const int cpb = (4096 + G - 1) / G;
    for (int chain = blockIdx.x * cpb + tid; tid < cpb && chain < 4096; chain += 4096) { const int bd = chain >> 9, ch = chain & 511; float h = 0.f;
        typedef float f32x2s __attribute__((ext_vector_type(2)));
#pragma unroll 1
        for (int p0 = 0; p0 < 68; p0 += 17) { f32x2s ph_[17];
#pragma unroll
            for (int i = 0; i < 17; ++i) ph_[i] = *(const f32x2s*)(S + ((size_t)(bd * 68 + p0 + i) * 512 + ch) * 2);
#pragma unroll
            for (int i = 0; i < 17; ++i) { HIN[(size_t)(bd * 68 + p0 + i) * 512 + ch] = h; h = ph_[i].x * h + ph_[i].y; } } }
}

#define EN(k) (((MASK) >> (k)) & 1)
template <int MASK> __global__ void __launch_bounds__(NWAVES * 64, 2) fwd_kernel(Args args) {
    extern __shared__ __attribute__((aligned(16))) unsigned char lds_raw[];
    LAS unsigned char* lds0 = (LAS unsigned char*)lds_raw;
    cg::grid_group grid = cg::this_grid();
    { const unsigned* aw = (const unsigned*)&args; const int tid = threadIdx.x; if (tid < 54) ((LAS unsigned*)(lds0 + ARGS_LDS_OFF))[tid] = aw[tid];
      if (tid >= 64 && tid < 66) ((LAS unsigned*)(lds0 + ARGS_LDS_OFF + 256))[tid - 64] = 0u; }
    __syncthreads();
    XcdBarrier xbar = xcd_barrier_post((unsigned*)args.ws, (volatile LAS unsigned*)(lds0 + ARGS_LDS_OFF + 256), threadIdx.x == 0);
    const int ph_lo = args.ph_lo, ph_hi = args.ph_hi;
    const int wave0 = __builtin_amdgcn_readfirstlane((int)threadIdx.x >> 6);
#ifndef PROBE_MASK
#define PROBE_MASK 0
#endif
#ifndef PROBE_SUB
#define PROBE_SUB 0
#endif
#define SUBOFF(bit) (rep && ((PROBE_SUB) & (bit)))
#define PROBE_HIT(ph) ((PROBE_MASK) != 0 && ((ph) == 0 ? (((PROBE_MASK) >> 13) & 1) : (ph) == 53 ? (((PROBE_MASK) >> 14) & 1) : (((PROBE_MASK) >> (((ph) - 1) % 13)) & 1)))
    for (int ph2 = 2 * ph_lo; ph2 < 2 * ph_hi; ++ph2) {
        const int ph = ph2 >> 1, rep = ph2 & 1;
        if (rep && !PROBE_HIT(ph)) continue;
        if (ph2 != 2 * ph_lo) {
            if (ph_lo < 0) grid.sync();
            else { int mk2_ = -1; asm volatile("" : "+s"(mk2_)); const bool t0_ = (wave0 == 0) && (__builtin_amdgcn_mbcnt_hi(mk2_, __builtin_amdgcn_mbcnt_lo(mk2_, 0)) == 0); xcd_barrier(xbar, t0_); }
        }
#define PH_PROLOG int wv_ = wave0; int mk_ = -1; asm volatile("" : "+s"(wv_), "+s"(mk_)); int tid = wv_ * 64 + (int)__builtin_amdgcn_mbcnt_hi(mk_, __builtin_amdgcn_mbcnt_lo(mk_, 0)); int G = gridDim.x, bx = blockIdx.x; asm volatile("" : "+s"(G), "+s"(bx)); \
        unsigned ldsi = (unsigned)(unsigned long long)lds0; asm volatile("" : "+s"(ldsi)); LAS unsigned char* lds = (LAS unsigned char*)(unsigned long long)ldsi; \
        const AH AHv{(const LAS unsigned*)(lds + ARGS_LDS_OFF)}; const int lane = tid & 63, wave = wv_; \
        const int gw = bx * NWAVES + wave, NGW = G * NWAVES; (void)gw; (void)NGW; (void)lane; (void)wave; (void)G; (void)bx; (void)tid;
        if (EN(13) && ph == 0) { PH_PROLOG phase_p0(AHv, lds, tid, G); __syncthreads(); convert_layer(AHv, 0, 0, CV_NIT, lds, gw, NGW, wave, lane); }
        else if (EN(14) && ph == 53) { PH_PROLOG final_rows(AHv, gw, NGW, lane); }
        else {
            const int l = (ph - 1) / 13, k = (ph - 1) - l * 13; const bool last = (l == DEPTH - 1);
#define ws (AHv.ws())
#define HN ((bf16*)(ws + WS_HN))
#define Zb ((bf16*)(ws + WS_Z))
#define X ((float*)(ws + WS_X))
#define modbuf ((const float*)(ws + WS_MOD))
            if (EN(0) && k == 0) { PH_PROLOG norm_rows(AHv, l, 0, gw, NGW, lane, l > 0 ? 11 : 0, modbuf + (size_t)(l > 0 ? l - 1 : 0) * 5 * MODW + 4 * MODW + 2 * 3072 + 2048, 0.5f); }
            else if (EN(3) && k == 3) { PH_PROLOG norm_rows(AHv, l, 1, gw, NGW, lane, 11, modbuf + (size_t)l * 5 * MODW + 4 * MODW + 0 * 3072 + 2048, 0.5f); }
            else if (EN(10) && k == 10) { PH_PROLOG norm_rows(AHv, l, 2, gw, NGW, lane, last ? 0 : 4, modbuf + (size_t)l * 5 * MODW + 4 * MODW + 1 * 3072 + 2048, 1.0f); }
            else if (EN(1) && (k == 1 || k == 11)) { PH_PROLOG const int j = (k == 1) ? 0 : 1;
                pg8::Gemm gm{HN, (const bf16*)(ws + (size_t)(l & 1) * WS_WSET + WS_WFI) + (size_t)j * 5632 * 1024, MTOK, 5632, 1024};
                pg8::EpiSwiglu E{Zb};
                if (last && k == 11) { pg8::LastLayerOrder S; S.init(5632, G, bx, 0); pg8::gemm_phase<1024, pg8::EpiSwiglu, pg8::LastLayerOrder, true, true>(lds, gm, S, E, tid); }
                else { pg8::StaticOrder S; S.init(MTOK, 5632, G, bx); pg8::gemm_phase<1024, pg8::EpiSwiglu, pg8::StaticOrder, true, true>(lds, gm, S, E, tid); } }
            else if (EN(2) && (k == 2 || k == 12)) { PH_PROLOG const int j = (k == 2) ? 0 : 1, sub = (k == 2) ? 0 : 2;
                pg8::Gemm gm{Zb, (const bf16*)(ws + (size_t)(l & 1) * WS_WSET + WS_WFO) + (size_t)j * 1024 * DFF, MTOK, 1024, DFF};
                pg8::EpiResid E{X, modbuf + (size_t)l * 5 * MODW + sub * 3072 + 2048, rep ? 0.0f : 0.5f, (float*)(ws + WS_PARTC)};
                if (last && k == 12) { pg8::LatOrder S{G, bx}; pg8::gemm_phase<DFF, pg8::EpiResid, pg8::LatOrder, true, true>(lds, gm, S, E, tid); }
                else { pg8::SplitOrder S{G, bx, 11, 4}; pg8::gemm_phase<DFF, pg8::EpiResid, pg8::SplitOrder, true, true>(lds, gm, S, E, tid); } }
            else if (EN(4) && k == 4) { PH_PROLOG
                pg8::Gemm gm{HN, (const bf16*)(ws + (size_t)(l & 1) * WS_WSET + WS_WIN), MTOK, DIN, 1024};
                pg8::EpiZ E{Zb, DIN};
                if (last) { pg8::LastLayerOrder S; S.init(DIN, G, bx, 28); pg8::gemm_phase<1024, pg8::EpiZ, pg8::LastLayerOrder, true, true>(lds, gm, S, E, tid); }
                else { pg8::StaticOrder S; S.init(MTOK, DIN, G, bx); pg8::gemm_phase<1024, pg8::EpiZ, pg8::StaticOrder, true, true>(lds, gm, S, E, tid); } }
            else if (EN(5) && k == 5) { PH_PROLOG
                if (!SUBOFF(1)) prep_qk(AHv, l, gw, NGW, lane);
                if (!SUBOFF(2)) for (int it = bx; it < 544; it += G) ret_u_item(AHv, l, it, lds, tid, wave, lane);
                __syncthreads();
                if (!SUBOFF(4)) { PH_PROLOG
                    const int H = 2 * 272, n3 = (544 > 2 * G && 544 <= 3 * G) ? 544 - 2 * G : 0, nb = G - n3;
                    for (int hi = bx; hi < H; hi += (bx < n3) ? H : nb) { const int li = hi >> 1; lru_task<false>(AHv, l, li / 68, li % 68, wave, lds, wave, lane, hi & 1); } } }
            else if (EN(6) && k == 6) { PH_PROLOG
                for (int it = bx; it < 256; it += G) ret_scan_item(AHv, l, it, tid);
                lru_scan(AHv, tid, G);
                const int nunits = last ? 512 : 544;
                for (int i = 0;; ++i) { const int u = i * G + bx; if (u >= nunits) break;
                    long qrow0, kvrow0; int hq, kvh, NT;
                    if (u < 512) { const int combo = u & 7, j = u >> 3; const int b = combo >> 1; kvh = combo & 1; hq = kvh * 4 + (j & 3); const int qb = j >> 2;
                        qrow0 = (long)b * SROW + LCTX + qb * 256; kvrow0 = (long)b * SROW; NT = 68; }
                    else { const int v = u - 512; const int b = v >> 3; hq = v & 7; kvh = hq >> 2; qrow0 = (long)b * SROW; kvrow0 = qrow0; NT = 4; }
                    attn_body::attn_unit<8>(qrow0, kvrow0, hq, kvh, NT, (const attn_body::bf16*)(ws + WS_QN), (const attn_body::bf16*)(ws + WS_KN), (const attn_body::bf16*)(Zb + ZC_AV),
                                            (attn_body::bf16*)((bf16*)(ws + WS_Y) + (size_t)2 * MTOK * 512), (char*)lds, tid); } }
            else if ((EN(7) || EN(15)) && k == 7) { PH_PROLOG
                const int nret = last ? 512 : 544, nlru = last ? 256 : 272;
                if (EN(7) && !SUBOFF(8)) for (int it = bx; it < nret; it += G) { const int item = last ? ((it >> 5) * 34 + 2 + (it & 31)) : it; ret_out_item(AHv, l, item, lds, tid, wave, lane); }
                __syncthreads();
                if (EN(15) && !SUBOFF(16)) { PH_PROLOG
                    const int H = 2 * nlru, n3 = (nret > 2 * G && nret <= 3 * G) ? nret - 2 * G : 0, nb = G - n3;
                    for (int hi = bx; hi < H; hi += (bx < n3) ? H : nb) { const int li = hi >> 1; const int b = last ? (li >> 6) : (li / 68), c64 = last ? (4 + (li & 63)) : (li % 68);
                        lru_final(AHv, l, b, c64, wave, lds, wave, lane, hi & 1); } } }
            else if (EN(8) && k == 8) { PH_PROLOG
                pg8::Gemm gm{(const bf16*)(ws + WS_Y), (const bf16*)(ws + (size_t)(l & 1) * WS_WSET + WS_WB), 3 * MTOK, 3 * 1024, 512}; pg8::MergeOrder S{G, bx, last ? 1 : 0};
                pg8::EpiMerge E{Zb, HN};
                pg8::gemm_phase<512, pg8::EpiMerge, pg8::MergeOrder, true, true>(lds, gm, S, E, tid);
                if (!last) {
                    const int nsec = (272 > G) ? ((272 - G < G) ? 272 - G : 0) : 0;
                    if (bx >= nsec) convert_layer(AHv, l + 1, 0, CV_NIT, lds, (bx - nsec) * NWAVES + wave, (G - nsec) * NWAVES, wave, lane); } }
            else if (EN(9) && k == 9) { PH_PROLOG
                pg8::Gemm gm{HN, (const bf16*)(ws + (size_t)(l & 1) * WS_WSET + WS_WO), MTOK, 1024, 1024};
                pg8::EpiResid E{X, modbuf + (size_t)l * 5 * MODW + 1 * 3072 + 2048, rep ? 0.0f : 1.0f, (float*)(ws + WS_PARTC)};
                if (last) { pg8::LatOrder S{G, bx}; pg8::gemm_phase<1024, pg8::EpiResid, pg8::LatOrder, true, true>(lds, gm, S, E, tid); }
                else { pg8::SplitOrder S{G, bx, 4, 4}; pg8::gemm_phase<1024, pg8::EpiResid, pg8::SplitOrder, true, true>(lds, gm, S, E, tid); } }
        }
#undef ws
#undef HN
#undef Zb
#undef X
#undef modbuf
    }
}

#ifndef MK_N_LAUNCHES
#define MK_N_LAUNCHES 1
#endif
#if MK_N_LAUNCHES == 1
#define FULLK fwd_kernel<0xffff>
#else
template <int MASK> static void launch_one(int grid, const Args& a, hipStream_t stream) {
    static bool init = false;
    if (!init) { (void)hipFuncSetAttribute((const void*)fwd_kernel<MASK>, hipFuncAttributeMaxDynamicSharedMemorySize, LDS_BYTES); init = true; }
    hipLaunchKernelGGL(fwd_kernel<MASK>, dim3(grid), dim3(NWAVES * 64), LDS_BYTES, stream, a);
}
#endif
extern "C" void kernel_launch(void* const* d_in, const int* in_sizes, int n_in, void* d_out, int out_size, void* d_ws, size_t ws_size, hipStream_t stream) {
    static int grid = 0;
    if (grid == 0) {
        if (n_in != 24 || ws_size < WS_END) { fprintf(stderr, "kernel_launch: unexpected n_in %d / ws %zu (need %zu)\n", n_in, ws_size, (size_t)WS_END); grid = -1; return; }
        int dev = 0, cus = 0;
        (void)hipGetDevice(&dev); (void)hipDeviceGetAttribute(&cus, hipDeviceAttributeMultiprocessorCount, dev);
#if MK_N_LAUNCHES == 1
        int per_cu = 0;
        (void)hipFuncSetAttribute((const void*)FULLK, hipFuncAttributeMaxDynamicSharedMemorySize, LDS_BYTES);
        if (hipOccupancyMaxActiveBlocksPerMultiprocessor(&per_cu, (const void*)FULLK, NWAVES * 64, LDS_BYTES) != hipSuccess || per_cu < 1) per_cu = 1;
        (void)hipGetLastError();
        grid = cus * per_cu;
#else
        grid = cus;
#endif
        if (grid <= 0) grid = 256;
    }
    if (grid < 0) return;
    (void)hipMemsetAsync(d_ws, 0, 16384, stream);
    Args a{};
    for (int i = 0; i < 24; ++i) a.in[i] = (const float*)d_in[i];
    a.out = (float*)d_out; a.ws = (unsigned char*)d_ws;
#if MK_N_LAUNCHES == 1
    a.ph_lo = 0; a.ph_hi = 54;
    void* params[] = {(void*)&a};
    hipError_t e = hipLaunchCooperativeKernel((const void*)FULLK, dim3(grid), dim3(NWAVES * 64), params, LDS_BYTES, stream);
    if (e != hipSuccess) fprintf(stderr, "cooperative launch failed: %s (grid %d)\n", hipGetErrorString(e), grid);
#else
    for (int ph = 0; ph < 54; ++ph) { a.ph_lo = ph; a.ph_hi = ph + 1;
        if (ph == 0) { launch_one<1 << 13>(grid, a, stream); continue; }
        if (ph == 53) { launch_one<1 << 14>(grid, a, stream); continue; }
        const int k = (ph - 1) % 13;
        switch (k) {
            case 0: launch_one<1 << 0>(grid, a, stream); break;
            case 1: case 11: launch_one<1 << 1>(grid, a, stream); break;
            case 2: case 12: launch_one<1 << 2>(grid, a, stream); break;
            case 3: launch_one<1 << 3>(grid, a, stream); break;
            case 4: launch_one<1 << 4>(grid, a, stream); break;
            case 5: launch_one<1 << 5>(grid, a, stream); break;
            case 6: launch_one<1 << 6>(grid, a, stream); break;
            case 7: launch_one<1 << 7>(grid, a, stream); launch_one<1 << 15>(grid, a, stream); break;
            case 8: launch_one<1 << 8>(grid, a, stream); break;
            case 9: launch_one<1 << 9>(grid, a, stream); break;
            case 10: launch_one<1 << 10>(grid, a, stream); break;
        }
    }
#endif
}
```

```cpp
#include <hip/hip_runtime.h>
#include <hip/hip_cooperative_groups.h>
#include <hip/hip_bf16.h>
#include <cstdio>
#include <cstdint>
#include <cmath>
namespace cg = cooperative_groups;
namespace pg8 {
#define PG8_LAS __attribute__((address_space(3)))
typedef unsigned short bf16_t;
typedef short bf16x8 __attribute__((ext_vector_type(8)));
typedef float f32x4 __attribute__((ext_vector_type(4)));
typedef unsigned u32x4 __attribute__((ext_vector_type(4)));
constexpr int BM = 256, BK = 64, HALF = 128, HTB = HALF * BK * 2  , STAGE_BYTES = 8 * HTB, NXCD = 8, WGM = 4;

__host__ __device__ __forceinline__ int lds_byte(int r, int c) { const int st = (r >> 4) * 2 + (c >> 5), rr = r & 15, cc = c & 31, ob = rr * 64 + cc * 2; return st * 1024 + (ob ^ (((ob >> 9) & 1) << 5)); }
__host__ __device__ __forceinline__ void stage_rc(int b, int& R, int& C) { const int st = b / 1024, sb = b % 1024, swz = sb ^ (((sb >> 9) & 1) << 5); R = (st >> 1) * 16 + swz / 64; C = (st & 1) * 32 + (swz % 64) / 2; }
__host__ __device__ __forceinline__ int perm32(int rho) { const int n = rho >> 4, i = rho & 15; return 8 * (i >> 2) + 4 * n + (i & 3); }

struct Unit { int pm, pn, k0, nk; };
struct Gemm { const bf16_t* A; const bf16_t* Bt; int M, N, K; };

struct StaticOrder {
    int nM, nN, nwg, G, c;
    __host__ __device__ void init(int M, int N, int G_, int c_) { nM = M / BM; nN = N / BM; nwg = nM * nN; G = G_; c = c_; }
    __host__ __device__ bool next(int i, Unit& u) const {
        const long L = (long)i * G + c; if (L >= nwg) return false;
        int wgid = (int)L; { const int q = nwg / NXCD, r = nwg % NXCD, xcd = wgid % NXCD, off = wgid / NXCD; wgid = (xcd < r ? xcd * (q + 1) : r * (q + 1) + (xcd - r) * q) + off; }
        const int nig = WGM * nN, gid = wgid / nig, fm = gid * WGM, gsz = (nM - fm) < WGM ? (nM - fm) : WGM;
        u.pm = fm + ((wgid % nig) % gsz); u.pn = (wgid % nig) / gsz; u.k0 = 0; u.nk = 0; return true;
    }
    __device__ __forceinline__ void a_ready(const Unit&) const {}
    __device__ __forceinline__ void done(const Unit&) const {}
};

typedef unsigned u32x2 __attribute__((ext_vector_type(2)));
__device__ __forceinline__ unsigned cvt_pk_bf16(float lo, float hi) { unsigned r; asm volatile("v_cvt_pk_bf16_f32 %0, %1, %2" : "=v"(r) : "v"(lo), "v"(hi)); return r; }
__device__ __forceinline__ float fast_sigmoid(float v) { return __builtin_amdgcn_rcpf(1.0f + __expf(-v)); }
__device__ __forceinline__ float bf_lo(unsigned w) { return __uint_as_float(w << 16); }
__device__ __forceinline__ float bf_hi(unsigned w) { return __uint_as_float(w & 0xffff0000u); }
struct EpiZ {
    static constexpr bool PERM = true, AFTER_DRAIN = false, CHAIN = false;
    bf16_t* O; int ldc;
    __device__ __forceinline__ void operator()(const f32x4 (&acc)[2][2][4][2], const Unit& u, int wr, int wc, int fr, int fq) const {
        const int row0 = u.pm * BM + wr * 64 + fr; const int col0 = u.pn * BM + wc * 32 + 8 * fq;
#pragma unroll
        for (int ai = 0; ai < 2; ++ai)
#pragma unroll
            for (int m = 0; m < 4; ++m) { bf16_t* rowp = O + (size_t)(row0 + ai * HALF + m * 16) * ldc + col0;
#pragma unroll
                for (int bj = 0; bj < 2; ++bj) { const f32x4 v0 = acc[ai][bj][m][0], v1 = acc[ai][bj][m][1];
                    u32x4 w; w.x = cvt_pk_bf16(v0[0], v0[1]); w.y = cvt_pk_bf16(v0[2], v0[3]); w.z = cvt_pk_bf16(v1[0], v1[1]); w.w = cvt_pk_bf16(v1[2], v1[3]);
                    *(u32x4*)(rowp + bj * HALF) = w; } }
    }
};
struct EpiSwiglu {
    static constexpr bool PERM = true, AFTER_DRAIN = false, CHAIN = false;
    bf16_t* O;
    __device__ __forceinline__ void operator()(const f32x4 (&acc)[2][2][4][2], const Unit& u, int wr, int wc, int fr, int fq) const {
        const int row0 = u.pm * BM + wr * 64 + fr; const int col0 = u.pn * HALF + wc * 32 + 8 * fq;
#pragma unroll
        for (int ai = 0; ai < 2; ++ai)
#pragma unroll
            for (int m = 0; m < 4; ++m) { bf16_t* rowp = O + (size_t)(row0 + ai * HALF + m * 16) * 2816 + col0;
                float h[8];
#pragma unroll
                for (int n = 0; n < 2; ++n)
#pragma unroll
                    for (int j = 0; j < 4; ++j) { const float a = acc[ai][0][m][n][j], b = acc[ai][1][m][n][j]; h[n * 4 + j] = a * fast_sigmoid(a) * b; }
                u32x4 w; w.x = cvt_pk_bf16(h[0], h[1]); w.y = cvt_pk_bf16(h[2], h[3]); w.z = cvt_pk_bf16(h[4], h[5]); w.w = cvt_pk_bf16(h[6], h[7]);
                *(u32x4*)rowp = w; }
    }
};
struct EpiResid {
    static constexpr bool PERM = false, AFTER_DRAIN = false, CHAIN = false;
    float* X; const float* gate; float scale; float* PARTC;
    __device__ __forceinline__ void operator()(const f32x4 (&acc)[2][2][4][2], const Unit& u, int wr, int wc, int fr, int fq) const {
        const int bb = u.pm / 17, mrow = (u.pm - bb * 17 == 0) ? 4 : bb;
        const int col0 = u.pn * BM + wc * 32 + 4 * fq;
        if (u.nk != 0) {
            const int sp = u.k0 / (u.nk * 64); bf16_t* base = (bf16_t*)PARTC + ((size_t)sp * 1024 + (size_t)bb * 256 + wr * 64 + fr) * 1024 + col0;
#pragma unroll
            for (int ai = 0; ai < 2; ++ai)
#pragma unroll
                for (int m = 0; m < 4; ++m)
#pragma unroll
                    for (int bj = 0; bj < 2; ++bj)
#pragma unroll
                        for (int n = 0; n < 2; ++n) { const f32x4 v = acc[ai][bj][m][n]; u32x2 w; w.x = cvt_pk_bf16(v[0], v[1]); w.y = cvt_pk_bf16(v[2], v[3]);
                            *(u32x2*)(base + (size_t)(ai * HALF + m * 16) * 1024 + bj * HALF + n * 16) = w; }
            return; }
        const float* g = gate + (size_t)mrow * 9216;
        const int row0 = u.pm * BM + wr * 64 + fr;
        f32x4 gv[2][2];
#pragma unroll
        for (int bj = 0; bj < 2; ++bj)
#pragma unroll
            for (int n = 0; n < 2; ++n) gv[bj][n] = *(const f32x4*)(g + col0 + bj * HALF + n * 16) * scale;
#pragma unroll
        for (int ai = 0; ai < 2; ++ai)
#pragma unroll
            for (int m = 0; m < 4; ++m) { float* rowp = X + (size_t)(row0 + ai * HALF + m * 16) * 1024 + col0;
#pragma unroll
                for (int bj = 0; bj < 2; ++bj)
#pragma unroll
                    for (int n = 0; n < 2; ++n) { f32x4* p = (f32x4*)(rowp + bj * HALF + n * 16); *p = *p + gv[bj][n] * acc[ai][bj][m][n]; }
                asm volatile("" ::: "memory"); }
    }
};
struct EpiMerge {
    static constexpr bool PERM = false, AFTER_DRAIN = false, CHAIN = true;
    const bf16_t* Z; bf16_t* MG;
    __device__ __forceinline__ void operator()(const f32x4 (&acc)[2][2][4][2], const Unit& u, int wr, int wc, int fr, int fq) const {}
    __device__ __forceinline__ bool chain(f32x4 (&acc)[2][2][4][2], const Unit& u, int wr, int wc, int fr, int fq) const {
        const int n = u.pm / 68, pm = u.pm - n * 68, pn = u.pn & 3;
        const int row0 = pm * BM + wr * 64 + fr; const int col0 = pn * BM + wc * 32 + 4 * fq;
#pragma unroll
        for (int ai = 0; ai < 2; ++ai)
#pragma unroll
            for (int m = 0; m < 4; ++m) { const size_t row = (size_t)(row0 + ai * HALF + m * 16);
#pragma unroll
                for (int bj = 0; bj < 2; ++bj)
#pragma unroll
                    for (int nn = 0; nn < 2; ++nn) { const int col = col0 + bj * HALF + nn * 16;
                        const bf16_t* zp = Z + row * 6912 + 3840 + n * 1024 + col;
                        const u32x2 ga = *(const u32x2*)zp;
                        const float ea0 = 1.0f + __expf(-bf_lo(ga.x)), ea1 = 1.0f + __expf(-bf_hi(ga.x)), ea2 = 1.0f + __expf(-bf_lo(ga.y)), ea3 = 1.0f + __expf(-bf_hi(ga.y));
                        f32x4 sc;
                        if (n < 2) { const u32x2 gb = *(const u32x2*)(zp + 1024);
                            sc[0] = (1.0f + __expf(-bf_lo(gb.x))) * __builtin_amdgcn_rcpf(ea0); sc[1] = (1.0f + __expf(-bf_hi(gb.x))) * __builtin_amdgcn_rcpf(ea1);
                            sc[2] = (1.0f + __expf(-bf_lo(gb.y))) * __builtin_amdgcn_rcpf(ea2); sc[3] = (1.0f + __expf(-bf_hi(gb.y))) * __builtin_amdgcn_rcpf(ea3);
                            acc[ai][bj][m][nn] = acc[ai][bj][m][nn] * sc; }
                        else { sc[0] = __builtin_amdgcn_rcpf(ea0); sc[1] = __builtin_amdgcn_rcpf(ea1); sc[2] = __builtin_amdgcn_rcpf(ea2); sc[3] = __builtin_amdgcn_rcpf(ea3);
                            const f32x4 v = acc[ai][bj][m][nn] * sc; u32x2 w; w.x = cvt_pk_bf16(v[0], v[1]); w.y = cvt_pk_bf16(v[2], v[3]); *(u32x2*)(MG + row * 1024 + col) = w; } }
                asm volatile("" ::: "memory"); }
        return n < 2;
    }
};
struct MergeOrder {
    int G, c, latonly;
    __device__ bool next(int i, Unit& u) const {
        const int ti = i / 3, n = i - ti * 3; const int L = ti * G + c; if (L >= (latonly ? 256 : 272)) return false;
        const int t = L >> 2; const int pm = latonly ? ((t >> 4) * 17 + 1 + (t & 15)) : t;
        u.pm = n * 68 + pm; u.pn = n * 4 + (L & 3); u.k0 = 0; u.nk = 0; return true;
    }
    __device__ __forceinline__ void a_ready(const Unit&) const {}
    __device__ __forceinline__ void done(const Unit&) const {}
};
struct LastLayerOrder {
    StaticOrder so; int nextra;
    __device__ void init(int N, int G, int c, int nextra_) { so.init(64 * BM, N, G, c); nextra = nextra_; }
    __device__ bool next(int i, Unit& u) const {
        if (so.next(i, u)) { const int v = u.pm; u.pm = (v >> 4) * 17 + 1 + (v & 15); return true; }
        const int L = i * so.G + so.c - so.nwg; if (L < 0 || L >= nextra) return false;
        const int t = L / 7, q = L - t * 7; u.pm = t * 17; u.pn = (q < 4) ? 2 + q : (q < 6) ? 4 + q : 14; u.k0 = 0; u.nk = 0; return true;
    }
    __device__ __forceinline__ void a_ready(const Unit&) const {}
    __device__ __forceinline__ void done(const Unit&) const {}
};
struct LatOrder {
    int G, c;
    __device__ bool next(int i, Unit& u) const {
        const int L = i * G + c; if (L >= 256) return false;
        const int t = L >> 2; u.pm = (t >> 4) * 17 + 1 + (t & 15); u.pn = L & 3; u.k0 = 0; u.nk = 0; return true;
    }
    __device__ __forceinline__ void a_ready(const Unit&) const {}
    __device__ __forceinline__ void done(const Unit&) const {}
};
struct SplitOrder {
    int G, c, nsplit, nkt;
    __device__ bool next(int i, Unit& u) const {
        int L = i * G + c;
        if (L < 256) { const int t = L >> 2; u.pm = (t >> 4) * 17 + 1 + (t & 15); u.pn = L & 3; u.k0 = 0; u.nk = 0; return true; }
        L -= 256; if (L >= 16 * nsplit) return false;
        const int t = L / nsplit, s = L - t * nsplit;
        u.pm = (t >> 2) * 17; u.pn = t & 3; u.k0 = s * nkt * 64; u.nk = nkt; return true;
    }
    __device__ __forceinline__ void a_ready(const Unit&) const {}
    __device__ __forceinline__ void done(const Unit&) const {}
};
template <int KT, class Epi, class Sched, bool ALIGN_EPI = false, bool SP2 = false>
__device__ __forceinline__ void gemm_phase(PG8_LAS unsigned char* lds, const Gemm g, const Sched& S, const Epi& E, const int tid) {
    const int wid = __builtin_amdgcn_readfirstlane(tid >> 6), lane = tid & 63, wr = wid >> 2, wc = wid & 3, fr = lane & 15, fq = lane >> 4;
    constexpr int K = KT, nt = K / BK;
    unsigned voffA[2], voffB[2];
#pragma unroll
    for (int i = 0; i < 2; ++i) { int R, C; stage_rc(tid * 16 + i * 8192, R, C); const int Rb = Epi::PERM ? ((R & ~31) + perm32(R & 31)) : R;
        voffA[i] = (unsigned)(R * K + C) * 2u; voffB[i] = (unsigned)(Rb * K + C) * 2u; }
    const size_t kstep = (size_t)(BK * 2);
    const size_t hstep = (size_t)HALF * K * 2;
    const size_t tstep = 2 * hstep;
    const unsigned ldsw = (unsigned)wid * 1024u;
    const int aoff = lds_byte(wr * 64 + fr, fq * 8), boff = lds_byte(wc * 32 + fr, fq * 8);
#define PG8_SA(b, h) (((b) * 2 + (h)) * HTB)
#define PG8_SB(b, h) ((4 + (b) * 2 + (h)) * HTB)
#define PG8_STAGE(bufoff, gbase, voff) do { _Pragma("unroll") for (int _i = 0; _i < 2; ++_i) \
        __builtin_amdgcn_global_load_lds((const unsigned*)((const char*)(gbase) + (voff)[_i]), (PG8_LAS unsigned*)(lds + (bufoff) + ldsw + _i * 8192), 16, 0, 0); } while (0)
#define PG8_LDA(dst, b, h) do { _Pragma("unroll") for (int m = 0; m < 4; ++m) _Pragma("unroll") for (int k = 0; k < 2; ++k) dst[m][k] = *(const PG8_LAS bf16x8*)(lds + PG8_SA(b, h) + aoff + m * 2048 + k * 1024); } while (0)
#define PG8_LDB(dst, b, h) do { _Pragma("unroll") for (int n = 0; n < 2; ++n) _Pragma("unroll") for (int k = 0; k < 2; ++k) dst[n][k] = *(const PG8_LAS bf16x8*)(lds + PG8_SB(b, h) + boff + n * 2048 + k * 1024); } while (0)
#define PG8_MMA(ai, bj, At, Bt) do { __builtin_amdgcn_s_setprio(1); _Pragma("unroll") for (int m = 0; m < 4; ++m) _Pragma("unroll") for (int n = 0; n < 2; ++n) _Pragma("unroll") for (int k = 0; k < 2; ++k) \
        acc[ai][bj][m][n] = __builtin_amdgcn_mfma_f32_16x16x32_bf16(Bt[n][k], At[m][k], acc[ai][bj][m][n], 0, 0, 0); __builtin_amdgcn_s_setprio(0); } while (0)
#define PG8_WAIT_V(n) asm volatile("s_waitcnt vmcnt(" #n ")" ::: "memory")
#define PG8_WAIT_L(n) asm volatile("s_waitcnt lgkmcnt(" #n ")" ::: "memory")
#define PG8_BAR __builtin_amdgcn_s_barrier()
#define PG8_SCHED __builtin_amdgcn_sched_barrier(0)
    Unit cur{0, 0, 0, 0}, nxt{0, 0, 0, 0}; int ui = 0;
    if (!S.next(0, cur)) return;
    f32x4 acc[2][2][4][2];
#pragma unroll
    for (int a = 0; a < 2; ++a)
#pragma unroll
        for (int b = 0; b < 2; ++b)
#pragma unroll
            for (int m = 0; m < 4; ++m)
#pragma unroll
                for (int n = 0; n < 2; ++n) acc[a][b][m][n] = (f32x4){0.f, 0.f, 0.f, 0.f};
    bf16x8 At[4][2], B0[2][2], B1[2][2];
    const char* cA = (const char*)g.A + (size_t)cur.pm * tstep + (size_t)cur.k0 * 2; const char* cB = (const char*)g.Bt + (size_t)cur.pn * tstep + (size_t)cur.k0 * 2;
    S.a_ready(cur);
    if constexpr (SP2) {
        PG8_STAGE(PG8_SB(0, 0), cB, voffB); PG8_STAGE(PG8_SB(0, 1), cB + hstep, voffB); PG8_STAGE(PG8_SA(0, 0), cA, voffA); PG8_STAGE(PG8_SA(0, 1), cA + hstep, voffA);
        if (wr == 1) PG8_BAR;
        PG8_WAIT_V(2); PG8_BAR;
        PG8_STAGE(PG8_SB(1, 0), cB + kstep, voffB); PG8_STAGE(PG8_SA(1, 0), cA + kstep, voffA); PG8_STAGE(PG8_SB(1, 1), cB + hstep + kstep, voffB);
        PG8_WAIT_V(6); PG8_BAR;
    } else {
        PG8_STAGE(PG8_SB(0, 0), cB, voffB); PG8_STAGE(PG8_SA(0, 0), cA, voffA); PG8_STAGE(PG8_SB(0, 1), cB + hstep, voffB); PG8_STAGE(PG8_SA(0, 1), cA + hstep, voffA);
        if (wr == 1) PG8_BAR;
        PG8_WAIT_V(4); PG8_BAR;
        PG8_STAGE(PG8_SB(1, 0), cB + kstep, voffB); PG8_STAGE(PG8_SA(1, 0), cA + kstep, voffA); PG8_STAGE(PG8_SB(1, 1), cB + hstep + kstep, voffB);
        PG8_WAIT_V(6); PG8_BAR;
    }
    for (;;) {
        const bool has_next = S.next(ui + 1, nxt);
        const char* nA = has_next ? (const char*)g.A + (size_t)nxt.pm * tstep + (size_t)nxt.k0 * 2 : cA; const char* nB = has_next ? (const char*)g.Bt + (size_t)nxt.pn * tstep + (size_t)nxt.k0 * 2 : cB;
        const int ntu = cur.nk ? cur.nk : nt;
        for (int t = 0; t < ntu; t += 2) {
            const bool last = (t == ntu - 2);
            const char* a1 = cA + (size_t)(t + 1) * kstep;
            const char* a2 = last ? nA : cA + (size_t)(t + 2) * kstep; const char* b2 = last ? nB : cB + (size_t)(t + 2) * kstep;
            const char* a3 = a2 + kstep; const char* b3 = b2 + kstep;
            if (last && has_next) S.a_ready(nxt);
            if constexpr (SP2) {
            PG8_LDB(B0, 0, 0); PG8_LDB(B1, 0, 1); PG8_SCHED; PG8_LDA(At, 0, 0); PG8_STAGE(PG8_SA(1, 1), a1 + hstep, voffA);
            PG8_WAIT_V(8); PG8_WAIT_L(0); PG8_BAR; PG8_MMA(0, 0, At, B0); PG8_MMA(0, 1, At, B1); PG8_BAR; PG8_SCHED;
            PG8_LDA(At, 0, 1); PG8_STAGE(PG8_SB(0, 0), b2, voffB); PG8_STAGE(PG8_SB(0, 1), b2 + hstep, voffB); PG8_STAGE(PG8_SA(0, 0), a2, voffA);
            PG8_WAIT_V(8); PG8_WAIT_L(0); PG8_BAR; PG8_MMA(1, 0, At, B0); PG8_MMA(1, 1, At, B1); PG8_BAR; PG8_SCHED;
            PG8_LDB(B0, 1, 0); PG8_LDB(B1, 1, 1); PG8_SCHED; PG8_LDA(At, 1, 0); PG8_STAGE(PG8_SA(0, 1), a2 + hstep, voffA);
            PG8_WAIT_V(8); PG8_WAIT_L(0); PG8_BAR; PG8_MMA(0, 0, At, B0); PG8_MMA(0, 1, At, B1); PG8_BAR; PG8_SCHED;
            PG8_LDA(At, 1, 1); PG8_STAGE(PG8_SB(1, 0), b3, voffB); PG8_STAGE(PG8_SB(1, 1), b3 + hstep, voffB); PG8_STAGE(PG8_SA(1, 0), a3, voffA);
            PG8_WAIT_V(8); PG8_WAIT_L(0); PG8_BAR; PG8_MMA(1, 0, At, B0); PG8_MMA(1, 1, At, B1); PG8_BAR; PG8_SCHED;
            } else {
            PG8_LDB(B0, 0, 0); PG8_SCHED; PG8_LDA(At, 0, 0); PG8_STAGE(PG8_SA(1, 1), a1 + hstep, voffA);
            PG8_WAIT_L(8); PG8_BAR; PG8_WAIT_L(0); PG8_MMA(0, 0, At, B0); PG8_BAR; PG8_SCHED;
            PG8_LDB(B1, 0, 1); PG8_STAGE(PG8_SB(0, 0), b2, voffB);
            PG8_BAR; PG8_WAIT_L(0); PG8_MMA(0, 1, At, B1); PG8_BAR;
            PG8_LDA(At, 0, 1); PG8_STAGE(PG8_SA(0, 0), a2, voffA);
            PG8_BAR; PG8_WAIT_L(0); PG8_MMA(1, 0, At, B0); PG8_BAR; PG8_SCHED;
            PG8_STAGE(PG8_SB(0, 1), b2 + hstep, voffB);
            PG8_WAIT_V(6); PG8_BAR; PG8_MMA(1, 1, At, B1); PG8_BAR;
            PG8_LDB(B0, 1, 0); PG8_SCHED; PG8_LDA(At, 1, 0); PG8_STAGE(PG8_SA(0, 1), a2 + hstep, voffA);
            PG8_WAIT_L(8); PG8_BAR; PG8_WAIT_L(0); PG8_MMA(0, 0, At, B0); PG8_BAR; PG8_SCHED;
            PG8_LDB(B1, 1, 1); PG8_STAGE(PG8_SB(1, 0), b3, voffB);
            PG8_BAR; PG8_WAIT_L(0); PG8_MMA(0, 1, At, B1); PG8_BAR;
            PG8_LDA(At, 1, 1); PG8_STAGE(PG8_SA(1, 0), a3, voffA);
            PG8_BAR; PG8_WAIT_L(0); PG8_MMA(1, 0, At, B0); PG8_BAR; PG8_SCHED;
            PG8_STAGE(PG8_SB(1, 1), b3 + hstep, voffB);
            PG8_WAIT_V(6); PG8_BAR; PG8_MMA(1, 1, At, B1); PG8_BAR;
            }
        }
        if constexpr (ALIGN_EPI) { if (wr == 0) PG8_BAR; }
        bool keep_acc = false;
        if constexpr (!Epi::AFTER_DRAIN) { if constexpr (Epi::CHAIN) keep_acc = E.chain(acc, cur, wr, wc, fr, fq); else E(acc, cur, wr, wc, fr, fq); S.done(cur); }
        if (!has_next) break;
        if (!keep_acc) {
#pragma unroll
        for (int a = 0; a < 2; ++a)
#pragma unroll
            for (int b = 0; b < 2; ++b)
#pragma unroll
                for (int m = 0; m < 4; ++m)
#pragma unroll
                    for (int n = 0; n < 2; ++n) acc[a][b][m][n] = (f32x4){0.f, 0.f, 0.f, 0.f};
        }
        cur = nxt; cA = nA; cB = nB; ++ui;
        if constexpr (ALIGN_EPI) { if (wr == 1) PG8_BAR; }
    }
    PG8_WAIT_V(0);
    if constexpr (!ALIGN_EPI) { if (wr == 0) PG8_BAR; }
    PG8_BAR;
    if constexpr (Epi::AFTER_DRAIN) { E.fused(acc, cur, wr, wc, fr, fq, lds, wid, lane); S.done(cur); }
#undef PG8_SA
#undef PG8_SB
#undef PG8_STAGE
#undef PG8_LDA
#undef PG8_LDB
#undef PG8_MMA
#undef PG8_WAIT_V
#undef PG8_WAIT_L
#undef PG8_BAR
#undef PG8_SCHED
}
}
namespace attn_body {
using bf16=__hip_bfloat16;
using bf16x8=__attribute__((ext_vector_type(8)))short;
using s16x4=__attribute__((ext_vector_type(4)))short;
using f32x16=__attribute__((ext_vector_type(16)))float;
using u32x4=__attribute__((ext_vector_type(4)))unsigned;
constexpr int D=64,QP=512,KP=128,VP=6912,OP=512;
constexpr int NW=8,QBLK=32,QB=QBLK*NW,KVBLK=64;
__device__ __forceinline__ int crow(int r,int hi){return (r&3)+8*(r>>2)+4*hi;}
#define SBAR() __builtin_amdgcn_sched_barrier(0)
constexpr int NSLOT=3, SLOTB=8192;
constexpr int LDS_K=0, LDS_V=NSLOT*SLOTB, LDS_WS=2*NSLOT*SLOTB, LDS_OST=LDS_WS+NW*64*4, LDS_BYTES=LDS_OST+NW*4096;
constexpr float C2=0.125f*1.4426950408889634f;
__device__ __forceinline__ void glds16(const void*gsrc,unsigned lds_dst){unsigned keep;
  asm volatile("s_mov_b32 %0, m0\n\ts_mov_b32 m0, %2\n\ts_nop 0\n\tglobal_load_lds_dwordx4 %1, off\n\ts_mov_b32 m0, %0":"=&s"(keep):"v"(gsrc),"s"(lds_dst):"memory");}
__device__ __forceinline__ float max3f(float a,float b,float c){float r;asm("v_max3_f32 %0, %1, %2, %3":"=v"(r):"v"(a),"v"(b),"v"(c));return r;}
__device__ __forceinline__ float max2f(float a,float b){float r;asm("v_max_f32_e32 %0, %1, %2":"=v"(r):"v"(a),"v"(b));return r;}
__device__ __forceinline__ float fadd_s(float a,float b){float r;asm("v_add_f32_e32 %0, %1, %2":"=v"(r):"v"(a),"v"(b));return r;}
__device__ __forceinline__ float fsub_s(float a,float b){float r;asm("v_sub_f32_e32 %0, %1, %2":"=v"(r):"v"(a),"v"(b));return r;}
typedef float f32x2_t __attribute__((ext_vector_type(2))); typedef __bf16 bf16x2_t __attribute__((ext_vector_type(2)));
__device__ __forceinline__ unsigned cvtpk_s(float lo,float hi){f32x2_t v={lo,hi};bf16x2_t b=__builtin_convertvector(v,bf16x2_t);return __builtin_bit_cast(unsigned,b);}
#define WAIT_BAR(N) asm volatile("s_waitcnt vmcnt(" #N ") lgkmcnt(0)\n\ts_barrier":::"memory")

__device__ __forceinline__ void qkt(f32x16&p0,f32x16&p1,const char*Kslot,const bf16x8*qr,const f32x16&negm,int r32,int hi){
  const char*kb=Kslot+hi*1024+r32*16;
  #pragma unroll
  for(int d0=0;d0<4;++d0){
    const bf16x8 b0=*reinterpret_cast<const bf16x8*>(kb+d0*2048);
    const bf16x8 b1=*reinterpret_cast<const bf16x8*>(kb+d0*2048+512);
    if(d0==0){p0=__builtin_amdgcn_mfma_f32_32x32x16_bf16(b0,qr[0],negm,0,0,0);p1=__builtin_amdgcn_mfma_f32_32x32x16_bf16(b1,qr[0],negm,0,0,0);}
    else{p0=__builtin_amdgcn_mfma_f32_32x32x16_bf16(b0,qr[d0],p0,0,0,0);p1=__builtin_amdgcn_mfma_f32_32x32x16_bf16(b1,qr[d0],p1,0,0,0);}}
}
typedef __attribute__((address_space(3))) const char* lds_cptr;
typedef short v4i16_t __attribute__((ext_vector_type(4)));
__device__ __forceinline__ void kload8(bf16x8*kf,lds_cptr kp){
  kf[0]=*(const __attribute__((address_space(3))) bf16x8*)(kp);      kf[1]=*(const __attribute__((address_space(3))) bf16x8*)(kp+512);
  kf[2]=*(const __attribute__((address_space(3))) bf16x8*)(kp+2048); kf[3]=*(const __attribute__((address_space(3))) bf16x8*)(kp+2560);
  kf[4]=*(const __attribute__((address_space(3))) bf16x8*)(kp+4096); kf[5]=*(const __attribute__((address_space(3))) bf16x8*)(kp+4608);
  kf[6]=*(const __attribute__((address_space(3))) bf16x8*)(kp+6144); kf[7]=*(const __attribute__((address_space(3))) bf16x8*)(kp+6656);
}
__device__ __forceinline__ void kload2(bf16x8*kf,lds_cptr kp,int j){ kf[2*j]=*(const __attribute__((address_space(3))) bf16x8*)(kp+j*2048); kf[2*j+1]=*(const __attribute__((address_space(3))) bf16x8*)(kp+j*2048+512); }
__device__ __forceinline__ s16x4 vtr(lds_cptr p){ return __builtin_bit_cast(s16x4,__builtin_amdgcn_ds_read_tr16_b64_v4i16((__attribute__((address_space(3))) v4i16_t*)p)); }
__device__ __forceinline__ float rowmax(const f32x16&p0,const f32x16&p1){
  float a=max3f(p0[0],p0[1],p1[0]),b=max3f(p0[2],p0[3],p1[1]);a=max3f(a,p1[2],p1[3]);
  #pragma unroll
  for(int r=4;r<16;r+=4){a=max3f(a,p0[r],p0[r+1]);b=max3f(b,p0[r+2],p0[r+3]);a=max3f(a,p1[r],p1[r+1]);b=max3f(b,p1[r+2],p1[r+3]);}
  const float m=max2f(a,b);
  auto rr=__builtin_amdgcn_permlane32_swap(__float_as_uint(m),__float_as_uint(m),false,false);
  return max2f(__uint_as_float(rr[0]),__uint_as_float(rr[1]));
}
__device__ __forceinline__ void pv(f32x16*o,int vb,bf16x8 pa0,bf16x8 pa1,bf16x8 pa2,bf16x8 pa3){
  #pragma unroll
  for(int d0=0;d0<2;++d0){s16x4 lo[4],hi[4];
    #pragma unroll
    for(int ks=0;ks<4;++ks){
      asm volatile("ds_read_b64_tr_b16 %0,%1 offset:%c2":"=&v"(lo[ks]):"v"(vb),"i"(d0*4096+ks*1024):"memory");
      asm volatile("ds_read_b64_tr_b16 %0,%1 offset:%c2":"=&v"(hi[ks]):"v"(vb),"i"(d0*4096+ks*1024+512):"memory");}
    asm volatile("s_waitcnt lgkmcnt(0)":::"memory");SBAR();
    #define PK(k) (bf16x8){lo[k][0],lo[k][1],lo[k][2],lo[k][3],hi[k][0],hi[k][1],hi[k][2],hi[k][3]}
    o[d0]=__builtin_amdgcn_mfma_f32_32x32x16_bf16(pa0,PK(0),o[d0],0,0,0);
    o[d0]=__builtin_amdgcn_mfma_f32_32x32x16_bf16(pa1,PK(1),o[d0],0,0,0);
    o[d0]=__builtin_amdgcn_mfma_f32_32x32x16_bf16(pa2,PK(2),o[d0],0,0,0);
    o[d0]=__builtin_amdgcn_mfma_f32_32x32x16_bf16(pa3,PK(3),o[d0],0,0,0);
    #undef PK
  }
}

#ifndef ATTN_STORE16
#define ATTN_STORE16(p,v) (*(u32x4*)(p)=(v))
#endif
template<int THRL> __device__ __forceinline__ void attn_unit(long qrow0,long kvrow0,int hq,int kvh,int NT,const bf16*Q,const bf16*__restrict__ K,const bf16*__restrict__ V,bf16*O,char*shm,const int tid,const float*gqp,const float*rbp,long tq){
  const int lane=tid&63,r32=lane&31,hi=lane>>5; const int wid=__builtin_amdgcn_readfirstlane(tid>>6);
  const bf16*Qw=Q+(qrow0+wid*QBLK)*QP+hq*D;
  const bf16*Kh=K+kvrow0*KP+kvh*D,*Vh=V+kvrow0*VP+kvh*D;
  const unsigned lds0=(unsigned)(uintptr_t)shm;
  float*wsf=(float*)(shm+LDS_WS)+wid*64;
  const bf16*ksrc=Kh+(long)lane*KP+wid*8;
  const bf16*vsrc=Vh+(long)(16*(wid&3)+(lane>>2))*VP+(wid>>2)*32+(lane&3)*8;
  const unsigned kdst=lds0+LDS_K+wid*1024, vdst=lds0+LDS_V+wid*1024;
  #define DMA_K(t,slot) glds16(ksrc+(long)(t)*KVBLK*KP,(unsigned)__builtin_amdgcn_readfirstlane(kdst+(slot)))
  #define DMA_V(t,slot) glds16(vsrc+(long)(t)*KVBLK*VP,(unsigned)__builtin_amdgcn_readfirstlane(vdst+(slot)))
  const int vb0=(int)(lds0+LDS_V)+((lane>>4)&1)*32+(lane&3)*8+(4*hi+((lane&15)>>2))*64;
  const char*Kbase=shm+LDS_K; bf16x8 kf[8];
  const lds_cptr shm3=(lds_cptr)shm; const lds_cptr kp0=shm3+LDS_K+hi*1024+r32*16; const lds_cptr vp0=shm3+LDS_V+((lane>>4)&1)*32+(lane&3)*8+(4*hi+((lane&15)>>2))*64;
  DMA_K(0,0);DMA_V(0,0);DMA_K(1,SLOTB);
  bf16x8 qr[4];
  { const bf16*Zq=Q+(qrow0+wid*QBLK+r32)*(long)VP+hq*D; float f[4][8]; float ss=0.f;
    #pragma unroll
    for(int d0=0;d0<4;++d0){ const bf16x8 raw=*reinterpret_cast<const bf16x8*>(Zq+d0*16+hi*8);
      #pragma unroll
      for(int j=0;j<8;++j){ f[d0][j]=__uint_as_float(((unsigned)(unsigned short)raw[j])<<16); ss+=f[d0][j]*f[d0][j]; } }
    { auto rr=__builtin_amdgcn_permlane32_swap(__float_as_uint(ss),__float_as_uint(ss),false,false); ss=__uint_as_float(rr[0])+__uint_as_float(rr[1]); }
    const float rstd=__builtin_amdgcn_rsqf(ss*(1.0f/64.0f)+1e-6f);
    #pragma unroll
    for(int d0=0;d0<4;++d0){ const float*gp=gqp+d0*16+hi*8;
      #pragma unroll
      for(int j=0;j<8;++j) f[d0][j]*=rstd*gp[j]; }
    if(tq>=0){ const long t=tq+wid*QBLK+r32; const int prow=(int)(t>>6), pcol=(int)(t&63);
      const float*tr=rbp+(prow*16+hi*8)*2; const float*tc=rbp+(pcol*16+hi*8)*2;
      #pragma unroll
      for(int j=0;j<8;++j){ const float cs=tr[2*j],sn=tr[2*j+1]; const float x1=f[0][j],x2=f[1][j]; f[0][j]=x1*cs-x2*sn; f[1][j]=x1*sn+x2*cs;
                            const float cc=tc[2*j],sc=tc[2*j+1]; const float y1=f[2][j],y2=f[3][j]; f[2][j]=y1*cc-y2*sc; f[3][j]=y1*sc+y2*cc; } }
    #pragma unroll
    for(int d0=0;d0<4;++d0){ u32x4 w; w.x=cvtpk_s(f[d0][0]*C2,f[d0][1]*C2); w.y=cvtpk_s(f[d0][2]*C2,f[d0][3]*C2); w.z=cvtpk_s(f[d0][4]*C2,f[d0][5]*C2); w.w=cvtpk_s(f[d0][6]*C2,f[d0][7]*C2);
      qr[d0]=__builtin_bit_cast(bf16x8,w); } }
  float mhat=0.f,l_reg=0.f;float z0_=0.f;asm volatile("":"+v"(z0_));f32x16 o[2];f32x16 negm;
  #pragma unroll
  for(int r=0;r<16;++r){o[0][r]=z0_;o[1][r]=z0_;negm[r]=z0_;}
  asm volatile("":"+v"(negm));
  #define CMASK(P0,P1,t) do{}while(0)
  bool resc=false;
  #define START(P0,P1) do{ const float rm=rowmax(P0,P1); resc=false; \
    { const float dl=rm; mhat=fadd_s(mhat,dl); \
      _Pragma("unroll") for(int r=0;r<16;++r){P0[r]=fsub_s(P0[r],dl);P1[r]=fsub_s(P1[r],dl);} \
      _Pragma("unroll") for(int r=0;r<16;++r)negm[r]=-mhat; asm volatile("":"+v"(negm)); } \
    _Pragma("unroll") for(int r=0;r<16;++r)P0[r]=__builtin_amdgcn_exp2f(P0[r]); }while(0)
  #define RESC() do{ if(resc){ asm volatile("s_waitcnt lgkmcnt(0)":::"memory"); \
      _Pragma("unroll") for(int d_=0;d_<2;++d_) _Pragma("unroll") for(int r=0;r<16;++r)o[d_][r]*=wsf[crow(r,hi)]; } }while(0)
  f32x16 pA0,pA1,pB0,pB1;
  int sl_prev=0,sl_cur=0,sl_next=SLOTB;
  #define ROT() do{sl_prev=sl_cur;sl_cur=sl_next;sl_next=(sl_next==(NSLOT-1)*SLOTB)?0:sl_next+SLOTB;}while(0)
  DMA_K(2,2*SLOTB);
  WAIT_BAR(3);
  qkt(pA0,pA1,Kbase,qr,negm,r32,hi);asm volatile("s_nop 15\n\ts_nop 7":"+v"(pA0),"+v"(pA1));CMASK(pA0,pA1,0);
  START(pA0,pA1);
  _Pragma("unroll") for(int r=0;r<16;++r)pA1[r]=__builtin_amdgcn_exp2f(pA1[r]);
  WAIT_BAR(0);
  DMA_K(3,0);DMA_V(1,SLOTB);
  ROT();
  kload8(kf,kp0+sl_cur);
  WAIT_BAR(2);
  s16x4 vlo[8],vhi[8]; u32x4 pw0,pw1,pw2,pw3;
  #define PKW(P,B) cvtpk_s(P[B],P[B+1])
  #define PAF(k) __builtin_bit_cast(bf16x8,pw##k)
  #define VFR(i) (bf16x8){vlo[i][0],vlo[i][1],vlo[i][2],vlo[i][3],vhi[i][0],vhi[i][1],vhi[i][2],vhi[i][3]}
  #define PIN(x) asm volatile("":"+v"(x))
  #define MX3(a,b,c) __builtin_fmaxf(__builtin_fmaxf((a),(b)),(c))
  #define GAPA(MF,A0,A1,A2,A3,W0,W1,PW) do{ MF; sacc+=A0; sacc+=A1; sacc+=A2; sacc+=A3; PIN(sacc); W0; W1; PIN(PW); SBAR(); }while(0)
  #define EX(v) __builtin_amdgcn_exp2f(v)
  #define GAPB(MF,X,B) do{ MF; X[B]=EX(X[B]); X[B+1]=EX(X[B+1]); X[B+2]=EX(X[B+2]); X[B+3]=EX(X[B+3]); PIN(X); SBAR(); }while(0)
  #define VRD(i) do{ vlo[i]=vtr(vp_+(((i)>>2)*4096+((i)&3)*1024)); vhi[i]=vtr(vp_+(((i)>>2)*4096+((i)&3)*1024+512)); }while(0)
  #define KRD(G,j) do{ if(G){ kload2(kf,kp0+sl_next,j); SBAR(); } }while(0)
  #define STEP(C0,C1,P0,P1,t,GK,GV,GL) do{ SBAR(); \
    const lds_cptr vp_=vp0+sl_prev; \
    VRD(0); SBAR(); float sacc=(P0[0]+P0[1]); \
    GAPA(C0=__builtin_amdgcn_mfma_f32_32x32x16_bf16(kf[0],qr[0],negm,0,0,0), P0[2],P0[3],P0[4],P0[5],     pw0[0]=PKW(P0,0), pw0[1]=PKW(P0,2), pw0); \
    VRD(4); SBAR(); GAPA(C1=__builtin_amdgcn_mfma_f32_32x32x16_bf16(kf[1],qr[0],negm,0,0,0), P0[6],P0[7],P0[8],P0[9],     pw0[2]=PKW(P0,4), pw0[3]=PKW(P0,6), pw0); \
    VRD(1); SBAR(); GAPA(C0=__builtin_amdgcn_mfma_f32_32x32x16_bf16(kf[2],qr[1],C0,0,0,0),   P0[10],P0[11],P0[12],P0[13], pw1[0]=PKW(P0,8), pw1[1]=PKW(P0,10), pw1); \
    VRD(5); SBAR(); GAPA(C1=__builtin_amdgcn_mfma_f32_32x32x16_bf16(kf[3],qr[1],C1,0,0,0),   P0[14],P0[15],P1[0],P1[1],   pw1[2]=PKW(P0,12),pw1[3]=PKW(P0,14), pw1); \
    VRD(2); SBAR(); GAPA(C0=__builtin_amdgcn_mfma_f32_32x32x16_bf16(kf[4],qr[2],C0,0,0,0),   P1[2],P1[3],P1[4],P1[5],     pw2[0]=PKW(P1,0), pw2[1]=PKW(P1,2), pw2); \
    VRD(6); SBAR(); GAPA(C1=__builtin_amdgcn_mfma_f32_32x32x16_bf16(kf[5],qr[2],C1,0,0,0),   P1[6],P1[7],P1[8],P1[9],     pw2[2]=PKW(P1,4), pw2[3]=PKW(P1,6), pw2); \
    VRD(3); SBAR(); GAPA(C0=__builtin_amdgcn_mfma_f32_32x32x16_bf16(kf[6],qr[3],C0,0,0,0),   P1[10],P1[11],P1[12],P1[13], pw3[0]=PKW(P1,8), pw3[1]=PKW(P1,10), pw3); \
    VRD(7); SBAR(); GAPA(C1=__builtin_amdgcn_mfma_f32_32x32x16_bf16(kf[7],qr[3],C1,0,0,0),   P1[14],P1[15],0.f,0.f,       pw3[2]=PKW(P1,12),pw3[3]=PKW(P1,14), pw3); \
    l_reg+=sacc; \
    if(GK){DMA_K((t)+3,sl_cur);} if(GV){DMA_V((t)+1,sl_next);} \
    CMASK(C0,C1,t); \
    { float a=MX3(C0[0],C0[1],C1[0]),b=MX3(C0[2],C0[3],C1[1]); a=MX3(a,C1[2],C1[3]); \
      _Pragma("unroll") for(int r=4;r<16;r+=4){a=MX3(a,C0[r],C0[r+1]);b=MX3(b,C0[r+2],C0[r+3]);a=MX3(a,C1[r],C1[r+1]);b=MX3(b,C1[r+2],C1[r+3]);} \
      float rm=__builtin_fmaxf(a,b); { auto rr=__builtin_amdgcn_permlane32_swap(__float_as_uint(rm),__float_as_uint(rm),false,false); rm=__builtin_fmaxf(__uint_as_float(rr[0]),__uint_as_float(rr[1])); } \
      resc=false; \
      if(__builtin_expect(__any(rm>(float)THRL),0)){ const float dl=__builtin_fmaxf(rm,0.f); mhat+=dl; \
        _Pragma("unroll") for(int r=0;r<16;++r){C0[r]-=dl;C1[r]-=dl;} \
        _Pragma("unroll") for(int r=0;r<16;++r)negm[r]=-mhat; asm volatile("":"+v"(negm)); \
        const float f=__builtin_amdgcn_exp2f(-dl); l_reg*=f; if(hi==0)wsf[r32]=f; resc=true; } } \
    SBAR(); \
    GAPB(o[0]=__builtin_amdgcn_mfma_f32_32x32x16_bf16(PAF(0),VFR(0),o[0],0,0,0), C0,0); \
    GAPB(o[1]=__builtin_amdgcn_mfma_f32_32x32x16_bf16(PAF(0),VFR(4),o[1],0,0,0), C0,4); \
    KRD(GL,0); GAPB(o[0]=__builtin_amdgcn_mfma_f32_32x32x16_bf16(PAF(1),VFR(1),o[0],0,0,0), C0,8); \
    KRD(GL,1); GAPB(o[1]=__builtin_amdgcn_mfma_f32_32x32x16_bf16(PAF(1),VFR(5),o[1],0,0,0), C0,12); \
    KRD(GL,2); GAPB(o[0]=__builtin_amdgcn_mfma_f32_32x32x16_bf16(PAF(2),VFR(2),o[0],0,0,0), C1,0); \
    KRD(GL,3); GAPB(o[1]=__builtin_amdgcn_mfma_f32_32x32x16_bf16(PAF(2),VFR(6),o[1],0,0,0), C1,4); \
    GAPB(o[0]=__builtin_amdgcn_mfma_f32_32x32x16_bf16(PAF(3),VFR(3),o[0],0,0,0), C1,8); \
    GAPB(o[1]=__builtin_amdgcn_mfma_f32_32x32x16_bf16(PAF(3),VFR(7),o[1],0,0,0), C1,12); \
    }while(0)
  int t=1;
  #undef CMASK
  #define CMASK(P0,P1,t) do{}while(0)
  for(;t+5<NT;t+=2){
    STEP(pB0,pB1,pA0,pA1,t,true,true,true);     WAIT_BAR(2); RESC(); ROT();
    STEP(pA0,pA1,pB0,pB1,t+1,true,true,true);   WAIT_BAR(2); RESC(); ROT();
  }
  #undef CMASK
  #define CMASK(P0,P1,t) do{}while(0)
  #define ENDW(tt) do{ if((tt)+3<NT){WAIT_BAR(2);} else if((tt)+2<NT){WAIT_BAR(1);} else {WAIT_BAR(0);} }while(0)
  for(;t+1<NT;t+=2){
    STEP(pB0,pB1,pA0,pA1,t,(t+3<NT),(t+1<NT),(t+1<NT));       ENDW(t);   RESC(); ROT();
    STEP(pA0,pA1,pB0,pB1,t+1,(t+4<NT),(t+2<NT),(t+2<NT));     ENDW(t+1); RESC(); ROT();
  }
  STEP(pB0,pB1,pA0,pA1,NT-1,false,false,false); RESC();
  { float sacc=pB0[0]+pB0[1]; _Pragma("unroll") for(int r=2;r<16;++r)sacc+=pB0[r]; _Pragma("unroll") for(int r=0;r<16;++r)sacc+=pB1[r]; l_reg+=sacc;
    pw0=(u32x4){PKW(pB0,0),PKW(pB0,2),PKW(pB0,4),PKW(pB0,6)};pw1=(u32x4){PKW(pB0,8),PKW(pB0,10),PKW(pB0,12),PKW(pB0,14)};pw2=(u32x4){PKW(pB1,0),PKW(pB1,2),PKW(pB1,4),PKW(pB1,6)};pw3=(u32x4){PKW(pB1,8),PKW(pB1,10),PKW(pB1,12),PKW(pB1,14)};
    SBAR(); pv(o,vb0+sl_cur,PAF(0),PAF(1),PAF(2),PAF(3)); }
  #undef PKW
  #undef PAF
  #undef VFR
  #undef PIN
  #undef MX3
  #undef GAPA
  #undef GAPB
  #undef EX
  #undef VRD
  #undef KRD
  #undef STEP
  #undef ENDW
  {auto rr=__builtin_amdgcn_permlane32_swap(__float_as_uint(l_reg),__float_as_uint(l_reg),false,false);l_reg=__uint_as_float(rr[0])+__uint_as_float(rr[1]);}
  if(hi==0)wsf[32+r32]=l_reg;asm volatile("s_waitcnt lgkmcnt(0)":::"memory");
  float rli[16];
  #pragma unroll
  for(int r=0;r<16;++r)rli[r]=__builtin_amdgcn_rcpf(wsf[32+crow(r,hi)]);
  bf16*Ow=O+(qrow0+wid*QBLK)*OP+hq*D;
  { bf16*stg=(bf16*)(shm+LDS_OST)+wid*2048;
    #pragma unroll
    for(int r=0;r<16;++r){const int orow=crow(r,hi);
      #pragma unroll
      for(int d0=0;d0<2;++d0)stg[orow*64+d0*32+r32]=__float2bfloat16(o[d0][r]*rli[r]);}
    asm volatile("s_waitcnt lgkmcnt(0)":::"memory");
    #pragma unroll
    for(int i=0;i<4;++i){const int row=i*8+(lane>>3),ch=lane&7; const u32x4 v=*(const u32x4*)(stg+row*64+ch*8); ATTN_STORE16(Ow+(long)row*OP+ch*8,v);} }
  asm volatile("s_waitcnt lgkmcnt(0)\n\ts_barrier":::"memory");
  #undef DMA_K
  #undef DMA_V
  #undef CMASK
  #undef START
  #undef RESC
  #undef ROT
}
constexpr int ATTN_LDS_BYTES=LDS_BYTES;
#undef SBAR
#undef WAIT_BAR
}
#define LAS __attribute__((address_space(3)))
typedef unsigned short bf16;
typedef unsigned v4u __attribute__((ext_vector_type(4)));
typedef unsigned v2u __attribute__((ext_vector_type(2)));
typedef float f32x4 __attribute__((ext_vector_type(4)));
typedef short bf16x8 __attribute__((ext_vector_type(8)));
constexpr int NWAVES = 8;
constexpr int NB = 4, LAT = 4096, LCTX = 256, SROW = 4352, MTOK = 17408, DMODEL = 1024, DEPTH = 4, DFF = 2816, DIN = 6912, MODW = 9216;
constexpr int ZC_RQ = 0, ZC_RK = 512, ZC_RV = 1024, ZC_RG = 1536, ZC_LX = 2048, ZC_LZ = 2560, ZC_AQ = 3072, ZC_AK = 3584, ZC_AV = 3712, ZC_GT = 3840;
constexpr float NORM_EPS = 1e-6f;
constexpr size_t MiB = 1u << 20;
constexpr size_t WS_MOD = 1 * MiB, WS_ROPE = 2 * MiB, WS_SUMM = 3 * MiB, WS_HIN = 6 * MiB;
constexpr size_t WS_WSET = 54 * MiB;
constexpr size_t WS_WFI = 8 * MiB;
constexpr size_t WS_WFO = 30 * MiB;
constexpr size_t WS_WIN = 41 * MiB;
constexpr size_t WS_WB = 55 * MiB;
constexpr size_t WS_WO = 58 * MiB;
constexpr size_t WS_LRUW = 60 * MiB;
constexpr size_t WS_X = 116 * MiB;
constexpr size_t WS_HN = 184 * MiB;
constexpr size_t WS_Z = 218 * MiB;
constexpr size_t WS_QN = 448 * MiB;
constexpr size_t WS_KN = 465 * MiB;
constexpr size_t WS_Y = 470 * MiB;
constexpr size_t WS_U = 521 * MiB;
constexpr size_t WS_SIN = 589 * MiB;
constexpr size_t WS_PARTC = 624 * MiB;
constexpr size_t WS_END = 670 * MiB;
constexpr int LDS_BYTES = 147456;

__device__ __forceinline__ unsigned f2bf(float f) { unsigned u = __builtin_bit_cast(unsigned, f); return (u + 0x7fffu + ((u >> 16) & 1u)) >> 16; }
__device__ __forceinline__ unsigned pk2(float lo, float hi) { return f2bf(lo) | (f2bf(hi) << 16); }
__device__ __forceinline__ float bflo(unsigned w) { return __uint_as_float(w << 16); }
__device__ __forceinline__ float bfhi(unsigned w) { return __uint_as_float(w & 0xffff0000u); }
__device__ __forceinline__ float bf1(bf16 h) { return __uint_as_float(((unsigned)h) << 16); }
__device__ __forceinline__ void unpack8(const v4u w, float* f) { f[0] = bflo(w.x); f[1] = bfhi(w.x); f[2] = bflo(w.y); f[3] = bfhi(w.y); f[4] = bflo(w.z); f[5] = bfhi(w.z); f[6] = bflo(w.w); f[7] = bfhi(w.w); }
__device__ __forceinline__ float sigmoidf_(float v) { return __builtin_amdgcn_rcpf(1.0f + __expf(-v)); }
__device__ __forceinline__ float shx(float v, int m, int lane) { return __builtin_bit_cast(float, __builtin_amdgcn_ds_bpermute((lane ^ m) << 2, __builtin_bit_cast(int, v))); }
__device__ __forceinline__ float shi(float v, int src) { return __builtin_bit_cast(float, __builtin_amdgcn_ds_bpermute(src << 2, __builtin_bit_cast(int, v))); }
__device__ __forceinline__ float wave_sum(float v, int lane) {
#pragma unroll
    for (int o = 1; o < 64; o <<= 1) v += shx(v, o, lane);
    return v;
}
#define LDS_WAIT() asm volatile("s_waitcnt lgkmcnt(0)" ::: "memory")

struct Args { const float* in[24]; float* out; unsigned char* ws; int ph_lo, ph_hi; };
constexpr int ARGS_LDS_OFF = 139520;
struct AH { const LAS unsigned* w;
    __device__ __forceinline__ const float* in(int i) const { const unsigned lo = __builtin_amdgcn_readfirstlane(w[2 * i]), hi = __builtin_amdgcn_readfirstlane(w[2 * i + 1]); return (const float*)(((unsigned long long)hi << 32) | lo); }
    __device__ __forceinline__ float* out() const { const unsigned lo = __builtin_amdgcn_readfirstlane(w[48]), hi = __builtin_amdgcn_readfirstlane(w[49]); return (float*)(((unsigned long long)hi << 32) | lo); }
    __device__ __forceinline__ unsigned char* ws() const { const unsigned lo = __builtin_amdgcn_readfirstlane(w[50]), hi = __builtin_amdgcn_readfirstlane(w[51]); return (unsigned char*)(((unsigned long long)hi << 32) | lo); }
};
enum { I_X = 0, I_C, I_CTX, I_CCTX, I_WMOD, I_BMOD, I_NORMG, I_FFNIN, I_FFNOUT, I_WIN, I_RETLOGIT, I_RETG, I_CONVW, I_CONVB, I_LWA, I_LBA, I_LWX, I_LBX, I_LAM, I_QG, I_KG, I_WBR, I_WOUT, I_FG };

__device__ __forceinline__ void tr_item(const float* W, int N, int k0, int n0, bf16* WT, int K, int orow0, LAS float* scr, int lane) {
    const float* src = W + (size_t)k0 * N + n0 + lane;
#pragma unroll 1
    for (int i = 0; i < 64; i += 16) { float v[16];
#pragma unroll
        for (int r = 0; r < 16; ++r) v[r] = src[(size_t)(i + r) * N];
#pragma unroll
        for (int r = 0; r < 16; ++r) scr[(i + r) * 65 + lane] = v[r]; }
    LDS_WAIT(); asm volatile("" ::: "memory");
    const int c = lane & 7;
#pragma unroll
    for (int j = 0; j < 8; ++j) { const int n = (lane >> 3) + 8 * j; const LAS float* s = scr + (8 * c) * 65 + n;
        v4u o; o.x = pk2(s[0 * 65], s[1 * 65]); o.y = pk2(s[2 * 65], s[3 * 65]); o.z = pk2(s[4 * 65], s[5 * 65]); o.w = pk2(s[6 * 65], s[7 * 65]);
        *(v4u*)(WT + (size_t)(orow0 + n) * K + k0 + 8 * c) = o; }
    LDS_WAIT(); asm volatile("" ::: "memory");
}

__device__ __forceinline__ void phase_p0(const AH A, LAS unsigned char* lds, int tid, int G) {
    unsigned char* ws = A.ws();
    constexpr int NGEMV = 144;
    const int bx = blockIdx.x;
    if (bx < NGEMV || G <= NGEMV) {
        LAS float* sv = (LAS float*)lds;
        LAS float* red = sv + 5 * 1024;
        const float* c = A.in(I_C); const float* cctx = A.in(I_CCTX);
        for (int i = tid; i < 5 * 1024; i += 512) { const int r = i >> 10, k = i & 1023; const float v = (r < 4) ? c[r * 1024 + k] : cctx[k]; sv[i] = v / (1.0f + __expf(-v)); }
        __syncthreads();
        float* modbuf = (float*)(ws + WS_MOD);
        const float* wmod = A.in(I_WMOD); const float* bmod = A.in(I_BMOD);
        for (int item = bx; item < NGEMV; item += G) {
            const int l = item / 36, n0 = (item - l * 36) * 256, c4 = tid & 63, kg = tid >> 6;
            const f32x4* W = (const f32x4*)(wmod + (size_t)l * 1024 * MODW + n0) + c4;
            f32x4 acc[5];
#pragma unroll
            for (int r = 0; r < 5; ++r) acc[r] = (f32x4){0.f, 0.f, 0.f, 0.f};
#pragma unroll 8
            for (int k = kg * 128; k < kg * 128 + 128; ++k) { const f32x4 w = W[(size_t)k * (MODW / 4)];
#pragma unroll
                for (int r = 0; r < 5; ++r) acc[r] += w * sv[r * 1024 + k]; }
#pragma unroll
            for (int r = 0; r < 5; ++r) *(LAS f32x4*)(red + (kg * 5 + r) * 256 + c4 * 4) = acc[r];
            __syncthreads();
            for (int o = tid; o < 5 * 256; o += 512) { const int r = o >> 8, cc = o & 255; float s = 0.f;
#pragma unroll
                for (int q = 0; q < 8; ++q) s += red[(q * 5 + r) * 256 + cc];
                modbuf[(size_t)(l * 5 + r) * MODW + n0 + cc] = s + bmod[(size_t)l * MODW + n0 + cc]; }
            __syncthreads();
        }
    }
    if (bx >= NGEMV || G <= NGEMV) {
        const int wb = (G > NGEMV) ? bx - NGEMV : bx, nwb = (G > NGEMV) ? G - NGEMV : G;
        const f32x4* x4 = (const f32x4*)A.in(I_X); const f32x4* c4p = (const f32x4*)A.in(I_CTX); f32x4* X4 = (f32x4*)(ws + WS_X);
        const int total = MTOK * 256, stride = nwb * 512;
        for (int i = wb * 512 + tid; i < total; i += 4 * stride) { f32x4 v[4];
#pragma unroll
            for (int q = 0; q < 4; ++q) { const int ii = i + q * stride; if (ii < total) { const int row = ii >> 8, qq = ii & 255; const int b = row / SROW, s = row - b * SROW;
                v[q] = (s < LCTX) ? c4p[(size_t)(b * LCTX + s) * 256 + qq] : x4[(size_t)(b * LAT + s - LCTX) * 256 + qq]; } }
#pragma unroll
            for (int q = 0; q < 4; ++q) { const int ii = i + q * stride; if (ii < total) X4[ii] = v[q]; } }
        float* ra = (float*)(ws + WS_ROPE); float* rb = ra + 64 * 32 * 2;
        for (int i = wb * 512 + tid; i < 64 * 32 + 64 * 16; i += nwb * 512) {
            if (i < 64 * 32) { const int pos = i >> 5, f = i & 31; const float fr = powf(10000.0f, -(float)(2 * f) / 64.0f); const float ang = (float)pos * fr; ra[2 * i] = cosf(ang); ra[2 * i + 1] = sinf(ang); }
            else { const int j = i - 64 * 32; const int pos = j >> 4, f = j & 15; const float fr = powf(10000.0f, -(float)(2 * f) / 32.0f); const float ang = (float)pos * fr; rb[2 * j] = cosf(ang); rb[2 * j + 1] = sinf(ang); } }
    }
}

constexpr int CV_FI = 16 * 88, CV_FO = 44 * 16, CV_IN = 16 * 108, CV_BR = 8 * 16, CV_OUT = 16 * 16, CV_LRU = 32;
constexpr int CV_NIT = 2 * CV_FI + 2 * CV_FO + CV_IN + 3 * CV_BR + CV_OUT + CV_LRU;
__device__ __forceinline__ void convert_layer(const AH A, int l, int it_lo, int it_hi, LAS unsigned char* lds, int gw, int NGW, int wave, int lane) {
    unsigned char* ws = A.ws() + (size_t)(l & 1) * WS_WSET;
    LAS float* scr = (LAS float*)(lds + wave * 16640);
    for (int it = it_lo + gw; it < it_hi; it += NGW) {
        int r = it; bool done = false;
#pragma unroll
        for (int j = 0; j < 2; ++j) { if (!done) { if (r < CV_FI) { const int kb = r / 88, nb = r - kb * 88, n0 = nb * 64;
                const int orow0 = (n0 < DFF) ? ((n0 >> 7) * 256 + (n0 & 127)) : (((n0 - DFF) >> 7) * 256 + 128 + ((n0 - DFF) & 127));
                tr_item(A.in(I_FFNIN) + (size_t)(l * 2 + j) * 1024 * 5632, 5632, kb * 64, n0, (bf16*)(ws + WS_WFI) + (size_t)j * 5632 * 1024, 1024, orow0, scr, lane); done = true; } else r -= CV_FI; } }
#pragma unroll
        for (int j = 0; j < 2; ++j) { if (!done) { if (r < CV_FO) { const int kb = r >> 4, nb = r & 15;
                tr_item(A.in(I_FFNOUT) + (size_t)(l * 2 + j) * DFF * 1024, 1024, kb * 64, nb * 64, (bf16*)(ws + WS_WFO) + (size_t)j * 1024 * DFF, DFF, nb * 64, scr, lane); done = true; } else r -= CV_FO; } }
        if (!done) { if (r < CV_IN) { const int kb = r / 108, nb = r - kb * 108;
                tr_item(A.in(I_WIN) + (size_t)l * 1024 * DIN, DIN, kb * 64, nb * 64, (bf16*)(ws + WS_WIN), 1024, nb * 64, scr, lane); done = true; } else r -= CV_IN; }
#pragma unroll
        for (int n = 0; n < 3; ++n) { if (!done) { if (r < CV_BR) { const int kb = r >> 4, nb = r & 15;
                tr_item(A.in(I_WBR) + (size_t)(l * 3 + n) * 512 * 1024, 1024, kb * 64, nb * 64, (bf16*)(ws + WS_WB) + (size_t)n * 1024 * 512, 512, nb * 64, scr, lane); done = true; } else r -= CV_BR; } }
        if (!done) { if (r < CV_OUT) { const int kb = r >> 4, nb = r & 15;
                tr_item(A.in(I_WOUT) + (size_t)l * 1024 * 1024, 1024, kb * 64, nb * 64, (bf16*)(ws + WS_WO), 1024, nb * 64, scr, lane); done = true; } else r -= CV_OUT; }
        if (!done) { const int mat = r; const int g = mat >> 4, d = (mat >> 3) & 1, blk = mat & 7;
                const float* src = (g ? A.in(I_LWX) : A.in(I_LWA)) + (size_t)((l * 2 + d) * 8 + blk) * 4096;
                tr_item(src, 64, 0, 0, (bf16*)(ws + WS_LRUW) + (size_t)mat * 4096, 64, 0, scr, lane); }
    }
}

__device__ __forceinline__ void norm_rows(const AH A, int l, int sub, int gw, int NGW, int lane, int pend_ns, const float* pend_gate, float pend_scale) {
    unsigned char* ws = A.ws();
    const float* X = (const float*)(ws + WS_X); bf16* HN = (bf16*)(ws + WS_HN);
    const float* g = A.in(I_NORMG) + (size_t)(l * 3 + sub) * 1024;
    const float* modl = (const float*)(ws + WS_MOD) + (size_t)l * 5 * MODW + sub * 3072;
    f32x4 gv[4];
#pragma unroll
    for (int j = 0; j < 4; ++j) gv[j] = ((const f32x4*)g)[lane + 64 * j];
    f32x4 nx[4];
    if (gw < MTOK) {
#pragma unroll
        for (int j = 0; j < 4; ++j) nx[j] = ((const f32x4*)(X + (size_t)gw * 1024))[lane + 64 * j]; }
    for (int row = gw; row < MTOK; row += NGW) {
        const int b = row / SROW, s = row - b * SROW; const int mr = (s < LCTX) ? 4 : b;
        const f32x4* sh = (const f32x4*)(modl + (size_t)mr * MODW); const f32x4* sc = (const f32x4*)(modl + (size_t)mr * MODW + 1024);
        f32x4 v[4]; float ss = 0.f;
#pragma unroll
        for (int j = 0; j < 4; ++j) v[j] = nx[j];
        if (row + NGW < MTOK) {
#pragma unroll
            for (int j = 0; j < 4; ++j) nx[j] = ((const f32x4*)(X + (size_t)(row + NGW) * 1024))[lane + 64 * j]; }
        f32x4 scv[4], shv[4];
#pragma unroll
        for (int j = 0; j < 4; ++j) { scv[j] = sc[lane + 64 * j]; shv[j] = sh[lane + 64 * j]; }
        if (pend_ns > 0 && s < LCTX) {
            const v2u* pc = (const v2u*)((const bf16*)(ws + WS_PARTC) + (size_t)(b * LCTX + s) * 1024); const f32x4* pg = (const f32x4*)pend_gate;
            f32x4 a4[4] = {(f32x4){0.f, 0.f, 0.f, 0.f}, (f32x4){0.f, 0.f, 0.f, 0.f}, (f32x4){0.f, 0.f, 0.f, 0.f}, (f32x4){0.f, 0.f, 0.f, 0.f}};
            for (int sp = 0; sp < pend_ns; ++sp) {
#pragma unroll
                for (int j = 0; j < 4; ++j) { const v2u w = pc[(size_t)sp * 262144 + lane + 64 * j]; a4[j] += (f32x4){bflo(w.x), bfhi(w.x), bflo(w.y), bfhi(w.y)}; } }
            f32x4* xw = (f32x4*)(ws + WS_X) + (size_t)row * 256;
#pragma unroll
            for (int j = 0; j < 4; ++j) { v[j] += (pg[lane + 64 * j] * pend_scale) * a4[j]; xw[lane + 64 * j] = v[j]; }
        }
#pragma unroll
        for (int j = 0; j < 4; ++j) ss += (v[j].x * v[j].x + v[j].y * v[j].y) + (v[j].z * v[j].z + v[j].w * v[j].w);
        const float rstd = rsqrtf(wave_sum(ss, lane) * (1.0f / 1024.0f) + NORM_EPS);
        v2u* o = (v2u*)(HN + (size_t)row * 1024);
#pragma unroll
        for (int j = 0; j < 4; ++j) { const f32x4 y = (v[j] * rstd) * gv[j] * (scv[j] + 1.0f) + shv[j];
            v2u w; w.x = pk2(y.x, y.y); w.y = pk2(y.z, y.w); o[lane + 64 * j] = w; }
    }
}
__device__ __forceinline__ void final_rows(const AH A, int gw, int NGW, int lane) {
    const float* X = (const float*)(A.ws() + WS_X); const float* g = A.in(I_FG);
    f32x4 gv[4];
#pragma unroll
    for (int j = 0; j < 4; ++j) gv[j] = ((const f32x4*)g)[lane + 64 * j];
    f32x4 nx[4];
    if (gw < NB * LAT) { const int b = gw >> 12, t = gw & 4095;
#pragma unroll
        for (int j = 0; j < 4; ++j) nx[j] = ((const f32x4*)(X + (size_t)(b * SROW + LCTX + t) * 1024))[lane + 64 * j]; }
    for (int r = gw; r < NB * LAT; r += NGW) {
        f32x4 v[4]; float ss = 0.f;
#pragma unroll
        for (int j = 0; j < 4; ++j) v[j] = nx[j];
        if (r + NGW < NB * LAT) { const int r2 = r + NGW, b = r2 >> 12, t = r2 & 4095;
#pragma unroll
            for (int j = 0; j < 4; ++j) nx[j] = ((const f32x4*)(X + (size_t)(b * SROW + LCTX + t) * 1024))[lane + 64 * j]; }
#pragma unroll
        for (int j = 0; j < 4; ++j) ss += (v[j].x * v[j].x + v[j].y * v[j].y) + (v[j].z * v[j].z + v[j].w * v[j].w);
        const float rstd = rsqrtf(wave_sum(ss, lane) * (1.0f / 1024.0f) + NORM_EPS);
        f32x4* o = (f32x4*)(A.out() + (size_t)r * 1024);
#pragma unroll
        for (int j = 0; j < 4; ++j) o[lane + 64 * j] = (v[j] * rstd) * gv[j];
    }
}
#define XB_TMO      128
#define XB_XCNT(j)  (256  + 64 * (j))
#define XB_XSUB(j)  (1280 + 64 * (j))
#define XB_XGEN(j)  (2304 + 64 * (j))
#define XB_TOP      3328
#define XB_TOPGEN   3392
#define XCD_BAR_WORDS 3456
#define XB_SPIN_CAP (1u << 22)

__device__ __forceinline__ unsigned xb_ld(unsigned* p)              { return __hip_atomic_load(p, __ATOMIC_RELAXED, __HIP_MEMORY_SCOPE_AGENT); }
__device__ __forceinline__ unsigned xb_add(unsigned* p, unsigned v) { return __hip_atomic_fetch_add(p, v, __ATOMIC_RELAXED, __HIP_MEMORY_SCOPE_AGENT); }
__device__ __forceinline__ unsigned xb_xcc_id() { return (unsigned)__builtin_amdgcn_s_getreg((3 << 11) | 20) & 0xFu; }
#define XB_SPIN(cond, bar) do { unsigned _sp = 0; while (cond) { __builtin_amdgcn_s_sleep(1); \
    if ((++_sp & 255u) == 0u) { if (xb_ld(&(bar)[XB_TMO])) break; if (_sp > XB_SPIN_CAP) { atomicAdd(&(bar)[XB_TMO], 1u); break; } } } } while (0)

struct XcdBarrier {
    unsigned* bar; unsigned x;
    volatile LAS unsigned* st;
};

__device__ __forceinline__ XcdBarrier xcd_barrier_post(unsigned* bar, volatile LAS unsigned* st, bool t0) {
    XcdBarrier b; b.bar = bar; b.x = xb_xcc_id(); b.st = st;
    if (t0) (void)xb_add(&bar[XB_XCNT(b.x)], 1u);
    return b;
}
__device__ __forceinline__ void xcd_barrier_complete(unsigned* bar, unsigned x, unsigned& nloc, unsigned& nx) {
    const unsigned G = gridDim.x * gridDim.y * gridDim.z;
    unsigned sum, cnt, mine, sp = 0u;
    for (;;) {
        sum = 0u; cnt = 0u; mine = 0u;
#pragma unroll
        for (unsigned j = 0; j < 16; ++j) { const unsigned c = xb_ld(&bar[XB_XCNT(j)]); sum += c; cnt += (c > 0u) ? 1u : 0u; mine = (j == x) ? c : mine; }
        if (sum == G) break;
        __builtin_amdgcn_s_sleep(1);
        if ((++sp & 255u) == 0u) { if (xb_ld(&bar[XB_TMO])) break; if (sp > XB_SPIN_CAP) { atomicAdd(&bar[XB_TMO], 1u); break; } }
    }
    nloc = mine > 0u ? mine : 1u; nx = cnt > 0u ? cnt : 1u;
}

__device__ __forceinline__ void xcd_barrier(const XcdBarrier& b, bool t0) {
    asm volatile("s_waitcnt vmcnt(0)" ::: "memory");
    __syncthreads();
    if (t0) {
        unsigned* bar = b.bar;
        __builtin_amdgcn_s_waitcnt(0);
        unsigned nloc = b.st[0], nx = b.st[1];
        if (nloc == 0u) { xcd_barrier_complete(bar, b.x, nloc, nx); b.st[0] = nloc; b.st[1] = nx; }
        const unsigned old = xb_add(&bar[XB_XSUB(b.x)], 1u);
        const unsigned gen = old / nloc;
        if (old + 1u == (gen + 1u) * nloc) {
            __builtin_amdgcn_fence(__ATOMIC_RELEASE, "agent");
            asm volatile("s_waitcnt vmcnt(0)" ::: "memory");
            const unsigned og = xb_add(&bar[XB_TOP], 1u);
            const unsigned tg = og / nx;
            if (og + 1u == (tg + 1u) * nx) xb_add(&bar[XB_TOPGEN], 1u);
            else XB_SPIN(xb_ld(&bar[XB_TOPGEN]) == tg, bar);
            __builtin_amdgcn_fence(__ATOMIC_ACQUIRE, "agent");
            xb_add(&bar[XB_XGEN(b.x)], 1u);
            asm volatile("s_waitcnt vmcnt(0)" ::: "memory");
        } else {
            XB_SPIN(xb_ld(&bar[XB_XGEN(b.x)]) == gen, bar);
            __builtin_amdgcn_fence(__ATOMIC_ACQUIRE, "agent");
            asm volatile("s_waitcnt vmcnt(0)" ::: "memory");
        }
    }
    __syncthreads();
}
__device__ __forceinline__ void prep_qk(const AH A, int l, int gw, int NGW, int lane) {
    unsigned char* ws = A.ws();
    const bf16* Z = (const bf16*)(ws + WS_Z); bf16* QN = (bf16*)(ws + WS_QN); bf16* KN = (bf16*)(ws + WS_KN);
    const float* rb = (const float*)(ws + WS_ROPE) + 64 * 32 * 2;
    const int e0 = (lane & 7) * 8, hq = lane >> 3;
    float gq[8], gk[8];
#pragma unroll
    for (int j = 0; j < 8; ++j) { gq[j] = A.in(I_QG)[l * 64 + e0 + j]; gk[j] = A.in(I_KG)[l * 64 + e0 + j]; }
    constexpr float C2 = 0.125f * 1.4426950408889634f;
    for (int row = gw; row < MTOK; row += NGW) {
        const int b = row / SROW, s = row - b * SROW; const bool lat = s >= LCTX; const int t = s - LCTX;
        const int pos = (lane & 4) ? (t & 63) : (t >> 6);
#pragma unroll
        for (int pass = 1; pass < 2; ++pass) {
            const bf16* src = Z + (size_t)row * DIN + (pass == 0 ? ZC_AQ : ZC_AK) + hq * 64 + e0;
            float f[8]; unpack8(*(const v4u*)src, f);
            float ss = 0.f;
#pragma unroll
            for (int j = 0; j < 8; ++j) ss += f[j] * f[j];
            ss += shx(ss, 1, lane); ss += shx(ss, 2, lane); ss += shx(ss, 4, lane);
            const float rstd = rsqrtf(ss * (1.0f / 64.0f) + NORM_EPS);
            float y[8], o[8];
#pragma unroll
            for (int j = 0; j < 8; ++j) y[j] = f[j] * rstd * (pass == 0 ? gq[j] : gk[j]);
#pragma unroll
            for (int j = 0; j < 8; ++j) { const float p = shx(y[j], 2, lane);
                if (lat) { const int fi = (lane & 1) * 8 + j; const float cs = rb[(pos * 16 + fi) * 2], sn = rb[(pos * 16 + fi) * 2 + 1];
                    o[j] = ((lane & 2) == 0) ? (y[j] * cs - p * sn) : (p * sn + y[j] * cs); }
                else o[j] = y[j];
                if (pass == 0) o[j] *= C2; }
            v4u w; w.x = pk2(o[0], o[1]); w.y = pk2(o[2], o[3]); w.z = pk2(o[4], o[5]); w.w = pk2(o[6], o[7]);
            if (pass == 0) *(v4u*)(QN + (size_t)row * 512 + hq * 64 + e0) = w;
            else if (lane < 16) *(v4u*)(KN + (size_t)row * 128 + hq * 64 + e0) = w;
        }
    }
}

constexpr int RLDP = 136;
constexpr int RBUF = 128 * RLDP * 2;
__device__ __forceinline__ float log_sigmoid_f(float x) { return (x < 0.f ? x : 0.f) - log1pf(__expf(-fabsf(x))); }
template <bool TRANSPOSED, bool ROPE>
__device__ __forceinline__ void ret_stage_pair(const bf16* Z, int r0, int zc, int h, bool lat, int t0, const float* ra, float scl, float lgdec, int decmode  , LAS bf16* dst, int tid) {
#pragma unroll
    for (int it = 0; it < 2; ++it) { const int task = tid + 512 * it; const int j = task & 127, pr = task >> 7; const int c = (pr & 3) + (pr >> 2) * 8;
        const bf16* p = Z + (size_t)(r0 + j) * DIN + zc + h * 128;
        float a[8], bq[8]; unpack8(*(const v4u*)(p + 8 * c), a); unpack8(*(const v4u*)(p + 8 * (c + 4)), bq);
        float sc = scl; if (decmode == 1) sc *= __expf(lgdec * (float)(127 - j)); else if (decmode == 2) sc *= __expf(lgdec * (float)j);
        if (ROPE && lat) { const int t = t0 + j; const int pos = (c < 8) ? (t >> 6) : (t & 63);
#pragma unroll
            for (int e = 0; e < 8; ++e) { const int fi = (c & 3) * 8 + e; const float cs = ra[(pos * 32 + fi) * 2], sn = ra[(pos * 32 + fi) * 2 + 1];
                const float x1 = a[e], x2 = bq[e]; a[e] = x1 * cs - x2 * sn; bq[e] = x1 * sn + x2 * cs; } }
        if (TRANSPOSED) {
#pragma unroll
            for (int e = 0; e < 8; ++e) { dst[(8 * c + e) * RLDP + j] = (bf16)f2bf(a[e] * sc); dst[(8 * (c + 4) + e) * RLDP + j] = (bf16)f2bf(bq[e] * sc); }
        } else {
            v4u w; w.x = pk2(a[0] * sc, a[1] * sc); w.y = pk2(a[2] * sc, a[3] * sc); w.z = pk2(a[4] * sc, a[5] * sc); w.w = pk2(a[6] * sc, a[7] * sc);
            *(LAS v4u*)(dst + j * RLDP + 8 * c) = w;
            w.x = pk2(bq[0] * sc, bq[1] * sc); w.y = pk2(bq[2] * sc, bq[3] * sc); w.z = pk2(bq[4] * sc, bq[5] * sc); w.w = pk2(bq[6] * sc, bq[7] * sc);
            *(LAS v4u*)(dst + j * RLDP + 8 * (c + 4)) = w;
        } }
}
__device__ __forceinline__ void wave_mm(f32x4 (&acc)[8], const LAS bf16* Am, int row0, const LAS bf16* Bm, int lane) {
    const int r = lane & 15, g = lane >> 4;
#pragma unroll
    for (int ks = 0; ks < 4; ++ks) { const bf16x8 a = *(const LAS bf16x8*)(Am + (row0 + r) * RLDP + ks * 32 + g * 8);
#pragma unroll
        for (int nt = 0; nt < 8; ++nt) { const bf16x8 bfr = *(const LAS bf16x8*)(Bm + (nt * 16 + r) * RLDP + ks * 32 + g * 8);
            acc[nt] = __builtin_amdgcn_mfma_f32_16x16x32_bf16(a, bfr, acc[nt], 0, 0, 0); } }
}
__device__ __forceinline__ int ret_chain_pos(int d, int cidx) { return d == 0 ? cidx : (cidx == 1 ? 0 : (cidx == 0 ? 1 : 35 - cidx)); }

__device__ __forceinline__ void ret_stage_k_both(const bf16* Z, int r0, int h, bool lat, int t0, const float* ra, float scl, float lgf, float lgb, LAS bf16* dstf, LAS bf16* dstb, int tid) {
#pragma unroll
    for (int it = 0; it < 2; ++it) { const int task = tid + 512 * it; const int j = task & 127, pr = task >> 7; const int c = (pr & 3) + (pr >> 2) * 8;
        const bf16* p = Z + (size_t)(r0 + j) * DIN + ZC_RK + h * 128;
        float a[8], bq[8]; unpack8(*(const v4u*)(p + 8 * c), a); unpack8(*(const v4u*)(p + 8 * (c + 4)), bq);
        const float sf = scl * __expf(lgf * (float)(127 - j)), sb = scl * __expf(lgb * (float)j);
        if (lat) { const int t = t0 + j; const int pos = (c < 8) ? (t >> 6) : (t & 63);
#pragma unroll
            for (int e = 0; e < 8; ++e) { const int fi = (c & 3) * 8 + e; const float cs = ra[(pos * 32 + fi) * 2], sn = ra[(pos * 32 + fi) * 2 + 1];
                const float x1 = a[e], x2 = bq[e]; a[e] = x1 * cs - x2 * sn; bq[e] = x1 * sn + x2 * cs; } }
#pragma unroll
        for (int e = 0; e < 8; ++e) { dstf[(8 * c + e) * RLDP + j] = (bf16)f2bf(a[e] * sf); dstf[(8 * (c + 4) + e) * RLDP + j] = (bf16)f2bf(bq[e] * sf);
                                      dstb[(8 * c + e) * RLDP + j] = (bf16)f2bf(a[e] * sb); dstb[(8 * (c + 4) + e) * RLDP + j] = (bf16)f2bf(bq[e] * sb); } }
}
__device__ __forceinline__ void ret_u_item(const AH A, int l, int item, LAS unsigned char* lds, int tid, int wave, int lane) {
    unsigned char* ws = A.ws(); const bf16* Z = (const bf16*)(ws + WS_Z); const float* ra = (const float*)(ws + WS_ROPE);
    const int cidx = item % 34, bh = item / 34, b = bh >> 2, h = bh & 3;
    const int pf = ret_chain_pos(0, cidx), pb = ret_chain_pos(1, cidx);
    const bool lat = cidx >= 2; const int r0 = b * SROW + cidx * 128, t0 = (cidx - 2) * 128;
    const float lgf = log_sigmoid_f(A.in(I_RETLOGIT)[(l * 2 + 0) * 4 + h]), lgb = log_sigmoid_f(A.in(I_RETLOGIT)[(l * 2 + 1) * 4 + h]);
    LAS bf16* Ktf = (LAS bf16*)lds; LAS bf16* Ktb = (LAS bf16*)(lds + RBUF); LAS bf16* Vt = (LAS bf16*)(lds + 2 * RBUF);
    ret_stage_k_both(Z, r0, h, lat, t0, ra, 0.08838834764831845f, lgf, lgb, Ktf, Ktb, tid);
    ret_stage_pair<true, false>(Z, r0, ZC_RV, h, false, 0, ra, 1.0f, 0.f, 0, Vt, tid);
    __syncthreads();
    const int g = lane >> 4, c = lane & 15;
    f32x4 accf[8], accb[8];
#pragma unroll
    for (int nt = 0; nt < 8; ++nt) { accf[nt] = (f32x4){0.f, 0.f, 0.f, 0.f}; accb[nt] = (f32x4){0.f, 0.f, 0.f, 0.f}; }
    if (pf != 33) wave_mm(accf, Vt, wave * 16, Ktf, lane);
    if (pb != 33) wave_mm(accb, Vt, wave * 16, Ktb, lane);
    __syncthreads();
    LAS bf16* stg = (LAS bf16*)lds + wave * (16 * RLDP);
#pragma unroll 1
    for (int d = 0; d < 2; ++d) { const int p = d ? pb : pf;
        if (p == 33) continue;
#pragma unroll
        for (int nt = 0; nt < 8; ++nt)
#pragma unroll
            for (int jj = 0; jj < 4; ++jj) stg[(4 * g + jj) * RLDP + nt * 16 + c] = (bf16)f2bf(d ? accb[nt][jj] : accf[nt][jj]);
        LDS_WAIT(); asm volatile("" ::: "memory");
        bf16* U = (bf16*)(ws + WS_U) + ((size_t)((b * 4 + h) * 2 + d) * 34 + p) * 16384 + (size_t)(wave * 16) * 128;
#pragma unroll
        for (int it = 0; it < 4; ++it) { const int id = lane + 64 * it, rr = id >> 4, ch = id & 15;
            *(v4u*)(U + rr * 128 + ch * 8) = *(const LAS v4u*)(stg + rr * RLDP + ch * 8); }
        LDS_WAIT(); asm volatile("" ::: "memory"); }
    __syncthreads();
}
__device__ __forceinline__ void ret_scan_item(const AH A, int l, int item, int tid) {
    unsigned char* ws = A.ws();
    const int bhd = item >> 3, sl = item & 7; const int d = bhd & 1, h = (bhd >> 1) & 3;
    const float lg = log_sigmoid_f(A.in(I_RETLOGIT)[(l * 2 + d) * 4 + h]); const float sdec = __expf(128.0f * lg);
    const v2u* U = (const v2u*)((const bf16*)(ws + WS_U) + (size_t)bhd * 34 * 16384) + sl * 512 + tid;
    v2u* S = (v2u*)((bf16*)(ws + WS_SIN) + (size_t)bhd * 34 * 16384) + sl * 512 + tid;
    f32x4 s = (f32x4){0.f, 0.f, 0.f, 0.f};
#pragma unroll 1
    for (int p0 = 0; p0 < 33; p0 += 11) { v2u u[11];
#pragma unroll
        for (int i = 0; i < 11; ++i) u[i] = U[(size_t)(p0 + i) * 4096];
#pragma unroll
        for (int i = 0; i < 11; ++i) { v2u w; w.x = pk2(s.x, s.y); w.y = pk2(s.z, s.w); S[(size_t)(p0 + i) * 4096] = w;
            const f32x4 uf = (f32x4){bflo(u[i].x), bfhi(u[i].x), bflo(u[i].y), bfhi(u[i].y)}; s = s * sdec + uf; } }
    { v2u w; w.x = pk2(s.x, s.y); w.y = pk2(s.z, s.w); S[(size_t)33 * 4096] = w; }
}
__device__ __forceinline__ void ret_out_item(const AH A, int l, int item, LAS unsigned char* lds, int tid, int wave, int lane) {
    unsigned char* ws = A.ws(); const bf16* Z = (const bf16*)(ws + WS_Z); const float* ra = (const float*)(ws + WS_ROPE);
    const int cidx = item % 34, bh = item / 34, b = bh >> 2, h = bh & 3;
    const bool lat = cidx >= 2; const int r0 = b * SROW + cidx * 128, t0 = (cidx - 2) * 128;
    const float lgf = log_sigmoid_f(A.in(I_RETLOGIT)[(l * 2 + 0) * 4 + h]) * 1.4426950408889634f, lgb = log_sigmoid_f(A.in(I_RETLOGIT)[(l * 2 + 1) * 4 + h]) * 1.4426950408889634f;
    LAS bf16* Qs = (LAS bf16*)lds; LAS bf16* Ks = (LAS bf16*)(lds + RBUF); LAS bf16* Vt = (LAS bf16*)(lds + 2 * RBUF); LAS bf16* Ss = (LAS bf16*)(lds + 3 * RBUF);
    const bf16* SINf = (const bf16*)(ws + WS_SIN) + ((size_t)((b * 4 + h) * 2 + 0) * 34 + ret_chain_pos(0, cidx)) * 16384;
    const bf16* SINb = (const bf16*)(ws + WS_SIN) + ((size_t)((b * 4 + h) * 2 + 1) * 34 + ret_chain_pos(1, cidx)) * 16384;
    ret_stage_pair<false, true>(Z, r0, ZC_RQ, h, lat, t0, ra, 1.0f, 0.f, 0, Qs, tid);
    ret_stage_pair<false, true>(Z, r0, ZC_RK, h, lat, t0, ra, 0.08838834764831845f, 0.f, 0, Ks, tid);
    ret_stage_pair<true, false>(Z, r0, ZC_RV, h, false, 0, ra, 1.0f, 0.f, 0, Vt, tid);
#pragma unroll
    for (int it = 0; it < 4; ++it) { const int task = tid + 512 * it, row = task >> 4, ch = task & 15; *(LAS v4u*)(Ss + row * RLDP + ch * 8) = *(const v4u*)(SINf + row * 128 + ch * 8); }
    v4u sbv[4];
#pragma unroll
    for (int it = 0; it < 4; ++it) { const int task = tid + 512 * it, row = task >> 4, ch = task & 15; sbv[it] = *(const v4u*)(SINb + row * 128 + ch * 8); }
    __syncthreads();
    const int g = lane >> 4, c = lane & 15, i0 = wave * 16 + 4 * g;
    f32x4 accs[8], acco[8];
#pragma unroll
    for (int nt = 0; nt < 8; ++nt) { accs[nt] = (f32x4){0.f, 0.f, 0.f, 0.f}; acco[nt] = (f32x4){0.f, 0.f, 0.f, 0.f}; }
    wave_mm(accs, Qs, wave * 16, Ks, lane);
    wave_mm(acco, Qs, wave * 16, Ss, lane);
#pragma unroll
    for (int jj = 0; jj < 4; ++jj) { const float qd = __builtin_amdgcn_exp2f(lgf * (float)(i0 + jj + 1));
#pragma unroll
        for (int nt = 0; nt < 8; ++nt) acco[nt][jj] *= qd; }
    int i0w = i0; asm volatile("" : "+v"(i0w));
#pragma unroll
    for (int nt = 0; nt < 8; ++nt)
#pragma unroll
        for (int jj = 0; jj < 4; ++jj) { const int diff = (i0w + jj) - (nt * 16 + c);
            const float w = diff > 0 ? __builtin_amdgcn_exp2f(lgf * (float)diff) : (diff < 0 ? __builtin_amdgcn_exp2f(lgb * (float)(-diff)) : 2.0f);
            accs[nt][jj] *= w; }
    __syncthreads();
#pragma unroll
    for (int nt = 0; nt < 8; ++nt)
#pragma unroll
        for (int jj = 0; jj < 4; ++jj) Ks[(i0 + jj) * RLDP + nt * 16 + c] = (bf16)f2bf(accs[nt][jj]);
#pragma unroll
    for (int it = 0; it < 4; ++it) { const int task = tid + 512 * it, row = task >> 4, ch = task & 15; *(LAS v4u*)(Ss + row * RLDP + ch * 8) = sbv[it]; }
    __syncthreads();
#pragma unroll
    for (int nt = 0; nt < 8; ++nt) accs[nt] = (f32x4){0.f, 0.f, 0.f, 0.f};
    wave_mm(accs, Qs, wave * 16, Ss, lane);
#pragma unroll
    for (int jj = 0; jj < 4; ++jj) { const float qd = __builtin_amdgcn_exp2f(lgb * (float)(128 - (i0 + jj)));
#pragma unroll
        for (int nt = 0; nt < 8; ++nt) acco[nt][jj] += qd * accs[nt][jj]; }
    wave_mm(acco, Ks, wave * 16, Vt, lane);
    const float* gn = A.in(I_RETG) + (size_t)l * 512 + h * 128;
    bf16* Y = (bf16*)(ws + WS_Y);
    float gnv[8];
#pragma unroll
    for (int nt = 0; nt < 8; ++nt) gnv[nt] = gn[nt * 16 + c];
#pragma unroll
    for (int jj = 0; jj < 4; ++jj) {
        float s1 = 0.f;
#pragma unroll
        for (int nt = 0; nt < 8; ++nt) s1 += acco[nt][jj];
        s1 += shx(s1, 1, lane); s1 += shx(s1, 2, lane); s1 += shx(s1, 4, lane); s1 += shx(s1, 8, lane);
        const float mu = s1 * (1.0f / 128.0f); float s2 = 0.f;
#pragma unroll
        for (int nt = 0; nt < 8; ++nt) { const float dlt = acco[nt][jj] - mu; s2 += dlt * dlt; }
        s2 += shx(s2, 1, lane); s2 += shx(s2, 2, lane); s2 += shx(s2, 4, lane); s2 += shx(s2, 8, lane);
        const float rstd = rsqrtf(s2 * (1.0f / 128.0f) + NORM_EPS);
#pragma unroll
        for (int nt = 0; nt < 8; ++nt) Qs[(i0 + jj) * RLDP + nt * 16 + c] = (bf16)f2bf((acco[nt][jj] - mu) * rstd * gnv[nt]);
    }
    LDS_WAIT(); asm volatile("" ::: "memory");
#pragma unroll
    for (int it = 0; it < 4; ++it) { const int id = lane + 64 * it, rr = wave * 16 + (id >> 4), ch = id & 15; const size_t row = (size_t)(r0 + rr);
        float yv[8], rg[8]; unpack8(*(const LAS v4u*)(Qs + rr * RLDP + ch * 8), yv); unpack8(*(const v4u*)(Z + row * DIN + ZC_RG + h * 128 + ch * 8), rg);
#pragma unroll
        for (int e = 0; e < 8; ++e) yv[e] *= rg[e] * sigmoidf_(rg[e]);
        v4u w; w.x = pk2(yv[0], yv[1]); w.y = pk2(yv[2], yv[3]); w.z = pk2(yv[4], yv[5]); w.w = pk2(yv[6], yv[7]);
        *(v4u*)(Y + row * 512 + h * 128 + ch * 8) = w; }
    __syncthreads();
}
constexpr int XLDP = 68;
constexpr int XWAVE_BYTES = 64 * XLDP * 4;
__device__ __forceinline__ float gelu_tanh(float x) { const float u = 0.7978845608028654f * (x + 0.044715f * x * x * x); const float th = 1.0f - 2.0f * __builtin_amdgcn_rcpf(1.0f + __expf(2.0f * u)); return 0.5f * x * (1.0f + th); }
__device__ __forceinline__ int lru_chain_pos(int d, int c64) { return d == 0 ? c64 : (c64 < 4 ? 3 - c64 : 71 - c64); }

struct LruFrag { bf16x8 ba[2], bx[2]; };
__device__ __forceinline__ LruFrag lru_frag_load(const unsigned char* ws, int l, int dir, int blk, int nt, int lane) {
    const int g = lane >> 4, c = lane & 15; LruFrag f;
    const bf16* wa = (const bf16*)(ws + (size_t)(l & 1) * WS_WSET + WS_LRUW) + (size_t)((0 * 2 + dir) * 8 + blk) * 4096 + (nt * 16 + c) * 64 + g * 8;
    const bf16* wx = (const bf16*)(ws + (size_t)(l & 1) * WS_WSET + WS_LRUW) + (size_t)((1 * 2 + dir) * 8 + blk) * 4096 + (nt * 16 + c) * 64 + g * 8;
#pragma unroll
    for (int ks = 0; ks < 2; ++ks) { f.ba[ks] = *(const bf16x8*)(wa + ks * 32); f.bx[ks] = *(const bf16x8*)(wx + ks * 32); }
    return f;
}
template <int DIR, bool FINAL>
__device__ __forceinline__ void lru_dir(const AH A, int l, int b, int c64, int blk, int nt, const bf16x8 (&af)[4][2], const float (&xv)[16], float (&hs)[16], int lane,
                                        const LruFrag& fr, float b_a, float b_x, float lam, float hin) {
    unsigned char* ws = A.ws();
    const int g = lane >> 4, c = lane & 15; const int ch = blk * 64 + nt * 16 + c;
    f32x4 accr[4], acci[4];
#pragma unroll
    for (int mt = 0; mt < 4; ++mt) { accr[mt] = (f32x4){0.f, 0.f, 0.f, 0.f}; acci[mt] = (f32x4){0.f, 0.f, 0.f, 0.f};
#pragma unroll
        for (int ks = 0; ks < 2; ++ks) { accr[mt] = __builtin_amdgcn_mfma_f32_16x16x32_bf16(af[mt][ks], fr.ba[ks], accr[mt], 0, 0, 0);
                                         acci[mt] = __builtin_amdgcn_mfma_f32_16x16x32_bf16(af[mt][ks], fr.bx[ks], acci[mt], 0, 0, 0); } }
    const float sp = fmaxf(-lam, 0.f) + log1pf(__expf(-fabsf(lam)));
    float a_[16], u_[16], la_[16];
#pragma unroll
    for (int q = 0; q < 16; ++q) { const int mt = q >> 2, jj = q & 3;
        const float r = sigmoidf_(accr[mt][jj] + b_a), ii = sigmoidf_(acci[mt][jj] + b_x);
        const float la = -8.0f * r * sp; a_[q] = __expf(la); la_[q] = la;
        const float x2 = 2.0f * la;
        const float em = -x2 * (1.0f + x2 * (0.5f + x2 * (0.16666667f + x2 * (0.041666668f + x2 * (0.0083333338f + x2 * 0.0013888889f)))));
        u_[q] = __builtin_amdgcn_sqrtf(em) * (ii * xv[q]); }
    float P = 1.f, H = 0.f;
#pragma unroll
    for (int qi = 0; qi < 16; ++qi) { const int q = DIR ? 15 - qi : qi; H = a_[q] * H + u_[q]; P *= a_[q]; }
    float Pg[4], Hg[4];
#pragma unroll
    for (int k = 0; k < 4; ++k) { Pg[k] = shi(P, c + 16 * k); Hg[k] = shi(H, c + 16 * k); }
    if (!FINAL) {
        const int p = lru_chain_pos(DIR, c64);
        const size_t idx = ((size_t)((b * 2 + DIR) * 68 + p)) * 512 + ch;
        float Hc, Pc = (Pg[0] * Pg[1]) * (Pg[2] * Pg[3]);
        if (DIR == 0) Hc = ((Hg[0] * Pg[1] + Hg[1]) * Pg[2] + Hg[2]) * Pg[3] + Hg[3];
        else          Hc = ((Hg[3] * Pg[2] + Hg[2]) * Pg[1] + Hg[1]) * Pg[0] + Hg[0];
        if (g == 0) { float* S = (float*)(ws + WS_SUMM); S[idx * 2] = Pc; S[idx * 2 + 1] = Hc; }
        const size_t e0 = ((((size_t)((b * 68 + c64) * 8 + blk) * 4 + nt) * 2 + DIR) * 64 + lane) * 16;
        bf16* LA = (bf16*)(ws + WS_HN) + e0; bf16* LU = (bf16*)(ws + WS_PARTC) + e0;
        v4u w;
        w.x = pk2(la_[0], la_[1]); w.y = pk2(la_[2], la_[3]); w.z = pk2(la_[4], la_[5]); w.w = pk2(la_[6], la_[7]); *(v4u*)LA = w;
        w.x = pk2(la_[8], la_[9]); w.y = pk2(la_[10], la_[11]); w.z = pk2(la_[12], la_[13]); w.w = pk2(la_[14], la_[15]); *(v4u*)(LA + 8) = w;
        w.x = pk2(u_[0], u_[1]); w.y = pk2(u_[2], u_[3]); w.z = pk2(u_[4], u_[5]); w.w = pk2(u_[6], u_[7]); *(v4u*)LU = w;
        w.x = pk2(u_[8], u_[9]); w.y = pk2(u_[10], u_[11]); w.z = pk2(u_[12], u_[13]); w.w = pk2(u_[14], u_[15]); *(v4u*)(LU + 8) = w;
    } else {
        float s0, s1, s2, s3;
        if (DIR == 0) { s0 = hin; s1 = s0 * Pg[0] + Hg[0]; s2 = s1 * Pg[1] + Hg[1]; s3 = s2 * Pg[2] + Hg[2]; }
        else          { s3 = hin; s2 = s3 * Pg[3] + Hg[3]; s1 = s2 * Pg[2] + Hg[2]; s0 = s1 * Pg[1] + Hg[1]; }
        float h = (g == 0) ? s0 : (g == 1) ? s1 : (g == 2) ? s2 : s3;
#pragma unroll
        for (int qi = 0; qi < 16; ++qi) { const int q = DIR ? 15 - qi : qi; h = a_[q] * h + u_[q]; hs[q] += h; }
    }
}
template <bool FINAL>
__device__ __forceinline__ void lru_task(const AH A, int l, int b, int c64, int blk, LAS unsigned char* lds, int wave, int lane, int half) {
    unsigned char* ws = A.ws(); const bf16* Z = (const bf16*)(ws + WS_Z);
    LAS float* xs = (LAS float*)(lds + wave * XWAVE_BYTES);
    const int r0 = b * SROW + c64 * 64;
    const int seq_lo = (c64 < 4) ? b * SROW : b * SROW + LCTX, seq_hi = (c64 < 4) ? b * SROW + LCTX : (b + 1) * SROW;
    const int g = lane >> 4, c = lane & 15;
    const int cgx = lane & 7, tg = lane >> 3, ch0 = blk * 64 + cgx * 8;
    v4u raw[11];
#pragma unroll
    for (int q = 0; q < 11; ++q) { const int row = r0 + tg * 8 - 1 + q;
        raw[q] = (row >= seq_lo && row < seq_hi) ? *(const v4u*)(Z + (size_t)row * DIN + ZC_LX + ch0) : (v4u){0u, 0u, 0u, 0u}; }
    f32x4 cwv[4][2], cbv[2];
#pragma unroll
    for (int e2 = 0; e2 < 2; ++e2) { cbv[e2] = *(const f32x4*)(A.in(I_CONVB) + l * 512 + ch0 + 4 * e2);
#pragma unroll
        for (int j = 0; j < 4; ++j) cwv[j][e2] = *(const f32x4*)(A.in(I_CONVW) + (l * 4 + j) * 512 + ch0 + 4 * e2); }
    float pba[2][2], pbx[2][2], plam[2][2], phin[2][2];
#pragma unroll
    for (int nti = 0; nti < 2; ++nti)
#pragma unroll
        for (int d = 0; d < 2; ++d) { const int ch = blk * 64 + (2 * half + nti) * 16 + c; const int pidx = (l * 2 + d) * 512 + ch;
            pba[nti][d] = A.in(I_LBA)[pidx]; pbx[nti][d] = A.in(I_LBX)[pidx]; plam[nti][d] = A.in(I_LAM)[pidx];
            phin[nti][d] = FINAL ? ((const float*)(ws + WS_HIN))[((size_t)((b * 2 + d) * 68 + lru_chain_pos(d, c64))) * 512 + ch] : 0.f; }
    LruFrag fcur = lru_frag_load(ws, l, 0, blk, 2 * half, lane);
    {
        float xw[4][8];
#pragma unroll
        for (int q = 0; q < 3; ++q) unpack8(raw[q], xw[q]);
#pragma unroll
        for (int tt = 0; tt < 8; ++tt) { unpack8(raw[tt + 3], xw[3]);
            float y[8];
#pragma unroll
            for (int e = 0; e < 8; ++e) { float sacc = cbv[e >> 2][e & 3];
#pragma unroll
                for (int j = 0; j < 4; ++j) sacc += cwv[j][e >> 2][e & 3] * xw[j][e];
                y[e] = sacc; }
            LAS f32x4* o = (LAS f32x4*)(xs + (tg * 8 + tt) * XLDP + cgx * 8);
            o[0] = (f32x4){y[0], y[1], y[2], y[3]}; o[1] = (f32x4){y[4], y[5], y[6], y[7]};
#pragma unroll
            for (int e = 0; e < 8; ++e) { xw[0][e] = xw[1][e]; xw[1][e] = xw[2][e]; xw[2][e] = xw[3][e]; } }
    }
    LDS_WAIT(); asm volatile("" ::: "memory");
    bf16x8 af[4][2];
    { const int m = lane & 15, gq = m >> 2, jq = m & 3, kq = (lane >> 4) * 8;
#pragma unroll
      for (int mt = 0; mt < 4; ++mt) { const int tok = 16 * gq + 4 * mt + jq;
#pragma unroll
          for (int ks = 0; ks < 2; ++ks) { const LAS f32x4* s = (const LAS f32x4*)(xs + tok * XLDP + ks * 32 + kq); const f32x4 v0 = s[0], v1 = s[1];
              v4u w; w.x = pk2(v0.x, v0.y); w.y = pk2(v0.z, v0.w); w.z = pk2(v1.x, v1.y); w.w = pk2(v1.z, v1.w); af[mt][ks] = __builtin_bit_cast(bf16x8, w); } } }
#pragma unroll
    for (int nti = 0; nti < 2; ++nti) { const int nt = 2 * half + nti;
        float xv[16], hs[16];
#pragma unroll
        for (int q = 0; q < 16; ++q) { xv[q] = xs[(16 * g + q) * XLDP + nt * 16 + c]; hs[q] = 0.f; }
        const LruFrag f1 = lru_frag_load(ws, l, 1, blk, nt, lane);
        lru_dir<0, FINAL>(A, l, b, c64, blk, nt, af, xv, hs, lane, fcur, pba[nti][0], pbx[nti][0], plam[nti][0], phin[nti][0]);
        if (nti == 0) fcur = lru_frag_load(ws, l, 0, blk, nt + 1, lane);
        lru_dir<1, FINAL>(A, l, b, c64, blk, nt, af, xv, hs, lane, f1, pba[nti][1], pbx[nti][1], plam[nti][1], phin[nti][1]);
        if (FINAL) {
#pragma unroll
            for (int q = 0; q < 16; ++q) xs[(16 * g + q) * XLDP + nt * 16 + c] = hs[q]; }
    }
    if (FINAL) {
        LDS_WAIT(); asm volatile("" ::: "memory");
        bf16* Y = (bf16*)(ws + WS_Y) + (size_t)MTOK * 512;
#pragma unroll
        for (int it = 0; it < 4; ++it) { const int id = lane + 64 * it, tok = id >> 2, chn = 4 * half + (id & 3); const size_t row = (size_t)(r0 + tok);
            const LAS f32x4* sp = (const LAS f32x4*)(xs + tok * XLDP + chn * 8); const f32x4 h0 = sp[0], h1 = sp[1];
            float lz[8]; unpack8(*(const v4u*)(Z + row * DIN + ZC_LZ + blk * 64 + chn * 8), lz);
            v4u w; w.x = pk2(gelu_tanh(lz[0]) * h0.x, gelu_tanh(lz[1]) * h0.y); w.y = pk2(gelu_tanh(lz[2]) * h0.z, gelu_tanh(lz[3]) * h0.w);
            w.z = pk2(gelu_tanh(lz[4]) * h1.x, gelu_tanh(lz[5]) * h1.y); w.w = pk2(gelu_tanh(lz[6]) * h1.z, gelu_tanh(lz[7]) * h1.w);
            *(v4u*)(Y + row * 512 + blk * 64 + chn * 8) = w; }
    }
    LDS_WAIT(); asm volatile("" ::: "memory");
}
template <int DIR>
__device__ __forceinline__ void lru_apply(const float (&a_)[16], const float (&u_)[16], float hin, float (&hs)[16], int lane) {
    const int g = lane >> 4, c = lane & 15;
    float P = 1.f, H = 0.f;
#pragma unroll
    for (int qi = 0; qi < 16; ++qi) { const int q = DIR ? 15 - qi : qi; H = a_[q] * H + u_[q]; P *= a_[q]; }
    float Pg[4], Hg[4];
#pragma unroll
    for (int k = 0; k < 4; ++k) { Pg[k] = shi(P, c + 16 * k); Hg[k] = shi(H, c + 16 * k); }
    float s0, s1, s2, s3;
    if (DIR == 0) { s0 = hin; s1 = s0 * Pg[0] + Hg[0]; s2 = s1 * Pg[1] + Hg[1]; s3 = s2 * Pg[2] + Hg[2]; }
    else          { s3 = hin; s2 = s3 * Pg[3] + Hg[3]; s1 = s2 * Pg[2] + Hg[2]; s0 = s1 * Pg[1] + Hg[1]; }
    float h = (g == 0) ? s0 : (g == 1) ? s1 : (g == 2) ? s2 : s3;
#pragma unroll
    for (int qi = 0; qi < 16; ++qi) { const int q = DIR ? 15 - qi : qi; h = a_[q] * h + u_[q]; hs[q] += h; }
}
__device__ __forceinline__ void lru_final(const AH A, int l, int b, int c64, int blk, LAS unsigned char* lds, int wave, int lane, int half) {
    unsigned char* ws = A.ws(); const bf16* Z = (const bf16*)(ws + WS_Z);
    LAS float* xs = (LAS float*)(lds + wave * XWAVE_BYTES);
    const int r0 = b * SROW + c64 * 64;
    const int g = lane >> 4, c = lane & 15;
    float phin[2][2];
#pragma unroll
    for (int nti = 0; nti < 2; ++nti)
#pragma unroll
        for (int d = 0; d < 2; ++d) { const int ch = blk * 64 + (2 * half + nti) * 16 + c;
            phin[nti][d] = ((const float*)(ws + WS_HIN))[((size_t)((b * 2 + d) * 68 + lru_chain_pos(d, c64))) * 512 + ch]; }
    v4u wl[2][2][2], wu[2][2][2];
#pragma unroll
    for (int nti = 0; nti < 2; ++nti)
#pragma unroll
        for (int d = 0; d < 2; ++d) { const size_t e0 = ((((size_t)((b * 68 + c64) * 8 + blk) * 4 + (2 * half + nti)) * 2 + d) * 64 + lane) * 16;
            const bf16* LA = (const bf16*)(ws + WS_HN) + e0; const bf16* LU = (const bf16*)(ws + WS_PARTC) + e0;
            wl[nti][d][0] = *(const v4u*)LA; wl[nti][d][1] = *(const v4u*)(LA + 8); wu[nti][d][0] = *(const v4u*)LU; wu[nti][d][1] = *(const v4u*)(LU + 8); }
#pragma unroll
    for (int nti = 0; nti < 2; ++nti) { const int nt = 2 * half + nti;
        float hs[16];
#pragma unroll
        for (int q = 0; q < 16; ++q) hs[q] = 0.f;
#pragma unroll
        for (int d = 0; d < 2; ++d) { float a_[16], u_[16];
            unpack8(wl[nti][d][0], a_); unpack8(wl[nti][d][1], a_ + 8); unpack8(wu[nti][d][0], u_); unpack8(wu[nti][d][1], u_ + 8);
#pragma unroll
            for (int q = 0; q < 16; ++q) a_[q] = __expf(a_[q]);
            if (d == 0) lru_apply<0>(a_, u_, phin[nti][0], hs, lane); else lru_apply<1>(a_, u_, phin[nti][1], hs, lane); }
#pragma unroll
        for (int q = 0; q < 16; ++q) xs[(16 * g + q) * XLDP + nt * 16 + c] = hs[q];
    }
    LDS_WAIT(); asm volatile("" ::: "memory");
    bf16* Y = (bf16*)(ws + WS_Y) + (size_t)MTOK * 512;
#pragma unroll
    for (int it = 0; it < 4; ++it) { const int id = lane + 64 * it, tok = id >> 2, chn = 4 * half + (id & 3); const size_t row = (size_t)(r0 + tok);
        const LAS f32x4* sp = (const LAS f32x4*)(xs + tok * XLDP + chn * 8); const f32x4 h0 = sp[0], h1 = sp[1];
        float lz[8]; unpack8(*(const v4u*)(Z + row * DIN + ZC_LZ + blk * 64 + chn * 8), lz);
        v4u w; w.x = pk2(gelu_tanh(lz[0]) * h0.x, gelu_tanh(lz[1]) * h0.y); w.y = pk2(gelu_tanh(lz[2]) * h0.z, gelu_tanh(lz[3]) * h0.w);
        w.z = pk2(gelu_tanh(lz[4]) * h1.x, gelu_tanh(lz[5]) * h1.y); w.w = pk2(gelu_tanh(lz[6]) * h1.z, gelu_tanh(lz[7]) * h1.w);
        *(v4u*)(Y + row * 512 + blk * 64 + chn * 8) = w; }
    LDS_WAIT(); asm volatile("" ::: "memory");
}
__device__ __forceinline__ void lru_scan(const AH A, int tid, int G) {
    unsigned char* ws = A.ws(); const float* S = (const float*)(ws + WS_SUMM); float* HIN = (float*)(ws + WS_HIN);
    const int cpb = (4096 + G - 1) / G;
    for (int chain = blockIdx.x * cpb + tid; tid < cpb && chain < 4096; chain += 4096) { const int bd = chain >> 9, ch = chain & 511; float h = 0.f;
        typedef float f32x2s __attribute__((ext_vector_type(2)));
#pragma unroll 1
        for (int p0 = 0; p0 < 68; p0 += 17) { f32x2s ph_[17];
#pragma unroll
            for (int i = 0; i < 17; ++i) ph_[i] = *(const f32x2s*)(S + ((size_t)(bd * 68 + p0 + i) * 512 + ch) * 2);
#pragma unroll
            for (int i = 0; i < 17; ++i) { HIN[(size_t)(bd * 68 + p0 + i) * 512 + ch] = h; h = ph_[i].x * h + ph_[i].y; } } }
}

#define EN(k) (((MASK) >> (k)) & 1)
template <int MASK> __global__ void __launch_bounds__(NWAVES * 64, 2) fwd_kernel(Args args) {
    extern __shared__ __attribute__((aligned(16))) unsigned char lds_raw[];
    LAS unsigned char* lds0 = (LAS unsigned char*)lds_raw;
    cg::grid_group grid = cg::this_grid();
    { const unsigned* aw = (const unsigned*)&args; const int tid = threadIdx.x; if (tid < 54) ((LAS unsigned*)(lds0 + ARGS_LDS_OFF))[tid] = aw[tid];
      if (tid >= 64 && tid < 66) ((LAS unsigned*)(lds0 + ARGS_LDS_OFF + 256))[tid - 64] = 0u; }
    __syncthreads();
    XcdBarrier xbar = xcd_barrier_post((unsigned*)args.ws, (volatile LAS unsigned*)(lds0 + ARGS_LDS_OFF + 256), threadIdx.x == 0);
    const int ph_lo = args.ph_lo, ph_hi = args.ph_hi;
    const int wave0 = __builtin_amdgcn_readfirstlane((int)threadIdx.x >> 6);
#ifndef PROBE_MASK
#define PROBE_MASK 0
#endif
#ifndef PROBE_SUB
#define PROBE_SUB 0
#endif
#define SUBOFF(bit) (rep && ((PROBE_SUB) & (bit)))
#define PROBE_HIT(ph) ((PROBE_MASK) != 0 && ((ph) == 0 ? (((PROBE_MASK) >> 13) & 1) : (ph) == 53 ? (((PROBE_MASK) >> 14) & 1) : (((PROBE_MASK) >> (((ph) - 1) % 13)) & 1)))
    for (int ph2 = 2 * ph_lo; ph2 < 2 * ph_hi; ++ph2) {
        const int ph = ph2 >> 1, rep = ph2 & 1;
        if (rep && !PROBE_HIT(ph)) continue;
        if (ph2 != 2 * ph_lo) {
            if (ph_lo < 0) grid.sync();
            else { int mk2_ = -1; asm volatile("" : "+s"(mk2_)); const bool t0_ = (wave0 == 0) && (__builtin_amdgcn_mbcnt_hi(mk2_, __builtin_amdgcn_mbcnt_lo(mk2_, 0)) == 0); xcd_barrier(xbar, t0_); }
        }
#define PH_PROLOG int wv_ = wave0; int mk_ = -1; asm volatile("" : "+s"(wv_), "+s"(mk_)); int tid = wv_ * 64 + (int)__builtin_amdgcn_mbcnt_hi(mk_, __builtin_amdgcn_mbcnt_lo(mk_, 0)); int G = gridDim.x, bx = blockIdx.x; asm volatile("" : "+s"(G), "+s"(bx)); \
        unsigned ldsi = (unsigned)(unsigned long long)lds0; asm volatile("" : "+s"(ldsi)); LAS unsigned char* lds = (LAS unsigned char*)(unsigned long long)ldsi; \
        const AH AHv{(const LAS unsigned*)(lds + ARGS_LDS_OFF)}; const int lane = tid & 63, wave = wv_; \
        const int gw = bx * NWAVES + wave, NGW = G * NWAVES; (void)gw; (void)NGW; (void)lane; (void)wave; (void)G; (void)bx; (void)tid;
        if (EN(13) && ph == 0) { PH_PROLOG phase_p0(AHv, lds, tid, G); __syncthreads(); convert_layer(AHv, 0, 0, CV_NIT, lds, gw, NGW, wave, lane); }
        else if (EN(14) && ph == 53) { PH_PROLOG final_rows(AHv, gw, NGW, lane); }
        else {
            const int l = (ph - 1) / 13, k = (ph - 1) - l * 13; const bool last = (l == DEPTH - 1);
#define ws (AHv.ws())
#define HN ((bf16*)(ws + WS_HN))
#define Zb ((bf16*)(ws + WS_Z))
#define X ((float*)(ws + WS_X))
#define modbuf ((const float*)(ws + WS_MOD))
            if (EN(0) && k == 0) { PH_PROLOG norm_rows(AHv, l, 0, gw, NGW, lane, l > 0 ? 11 : 0, modbuf + (size_t)(l > 0 ? l - 1 : 0) * 5 * MODW + 4 * MODW + 2 * 3072 + 2048, 0.5f); }
            else if (EN(3) && k == 3) { PH_PROLOG norm_rows(AHv, l, 1, gw, NGW, lane, 11, modbuf + (size_t)l * 5 * MODW + 4 * MODW + 0 * 3072 + 2048, 0.5f); }
            else if (EN(10) && k == 10) { PH_PROLOG norm_rows(AHv, l, 2, gw, NGW, lane, last ? 0 : 4, modbuf + (size_t)l * 5 * MODW + 4 * MODW + 1 * 3072 + 2048, 1.0f); }
            else if (EN(1) && (k == 1 || k == 11)) { PH_PROLOG const int j = (k == 1) ? 0 : 1;
                pg8::Gemm gm{HN, (const bf16*)(ws + (size_t)(l & 1) * WS_WSET + WS_WFI) + (size_t)j * 5632 * 1024, MTOK, 5632, 1024};
                pg8::EpiSwiglu E{Zb};
                if (last && k == 11) { pg8::LastLayerOrder S; S.init(5632, G, bx, 0); pg8::gemm_phase<1024, pg8::EpiSwiglu, pg8::LastLayerOrder, true, true>(lds, gm, S, E, tid); }
                else { pg8::StaticOrder S; S.init(MTOK, 5632, G, bx); pg8::gemm_phase<1024, pg8::EpiSwiglu, pg8::StaticOrder, true, true>(lds, gm, S, E, tid); } }
            else if (EN(2) && (k == 2 || k == 12)) { PH_PROLOG const int j = (k == 2) ? 0 : 1, sub = (k == 2) ? 0 : 2;
                pg8::Gemm gm{Zb, (const bf16*)(ws + (size_t)(l & 1) * WS_WSET + WS_WFO) + (size_t)j * 1024 * DFF, MTOK, 1024, DFF};
                pg8::EpiResid E{X, modbuf + (size_t)l * 5 * MODW + sub * 3072 + 2048, rep ? 0.0f : 0.5f, (float*)(ws + WS_PARTC)};
                if (last && k == 12) { pg8::LatOrder S{G, bx}; pg8::gemm_phase<DFF, pg8::EpiResid, pg8::LatOrder, true, true>(lds, gm, S, E, tid); }
                else { pg8::SplitOrder S{G, bx, 11, 4}; pg8::gemm_phase<DFF, pg8::EpiResid, pg8::SplitOrder, true, true>(lds, gm, S, E, tid); } }
            else if (EN(4) && k == 4) { PH_PROLOG
                pg8::Gemm gm{HN, (const bf16*)(ws + (size_t)(l & 1) * WS_WSET + WS_WIN), MTOK, DIN, 1024};
                pg8::EpiZ E{Zb, DIN};
                if (last) { pg8::LastLayerOrder S; S.init(DIN, G, bx, 28); pg8::gemm_phase<1024, pg8::EpiZ, pg8::LastLayerOrder, true, true>(lds, gm, S, E, tid); }
                else { pg8::StaticOrder S; S.init(MTOK, DIN, G, bx); pg8::gemm_phase<1024, pg8::EpiZ, pg8::StaticOrder, true, true>(lds, gm, S, E, tid); } }
            else if (EN(5) && k == 5) { PH_PROLOG
                if (!SUBOFF(1)) prep_qk(AHv, l, gw, NGW, lane);
                if (!SUBOFF(2)) for (int it = bx; it < 544; it += G) ret_u_item(AHv, l, it, lds, tid, wave, lane);
                __syncthreads();
                if (!SUBOFF(4)) { PH_PROLOG
                    const int H = 2 * 272, n3 = (544 > 2 * G && 544 <= 3 * G) ? 544 - 2 * G : 0, nb = G - n3;
                    for (int hi = bx; hi < H; hi += (bx < n3) ? H : nb) { const int li = hi >> 1; lru_task<false>(AHv, l, li / 68, li % 68, wave, lds, wave, lane, hi & 1); } } }
            else if (EN(6) && k == 6) { PH_PROLOG
                for (int it = bx; it < 256; it += G) ret_scan_item(AHv, l, it, tid);
                lru_scan(AHv, tid, G);
                const int nunits = last ? 512 : 544;
                for (int i = 0;; ++i) { const int u = i * G + bx; if (u >= nunits) break;
                    long qrow0, kvrow0; int hq, kvh, NT;
                    if (u < 512) { const int combo = u & 7, j = u >> 3; const int b = combo >> 1; kvh = combo & 1; hq = kvh * 4 + (j & 3); const int qb = j >> 2;
                        qrow0 = (long)b * SROW + LCTX + qb * 256; kvrow0 = (long)b * SROW; NT = 68; }
                    else { const int v = u - 512; const int b = v >> 3; hq = v & 7; kvh = hq >> 2; qrow0 = (long)b * SROW; kvrow0 = qrow0; NT = 4; }
                    attn_body::attn_unit<8>(qrow0, kvrow0, hq, kvh, NT, (const attn_body::bf16*)(Zb + ZC_AQ), (const attn_body::bf16*)(ws + WS_KN), (const attn_body::bf16*)(Zb + ZC_AV),
                                            (attn_body::bf16*)((bf16*)(ws + WS_Y) + (size_t)2 * MTOK * 512), (char*)lds, tid,
                                            AHv.in(I_QG) + l * 64, (const float*)(ws + WS_ROPE) + 64 * 32 * 2, (u < 512) ? (long)(qrow0 - kvrow0 - LCTX) : -1L); } }
            else if ((EN(7) || EN(15)) && k == 7) { PH_PROLOG
                const int nret = last ? 512 : 544, nlru = last ? 256 : 272;
                if (EN(7) && !SUBOFF(8)) for (int it = bx; it < nret; it += G) { const int item = last ? ((it >> 5) * 34 + 2 + (it & 31)) : it; ret_out_item(AHv, l, item, lds, tid, wave, lane); }
                __syncthreads();
                if (EN(15) && !SUBOFF(16)) { PH_PROLOG
                    const int H = 2 * nlru, n3 = (nret > 2 * G && nret <= 3 * G) ? nret - 2 * G : 0, nb = G - n3;
                    for (int hi = bx; hi < H; hi += (bx < n3) ? H : nb) { const int li = hi >> 1; const int b = last ? (li >> 6) : (li / 68), c64 = last ? (4 + (li & 63)) : (li % 68);
                        lru_final(AHv, l, b, c64, wave, lds, wave, lane, hi & 1); } } }
            else if (EN(8) && k == 8) { PH_PROLOG
                pg8::Gemm gm{(const bf16*)(ws + WS_Y), (const bf16*)(ws + (size_t)(l & 1) * WS_WSET + WS_WB), 3 * MTOK, 3 * 1024, 512}; pg8::MergeOrder S{G, bx, last ? 1 : 0};
                pg8::EpiMerge E{Zb, HN};
                pg8::gemm_phase<512, pg8::EpiMerge, pg8::MergeOrder, true, true>(lds, gm, S, E, tid);
                if (!last) {
                    const int nsec = (272 > G) ? ((272 - G < G) ? 272 - G : 0) : 0;
                    if (bx >= nsec) convert_layer(AHv, l + 1, 0, CV_NIT, lds, (bx - nsec) * NWAVES + wave, (G - nsec) * NWAVES, wave, lane); } }
            else if (EN(9) && k == 9) { PH_PROLOG
                pg8::Gemm gm{HN, (const bf16*)(ws + (size_t)(l & 1) * WS_WSET + WS_WO), MTOK, 1024, 1024};
                pg8::EpiResid E{X, modbuf + (size_t)l * 5 * MODW + 1 * 3072 + 2048, rep ? 0.0f : 1.0f, (float*)(ws + WS_PARTC)};
                if (last) { pg8::LatOrder S{G, bx}; pg8::gemm_phase<1024, pg8::EpiResid, pg8::LatOrder, true, true>(lds, gm, S, E, tid); }
                else { pg8::SplitOrder S{G, bx, 4, 4}; pg8::gemm_phase<1024, pg8::EpiResid, pg8::SplitOrder, true, true>(lds, gm, S, E, tid); } }
        }
#undef ws
#undef HN
#undef Zb
#undef X
#undef modbuf
    }
}

#ifndef MK_N_LAUNCHES
#define MK_N_LAUNCHES 1
#endif
#if MK_N_LAUNCHES == 1
#define FULLK fwd_kernel<0xffff>
#else
template <int MASK> static void launch_one(int grid, const Args& a, hipStream_t stream) {
    static bool init = false;
    if (!init) { (void)hipFuncSetAttribute((const void*)fwd_kernel<MASK>, hipFuncAttributeMaxDynamicSharedMemorySize, LDS_BYTES); init = true; }
    hipLaunchKernelGGL(fwd_kernel<MASK>, dim3(grid), dim3(NWAVES * 64), LDS_BYTES, stream, a);
}
#endif
extern "C" void kernel_launch(void* const* d_in, const int* in_sizes, int n_in, void* d_out, int out_size, void* d_ws, size_t ws_size, hipStream_t stream) {
    static int grid = 0;
    if (grid == 0) {
        if (n_in != 24 || ws_size < WS_END) { fprintf(stderr, "kernel_launch: unexpected n_in %d / ws %zu (need %zu)\n", n_in, ws_size, (size_t)WS_END); grid = -1; return; }
        int dev = 0, cus = 0;
        (void)hipGetDevice(&dev); (void)hipDeviceGetAttribute(&cus, hipDeviceAttributeMultiprocessorCount, dev);
#if MK_N_LAUNCHES == 1
        int per_cu = 0;
        (void)hipFuncSetAttribute((const void*)FULLK, hipFuncAttributeMaxDynamicSharedMemorySize, LDS_BYTES);
        if (hipOccupancyMaxActiveBlocksPerMultiprocessor(&per_cu, (const void*)FULLK, NWAVES * 64, LDS_BYTES) != hipSuccess || per_cu < 1) per_cu = 1;
        (void)hipGetLastError();
        grid = cus * per_cu;
#else
        grid = cus;
#endif
        if (grid <= 0) grid = 256;
    }
    if (grid < 0) return;
    (void)hipMemsetAsync(d_ws, 0, 16384, stream);
    Args a{};
    for (int i = 0; i < 24; ++i) a.in[i] = (const float*)d_in[i];
    a.out = (float*)d_out; a.ws = (unsigned char*)d_ws;
#if MK_N_LAUNCHES == 1
    a.ph_lo = 0; a.ph_hi = 54;
    void* params[] = {(void*)&a};
    hipError_t e = hipLaunchCooperativeKernel((const void*)FULLK, dim3(grid), dim3(NWAVES * 64), params, LDS_BYTES, stream);
    if (e != hipSuccess) fprintf(stderr, "cooperative launch failed: %s (grid %d)\n", hipGetErrorString(e), grid);
#else
    for (int ph = 0; ph < 54; ++ph) { a.ph_lo = ph; a.ph_hi = ph + 1;
        if (ph == 0) { launch_one<1 << 13>(grid, a, stream); continue; }
        if (ph == 53) { launch_one<1 << 14>(grid, a, stream); continue; }
        const int k = (ph - 1) % 13;
        switch (k) {
            case 0: launch_one<1 << 0>(grid, a, stream); break;
            case 1: case 11: launch_one<1 << 1>(grid, a, stream); break;
            case 2: case 12: launch_one<1 << 2>(grid, a, stream); break;
            case 3: launch_one<1 << 3>(grid, a, stream); break;
            case 4: launch_one<1 << 4>(grid, a, stream); break;
            case 5: launch_one<1 << 5>(grid, a, stream); break;
            case 6: launch_one<1 << 6>(grid, a, stream); break;
            case 7: launch_one<1 << 7>(grid, a, stream); launch_one<1 << 15>(grid, a, stream); break;
            case 8: launch_one<1 << 8>(grid, a, stream); break;
            case 9: launch_one<1 << 9>(grid, a, stream); break;
            case 10: launch_one<1 << 10>(grid, a, stream); break;
        }
    }
#endif
}
```

```cpp
#include <hip/hip_runtime.h>
#include <hip/hip_cooperative_groups.h>
#include <hip/hip_bf16.h>
#include <cstdio>
#include <cstdint>
#include <cmath>
namespace cg = cooperative_groups;
namespace pg8 {
#define PG8_LAS __attribute__((address_space(3)))
typedef unsigned short bf16_t;
typedef short bf16x8 __attribute__((ext_vector_type(8)));
typedef float f32x4 __attribute__((ext_vector_type(4)));
typedef unsigned u32x4 __attribute__((ext_vector_type(4)));
constexpr int BM = 256, BK = 64, HALF = 128, HTB = HALF * BK * 2  , STAGE_BYTES = 8 * HTB, NXCD = 8, WGM = 4;

__host__ __device__ __forceinline__ int lds_byte(int r, int c) { const int st = (r >> 4) * 2 + (c >> 5), rr = r & 15, cc = c & 31, ob = rr * 64 + cc * 2; return st * 1024 + (ob ^ (((ob >> 9) & 1) << 5)); }
__host__ __device__ __forceinline__ void stage_rc(int b, int& R, int& C) { const int st = b / 1024, sb = b % 1024, swz = sb ^ (((sb >> 9) & 1) << 5); R = (st >> 1) * 16 + swz / 64; C = (st & 1) * 32 + (swz % 64) / 2; }
__host__ __device__ __forceinline__ int perm32(int rho) { const int n = rho >> 4, i = rho & 15; return 8 * (i >> 2) + 4 * n + (i & 3); }

struct Unit { int pm, pn, k0, nk; };
struct Gemm { const bf16_t* A; const bf16_t* Bt; int M, N, K; };

struct StaticOrder {
    int nM, nN, nwg, G, c;
    __host__ __device__ void init(int M, int N, int G_, int c_) { nM = M / BM; nN = N / BM; nwg = nM * nN; G = G_; c = c_; }
    __host__ __device__ bool next(int i, Unit& u) const {
        const long L = (long)i * G + c; if (L >= nwg) return false;
        int wgid = (int)L; { const int q = nwg / NXCD, r = nwg % NXCD, xcd = wgid % NXCD, off = wgid / NXCD; wgid = (xcd < r ? xcd * (q + 1) : r * (q + 1) + (xcd - r) * q) + off; }
        const int nig = WGM * nN, gid = wgid / nig, fm = gid * WGM, gsz = (nM - fm) < WGM ? (nM - fm) : WGM;
        u.pm = fm + ((wgid % nig) % gsz); u.pn = (wgid % nig) / gsz; u.k0 = 0; u.nk = 0; return true;
    }
    __device__ __forceinline__ void a_ready(const Unit&) const {}
    __device__ __forceinline__ void done(const Unit&) const {}
};

typedef unsigned u32x2 __attribute__((ext_vector_type(2)));
__device__ __forceinline__ unsigned cvt_pk_bf16(float lo, float hi) { unsigned r; asm volatile("v_cvt_pk_bf16_f32 %0, %1, %2" : "=v"(r) : "v"(lo), "v"(hi)); return r; }
__device__ __forceinline__ float fast_sigmoid(float v) { return __builtin_amdgcn_rcpf(1.0f + __expf(-v)); }
__device__ __forceinline__ float bf_lo(unsigned w) { return __uint_as_float(w << 16); }
__device__ __forceinline__ float bf_hi(unsigned w) { return __uint_as_float(w & 0xffff0000u); }
struct EpiZ {
    static constexpr bool PERM = true, AFTER_DRAIN = false, CHAIN = false;
    bf16_t* O; int ldc;
    __device__ __forceinline__ void operator()(const f32x4 (&acc)[2][2][4][2], const Unit& u, int wr, int wc, int fr, int fq) const {
        const int row0 = u.pm * BM + wr * 64 + fr; const int col0 = u.pn * BM + wc * 32 + 8 * fq;
#pragma unroll
        for (int ai = 0; ai < 2; ++ai)
#pragma unroll
            for (int m = 0; m < 4; ++m) { bf16_t* rowp = O + (size_t)(row0 + ai * HALF + m * 16) * ldc + col0;
#pragma unroll
                for (int bj = 0; bj < 2; ++bj) { const f32x4 v0 = acc[ai][bj][m][0], v1 = acc[ai][bj][m][1];
                    u32x4 w; w.x = cvt_pk_bf16(v0[0], v0[1]); w.y = cvt_pk_bf16(v0[2], v0[3]); w.z = cvt_pk_bf16(v1[0], v1[1]); w.w = cvt_pk_bf16(v1[2], v1[3]);
                    *(u32x4*)(rowp + bj * HALF) = w; } }
    }
};
struct EpiSwiglu {
    static constexpr bool PERM = true, AFTER_DRAIN = false, CHAIN = false;
    bf16_t* O;
    __device__ __forceinline__ void operator()(const f32x4 (&acc)[2][2][4][2], const Unit& u, int wr, int wc, int fr, int fq) const {
        const int row0 = u.pm * BM + wr * 64 + fr; const int col0 = u.pn * HALF + wc * 32 + 8 * fq;
#pragma unroll
        for (int ai = 0; ai < 2; ++ai)
#pragma unroll
            for (int m = 0; m < 4; ++m) { bf16_t* rowp = O + (size_t)(row0 + ai * HALF + m * 16) * 2816 + col0;
                float h[8];
#pragma unroll
                for (int n = 0; n < 2; ++n)
#pragma unroll
                    for (int j = 0; j < 4; ++j) { const float a = acc[ai][0][m][n][j], b = acc[ai][1][m][n][j]; h[n * 4 + j] = a * fast_sigmoid(a) * b; }
                u32x4 w; w.x = cvt_pk_bf16(h[0], h[1]); w.y = cvt_pk_bf16(h[2], h[3]); w.z = cvt_pk_bf16(h[4], h[5]); w.w = cvt_pk_bf16(h[6], h[7]);
                *(u32x4*)rowp = w; }
    }
};
struct EpiResid {
    static constexpr bool PERM = false, AFTER_DRAIN = false, CHAIN = false;
    float* X; const float* gate; float scale; float* PARTC;
    __device__ __forceinline__ void operator()(const f32x4 (&acc)[2][2][4][2], const Unit& u, int wr, int wc, int fr, int fq) const {
        const int bb = u.pm / 17, mrow = (u.pm - bb * 17 == 0) ? 4 : bb;
        const int col0 = u.pn * BM + wc * 32 + 4 * fq;
        if (u.nk != 0) {
            const int sp = u.k0 / (u.nk * 64); bf16_t* base = (bf16_t*)PARTC + ((size_t)sp * 1024 + (size_t)bb * 256 + wr * 64 + fr) * 1024 + col0;
#pragma unroll
            for (int ai = 0; ai < 2; ++ai)
#pragma unroll
                for (int m = 0; m < 4; ++m)
#pragma unroll
                    for (int bj = 0; bj < 2; ++bj)
#pragma unroll
                        for (int n = 0; n < 2; ++n) { const f32x4 v = acc[ai][bj][m][n]; u32x2 w; w.x = cvt_pk_bf16(v[0], v[1]); w.y = cvt_pk_bf16(v[2], v[3]);
                            *(u32x2*)(base + (size_t)(ai * HALF + m * 16) * 1024 + bj * HALF + n * 16) = w; }
            return; }
        const float* g = gate + (size_t)mrow * 9216;
        const int row0 = u.pm * BM + wr * 64 + fr;
        f32x4 gv[2][2];
#pragma unroll
        for (int bj = 0; bj < 2; ++bj)
#pragma unroll
            for (int n = 0; n < 2; ++n) gv[bj][n] = *(const f32x4*)(g + col0 + bj * HALF + n * 16) * scale;
#pragma unroll
        for (int ai = 0; ai < 2; ++ai)
#pragma unroll
            for (int m = 0; m < 4; ++m) { float* rowp = X + (size_t)(row0 + ai * HALF + m * 16) * 1024 + col0;
#pragma unroll
                for (int bj = 0; bj < 2; ++bj)
#pragma unroll
                    for (int n = 0; n < 2; ++n) { f32x4* p = (f32x4*)(rowp + bj * HALF + n * 16); *p = *p + gv[bj][n] * acc[ai][bj][m][n]; }
                asm volatile("" ::: "memory"); }
    }
};
struct EpiMerge {
    static constexpr bool PERM = false, AFTER_DRAIN = false, CHAIN = true;
    const bf16_t* Z; bf16_t* MG;
    __device__ __forceinline__ void operator()(const f32x4 (&acc)[2][2][4][2], const Unit& u, int wr, int wc, int fr, int fq) const {}
    __device__ __forceinline__ bool chain(f32x4 (&acc)[2][2][4][2], const Unit& u, int wr, int wc, int fr, int fq) const {
        const int n = u.pm / 68, pm = u.pm - n * 68, pn = u.pn & 3;
        const int row0 = pm * BM + wr * 64 + fr; const int col0 = pn * BM + wc * 32 + 4 * fq;
#pragma unroll
        for (int ai = 0; ai < 2; ++ai)
#pragma unroll
            for (int m = 0; m < 4; ++m) { const size_t row = (size_t)(row0 + ai * HALF + m * 16);
#pragma unroll
                for (int bj = 0; bj < 2; ++bj)
#pragma unroll
                    for (int nn = 0; nn < 2; ++nn) { const int col = col0 + bj * HALF + nn * 16;
                        const bf16_t* zp = Z + row * 6912 + 3840 + n * 1024 + col;
                        const u32x2 ga = *(const u32x2*)zp;
                        const float ea0 = 1.0f + __expf(-bf_lo(ga.x)), ea1 = 1.0f + __expf(-bf_hi(ga.x)), ea2 = 1.0f + __expf(-bf_lo(ga.y)), ea3 = 1.0f + __expf(-bf_hi(ga.y));
                        f32x4 sc;
                        if (n < 2) { const u32x2 gb = *(const u32x2*)(zp + 1024);
                            sc[0] = (1.0f + __expf(-bf_lo(gb.x))) * __builtin_amdgcn_rcpf(ea0); sc[1] = (1.0f + __expf(-bf_hi(gb.x))) * __builtin_amdgcn_rcpf(ea1);
                            sc[2] = (1.0f + __expf(-bf_lo(gb.y))) * __builtin_amdgcn_rcpf(ea2); sc[3] = (1.0f + __expf(-bf_hi(gb.y))) * __builtin_amdgcn_rcpf(ea3);
                            acc[ai][bj][m][nn] = acc[ai][bj][m][nn] * sc; }
                        else { sc[0] = __builtin_amdgcn_rcpf(ea0); sc[1] = __builtin_amdgcn_rcpf(ea1); sc[2] = __builtin_amdgcn_rcpf(ea2); sc[3] = __builtin_amdgcn_rcpf(ea3);
                            const f32x4 v = acc[ai][bj][m][nn] * sc; u32x2 w; w.x = cvt_pk_bf16(v[0], v[1]); w.y = cvt_pk_bf16(v[2], v[3]); *(u32x2*)(MG + row * 1024 + col) = w; } }
                asm volatile("" ::: "memory"); }
        return n < 2;
    }
};
struct MergeOrder {
    int G, c, latonly;
    __device__ bool next(int i, Unit& u) const {
        const int ti = i / 3, n = i - ti * 3; const int L = ti * G + c; if (L >= (latonly ? 256 : 272)) return false;
        const int t = L >> 2; const int pm = latonly ? ((t >> 4) * 17 + 1 + (t & 15)) : t;
        u.pm = n * 68 + pm; u.pn = n * 4 + (L & 3); u.k0 = 0; u.nk = 0; return true;
    }
    __device__ __forceinline__ void a_ready(const Unit&) const {}
    __device__ __forceinline__ void done(const Unit&) const {}
};
struct LastLayerOrder {
    StaticOrder so; int nextra;
    __device__ void init(int N, int G, int c, int nextra_) { so.init(64 * BM, N, G, c); nextra = nextra_; }
    __device__ bool next(int i, Unit& u) const {
        if (so.next(i, u)) { const int v = u.pm; u.pm = (v >> 4) * 17 + 1 + (v & 15); return true; }
        const int L = i * so.G + so.c - so.nwg; if (L < 0 || L >= nextra) return false;
        const int t = L / 7, q = L - t * 7; u.pm = t * 17; u.pn = (q < 4) ? 2 + q : (q < 6) ? 4 + q : 14; u.k0 = 0; u.nk = 0; return true;
    }
    __device__ __forceinline__ void a_ready(const Unit&) const {}
    __device__ __forceinline__ void done(const Unit&) const {}
};
struct LatOrder {
    int G, c;
    __device__ bool next(int i, Unit& u) const {
        const int L = i * G + c; if (L >= 256) return false;
        const int t = L >> 2; u.pm = (t >> 4) * 17 + 1 + (t & 15); u.pn = L & 3; u.k0 = 0; u.nk = 0; return true;
    }
    __device__ __forceinline__ void a_ready(const Unit&) const {}
    __device__ __forceinline__ void done(const Unit&) const {}
};
struct SplitOrder {
    int G, c, nsplit, nkt;
    __device__ bool next(int i, Unit& u) const {
        int L = i * G + c;
        if (L < 256) { const int t = L >> 2; u.pm = (t >> 4) * 17 + 1 + (t & 15); u.pn = L & 3; u.k0 = 0; u.nk = 0; return true; }
        L -= 256; if (L >= 16 * nsplit) return false;
        const int t = L / nsplit, s = L - t * nsplit;
        u.pm = (t >> 2) * 17; u.pn = t & 3; u.k0 = s * nkt * 64; u.nk = nkt; return true;
    }
    __device__ __forceinline__ void a_ready(const Unit&) const {}
    __device__ __forceinline__ void done(const Unit&) const {}
};
template <int KT, class Epi, class Sched, bool ALIGN_EPI = false, bool SP2 = false>
__device__ __forceinline__ void gemm_phase(PG8_LAS unsigned char* lds, const Gemm g, const Sched& S, const Epi& E, const int tid) {
    const int wid = __builtin_amdgcn_readfirstlane(tid >> 6), lane = tid & 63, wr = wid >> 2, wc = wid & 3, fr = lane & 15, fq = lane >> 4;
    constexpr int K = KT, nt = K / BK;
    unsigned voffA[2], voffB[2];
#pragma unroll
    for (int i = 0; i < 2; ++i) { int R, C; stage_rc(tid * 16 + i * 8192, R, C); const int Rb = Epi::PERM ? ((R & ~31) + perm32(R & 31)) : R;
        voffA[i] = (unsigned)(R * K + C) * 2u; voffB[i] = (unsigned)(Rb * K + C) * 2u; }
    const size_t kstep = (size_t)(BK * 2);
    const size_t hstep = (size_t)HALF * K * 2;
    const size_t tstep = 2 * hstep;
    const unsigned ldsw = (unsigned)wid * 1024u;
    const int aoff = lds_byte(wr * 64 + fr, fq * 8), boff = lds_byte(wc * 32 + fr, fq * 8);
#define PG8_SA(b, h) (((b) * 2 + (h)) * HTB)
#define PG8_SB(b, h) ((4 + (b) * 2 + (h)) * HTB)
#define PG8_STAGE(bufoff, gbase, voff) do { _Pragma("unroll") for (int _i = 0; _i < 2; ++_i) \
        __builtin_amdgcn_global_load_lds((const unsigned*)((const char*)(gbase) + (voff)[_i]), (PG8_LAS unsigned*)(lds + (bufoff) + ldsw + _i * 8192), 16, 0, 0); } while (0)
#define PG8_LDA(dst, b, h) do { _Pragma("unroll") for (int m = 0; m < 4; ++m) _Pragma("unroll") for (int k = 0; k < 2; ++k) dst[m][k] = *(const PG8_LAS bf16x8*)(lds + PG8_SA(b, h) + aoff + m * 2048 + k * 1024); } while (0)
#define PG8_LDB(dst, b, h) do { _Pragma("unroll") for (int n = 0; n < 2; ++n) _Pragma("unroll") for (int k = 0; k < 2; ++k) dst[n][k] = *(const PG8_LAS bf16x8*)(lds + PG8_SB(b, h) + boff + n * 2048 + k * 1024); } while (0)
#define PG8_MMA(ai, bj, At, Bt) do { __builtin_amdgcn_s_setprio(1); _Pragma("unroll") for (int m = 0; m < 4; ++m) _Pragma("unroll") for (int n = 0; n < 2; ++n) _Pragma("unroll") for (int k = 0; k < 2; ++k) \
        acc[ai][bj][m][n] = __builtin_amdgcn_mfma_f32_16x16x32_bf16(Bt[n][k], At[m][k], acc[ai][bj][m][n], 0, 0, 0); __builtin_amdgcn_s_setprio(0); } while (0)
#define PG8_WAIT_V(n) asm volatile("s_waitcnt vmcnt(" #n ")" ::: "memory")
#define PG8_WAIT_L(n) asm volatile("s_waitcnt lgkmcnt(" #n ")" ::: "memory")
#define PG8_BAR __builtin_amdgcn_s_barrier()
#define PG8_SCHED __builtin_amdgcn_sched_barrier(0)
    Unit cur{0, 0, 0, 0}, nxt{0, 0, 0, 0}; int ui = 0;
    if (!S.next(0, cur)) return;
    f32x4 acc[2][2][4][2];
#pragma unroll
    for (int a = 0; a < 2; ++a)
#pragma unroll
        for (int b = 0; b < 2; ++b)
#pragma unroll
            for (int m = 0; m < 4; ++m)
#pragma unroll
                for (int n = 0; n < 2; ++n) acc[a][b][m][n] = (f32x4){0.f, 0.f, 0.f, 0.f};
    bf16x8 At[4][2], B0[2][2], B1[2][2];
    const char* cA = (const char*)g.A + (size_t)cur.pm * tstep + (size_t)cur.k0 * 2; const char* cB = (const char*)g.Bt + (size_t)cur.pn * tstep + (size_t)cur.k0 * 2;
    S.a_ready(cur);
    if constexpr (SP2) {
        PG8_STAGE(PG8_SB(0, 0), cB, voffB); PG8_STAGE(PG8_SB(0, 1), cB + hstep, voffB); PG8_STAGE(PG8_SA(0, 0), cA, voffA); PG8_STAGE(PG8_SA(0, 1), cA + hstep, voffA);
        if (wr == 1) PG8_BAR;
        PG8_WAIT_V(2); PG8_BAR;
        PG8_STAGE(PG8_SB(1, 0), cB + kstep, voffB); PG8_STAGE(PG8_SA(1, 0), cA + kstep, voffA); PG8_STAGE(PG8_SB(1, 1), cB + hstep + kstep, voffB);
        PG8_WAIT_V(6); PG8_BAR;
    } else {
        PG8_STAGE(PG8_SB(0, 0), cB, voffB); PG8_STAGE(PG8_SA(0, 0), cA, voffA); PG8_STAGE(PG8_SB(0, 1), cB + hstep, voffB); PG8_STAGE(PG8_SA(0, 1), cA + hstep, voffA);
        if (wr == 1) PG8_BAR;
        PG8_WAIT_V(4); PG8_BAR;
        PG8_STAGE(PG8_SB(1, 0), cB + kstep, voffB); PG8_STAGE(PG8_SA(1, 0), cA + kstep, voffA); PG8_STAGE(PG8_SB(1, 1), cB + hstep + kstep, voffB);
        PG8_WAIT_V(6); PG8_BAR;
    }
    for (;;) {
        const bool has_next = S.next(ui + 1, nxt);
        const char* nA = has_next ? (const char*)g.A + (size_t)nxt.pm * tstep + (size_t)nxt.k0 * 2 : cA; const char* nB = has_next ? (const char*)g.Bt + (size_t)nxt.pn * tstep + (size_t)nxt.k0 * 2 : cB;
        const int ntu = cur.nk ? cur.nk : nt;
        for (int t = 0; t < ntu; t += 2) {
            const bool last = (t == ntu - 2);
            const char* a1 = cA + (size_t)(t + 1) * kstep;
            const char* a2 = last ? nA : cA + (size_t)(t + 2) * kstep; const char* b2 = last ? nB : cB + (size_t)(t + 2) * kstep;
            const char* a3 = a2 + kstep; const char* b3 = b2 + kstep;
            if (last && has_next) S.a_ready(nxt);
            if constexpr (SP2) {
            PG8_LDB(B0, 0, 0); PG8_LDB(B1, 0, 1); PG8_SCHED; PG8_LDA(At, 0, 0); PG8_STAGE(PG8_SA(1, 1), a1 + hstep, voffA);
            PG8_WAIT_V(8); PG8_WAIT_L(0); PG8_BAR; PG8_MMA(0, 0, At, B0); PG8_MMA(0, 1, At, B1); PG8_BAR; PG8_SCHED;
            PG8_LDA(At, 0, 1); PG8_STAGE(PG8_SB(0, 0), b2, voffB); PG8_STAGE(PG8_SB(0, 1), b2 + hstep, voffB); PG8_STAGE(PG8_SA(0, 0), a2, voffA);
            PG8_WAIT_V(8); PG8_WAIT_L(0); PG8_BAR; PG8_MMA(1, 0, At, B0); PG8_MMA(1, 1, At, B1); PG8_BAR; PG8_SCHED;
            PG8_LDB(B0, 1, 0); PG8_LDB(B1, 1, 1); PG8_SCHED; PG8_LDA(At, 1, 0); PG8_STAGE(PG8_SA(0, 1), a2 + hstep, voffA);
            PG8_WAIT_V(8); PG8_WAIT_L(0); PG8_BAR; PG8_MMA(0, 0, At, B0); PG8_MMA(0, 1, At, B1); PG8_BAR; PG8_SCHED;
            PG8_LDA(At, 1, 1); PG8_STAGE(PG8_SB(1, 0), b3, voffB); PG8_STAGE(PG8_SB(1, 1), b3 + hstep, voffB); PG8_STAGE(PG8_SA(1, 0), a3, voffA);
            PG8_WAIT_V(8); PG8_WAIT_L(0); PG8_BAR; PG8_MMA(1, 0, At, B0); PG8_MMA(1, 1, At, B1); PG8_BAR; PG8_SCHED;
            } else {
            PG8_LDB(B0, 0, 0); PG8_SCHED; PG8_LDA(At, 0, 0); PG8_STAGE(PG8_SA(1, 1), a1 + hstep, voffA);
            PG8_WAIT_L(8); PG8_BAR; PG8_WAIT_L(0); PG8_MMA(0, 0, At, B0); PG8_BAR; PG8_SCHED;
            PG8_LDB(B1, 0, 1); PG8_STAGE(PG8_SB(0, 0), b2, voffB);
            PG8_BAR; PG8_WAIT_L(0); PG8_MMA(0, 1, At, B1); PG8_BAR;
            PG8_LDA(At, 0, 1); PG8_STAGE(PG8_SA(0, 0), a2, voffA);
            PG8_BAR; PG8_WAIT_L(0); PG8_MMA(1, 0, At, B0); PG8_BAR; PG8_SCHED;
            PG8_STAGE(PG8_SB(0, 1), b2 + hstep, voffB);
            PG8_WAIT_V(6); PG8_BAR; PG8_MMA(1, 1, At, B1); PG8_BAR;
            PG8_LDB(B0, 1, 0); PG8_SCHED; PG8_LDA(At, 1, 0); PG8_STAGE(PG8_SA(0, 1), a2 + hstep, voffA);
            PG8_WAIT_L(8); PG8_BAR; PG8_WAIT_L(0); PG8_MMA(0, 0, At, B0); PG8_BAR; PG8_SCHED;
            PG8_LDB(B1, 1, 1); PG8_STAGE(PG8_SB(1, 0), b3, voffB);
            PG8_BAR; PG8_WAIT_L(0); PG8_MMA(0, 1, At, B1); PG8_BAR;
            PG8_LDA(At, 1, 1); PG8_STAGE(PG8_SA(1, 0), a3, voffA);
            PG8_BAR; PG8_WAIT_L(0); PG8_MMA(1, 0, At, B0); PG8_BAR; PG8_SCHED;
            PG8_STAGE(PG8_SB(1, 1), b3 + hstep, voffB);
            PG8_WAIT_V(6); PG8_BAR; PG8_MMA(1, 1, At, B1); PG8_BAR;
            }
        }
        if constexpr (ALIGN_EPI) { if (wr == 0) PG8_BAR; }
        bool keep_acc = false;
        if constexpr (!Epi::AFTER_DRAIN) { if constexpr (Epi::CHAIN) keep_acc = E.chain(acc, cur, wr, wc, fr, fq); else E(acc, cur, wr, wc, fr, fq); S.done(cur); }
        if (!has_next) break;
        if (!keep_acc) {
#pragma unroll
        for (int a = 0; a < 2; ++a)
#pragma unroll
            for (int b = 0; b < 2; ++b)
#pragma unroll
                for (int m = 0; m < 4; ++m)
#pragma unroll
                    for (int n = 0; n < 2; ++n) acc[a][b][m][n] = (f32x4){0.f, 0.f, 0.f, 0.f};
        }
        cur = nxt; cA = nA; cB = nB; ++ui;
        if constexpr (ALIGN_EPI) { if (wr == 1) PG8_BAR; }
    }
    PG8_WAIT_V(0);
    if constexpr (!ALIGN_EPI) { if (wr == 0) PG8_BAR; }
    PG8_BAR;
    if constexpr (Epi::AFTER_DRAIN) { E.fused(acc, cur, wr, wc, fr, fq, lds, wid, lane); S.done(cur); }
#undef PG8_SA
#undef PG8_SB
#undef PG8_STAGE
#undef PG8_LDA
#undef PG8_LDB
#undef PG8_MMA
#undef PG8_WAIT_V
#undef PG8_WAIT_L
#undef PG8_BAR
#undef PG8_SCHED
}
}
namespace attn_body {
using bf16=__hip_bfloat16;
using bf16x8=__attribute__((ext_vector_type(8)))short;
using s16x4=__attribute__((ext_vector_type(4)))short;
using f32x16=__attribute__((ext_vector_type(16)))float;
using u32x4=__attribute__((ext_vector_type(4)))unsigned;
constexpr int D=64,QP=512,KP=128,VP=6912,OP=512;
constexpr int NW=8,QBLK=32,QB=QBLK*NW,KVBLK=64;
__device__ __forceinline__ int crow(int r,int hi){return (r&3)+8*(r>>2)+4*hi;}
#define SBAR() __builtin_amdgcn_sched_barrier(0)
constexpr int NSLOT=3, SLOTB=8192;
constexpr int LDS_K=0, LDS_V=NSLOT*SLOTB, LDS_WS=2*NSLOT*SLOTB, LDS_OST=LDS_WS+NW*64*4, LDS_BYTES=LDS_OST+NW*4096;
constexpr float C2=0.125f*1.4426950408889634f;
__device__ __forceinline__ void glds16(const void*gsrc,unsigned lds_dst){unsigned keep;
  asm volatile("s_mov_b32 %0, m0\n\ts_mov_b32 m0, %2\n\ts_nop 0\n\tglobal_load_lds_dwordx4 %1, off\n\ts_mov_b32 m0, %0":"=&s"(keep):"v"(gsrc),"s"(lds_dst):"memory");}
__device__ __forceinline__ float max3f(float a,float b,float c){float r;asm("v_max3_f32 %0, %1, %2, %3":"=v"(r):"v"(a),"v"(b),"v"(c));return r;}
__device__ __forceinline__ float max2f(float a,float b){float r;asm("v_max_f32_e32 %0, %1, %2":"=v"(r):"v"(a),"v"(b));return r;}
__device__ __forceinline__ float fadd_s(float a,float b){float r;asm("v_add_f32_e32 %0, %1, %2":"=v"(r):"v"(a),"v"(b));return r;}
__device__ __forceinline__ float fsub_s(float a,float b){float r;asm("v_sub_f32_e32 %0, %1, %2":"=v"(r):"v"(a),"v"(b));return r;}
typedef float f32x2_t __attribute__((ext_vector_type(2))); typedef __bf16 bf16x2_t __attribute__((ext_vector_type(2)));
__device__ __forceinline__ unsigned cvtpk_s(float lo,float hi){f32x2_t v={lo,hi};bf16x2_t b=__builtin_convertvector(v,bf16x2_t);return __builtin_bit_cast(unsigned,b);}
#define WAIT_BAR(N) asm volatile("s_waitcnt vmcnt(" #N ") lgkmcnt(0)\n\ts_barrier":::"memory")

__device__ __forceinline__ void qkt(f32x16&p0,f32x16&p1,const char*Kslot,const bf16x8*qr,const f32x16&negm,int r32,int hi){
  const char*kb=Kslot+hi*1024+r32*16;
  #pragma unroll
  for(int d0=0;d0<4;++d0){
    const bf16x8 b0=*reinterpret_cast<const bf16x8*>(kb+d0*2048);
    const bf16x8 b1=*reinterpret_cast<const bf16x8*>(kb+d0*2048+512);
    if(d0==0){p0=__builtin_amdgcn_mfma_f32_32x32x16_bf16(b0,qr[0],negm,0,0,0);p1=__builtin_amdgcn_mfma_f32_32x32x16_bf16(b1,qr[0],negm,0,0,0);}
    else{p0=__builtin_amdgcn_mfma_f32_32x32x16_bf16(b0,qr[d0],p0,0,0,0);p1=__builtin_amdgcn_mfma_f32_32x32x16_bf16(b1,qr[d0],p1,0,0,0);}}
}
typedef __attribute__((address_space(3))) const char* lds_cptr;
typedef short v4i16_t __attribute__((ext_vector_type(4)));
__device__ __forceinline__ void kload8(bf16x8*kf,lds_cptr kp){
  kf[0]=*(const __attribute__((address_space(3))) bf16x8*)(kp);      kf[1]=*(const __attribute__((address_space(3))) bf16x8*)(kp+512);
  kf[2]=*(const __attribute__((address_space(3))) bf16x8*)(kp+2048); kf[3]=*(const __attribute__((address_space(3))) bf16x8*)(kp+2560);
  kf[4]=*(const __attribute__((address_space(3))) bf16x8*)(kp+4096); kf[5]=*(const __attribute__((address_space(3))) bf16x8*)(kp+4608);
  kf[6]=*(const __attribute__((address_space(3))) bf16x8*)(kp+6144); kf[7]=*(const __attribute__((address_space(3))) bf16x8*)(kp+6656);
}
__device__ __forceinline__ void kload2(bf16x8*kf,lds_cptr kp,int j){ kf[2*j]=*(const __attribute__((address_space(3))) bf16x8*)(kp+j*2048); kf[2*j+1]=*(const __attribute__((address_space(3))) bf16x8*)(kp+j*2048+512); }
__device__ __forceinline__ s16x4 vtr(lds_cptr p){ return __builtin_bit_cast(s16x4,__builtin_amdgcn_ds_read_tr16_b64_v4i16((__attribute__((address_space(3))) v4i16_t*)p)); }
__device__ __forceinline__ float rowmax(const f32x16&p0,const f32x16&p1){
  float a=max3f(p0[0],p0[1],p1[0]),b=max3f(p0[2],p0[3],p1[1]);a=max3f(a,p1[2],p1[3]);
  #pragma unroll
  for(int r=4;r<16;r+=4){a=max3f(a,p0[r],p0[r+1]);b=max3f(b,p0[r+2],p0[r+3]);a=max3f(a,p1[r],p1[r+1]);b=max3f(b,p1[r+2],p1[r+3]);}
  const float m=max2f(a,b);
  auto rr=__builtin_amdgcn_permlane32_swap(__float_as_uint(m),__float_as_uint(m),false,false);
  return max2f(__uint_as_float(rr[0]),__uint_as_float(rr[1]));
}
__device__ __forceinline__ void pv(f32x16*o,int vb,bf16x8 pa0,bf16x8 pa1,bf16x8 pa2,bf16x8 pa3){
  #pragma unroll
  for(int d0=0;d0<2;++d0){s16x4 lo[4],hi[4];
    #pragma unroll
    for(int ks=0;ks<4;++ks){
      asm volatile("ds_read_b64_tr_b16 %0,%1 offset:%c2":"=&v"(lo[ks]):"v"(vb),"i"(d0*4096+ks*1024):"memory");
      asm volatile("ds_read_b64_tr_b16 %0,%1 offset:%c2":"=&v"(hi[ks]):"v"(vb),"i"(d0*4096+ks*1024+512):"memory");}
    asm volatile("s_waitcnt lgkmcnt(0)":::"memory");SBAR();
    #define PK(k) (bf16x8){lo[k][0],lo[k][1],lo[k][2],lo[k][3],hi[k][0],hi[k][1],hi[k][2],hi[k][3]}
    o[d0]=__builtin_amdgcn_mfma_f32_32x32x16_bf16(pa0,PK(0),o[d0],0,0,0);
    o[d0]=__builtin_amdgcn_mfma_f32_32x32x16_bf16(pa1,PK(1),o[d0],0,0,0);
    o[d0]=__builtin_amdgcn_mfma_f32_32x32x16_bf16(pa2,PK(2),o[d0],0,0,0);
    o[d0]=__builtin_amdgcn_mfma_f32_32x32x16_bf16(pa3,PK(3),o[d0],0,0,0);
    #undef PK
  }
}

#ifndef ATTN_STORE16
#define ATTN_STORE16(p,v) (*(u32x4*)(p)=(v))
#endif
template<int THRL> __device__ __forceinline__ void attn_unit(long qrow0,long kvrow0,int hq,int kvh,int NT,const bf16*Q,const bf16*__restrict__ K,const bf16*__restrict__ V,bf16*O,char*shm,const int tid,const float*gqp,const float*rbp,long tq){
  const int lane=tid&63,r32=lane&31,hi=lane>>5; const int wid=__builtin_amdgcn_readfirstlane(tid>>6);
  const bf16*Qw=Q+(qrow0+wid*QBLK)*QP+hq*D;
  const bf16*Kh=K+kvrow0*KP+kvh*D,*Vh=V+kvrow0*VP+kvh*D;
  const unsigned lds0=(unsigned)(uintptr_t)shm;
  float*wsf=(float*)(shm+LDS_WS)+wid*64;
  const bf16*ksrc=Kh+(long)lane*KP+wid*8;
  const bf16*vsrc=Vh+(long)(16*(wid&3)+(lane>>2))*VP+(wid>>2)*32+(lane&3)*8;
  const unsigned kdst=lds0+LDS_K+wid*1024, vdst=lds0+LDS_V+wid*1024;
  #define DMA_K(t,slot) glds16(ksrc+(long)(t)*KVBLK*KP,(unsigned)__builtin_amdgcn_readfirstlane(kdst+(slot)))
  #define DMA_V(t,slot) glds16(vsrc+(long)(t)*KVBLK*VP,(unsigned)__builtin_amdgcn_readfirstlane(vdst+(slot)))
  const int vb0=(int)(lds0+LDS_V)+((lane>>4)&1)*32+(lane&3)*8+(4*hi+((lane&15)>>2))*64;
  const char*Kbase=shm+LDS_K; bf16x8 kf[8];
  const lds_cptr shm3=(lds_cptr)shm; const lds_cptr kp0=shm3+LDS_K+hi*1024+r32*16; const lds_cptr vp0=shm3+LDS_V+((lane>>4)&1)*32+(lane&3)*8+(4*hi+((lane&15)>>2))*64;
  DMA_K(0,0);DMA_V(0,0);DMA_K(1,SLOTB);
  bf16x8 qr[4];
  { const bf16*Zq=Q+(qrow0+wid*QBLK+r32)*(long)VP+hq*D; float f[4][8]; float ss=0.f;
    #pragma unroll
    for(int d0=0;d0<4;++d0){ const bf16x8 raw=*reinterpret_cast<const bf16x8*>(Zq+d0*16+hi*8);
      #pragma unroll
      for(int j=0;j<8;++j){ f[d0][j]=__uint_as_float(((unsigned)(unsigned short)raw[j])<<16); ss+=f[d0][j]*f[d0][j]; } }
    { auto rr=__builtin_amdgcn_permlane32_swap(__float_as_uint(ss),__float_as_uint(ss),false,false); ss=__uint_as_float(rr[0])+__uint_as_float(rr[1]); }
    const float rstd=__builtin_amdgcn_rsqf(ss*(1.0f/64.0f)+1e-6f);
    #pragma unroll
    for(int d0=0;d0<4;++d0){ const float*gp=gqp+d0*16+hi*8;
      #pragma unroll
      for(int j=0;j<8;++j) f[d0][j]*=rstd*gp[j]; }
    if(tq>=0){ const long t=tq+wid*QBLK+r32; const int prow=(int)(t>>6), pcol=(int)(t&63);
      const float*tr=rbp+(prow*16+hi*8)*2; const float*tc=rbp+(pcol*16+hi*8)*2;
      #pragma unroll
      for(int j=0;j<8;++j){ const float cs=tr[2*j],sn=tr[2*j+1]; const float x1=f[0][j],x2=f[1][j]; f[0][j]=x1*cs-x2*sn; f[1][j]=x1*sn+x2*cs;
                            const float cc=tc[2*j],sc=tc[2*j+1]; const float y1=f[2][j],y2=f[3][j]; f[2][j]=y1*cc-y2*sc; f[3][j]=y1*sc+y2*cc; } }
    #pragma unroll
    for(int d0=0;d0<4;++d0){ u32x4 w; w.x=cvtpk_s(f[d0][0]*C2,f[d0][1]*C2); w.y=cvtpk_s(f[d0][2]*C2,f[d0][3]*C2); w.z=cvtpk_s(f[d0][4]*C2,f[d0][5]*C2); w.w=cvtpk_s(f[d0][6]*C2,f[d0][7]*C2);
      qr[d0]=__builtin_bit_cast(bf16x8,w); } }
  float mhat=0.f,l_reg=0.f;float z0_=0.f;asm volatile("":"+v"(z0_));f32x16 o[2];f32x16 negm;
  #pragma unroll
  for(int r=0;r<16;++r){o[0][r]=z0_;o[1][r]=z0_;negm[r]=z0_;}
  asm volatile("":"+v"(negm));
  #define CMASK(P0,P1,t) do{}while(0)
  bool resc=false;
  #define START(P0,P1) do{ const float rm=rowmax(P0,P1); resc=false; \
    { const float dl=rm; mhat=fadd_s(mhat,dl); \
      _Pragma("unroll") for(int r=0;r<16;++r){P0[r]=fsub_s(P0[r],dl);P1[r]=fsub_s(P1[r],dl);} \
      _Pragma("unroll") for(int r=0;r<16;++r)negm[r]=-mhat; asm volatile("":"+v"(negm)); } \
    _Pragma("unroll") for(int r=0;r<16;++r)P0[r]=__builtin_amdgcn_exp2f(P0[r]); }while(0)
  #define RESC() do{ if(resc){ asm volatile("s_waitcnt lgkmcnt(0)":::"memory"); \
      _Pragma("unroll") for(int d_=0;d_<2;++d_) _Pragma("unroll") for(int r=0;r<16;++r)o[d_][r]*=wsf[crow(r,hi)]; } }while(0)
  f32x16 pA0,pA1,pB0,pB1;
  int sl_prev=0,sl_cur=0,sl_next=SLOTB;
  #define ROT() do{sl_prev=sl_cur;sl_cur=sl_next;sl_next=(sl_next==(NSLOT-1)*SLOTB)?0:sl_next+SLOTB;}while(0)
  DMA_K(2,2*SLOTB);
  WAIT_BAR(3);
  qkt(pA0,pA1,Kbase,qr,negm,r32,hi);asm volatile("s_nop 15\n\ts_nop 7":"+v"(pA0),"+v"(pA1));CMASK(pA0,pA1,0);
  START(pA0,pA1);
  _Pragma("unroll") for(int r=0;r<16;++r)pA1[r]=__builtin_amdgcn_exp2f(pA1[r]);
  WAIT_BAR(0);
  DMA_K(3,0);DMA_V(1,SLOTB);
  ROT();
  kload8(kf,kp0+sl_cur);
  WAIT_BAR(2);
  s16x4 vlo[8],vhi[8]; u32x4 pw0,pw1,pw2,pw3;
  #define PKW(P,B) cvtpk_s(P[B],P[B+1])
  #define PAF(k) __builtin_bit_cast(bf16x8,pw##k)
  #define VFR(i) (bf16x8){vlo[i][0],vlo[i][1],vlo[i][2],vlo[i][3],vhi[i][0],vhi[i][1],vhi[i][2],vhi[i][3]}
  #define PIN(x) asm volatile("":"+v"(x))
  #define MX3(a,b,c) __builtin_fmaxf(__builtin_fmaxf((a),(b)),(c))
  #define GAPA(MF,A0,A1,A2,A3,W0,W1,PW) do{ MF; sacc+=A0; sacc+=A1; sacc+=A2; sacc+=A3; PIN(sacc); W0; W1; PIN(PW); SBAR(); }while(0)
  #define EX(v) __builtin_amdgcn_exp2f(v)
  #define GAPB(MF,X,B) do{ MF; X[B]=EX(X[B]); X[B+1]=EX(X[B+1]); X[B+2]=EX(X[B+2]); X[B+3]=EX(X[B+3]); PIN(X); SBAR(); }while(0)
  #define VRD(i) do{ vlo[i]=vtr(vp_+(((i)>>2)*4096+((i)&3)*1024)); vhi[i]=vtr(vp_+(((i)>>2)*4096+((i)&3)*1024+512)); }while(0)
  #define KRD(G,j) do{ if(G){ kload2(kf,kp0+sl_next,j); SBAR(); } }while(0)
  #define STEP(C0,C1,P0,P1,t,GK,GV,GL) do{ SBAR(); \
    const lds_cptr vp_=vp0+sl_prev; \
    VRD(0); SBAR(); float sacc=(P0[0]+P0[1]); \
    GAPA(C0=__builtin_amdgcn_mfma_f32_32x32x16_bf16(kf[0],qr[0],negm,0,0,0), P0[2],P0[3],P0[4],P0[5],     pw0[0]=PKW(P0,0), pw0[1]=PKW(P0,2), pw0); \
    VRD(4); SBAR(); GAPA(C1=__builtin_amdgcn_mfma_f32_32x32x16_bf16(kf[1],qr[0],negm,0,0,0), P0[6],P0[7],P0[8],P0[9],     pw0[2]=PKW(P0,4), pw0[3]=PKW(P0,6), pw0); \
    VRD(1); SBAR(); GAPA(C0=__builtin_amdgcn_mfma_f32_32x32x16_bf16(kf[2],qr[1],C0,0,0,0),   P0[10],P0[11],P0[12],P0[13], pw1[0]=PKW(P0,8), pw1[1]=PKW(P0,10), pw1); \
    VRD(5); SBAR(); GAPA(C1=__builtin_amdgcn_mfma_f32_32x32x16_bf16(kf[3],qr[1],C1,0,0,0),   P0[14],P0[15],P1[0],P1[1],   pw1[2]=PKW(P0,12),pw1[3]=PKW(P0,14), pw1); \
    VRD(2); SBAR(); GAPA(C0=__builtin_amdgcn_mfma_f32_32x32x16_bf16(kf[4],qr[2],C0,0,0,0),   P1[2],P1[3],P1[4],P1[5],     pw2[0]=PKW(P1,0), pw2[1]=PKW(P1,2), pw2); \
    VRD(6); SBAR(); GAPA(C1=__builtin_amdgcn_mfma_f32_32x32x16_bf16(kf[5],qr[2],C1,0,0,0),   P1[6],P1[7],P1[8],P1[9],     pw2[2]=PKW(P1,4), pw2[3]=PKW(P1,6), pw2); \
    VRD(3); SBAR(); GAPA(C0=__builtin_amdgcn_mfma_f32_32x32x16_bf16(kf[6],qr[3],C0,0,0,0),   P1[10],P1[11],P1[12],P1[13], pw3[0]=PKW(P1,8), pw3[1]=PKW(P1,10), pw3); \
    VRD(7); SBAR(); GAPA(C1=__builtin_amdgcn_mfma_f32_32x32x16_bf16(kf[7],qr[3],C1,0,0,0),   P1[14],P1[15],0.f,0.f,       pw3[2]=PKW(P1,12),pw3[3]=PKW(P1,14), pw3); \
    l_reg+=sacc; \
    if(GK){DMA_K((t)+3,sl_cur);} if(GV){DMA_V((t)+1,sl_next);} \
    CMASK(C0,C1,t); \
    { float a=MX3(C0[0],C0[1],C1[0]),b=MX3(C0[2],C0[3],C1[1]); a=MX3(a,C1[2],C1[3]); \
      _Pragma("unroll") for(int r=4;r<16;r+=4){a=MX3(a,C0[r],C0[r+1]);b=MX3(b,C0[r+2],C0[r+3]);a=MX3(a,C1[r],C1[r+1]);b=MX3(b,C1[r+2],C1[r+3]);} \
      float rm=__builtin_fmaxf(a,b); { auto rr=__builtin_amdgcn_permlane32_swap(__float_as_uint(rm),__float_as_uint(rm),false,false); rm=__builtin_fmaxf(__uint_as_float(rr[0]),__uint_as_float(rr[1])); } \
      resc=false; \
      if(__builtin_expect(__any(rm>(float)THRL),0)){ const float dl=__builtin_fmaxf(rm,0.f); mhat+=dl; \
        _Pragma("unroll") for(int r=0;r<16;++r){C0[r]-=dl;C1[r]-=dl;} \
        _Pragma("unroll") for(int r=0;r<16;++r)negm[r]=-mhat; asm volatile("":"+v"(negm)); \
        const float f=__builtin_amdgcn_exp2f(-dl); l_reg*=f; if(hi==0)wsf[r32]=f; resc=true; } } \
    SBAR(); \
    GAPB(o[0]=__builtin_amdgcn_mfma_f32_32x32x16_bf16(PAF(0),VFR(0),o[0],0,0,0), C0,0); \
    GAPB(o[1]=__builtin_amdgcn_mfma_f32_32x32x16_bf16(PAF(0),VFR(4),o[1],0,0,0), C0,4); \
    KRD(GL,0); GAPB(o[0]=__builtin_amdgcn_mfma_f32_32x32x16_bf16(PAF(1),VFR(1),o[0],0,0,0), C0,8); \
    KRD(GL,1); GAPB(o[1]=__builtin_amdgcn_mfma_f32_32x32x16_bf16(PAF(1),VFR(5),o[1],0,0,0), C0,12); \
    KRD(GL,2); GAPB(o[0]=__builtin_amdgcn_mfma_f32_32x32x16_bf16(PAF(2),VFR(2),o[0],0,0,0), C1,0); \
    KRD(GL,3); GAPB(o[1]=__builtin_amdgcn_mfma_f32_32x32x16_bf16(PAF(2),VFR(6),o[1],0,0,0), C1,4); \
    GAPB(o[0]=__builtin_amdgcn_mfma_f32_32x32x16_bf16(PAF(3),VFR(3),o[0],0,0,0), C1,8); \
    GAPB(o[1]=__builtin_amdgcn_mfma_f32_32x32x16_bf16(PAF(3),VFR(7),o[1],0,0,0), C1,12); \
    }while(0)
  int t=1;
  #undef CMASK
  #define CMASK(P0,P1,t) do{}while(0)
  for(;t+5<NT;t+=2){
    STEP(pB0,pB1,pA0,pA1,t,true,true,true);     WAIT_BAR(2); RESC(); ROT();
    STEP(pA0,pA1,pB0,pB1,t+1,true,true,true);   WAIT_BAR(2); RESC(); ROT();
  }
  #undef CMASK
  #define CMASK(P0,P1,t) do{}while(0)
  #define ENDW(tt) do{ if((tt)+3<NT){WAIT_BAR(2);} else if((tt)+2<NT){WAIT_BAR(1);} else {WAIT_BAR(0);} }while(0)
  for(;t+1<NT;t+=2){
    STEP(pB0,pB1,pA0,pA1,t,(t+3<NT),(t+1<NT),(t+1<NT));       ENDW(t);   RESC(); ROT();
    STEP(pA0,pA1,pB0,pB1,t+1,(t+4<NT),(t+2<NT),(t+2<NT));     ENDW(t+1); RESC(); ROT();
  }
  STEP(pB0,pB1,pA0,pA1,NT-1,false,false,false); RESC();
  { float sacc=pB0[0]+pB0[1]; _Pragma("unroll") for(int r=2;r<16;++r)sacc+=pB0[r]; _Pragma("unroll") for(int r=0;r<16;++r)sacc+=pB1[r]; l_reg+=sacc;
    pw0=(u32x4){PKW(pB0,0),PKW(pB0,2),PKW(pB0,4),PKW(pB0,6)};pw1=(u32x4){PKW(pB0,8),PKW(pB0,10),PKW(pB0,12),PKW(pB0,14)};pw2=(u32x4){PKW(pB1,0),PKW(pB1,2),PKW(pB1,4),PKW(pB1,6)};pw3=(u32x4){PKW(pB1,8),PKW(pB1,10),PKW(pB1,12),PKW(pB1,14)};
    SBAR(); pv(o,vb0+sl_cur,PAF(0),PAF(1),PAF(2),PAF(3)); }
  #undef PKW
  #undef PAF
  #undef VFR
  #undef PIN
  #undef MX3
  #undef GAPA
  #undef GAPB
  #undef EX
  #undef VRD
  #undef KRD
  #undef STEP
  #undef ENDW
  {auto rr=__builtin_amdgcn_permlane32_swap(__float_as_uint(l_reg),__float_as_uint(l_reg),false,false);l_reg=__uint_as_float(rr[0])+__uint_as_float(rr[1]);}
  if(hi==0)wsf[32+r32]=l_reg;asm volatile("s_waitcnt lgkmcnt(0)":::"memory");
  float rli[16];
  #pragma unroll
  for(int r=0;r<16;++r)rli[r]=__builtin_amdgcn_rcpf(wsf[32+crow(r,hi)]);
  bf16*Ow=O+(qrow0+wid*QBLK)*OP+hq*D;
  { bf16*stg=(bf16*)(shm+LDS_OST)+wid*2048;
    #pragma unroll
    for(int r=0;r<16;++r){const int orow=crow(r,hi);
      #pragma unroll
      for(int d0=0;d0<2;++d0)stg[orow*64+d0*32+r32]=__float2bfloat16(o[d0][r]*rli[r]);}
    asm volatile("s_waitcnt lgkmcnt(0)":::"memory");
    #pragma unroll
    for(int i=0;i<4;++i){const int row=i*8+(lane>>3),ch=lane&7; const u32x4 v=*(const u32x4*)(stg+row*64+ch*8); ATTN_STORE16(Ow+(long)row*OP+ch*8,v);} }
  asm volatile("s_waitcnt lgkmcnt(0)\n\ts_barrier":::"memory");
  #undef DMA_K
  #undef DMA_V
  #undef CMASK
  #undef START
  #undef RESC
  #undef ROT
}
constexpr int ATTN_LDS_BYTES=LDS_BYTES;
#undef SBAR
#undef WAIT_BAR
}
#define LAS __attribute__((address_space(3)))
typedef unsigned short bf16;
typedef unsigned v4u __attribute__((ext_vector_type(4)));
typedef unsigned v2u __attribute__((ext_vector_type(2)));
typedef float f32x4 __attribute__((ext_vector_type(4)));
typedef short bf16x8 __attribute__((ext_vector_type(8)));
constexpr int NWAVES = 8;
constexpr int NB = 4, LAT = 4096, LCTX = 256, SROW = 4352, MTOK = 17408, DMODEL = 1024, DEPTH = 4, DFF = 2816, DIN = 6912, MODW = 9216;
constexpr int ZC_RQ = 0, ZC_RK = 512, ZC_RV = 1024, ZC_RG = 1536, ZC_LX = 2048, ZC_LZ = 2560, ZC_AQ = 3072, ZC_AK = 3584, ZC_AV = 3712, ZC_GT = 3840;
constexpr float NORM_EPS = 1e-6f;
constexpr size_t MiB = 1u << 20;
constexpr size_t WS_MOD = 1 * MiB, WS_ROPE = 2 * MiB, WS_SUMM = 3 * MiB, WS_HIN = 6 * MiB;
constexpr size_t WS_WSET = 54 * MiB;
constexpr size_t WS_WFI = 8 * MiB;
constexpr size_t WS_WFO = 30 * MiB;
constexpr size_t WS_WIN = 41 * MiB;
constexpr size_t WS_WB = 55 * MiB;
constexpr size_t WS_WO = 58 * MiB;
constexpr size_t WS_LRUW = 60 * MiB;
constexpr size_t WS_X = 116 * MiB;
constexpr size_t WS_HN = 184 * MiB;
constexpr size_t WS_Z = 218 * MiB;
constexpr size_t WS_QN = 448 * MiB;
constexpr size_t WS_KN = 465 * MiB;
constexpr size_t WS_Y = 470 * MiB;
constexpr size_t WS_U = 521 * MiB;
constexpr size_t WS_SIN = 589 * MiB;
constexpr size_t WS_PARTC = 624 * MiB;
constexpr size_t WS_END = 670 * MiB;
constexpr int LDS_BYTES = 147456;

__device__ __forceinline__ unsigned f2bf(float f) { unsigned u = __builtin_bit_cast(unsigned, f); return (u + 0x7fffu + ((u >> 16) & 1u)) >> 16; }
__device__ __forceinline__ unsigned pk2(float lo, float hi) { return f2bf(lo) | (f2bf(hi) << 16); }
__device__ __forceinline__ float bflo(unsigned w) { return __uint_as_float(w << 16); }
__device__ __forceinline__ float bfhi(unsigned w) { return __uint_as_float(w & 0xffff0000u); }
__device__ __forceinline__ float bf1(bf16 h) { return __uint_as_float(((unsigned)h) << 16); }
__device__ __forceinline__ void unpack8(const v4u w, float* f) { f[0] = bflo(w.x); f[1] = bfhi(w.x); f[2] = bflo(w.y); f[3] = bfhi(w.y); f[4] = bflo(w.z); f[5] = bfhi(w.z); f[6] = bflo(w.w); f[7] = bfhi(w.w); }
__device__ __forceinline__ float sigmoidf_(float v) { return __builtin_amdgcn_rcpf(1.0f + __expf(-v)); }
__device__ __forceinline__ float shx(float v, int m, int lane) { return __builtin_bit_cast(float, __builtin_amdgcn_ds_bpermute((lane ^ m) << 2, __builtin_bit_cast(int, v))); }
__device__ __forceinline__ float shi(float v, int src) { return __builtin_bit_cast(float, __builtin_amdgcn_ds_bpermute(src << 2, __builtin_bit_cast(int, v))); }
__device__ __forceinline__ float wave_sum(float v, int lane) {
#pragma unroll
    for (int o = 1; o < 64; o <<= 1) v += shx(v, o, lane);
    return v;
}
#define LDS_WAIT() asm volatile("s_waitcnt lgkmcnt(0)" ::: "memory")

struct Args { const float* in[24]; float* out; unsigned char* ws; int ph_lo, ph_hi; };
constexpr int ARGS_LDS_OFF = 139520;
struct AH { const LAS unsigned* w;
    __device__ __forceinline__ const float* in(int i) const { const unsigned lo = __builtin_amdgcn_readfirstlane(w[2 * i]), hi = __builtin_amdgcn_readfirstlane(w[2 * i + 1]); return (const float*)(((unsigned long long)hi << 32) | lo); }
    __device__ __forceinline__ float* out() const { const unsigned lo = __builtin_amdgcn_readfirstlane(w[48]), hi = __builtin_amdgcn_readfirstlane(w[49]); return (float*)(((unsigned long long)hi << 32) | lo); }
    __device__ __forceinline__ unsigned char* ws() const { const unsigned lo = __builtin_amdgcn_readfirstlane(w[50]), hi = __builtin_amdgcn_readfirstlane(w[51]); return (unsigned char*)(((unsigned long long)hi << 32) | lo); }
};
enum { I_X = 0, I_C, I_CTX, I_CCTX, I_WMOD, I_BMOD, I_NORMG, I_FFNIN, I_FFNOUT, I_WIN, I_RETLOGIT, I_RETG, I_CONVW, I_CONVB, I_LWA, I_LBA, I_LWX, I_LBX, I_LAM, I_QG, I_KG, I_WBR, I_WOUT, I_FG };

__device__ __forceinline__ void tr_item(const float* W, int N, int k0, int n0, bf16* WT, int K, int orow0, LAS float* scr, int lane) {
    const float* src = W + (size_t)k0 * N + n0 + lane;
#pragma unroll 1
    for (int i = 0; i < 64; i += 16) { float v[16];
#pragma unroll
        for (int r = 0; r < 16; ++r) v[r] = src[(size_t)(i + r) * N];
#pragma unroll
        for (int r = 0; r < 16; ++r) scr[(i + r) * 65 + lane] = v[r]; }
    LDS_WAIT(); asm volatile("" ::: "memory");
    const int c = lane & 7;
#pragma unroll
    for (int j = 0; j < 8; ++j) { const int n = (lane >> 3) + 8 * j; const LAS float* s = scr + (8 * c) * 65 + n;
        v4u o; o.x = pk2(s[0 * 65], s[1 * 65]); o.y = pk2(s[2 * 65], s[3 * 65]); o.z = pk2(s[4 * 65], s[5 * 65]); o.w = pk2(s[6 * 65], s[7 * 65]);
        *(v4u*)(WT + (size_t)(orow0 + n) * K + k0 + 8 * c) = o; }
    LDS_WAIT(); asm volatile("" ::: "memory");
}

__device__ __forceinline__ void phase_p0(const AH A, LAS unsigned char* lds, int tid, int G) {
    unsigned char* ws = A.ws();
    constexpr int NGEMV = 144;
    const int bx = blockIdx.x;
    if (bx < NGEMV || G <= NGEMV) {
        LAS float* sv = (LAS float*)lds;
        LAS float* red = sv + 5 * 1024;
        const float* c = A.in(I_C); const float* cctx = A.in(I_CCTX);
        for (int i = tid; i < 5 * 1024; i += 512) { const int r = i >> 10, k = i & 1023; const float v = (r < 4) ? c[r * 1024 + k] : cctx[k]; sv[i] = v / (1.0f + __expf(-v)); }
        __syncthreads();
        float* modbuf = (float*)(ws + WS_MOD);
        const float* wmod = A.in(I_WMOD); const float* bmod = A.in(I_BMOD);
        for (int item = bx; item < NGEMV; item += G) {
            const int l = item / 36, n0 = (item - l * 36) * 256, c4 = tid & 63, kg = tid >> 6;
            const f32x4* W = (const f32x4*)(wmod + (size_t)l * 1024 * MODW + n0) + c4;
            f32x4 acc[5];
#pragma unroll
            for (int r = 0; r < 5; ++r) acc[r] = (f32x4){0.f, 0.f, 0.f, 0.f};
#pragma unroll 8
            for (int k = kg * 128; k < kg * 128 + 128; ++k) { const f32x4 w = W[(size_t)k * (MODW / 4)];
#pragma unroll
                for (int r = 0; r < 5; ++r) acc[r] += w * sv[r * 1024 + k]; }
#pragma unroll
            for (int r = 0; r < 5; ++r) *(LAS f32x4*)(red + (kg * 5 + r) * 256 + c4 * 4) = acc[r];
            __syncthreads();
            for (int o = tid; o < 5 * 256; o += 512) { const int r = o >> 8, cc = o & 255; float s = 0.f;
#pragma unroll
                for (int q = 0; q < 8; ++q) s += red[(q * 5 + r) * 256 + cc];
                modbuf[(size_t)(l * 5 + r) * MODW + n0 + cc] = s + bmod[(size_t)l * MODW + n0 + cc]; }
            __syncthreads();
        }
    }
    if (bx >= NGEMV || G <= NGEMV) {
        const int wb = (G > NGEMV) ? bx - NGEMV : bx, nwb = (G > NGEMV) ? G - NGEMV : G;
        const f32x4* x4 = (const f32x4*)A.in(I_X); const f32x4* c4p = (const f32x4*)A.in(I_CTX); f32x4* X4 = (f32x4*)(ws + WS_X);
        const int total = MTOK * 256, stride = nwb * 512;
        for (int i = wb * 512 + tid; i < total; i += 4 * stride) { f32x4 v[4];
#pragma unroll
            for (int q = 0; q < 4; ++q) { const int ii = i + q * stride; if (ii < total) { const int row = ii >> 8, qq = ii & 255; const int b = row / SROW, s = row - b * SROW;
                v[q] = (s < LCTX) ? c4p[(size_t)(b * LCTX + s) * 256 + qq] : x4[(size_t)(b * LAT + s - LCTX) * 256 + qq]; } }
#pragma unroll
            for (int q = 0; q < 4; ++q) { const int ii = i + q * stride; if (ii < total) X4[ii] = v[q]; } }
        float* ra = (float*)(ws + WS_ROPE); float* rb = ra + 64 * 32 * 2;
        for (int i = wb * 512 + tid; i < 64 * 32 + 64 * 16; i += nwb * 512) {
            if (i < 64 * 32) { const int pos = i >> 5, f = i & 31; const float fr = powf(10000.0f, -(float)(2 * f) / 64.0f); const float ang = (float)pos * fr; ra[2 * i] = cosf(ang); ra[2 * i + 1] = sinf(ang); }
            else { const int j = i - 64 * 32; const int pos = j >> 4, f = j & 15; const float fr = powf(10000.0f, -(float)(2 * f) / 32.0f); const float ang = (float)pos * fr; rb[2 * j] = cosf(ang); rb[2 * j + 1] = sinf(ang); } }
    }
}

constexpr int CV_FI = 16 * 88, CV_FO = 44 * 16, CV_IN = 16 * 108, CV_BR = 8 * 16, CV_OUT = 16 * 16, CV_LRU = 32;
constexpr int CV_NIT = 2 * CV_FI + 2 * CV_FO + CV_IN + 3 * CV_BR + CV_OUT + CV_LRU;
__device__ __forceinline__ void convert_layer(const AH A, int l, int it_lo, int it_hi, LAS unsigned char* lds, int gw, int NGW, int wave, int lane) {
    unsigned char* ws = A.ws() + (size_t)(l & 1) * WS_WSET;
    LAS float* scr = (LAS float*)(lds + wave * 16640);
    for (int it = it_lo + gw; it < it_hi; it += NGW) {
        int r = it; bool done = false;
#pragma unroll
        for (int j = 0; j < 2; ++j) { if (!done) { if (r < CV_FI) { const int kb = r / 88, nb = r - kb * 88, n0 = nb * 64;
                const int orow0 = (n0 < DFF) ? ((n0 >> 7) * 256 + (n0 & 127)) : (((n0 - DFF) >> 7) * 256 + 128 + ((n0 - DFF) & 127));
                tr_item(A.in(I_FFNIN) + (size_t)(l * 2 + j) * 1024 * 5632, 5632, kb * 64, n0, (bf16*)(ws + WS_WFI) + (size_t)j * 5632 * 1024, 1024, orow0, scr, lane); done = true; } else r -= CV_FI; } }
#pragma unroll
        for (int j = 0; j < 2; ++j) { if (!done) { if (r < CV_FO) { const int kb = r >> 4, nb = r & 15;
                tr_item(A.in(I_FFNOUT) + (size_t)(l * 2 + j) * DFF * 1024, 1024, kb * 64, nb * 64, (bf16*)(ws + WS_WFO) + (size_t)j * 1024 * DFF, DFF, nb * 64, scr, lane); done = true; } else r -= CV_FO; } }
        if (!done) { if (r < CV_IN) { const int kb = r / 108, nb = r - kb * 108;
                tr_item(A.in(I_WIN) + (size_t)l * 1024 * DIN, DIN, kb * 64, nb * 64, (bf16*)(ws + WS_WIN), 1024, nb * 64, scr, lane); done = true; } else r -= CV_IN; }
#pragma unroll
        for (int n = 0; n < 3; ++n) { if (!done) { if (r < CV_BR) { const int kb = r >> 4, nb = r & 15;
                tr_item(A.in(I_WBR) + (size_t)(l * 3 + n) * 512 * 1024, 1024, kb * 64, nb * 64, (bf16*)(ws + WS_WB) + (size_t)n * 1024 * 512, 512, nb * 64, scr, lane); done = true; } else r -= CV_BR; } }
        if (!done) { if (r < CV_OUT) { const int kb = r >> 4, nb = r & 15;
                tr_item(A.in(I_WOUT) + (size_t)l * 1024 * 1024, 1024, kb * 64, nb * 64, (bf16*)(ws + WS_WO), 1024, nb * 64, scr, lane); done = true; } else r -= CV_OUT; }
        if (!done) { const int mat = r; const int g = mat >> 4, d = (mat >> 3) & 1, blk = mat & 7;
                const float* src = (g ? A.in(I_LWX) : A.in(I_LWA)) + (size_t)((l * 2 + d) * 8 + blk) * 4096;
                tr_item(src, 64, 0, 0, (bf16*)(ws + WS_LRUW) + (size_t)mat * 4096, 64, 0, scr, lane); }
    }
}

__device__ __forceinline__ void norm_rows(const AH A, int l, int sub, int gw, int NGW, int lane, int pend_ns, const float* pend_gate, float pend_scale) {
    unsigned char* ws = A.ws();
    const float* X = (const float*)(ws + WS_X); bf16* HN = (bf16*)(ws + WS_HN);
    const float* g = A.in(I_NORMG) + (size_t)(l * 3 + sub) * 1024;
    const float* modl = (const float*)(ws + WS_MOD) + (size_t)l * 5 * MODW + sub * 3072;
    f32x4 gv[4];
#pragma unroll
    for (int j = 0; j < 4; ++j) gv[j] = ((const f32x4*)g)[lane + 64 * j];
    f32x4 nx[4];
    if (gw < MTOK) {
#pragma unroll
        for (int j = 0; j < 4; ++j) nx[j] = ((const f32x4*)(X + (size_t)gw * 1024))[lane + 64 * j]; }
    for (int row = gw; row < MTOK; row += NGW) {
        const int b = row / SROW, s = row - b * SROW; const int mr = (s < LCTX) ? 4 : b;
        const f32x4* sh = (const f32x4*)(modl + (size_t)mr * MODW); const f32x4* sc = (const f32x4*)(modl + (size_t)mr * MODW + 1024);
        f32x4 v[4]; float ss = 0.f;
#pragma unroll
        for (int j = 0; j < 4; ++j) v[j] = nx[j];
        if (row + NGW < MTOK) {
#pragma unroll
            for (int j = 0; j < 4; ++j) nx[j] = ((const f32x4*)(X + (size_t)(row + NGW) * 1024))[lane + 64 * j]; }
        f32x4 scv[4], shv[4];
#pragma unroll
        for (int j = 0; j < 4; ++j) { scv[j] = sc[lane + 64 * j]; shv[j] = sh[lane + 64 * j]; }
        if (pend_ns > 0 && s < LCTX) {
            const v2u* pc = (const v2u*)((const bf16*)(ws + WS_PARTC) + (size_t)(b * LCTX + s) * 1024); const f32x4* pg = (const f32x4*)pend_gate;
            f32x4 a4[4] = {(f32x4){0.f, 0.f, 0.f, 0.f}, (f32x4){0.f, 0.f, 0.f, 0.f}, (f32x4){0.f, 0.f, 0.f, 0.f}, (f32x4){0.f, 0.f, 0.f, 0.f}};
            for (int sp = 0; sp < pend_ns; ++sp) {
#pragma unroll
                for (int j = 0; j < 4; ++j) { const v2u w = pc[(size_t)sp * 262144 + lane + 64 * j]; a4[j] += (f32x4){bflo(w.x), bfhi(w.x), bflo(w.y), bfhi(w.y)}; } }
            f32x4* xw = (f32x4*)(ws + WS_X) + (size_t)row * 256;
#pragma unroll
            for (int j = 0; j < 4; ++j) { v[j] += (pg[lane + 64 * j] * pend_scale) * a4[j]; xw[lane + 64 * j] = v[j]; }
        }
#pragma unroll
        for (int j = 0; j < 4; ++j) ss += (v[j].x * v[j].x + v[j].y * v[j].y) + (v[j].z * v[j].z + v[j].w * v[j].w);
        const float rstd = rsqrtf(wave_sum(ss, lane) * (1.0f / 1024.0f) + NORM_EPS);
        v2u* o = (v2u*)(HN + (size_t)row * 1024);
#pragma unroll
        for (int j = 0; j < 4; ++j) { const f32x4 y = (v[j] * rstd) * gv[j] * (scv[j] + 1.0f) + shv[j];
            v2u w; w.x = pk2(y.x, y.y); w.y = pk2(y.z, y.w); o[lane + 64 * j] = w; }
    }
}
__device__ __forceinline__ void final_rows(const AH A, int gw, int NGW, int lane) {
    const float* X = (const float*)(A.ws() + WS_X); const float* g = A.in(I_FG);
    f32x4 gv[4];
#pragma unroll
    for (int j = 0; j < 4; ++j) gv[j] = ((const f32x4*)g)[lane + 64 * j];
    f32x4 nx[4];
    if (gw < NB * LAT) { const int b = gw >> 12, t = gw & 4095;
#pragma unroll
        for (int j = 0; j < 4; ++j) nx[j] = ((const f32x4*)(X + (size_t)(b * SROW + LCTX + t) * 1024))[lane + 64 * j]; }
    for (int r = gw; r < NB * LAT; r += NGW) {
        f32x4 v[4]; float ss = 0.f;
#pragma unroll
        for (int j = 0; j < 4; ++j) v[j] = nx[j];
        if (r + NGW < NB * LAT) { const int r2 = r + NGW, b = r2 >> 12, t = r2 & 4095;
#pragma unroll
            for (int j = 0; j < 4; ++j) nx[j] = ((const f32x4*)(X + (size_t)(b * SROW + LCTX + t) * 1024))[lane + 64 * j]; }
#pragma unroll
        for (int j = 0; j < 4; ++j) ss += (v[j].x * v[j].x + v[j].y * v[j].y) + (v[j].z * v[j].z + v[j].w * v[j].w);
        const float rstd = rsqrtf(wave_sum(ss, lane) * (1.0f / 1024.0f) + NORM_EPS);
        f32x4* o = (f32x4*)(A.out() + (size_t)r * 1024);
#pragma unroll
        for (int j = 0; j < 4; ++j) o[lane + 64 * j] = (v[j] * rstd) * gv[j];
    }
}
#define XB_TMO      128
#define XB_XCNT(j)  (256  + 64 * (j))
#define XB_XSUB(j)  (1280 + 64 * (j))
#define XB_XGEN(j)  (2304 + 64 * (j))
#define XB_TOP      3328
#define XB_TOPGEN   3392
#define XCD_BAR_WORDS 3456
#define XB_SPIN_CAP (1u << 22)

__device__ __forceinline__ unsigned xb_ld(unsigned* p)              { return __hip_atomic_load(p, __ATOMIC_RELAXED, __HIP_MEMORY_SCOPE_AGENT); }
__device__ __forceinline__ unsigned xb_add(unsigned* p, unsigned v) { return __hip_atomic_fetch_add(p, v, __ATOMIC_RELAXED, __HIP_MEMORY_SCOPE_AGENT); }
__device__ __forceinline__ unsigned xb_xcc_id() { return (unsigned)__builtin_amdgcn_s_getreg((3 << 11) | 20) & 0xFu; }
#define XB_SPIN(cond, bar) do { unsigned _sp = 0; while (cond) { __builtin_amdgcn_s_sleep(1); \
    if ((++_sp & 255u) == 0u) { if (xb_ld(&(bar)[XB_TMO])) break; if (_sp > XB_SPIN_CAP) { atomicAdd(&(bar)[XB_TMO], 1u); break; } } } } while (0)

struct XcdBarrier {
    unsigned* bar; unsigned x;
    volatile LAS unsigned* st;
};

__device__ __forceinline__ XcdBarrier xcd_barrier_post(unsigned* bar, volatile LAS unsigned* st, bool t0) {
    XcdBarrier b; b.bar = bar; b.x = xb_xcc_id(); b.st = st;
    if (t0) (void)xb_add(&bar[XB_XCNT(b.x)], 1u);
    return b;
}
__device__ __forceinline__ void xcd_barrier_complete(unsigned* bar, unsigned x, unsigned& nloc, unsigned& nx) {
    const unsigned G = gridDim.x * gridDim.y * gridDim.z;
    unsigned sum, cnt, mine, sp = 0u;
    for (;;) {
        sum = 0u; cnt = 0u; mine = 0u;
#pragma unroll
        for (unsigned j = 0; j < 16; ++j) { const unsigned c = xb_ld(&bar[XB_XCNT(j)]); sum += c; cnt += (c > 0u) ? 1u : 0u; mine = (j == x) ? c : mine; }
        if (sum == G) break;
        __builtin_amdgcn_s_sleep(1);
        if ((++sp & 255u) == 0u) { if (xb_ld(&bar[XB_TMO])) break; if (sp > XB_SPIN_CAP) { atomicAdd(&bar[XB_TMO], 1u); break; } }
    }
    nloc = mine > 0u ? mine : 1u; nx = cnt > 0u ? cnt : 1u;
}

__device__ __forceinline__ void xcd_barrier(const XcdBarrier& b, bool t0) {
    asm volatile("s_waitcnt vmcnt(0)" ::: "memory");
    __syncthreads();
    if (t0) {
        unsigned* bar = b.bar;
        __builtin_amdgcn_s_waitcnt(0);
        unsigned nloc = b.st[0], nx = b.st[1];
        if (nloc == 0u) { xcd_barrier_complete(bar, b.x, nloc, nx); b.st[0] = nloc; b.st[1] = nx; }
        const unsigned old = xb_add(&bar[XB_XSUB(b.x)], 1u);
        const unsigned gen = old / nloc;
        if (old + 1u == (gen + 1u) * nloc) {
            __builtin_amdgcn_fence(__ATOMIC_RELEASE, "agent");
            asm volatile("s_waitcnt vmcnt(0)" ::: "memory");
            const unsigned og = xb_add(&bar[XB_TOP], 1u);
            const unsigned tg = og / nx;
            if (og + 1u == (tg + 1u) * nx) xb_add(&bar[XB_TOPGEN], 1u);
            else XB_SPIN(xb_ld(&bar[XB_TOPGEN]) == tg, bar);
            __builtin_amdgcn_fence(__ATOMIC_ACQUIRE, "agent");
            xb_add(&bar[XB_XGEN(b.x)], 1u);
            asm volatile("s_waitcnt vmcnt(0)" ::: "memory");
        } else {
            XB_SPIN(xb_ld(&bar[XB_XGEN(b.x)]) == gen, bar);
            __builtin_amdgcn_fence(__ATOMIC_ACQUIRE, "agent");
            asm volatile("s_waitcnt vmcnt(0)" ::: "memory");
        }
    }
    __syncthreads();
}
__device__ __forceinline__ void prep_qk(const AH A, int l, int gw, int NGW, int lane) {
    unsigned char* ws = A.ws();
    const bf16* Z = (const bf16*)(ws + WS_Z); bf16* KN = (bf16*)(ws + WS_KN);
    const float* rb = (const float*)(ws + WS_ROPE) + 64 * 32 * 2;
    const int e0 = (lane & 7) * 8, kh = (lane >> 3) & 1, sub = lane >> 4;
    float gk[8];
#pragma unroll
    for (int j = 0; j < 8; ++j) gk[j] = A.in(I_KG)[l * 64 + e0 + j];
    v4u nxt = (v4u){0u, 0u, 0u, 0u};
    { const int r = gw * 4 + sub; if (r < MTOK) nxt = *(const v4u*)(Z + (size_t)r * DIN + ZC_AK + kh * 64 + e0); }
    for (int row = gw * 4 + sub; row < MTOK; row += NGW * 4) {
        const int b = row / SROW, s = row - b * SROW; const bool lat = s >= LCTX; const int t = s - LCTX;
        const int pos = (lane & 4) ? (t & 63) : (t >> 6);
        const v4u cur = nxt;
        if (row + NGW * 4 < MTOK) nxt = *(const v4u*)(Z + (size_t)(row + NGW * 4) * DIN + ZC_AK + kh * 64 + e0);
        float f[8]; unpack8(cur, f);
        float ss = 0.f;
#pragma unroll
        for (int j = 0; j < 8; ++j) ss += f[j] * f[j];
        ss += shx(ss, 1, lane); ss += shx(ss, 2, lane); ss += shx(ss, 4, lane);
        const float rstd = rsqrtf(ss * (1.0f / 64.0f) + NORM_EPS);
        float y[8], o[8];
#pragma unroll
        for (int j = 0; j < 8; ++j) y[j] = f[j] * rstd * gk[j];
#pragma unroll
        for (int j = 0; j < 8; ++j) { const float p = shx(y[j], 2, lane);
            if (lat) { const int fi = (lane & 1) * 8 + j; const float cs = rb[(pos * 16 + fi) * 2], sn = rb[(pos * 16 + fi) * 2 + 1];
                o[j] = ((lane & 2) == 0) ? (y[j] * cs - p * sn) : (p * sn + y[j] * cs); }
            else o[j] = y[j]; }
        v4u w; w.x = pk2(o[0], o[1]); w.y = pk2(o[2], o[3]); w.z = pk2(o[4], o[5]); w.w = pk2(o[6], o[7]);
        *(v4u*)(KN + (size_t)row * 128 + kh * 64 + e0) = w;
    }
}

constexpr int RLDP = 136;
constexpr int RBUF = 128 * RLDP * 2;
__device__ __forceinline__ float log_sigmoid_f(float x) { return (x < 0.f ? x : 0.f) - log1pf(__expf(-fabsf(x))); }
template <bool TRANSPOSED, bool ROPE>
__device__ __forceinline__ void ret_stage_pair(const bf16* Z, int r0, int zc, int h, bool lat, int t0, const float* ra, float scl, float lgdec, int decmode  , LAS bf16* dst, int tid) {
#pragma unroll
    for (int it = 0; it < 2; ++it) { const int task = tid + 512 * it; const int j = task & 127, pr = task >> 7; const int c = (pr & 3) + (pr >> 2) * 8;
        const bf16* p = Z + (size_t)(r0 + j) * DIN + zc + h * 128;
        float a[8], bq[8]; unpack8(*(const v4u*)(p + 8 * c), a); unpack8(*(const v4u*)(p + 8 * (c + 4)), bq);
        float sc = scl; if (decmode == 1) sc *= __expf(lgdec * (float)(127 - j)); else if (decmode == 2) sc *= __expf(lgdec * (float)j);
        if (ROPE && lat) { const int t = t0 + j; const int pos = (c < 8) ? (t >> 6) : (t & 63);
#pragma unroll
            for (int e = 0; e < 8; ++e) { const int fi = (c & 3) * 8 + e; const float cs = ra[(pos * 32 + fi) * 2], sn = ra[(pos * 32 + fi) * 2 + 1];
                const float x1 = a[e], x2 = bq[e]; a[e] = x1 * cs - x2 * sn; bq[e] = x1 * sn + x2 * cs; } }
        if (TRANSPOSED) {
#pragma unroll
            for (int e = 0; e < 8; ++e) { dst[(8 * c + e) * RLDP + j] = (bf16)f2bf(a[e] * sc); dst[(8 * (c + 4) + e) * RLDP + j] = (bf16)f2bf(bq[e] * sc); }
        } else {
            v4u w; w.x = pk2(a[0] * sc, a[1] * sc); w.y = pk2(a[2] * sc, a[3] * sc); w.z = pk2(a[4] * sc, a[5] * sc); w.w = pk2(a[6] * sc, a[7] * sc);
            *(LAS v4u*)(dst + j * RLDP + 8 * c) = w;
            w.x = pk2(bq[0] * sc, bq[1] * sc); w.y = pk2(bq[2] * sc, bq[3] * sc); w.z = pk2(bq[4] * sc, bq[5] * sc); w.w = pk2(bq[6] * sc, bq[7] * sc);
            *(LAS v4u*)(dst + j * RLDP + 8 * (c + 4)) = w;
        } }
}
__device__ __forceinline__ void wave_mm(f32x4 (&acc)[8], const LAS bf16* Am, int row0, const LAS bf16* Bm, int lane) {
    const int r = lane & 15, g = lane >> 4;
#pragma unroll
    for (int ks = 0; ks < 4; ++ks) { const bf16x8 a = *(const LAS bf16x8*)(Am + (row0 + r) * RLDP + ks * 32 + g * 8);
#pragma unroll
        for (int nt = 0; nt < 8; ++nt) { const bf16x8 bfr = *(const LAS bf16x8*)(Bm + (nt * 16 + r) * RLDP + ks * 32 + g * 8);
            acc[nt] = __builtin_amdgcn_mfma_f32_16x16x32_bf16(a, bfr, acc[nt], 0, 0, 0); } }
}
__device__ __forceinline__ int ret_chain_pos(int d, int cidx) { return d == 0 ? cidx : (cidx == 1 ? 0 : (cidx == 0 ? 1 : 35 - cidx)); }

__device__ __forceinline__ void ret_stage_k_both(const bf16* Z, int r0, int h, bool lat, int t0, const float* ra, float scl, float lgf, float lgb, LAS bf16* dstf, LAS bf16* dstb, int tid) {
#pragma unroll
    for (int it = 0; it < 2; ++it) { const int task = tid + 512 * it; const int j = task & 127, pr = task >> 7; const int c = (pr & 3) + (pr >> 2) * 8;
        const bf16* p = Z + (size_t)(r0 + j) * DIN + ZC_RK + h * 128;
        float a[8], bq[8]; unpack8(*(const v4u*)(p + 8 * c), a); unpack8(*(const v4u*)(p + 8 * (c + 4)), bq);
        const float sf = scl * __expf(lgf * (float)(127 - j)), sb = scl * __expf(lgb * (float)j);
        if (lat) { const int t = t0 + j; const int pos = (c < 8) ? (t >> 6) : (t & 63);
#pragma unroll
            for (int e = 0; e < 8; ++e) { const int fi = (c & 3) * 8 + e; const float cs = ra[(pos * 32 + fi) * 2], sn = ra[(pos * 32 + fi) * 2 + 1];
                const float x1 = a[e], x2 = bq[e]; a[e] = x1 * cs - x2 * sn; bq[e] = x1 * sn + x2 * cs; } }
#pragma unroll
        for (int e = 0; e < 8; ++e) { dstf[(8 * c + e) * RLDP + j] = (bf16)f2bf(a[e] * sf); dstf[(8 * (c + 4) + e) * RLDP + j] = (bf16)f2bf(bq[e] * sf);
                                      dstb[(8 * c + e) * RLDP + j] = (bf16)f2bf(a[e] * sb); dstb[(8 * (c + 4) + e) * RLDP + j] = (bf16)f2bf(bq[e] * sb); } }
}
__device__ __forceinline__ void ret_u_item(const AH A, int l, int item, LAS unsigned char* lds, int tid, int wave, int lane) {
    unsigned char* ws = A.ws(); const bf16* Z = (const bf16*)(ws + WS_Z); const float* ra = (const float*)(ws + WS_ROPE);
    const int cidx = item % 34, bh = item / 34, b = bh >> 2, h = bh & 3;
    const int pf = ret_chain_pos(0, cidx), pb = ret_chain_pos(1, cidx);
    const bool lat = cidx >= 2; const int r0 = b * SROW + cidx * 128, t0 = (cidx - 2) * 128;
    const float lgf = log_sigmoid_f(A.in(I_RETLOGIT)[(l * 2 + 0) * 4 + h]), lgb = log_sigmoid_f(A.in(I_RETLOGIT)[(l * 2 + 1) * 4 + h]);
    LAS bf16* Ktf = (LAS bf16*)lds; LAS bf16* Ktb = (LAS bf16*)(lds + RBUF); LAS bf16* Vt = (LAS bf16*)(lds + 2 * RBUF);
    ret_stage_k_both(Z, r0, h, lat, t0, ra, 0.08838834764831845f, lgf, lgb, Ktf, Ktb, tid);
    ret_stage_pair<true, false>(Z, r0, ZC_RV, h, false, 0, ra, 1.0f, 0.f, 0, Vt, tid);
    __syncthreads();
    const int g = lane >> 4, c = lane & 15;
    f32x4 accf[8], accb[8];
#pragma unroll
    for (int nt = 0; nt < 8; ++nt) { accf[nt] = (f32x4){0.f, 0.f, 0.f, 0.f}; accb[nt] = (f32x4){0.f, 0.f, 0.f, 0.f}; }
    if (pf != 33) wave_mm(accf, Vt, wave * 16, Ktf, lane);
    if (pb != 33) wave_mm(accb, Vt, wave * 16, Ktb, lane);
    __syncthreads();
    LAS bf16* stg = (LAS bf16*)lds + wave * (16 * RLDP);
#pragma unroll 1
    for (int d = 0; d < 2; ++d) { const int p = d ? pb : pf;
        if (p == 33) continue;
#pragma unroll
        for (int nt = 0; nt < 8; ++nt)
#pragma unroll
            for (int jj = 0; jj < 4; ++jj) stg[(4 * g + jj) * RLDP + nt * 16 + c] = (bf16)f2bf(d ? accb[nt][jj] : accf[nt][jj]);
        LDS_WAIT(); asm volatile("" ::: "memory");
        bf16* U = (bf16*)(ws + WS_U) + ((size_t)((b * 4 + h) * 2 + d) * 34 + p) * 16384 + (size_t)(wave * 16) * 128;
#pragma unroll
        for (int it = 0; it < 4; ++it) { const int id = lane + 64 * it, rr = id >> 4, ch = id & 15;
            *(v4u*)(U + rr * 128 + ch * 8) = *(const LAS v4u*)(stg + rr * RLDP + ch * 8); }
        LDS_WAIT(); asm volatile("" ::: "memory"); }
    __syncthreads();
}
__device__ __forceinline__ void ret_scan_item(const AH A, int l, int item, int tid) {
    unsigned char* ws = A.ws();
    const int bhd = item >> 3, sl = item & 7; const int d = bhd & 1, h = (bhd >> 1) & 3;
    const float lg = log_sigmoid_f(A.in(I_RETLOGIT)[(l * 2 + d) * 4 + h]); const float sdec = __expf(128.0f * lg);
    const v2u* U = (const v2u*)((const bf16*)(ws + WS_U) + (size_t)bhd * 34 * 16384) + sl * 512 + tid;
    v2u* S = (v2u*)((bf16*)(ws + WS_SIN) + (size_t)bhd * 34 * 16384) + sl * 512 + tid;
    f32x4 s = (f32x4){0.f, 0.f, 0.f, 0.f};
#pragma unroll 1
    for (int p0 = 0; p0 < 33; p0 += 11) { v2u u[11];
#pragma unroll
        for (int i = 0; i < 11; ++i) u[i] = U[(size_t)(p0 + i) * 4096];
#pragma unroll
        for (int i = 0; i < 11; ++i) { v2u w; w.x = pk2(s.x, s.y); w.y = pk2(s.z, s.w); S[(size_t)(p0 + i) * 4096] = w;
            const f32x4 uf = (f32x4){bflo(u[i].x), bfhi(u[i].x), bflo(u[i].y), bfhi(u[i].y)}; s = s * sdec + uf; } }
    { v2u w; w.x = pk2(s.x, s.y); w.y = pk2(s.z, s.w); S[(size_t)33 * 4096] = w; }
}
__device__ __forceinline__ void ret_out_item(const AH A, int l, int item, LAS unsigned char* lds, int tid, int wave, int lane) {
    unsigned char* ws = A.ws(); const bf16* Z = (const bf16*)(ws + WS_Z); const float* ra = (const float*)(ws + WS_ROPE);
    const int cidx = item % 34, bh = item / 34, b = bh >> 2, h = bh & 3;
    const bool lat = cidx >= 2; const int r0 = b * SROW + cidx * 128, t0 = (cidx - 2) * 128;
    const float lgf = log_sigmoid_f(A.in(I_RETLOGIT)[(l * 2 + 0) * 4 + h]) * 1.4426950408889634f, lgb = log_sigmoid_f(A.in(I_RETLOGIT)[(l * 2 + 1) * 4 + h]) * 1.4426950408889634f;
    LAS bf16* Qs = (LAS bf16*)lds; LAS bf16* Ks = (LAS bf16*)(lds + RBUF); LAS bf16* Vt = (LAS bf16*)(lds + 2 * RBUF); LAS bf16* Ss = (LAS bf16*)(lds + 3 * RBUF);
    const bf16* SINf = (const bf16*)(ws + WS_SIN) + ((size_t)((b * 4 + h) * 2 + 0) * 34 + ret_chain_pos(0, cidx)) * 16384;
    const bf16* SINb = (const bf16*)(ws + WS_SIN) + ((size_t)((b * 4 + h) * 2 + 1) * 34 + ret_chain_pos(1, cidx)) * 16384;
    ret_stage_pair<false, true>(Z, r0, ZC_RQ, h, lat, t0, ra, 1.0f, 0.f, 0, Qs, tid);
    ret_stage_pair<false, true>(Z, r0, ZC_RK, h, lat, t0, ra, 0.08838834764831845f, 0.f, 0, Ks, tid);
    ret_stage_pair<true, false>(Z, r0, ZC_RV, h, false, 0, ra, 1.0f, 0.f, 0, Vt, tid);
#pragma unroll
    for (int it = 0; it < 4; ++it) { const int task = tid + 512 * it, row = task >> 4, ch = task & 15; *(LAS v4u*)(Ss + row * RLDP + ch * 8) = *(const v4u*)(SINf + row * 128 + ch * 8); }
    v4u sbv[4];
#pragma unroll
    for (int it = 0; it < 4; ++it) { const int task = tid + 512 * it, row = task >> 4, ch = task & 15; sbv[it] = *(const v4u*)(SINb + row * 128 + ch * 8); }
    __syncthreads();
    const int g = lane >> 4, c = lane & 15, i0 = wave * 16 + 4 * g;
    f32x4 accs[8], acco[8];
#pragma unroll
    for (int nt = 0; nt < 8; ++nt) { accs[nt] = (f32x4){0.f, 0.f, 0.f, 0.f}; acco[nt] = (f32x4){0.f, 0.f, 0.f, 0.f}; }
    wave_mm(accs, Qs, wave * 16, Ks, lane);
    wave_mm(acco, Qs, wave * 16, Ss, lane);
#pragma unroll
    for (int jj = 0; jj < 4; ++jj) { const float qd = __builtin_amdgcn_exp2f(lgf * (float)(i0 + jj + 1));
#pragma unroll
        for (int nt = 0; nt < 8; ++nt) acco[nt][jj] *= qd; }
    int i0w = i0; asm volatile("" : "+v"(i0w));
#pragma unroll
    for (int nt = 0; nt < 8; ++nt)
#pragma unroll
        for (int jj = 0; jj < 4; ++jj) { const int diff = (i0w + jj) - (nt * 16 + c);
            const float w = diff > 0 ? __builtin_amdgcn_exp2f(lgf * (float)diff) : (diff < 0 ? __builtin_amdgcn_exp2f(lgb * (float)(-diff)) : 2.0f);
            accs[nt][jj] *= w; }
    __syncthreads();
#pragma unroll
    for (int nt = 0; nt < 8; ++nt)
#pragma unroll
        for (int jj = 0; jj < 4; ++jj) Ks[(i0 + jj) * RLDP + nt * 16 + c] = (bf16)f2bf(accs[nt][jj]);
#pragma unroll
    for (int it = 0; it < 4; ++it) { const int task = tid + 512 * it, row = task >> 4, ch = task & 15; *(LAS v4u*)(Ss + row * RLDP + ch * 8) = sbv[it]; }
    __syncthreads();
#pragma unroll
    for (int nt = 0; nt < 8; ++nt) accs[nt] = (f32x4){0.f, 0.f, 0.f, 0.f};
    wave_mm(accs, Qs, wave * 16, Ss, lane);
#pragma unroll
    for (int jj = 0; jj < 4; ++jj) { const float qd = __builtin_amdgcn_exp2f(lgb * (float)(128 - (i0 + jj)));
#pragma unroll
        for (int nt = 0; nt < 8; ++nt) acco[nt][jj] += qd * accs[nt][jj]; }
    wave_mm(acco, Ks, wave * 16, Vt, lane);
    const float* gn = A.in(I_RETG) + (size_t)l * 512 + h * 128;
    bf16* Y = (bf16*)(ws + WS_Y);
    float gnv[8];
#pragma unroll
    for (int nt = 0; nt < 8; ++nt) gnv[nt] = gn[nt * 16 + c];
#pragma unroll
    for (int jj = 0; jj < 4; ++jj) {
        float s1 = 0.f;
#pragma unroll
        for (int nt = 0; nt < 8; ++nt) s1 += acco[nt][jj];
        s1 += shx(s1, 1, lane); s1 += shx(s1, 2, lane); s1 += shx(s1, 4, lane); s1 += shx(s1, 8, lane);
        const float mu = s1 * (1.0f / 128.0f); float s2 = 0.f;
#pragma unroll
        for (int nt = 0; nt < 8; ++nt) { const float dlt = acco[nt][jj] - mu; s2 += dlt * dlt; }
        s2 += shx(s2, 1, lane); s2 += shx(s2, 2, lane); s2 += shx(s2, 4, lane); s2 += shx(s2, 8, lane);
        const float rstd = rsqrtf(s2 * (1.0f / 128.0f) + NORM_EPS);
#pragma unroll
        for (int nt = 0; nt < 8; ++nt) Qs[(i0 + jj) * RLDP + nt * 16 + c] = (bf16)f2bf((acco[nt][jj] - mu) * rstd * gnv[nt]);
    }
    LDS_WAIT(); asm volatile("" ::: "memory");
#pragma unroll
    for (int it = 0; it < 4; ++it) { const int id = lane + 64 * it, rr = wave * 16 + (id >> 4), ch = id & 15; const size_t row = (size_t)(r0 + rr);
        float yv[8], rg[8]; unpack8(*(const LAS v4u*)(Qs + rr * RLDP + ch * 8), yv); unpack8(*(const v4u*)(Z + row * DIN + ZC_RG + h * 128 + ch * 8), rg);
#pragma unroll
        for (int e = 0; e < 8; ++e) yv[e] *= rg[e] * sigmoidf_(rg[e]);
        v4u w; w.x = pk2(yv[0], yv[1]); w.y = pk2(yv[2], yv[3]); w.z = pk2(yv[4], yv[5]); w.w = pk2(yv[6], yv[7]);
        *(v4u*)(Y + row * 512 + h * 128 + ch * 8) = w; }
    __syncthreads();
}
constexpr int XLDP = 68;
constexpr int XWAVE_BYTES = 64 * XLDP * 4;
__device__ __forceinline__ float gelu_tanh(float x) { const float u = 0.7978845608028654f * (x + 0.044715f * x * x * x); const float th = 1.0f - 2.0f * __builtin_amdgcn_rcpf(1.0f + __expf(2.0f * u)); return 0.5f * x * (1.0f + th); }
__device__ __forceinline__ int lru_chain_pos(int d, int c64) { return d == 0 ? c64 : (c64 < 4 ? 3 - c64 : 71 - c64); }

struct LruFrag { bf16x8 ba[2], bx[2]; };
__device__ __forceinline__ LruFrag lru_frag_load(const unsigned char* ws, int l, int dir, int blk, int nt, int lane) {
    const int g = lane >> 4, c = lane & 15; LruFrag f;
    const bf16* wa = (const bf16*)(ws + (size_t)(l & 1) * WS_WSET + WS_LRUW) + (size_t)((0 * 2 + dir) * 8 + blk) * 4096 + (nt * 16 + c) * 64 + g * 8;
    const bf16* wx = (const bf16*)(ws + (size_t)(l & 1) * WS_WSET + WS_LRUW) + (size_t)((1 * 2 + dir) * 8 + blk) * 4096 + (nt * 16 + c) * 64 + g * 8;
#pragma unroll
    for (int ks = 0; ks < 2; ++ks) { f.ba[ks] = *(const bf16x8*)(wa + ks * 32); f.bx[ks] = *(const bf16x8*)(wx + ks * 32); }
    return f;
}
template <int DIR, bool FINAL>
__device__ __forceinline__ void lru_dir(const AH A, int l, int b, int c64, int blk, int nt, const bf16x8 (&af)[4][2], const float (&xv)[16], float (&hs)[16], int lane,
                                        const LruFrag& fr, float b_a, float b_x, float lam, float hin) {
    unsigned char* ws = A.ws();
    const int g = lane >> 4, c = lane & 15; const int ch = blk * 64 + nt * 16 + c;
    f32x4 accr[4], acci[4];
#pragma unroll
    for (int mt = 0; mt < 4; ++mt) { accr[mt] = (f32x4){0.f, 0.f, 0.f, 0.f}; acci[mt] = (f32x4){0.f, 0.f, 0.f, 0.f};
#pragma unroll
        for (int ks = 0; ks < 2; ++ks) { accr[mt] = __builtin_amdgcn_mfma_f32_16x16x32_bf16(af[mt][ks], fr.ba[ks], accr[mt], 0, 0, 0);
                                         acci[mt] = __builtin_amdgcn_mfma_f32_16x16x32_bf16(af[mt][ks], fr.bx[ks], acci[mt], 0, 0, 0); } }
    const float sp = fmaxf(-lam, 0.f) + log1pf(__expf(-fabsf(lam)));
    float a_[16], u_[16], la_[16];
#pragma unroll
    for (int q = 0; q < 16; ++q) { const int mt = q >> 2, jj = q & 3;
        const float r = sigmoidf_(accr[mt][jj] + b_a), ii = sigmoidf_(acci[mt][jj] + b_x);
        const float la = -8.0f * r * sp; a_[q] = __expf(la); la_[q] = la;
        const float x2 = 2.0f * la;
        const float em = -x2 * (1.0f + x2 * (0.5f + x2 * (0.16666667f + x2 * (0.041666668f + x2 * (0.0083333338f + x2 * 0.0013888889f)))));
        u_[q] = __builtin_amdgcn_sqrtf(em) * (ii * xv[q]); }
    float P = 1.f, H = 0.f;
#pragma unroll
    for (int qi = 0; qi < 16; ++qi) { const int q = DIR ? 15 - qi : qi; H = a_[q] * H + u_[q]; P *= a_[q]; }
    float Pg[4], Hg[4];
#pragma unroll
    for (int k = 0; k < 4; ++k) { Pg[k] = shi(P, c + 16 * k); Hg[k] = shi(H, c + 16 * k); }
    if (!FINAL) {
        const int p = lru_chain_pos(DIR, c64);
        const size_t idx = ((size_t)((b * 2 + DIR) * 68 + p)) * 512 + ch;
        float Hc, Pc = (Pg[0] * Pg[1]) * (Pg[2] * Pg[3]);
        if (DIR == 0) Hc = ((Hg[0] * Pg[1] + Hg[1]) * Pg[2] + Hg[2]) * Pg[3] + Hg[3];
        else          Hc = ((Hg[3] * Pg[2] + Hg[2]) * Pg[1] + Hg[1]) * Pg[0] + Hg[0];
        if (g == 0) { float* S = (float*)(ws + WS_SUMM); S[idx * 2] = Pc; S[idx * 2 + 1] = Hc; }
        const size_t e0 = ((((size_t)((b * 68 + c64) * 8 + blk) * 4 + nt) * 2 + DIR) * 64 + lane) * 16;
        bf16* LA = (bf16*)(ws + WS_HN) + e0; bf16* LU = (bf16*)(ws + WS_PARTC) + e0;
        v4u w;
        w.x = pk2(la_[0], la_[1]); w.y = pk2(la_[2], la_[3]); w.z = pk2(la_[4], la_[5]); w.w = pk2(la_[6], la_[7]); *(v4u*)LA = w;
        w.x = pk2(la_[8], la_[9]); w.y = pk2(la_[10], la_[11]); w.z = pk2(la_[12], la_[13]); w.w = pk2(la_[14], la_[15]); *(v4u*)(LA + 8) = w;
        w.x = pk2(u_[0], u_[1]); w.y = pk2(u_[2], u_[3]); w.z = pk2(u_[4], u_[5]); w.w = pk2(u_[6], u_[7]); *(v4u*)LU = w;
        w.x = pk2(u_[8], u_[9]); w.y = pk2(u_[10], u_[11]); w.z = pk2(u_[12], u_[13]); w.w = pk2(u_[14], u_[15]); *(v4u*)(LU + 8) = w;
    } else {
        float s0, s1, s2, s3;
        if (DIR == 0) { s0 = hin; s1 = s0 * Pg[0] + Hg[0]; s2 = s1 * Pg[1] + Hg[1]; s3 = s2 * Pg[2] + Hg[2]; }
        else          { s3 = hin; s2 = s3 * Pg[3] + Hg[3]; s1 = s2 * Pg[2] + Hg[2]; s0 = s1 * Pg[1] + Hg[1]; }
        float h = (g == 0) ? s0 : (g == 1) ? s1 : (g == 2) ? s2 : s3;
#pragma unroll
        for (int qi = 0; qi < 16; ++qi) { const int q = DIR ? 15 - qi : qi; h = a_[q] * h + u_[q]; hs[q] += h; }
    }
}
template <bool FINAL>
__device__ __forceinline__ void lru_task(const AH A, int l, int b, int c64, int blk, LAS unsigned char* lds, int wave, int lane, int half) {
    unsigned char* ws = A.ws(); const bf16* Z = (const bf16*)(ws + WS_Z);
    LAS float* xs = (LAS float*)(lds + wave * XWAVE_BYTES);
    const int r0 = b * SROW + c64 * 64;
    const int seq_lo = (c64 < 4) ? b * SROW : b * SROW + LCTX, seq_hi = (c64 < 4) ? b * SROW + LCTX : (b + 1) * SROW;
    const int g = lane >> 4, c = lane & 15;
    const int cgx = lane & 7, tg = lane >> 3, ch0 = blk * 64 + cgx * 8;
    v4u raw[11];
#pragma unroll
    for (int q = 0; q < 11; ++q) { const int row = r0 + tg * 8 - 1 + q;
        raw[q] = (row >= seq_lo && row < seq_hi) ? *(const v4u*)(Z + (size_t)row * DIN + ZC_LX + ch0) : (v4u){0u, 0u, 0u, 0u}; }
    f32x4 cwv[4][2], cbv[2];
#pragma unroll
    for (int e2 = 0; e2 < 2; ++e2) { cbv[e2] = *(const f32x4*)(A.in(I_CONVB) + l * 512 + ch0 + 4 * e2);
#pragma unroll
        for (int j = 0; j < 4; ++j) cwv[j][e2] = *(const f32x4*)(A.in(I_CONVW) + (l * 4 + j) * 512 + ch0 + 4 * e2); }
    float pba[2][2], pbx[2][2], plam[2][2], phin[2][2];
#pragma unroll
    for (int nti = 0; nti < 2; ++nti)
#pragma unroll
        for (int d = 0; d < 2; ++d) { const int ch = blk * 64 + (2 * half + nti) * 16 + c; const int pidx = (l * 2 + d) * 512 + ch;
            pba[nti][d] = A.in(I_LBA)[pidx]; pbx[nti][d] = A.in(I_LBX)[pidx]; plam[nti][d] = A.in(I_LAM)[pidx];
            phin[nti][d] = FINAL ? ((const float*)(ws + WS_HIN))[((size_t)((b * 2 + d) * 68 + lru_chain_pos(d, c64))) * 512 + ch] : 0.f; }
    LruFrag fcur = lru_frag_load(ws, l, 0, blk, 2 * half, lane);
    {
        float xw[4][8];
#pragma unroll
        for (int q = 0; q < 3; ++q) unpack8(raw[q], xw[q]);
#pragma unroll
        for (int tt = 0; tt < 8; ++tt) { unpack8(raw[tt + 3], xw[3]);
            float y[8];
#pragma unroll
            for (int e = 0; e < 8; ++e) { float sacc = cbv[e >> 2][e & 3];
#pragma unroll
                for (int j = 0; j < 4; ++j) sacc += cwv[j][e >> 2][e & 3] * xw[j][e];
                y[e] = sacc; }
            LAS f32x4* o = (LAS f32x4*)(xs + (tg * 8 + tt) * XLDP + cgx * 8);
            o[0] = (f32x4){y[0], y[1], y[2], y[3]}; o[1] = (f32x4){y[4], y[5], y[6], y[7]};
#pragma unroll
            for (int e = 0; e < 8; ++e) { xw[0][e] = xw[1][e]; xw[1][e] = xw[2][e]; xw[2][e] = xw[3][e]; } }
    }
    LDS_WAIT(); asm volatile("" ::: "memory");
    bf16x8 af[4][2];
    { const int m = lane & 15, gq = m >> 2, jq = m & 3, kq = (lane >> 4) * 8;
#pragma unroll
      for (int mt = 0; mt < 4; ++mt) { const int tok = 16 * gq + 4 * mt + jq;
#pragma unroll
          for (int ks = 0; ks < 2; ++ks) { const LAS f32x4* s = (const LAS f32x4*)(xs + tok * XLDP + ks * 32 + kq); const f32x4 v0 = s[0], v1 = s[1];
              v4u w; w.x = pk2(v0.x, v0.y); w.y = pk2(v0.z, v0.w); w.z = pk2(v1.x, v1.y); w.w = pk2(v1.z, v1.w); af[mt][ks] = __builtin_bit_cast(bf16x8, w); } } }
#pragma unroll
    for (int nti = 0; nti < 2; ++nti) { const int nt = 2 * half + nti;
        float xv[16], hs[16];
#pragma unroll
        for (int q = 0; q < 16; ++q) { xv[q] = xs[(16 * g + q) * XLDP + nt * 16 + c]; hs[q] = 0.f; }
        const LruFrag f1 = lru_frag_load(ws, l, 1, blk, nt, lane);
        lru_dir<0, FINAL>(A, l, b, c64, blk, nt, af, xv, hs, lane, fcur, pba[nti][0], pbx[nti][0], plam[nti][0], phin[nti][0]);
        if (nti == 0) fcur = lru_frag_load(ws, l, 0, blk, nt + 1, lane);
        lru_dir<1, FINAL>(A, l, b, c64, blk, nt, af, xv, hs, lane, f1, pba[nti][1], pbx[nti][1], plam[nti][1], phin[nti][1]);
        if (FINAL) {
#pragma unroll
            for (int q = 0; q < 16; ++q) xs[(16 * g + q) * XLDP + nt * 16 + c] = hs[q]; }
    }
    if (FINAL) {
        LDS_WAIT(); asm volatile("" ::: "memory");
        bf16* Y = (bf16*)(ws + WS_Y) + (size_t)MTOK * 512;
#pragma unroll
        for (int it = 0; it < 4; ++it) { const int id = lane + 64 * it, tok = id >> 2, chn = 4 * half + (id & 3); const size_t row = (size_t)(r0 + tok);
            const LAS f32x4* sp = (const LAS f32x4*)(xs + tok * XLDP + chn * 8); const f32x4 h0 = sp[0], h1 = sp[1];
            float lz[8]; unpack8(*(const v4u*)(Z + row * DIN + ZC_LZ + blk * 64 + chn * 8), lz);
            v4u w; w.x = pk2(gelu_tanh(lz[0]) * h0.x, gelu_tanh(lz[1]) * h0.y); w.y = pk2(gelu_tanh(lz[2]) * h0.z, gelu_tanh(lz[3]) * h0.w);
            w.z = pk2(gelu_tanh(lz[4]) * h1.x, gelu_tanh(lz[5]) * h1.y); w.w = pk2(gelu_tanh(lz[6]) * h1.z, gelu_tanh(lz[7]) * h1.w);
            *(v4u*)(Y + row * 512 + blk * 64 + chn * 8) = w; }
    }
    LDS_WAIT(); asm volatile("" ::: "memory");
}
template <int DIR>
__device__ __forceinline__ void lru_apply(const float (&a_)[16], const float (&u_)[16], float hin, float (&hs)[16], int lane) {
    const int g = lane >> 4, c = lane & 15;
    float P = 1.f, H = 0.f;
#pragma unroll
    for (int qi = 0; qi < 16; ++qi) { const int q = DIR ? 15 - qi : qi; H = a_[q] * H + u_[q]; P *= a_[q]; }
    float Pg[4], Hg[4];
#pragma unroll
    for (int k = 0; k < 4; ++k) { Pg[k] = shi(P, c + 16 * k); Hg[k] = shi(H, c + 16 * k); }
    float s0, s1, s2, s3;
    if (DIR == 0) { s0 = hin; s1 = s0 * Pg[0] + Hg[0]; s2 = s1 * Pg[1] + Hg[1]; s3 = s2 * Pg[2] + Hg[2]; }
    else          { s3 = hin; s2 = s3 * Pg[3] + Hg[3]; s1 = s2 * Pg[2] + Hg[2]; s0 = s1 * Pg[1] + Hg[1]; }
    float h = (g == 0) ? s0 : (g == 1) ? s1 : (g == 2) ? s2 : s3;
#pragma unroll
    for (int qi = 0; qi < 16; ++qi) { const int q = DIR ? 15 - qi : qi; h = a_[q] * h + u_[q]; hs[q] += h; }
}
__device__ __forceinline__ void lru_final(const AH A, int l, int b, int c64, int blk, LAS unsigned char* lds, int wave, int lane, int half) {
    unsigned char* ws = A.ws(); const bf16* Z = (const bf16*)(ws + WS_Z);
    LAS float* xs = (LAS float*)(lds + wave * XWAVE_BYTES);
    const int r0 = b * SROW + c64 * 64;
    const int g = lane >> 4, c = lane & 15;
    float phin[2][2];
#pragma unroll
    for (int nti = 0; nti < 2; ++nti)
#pragma unroll
        for (int d = 0; d < 2; ++d) { const int ch = blk * 64 + (2 * half + nti) * 16 + c;
            phin[nti][d] = ((const float*)(ws + WS_HIN))[((size_t)((b * 2 + d) * 68 + lru_chain_pos(d, c64))) * 512 + ch]; }
    v4u wl[2][2][2], wu[2][2][2];
#pragma unroll
    for (int nti = 0; nti < 2; ++nti)
#pragma unroll
        for (int d = 0; d < 2; ++d) { const size_t e0 = ((((size_t)((b * 68 + c64) * 8 + blk) * 4 + (2 * half + nti)) * 2 + d) * 64 + lane) * 16;
            const bf16* LA = (const bf16*)(ws + WS_HN) + e0; const bf16* LU = (const bf16*)(ws + WS_PARTC) + e0;
            wl[nti][d][0] = *(const v4u*)LA; wl[nti][d][1] = *(const v4u*)(LA + 8); wu[nti][d][0] = *(const v4u*)LU; wu[nti][d][1] = *(const v4u*)(LU + 8); }
#pragma unroll
    for (int nti = 0; nti < 2; ++nti) { const int nt = 2 * half + nti;
        float hs[16];
#pragma unroll
        for (int q = 0; q < 16; ++q) hs[q] = 0.f;
#pragma unroll
        for (int d = 0; d < 2; ++d) { float a_[16], u_[16];
            unpack8(wl[nti][d][0], a_); unpack8(wl[nti][d][1], a_ + 8); unpack8(wu[nti][d][0], u_); unpack8(wu[nti][d][1], u_ + 8);
#pragma unroll
            for (int q = 0; q < 16; ++q) a_[q] = __expf(a_[q]);
            if (d == 0) lru_apply<0>(a_, u_, phin[nti][0], hs, lane); else lru_apply<1>(a_, u_, phin[nti][1], hs, lane); }
#pragma unroll
        for (int q = 0; q < 16; ++q) xs[(16 * g + q) * XLDP + nt * 16 + c] = hs[q];
    }
    LDS_WAIT(); asm volatile("" ::: "memory");
    bf16* Y = (bf16*)(ws + WS_Y) + (size_t)MTOK * 512;
#pragma unroll
    for (int it = 0; it < 4; ++it) { const int id = lane + 64 * it, tok = id >> 2, chn = 4 * half + (id & 3); const size_t row = (size_t)(r0 + tok);
        const LAS f32x4* sp = (const LAS f32x4*)(xs + tok * XLDP + chn * 8); const f32x4 h0 = sp[0], h1 = sp[1];
        float lz[8]; unpack8(*(const v4u*)(Z + row * DIN + ZC_LZ + blk * 64 + chn * 8), lz);
        v4u w; w.x = pk2(gelu_tanh(lz[0]) * h0.x, gelu_tanh(lz[1]) * h0.y); w.y = pk2(gelu_tanh(lz[2]) * h0.z, gelu_tanh(lz[3]) * h0.w);
        w.z = pk2(gelu_tanh(lz[4]) * h1.x, gelu_tanh(lz[5]) * h1.y); w.w = pk2(gelu_tanh(lz[6]) * h1.z, gelu_tanh(lz[7]) * h1.w);
        *(v4u*)(Y + row * 512 + blk * 64 + chn * 8) = w; }
    LDS_WAIT(); asm volatile("" ::: "memory");
}
__device__ __forceinline__ void lru_scan(const AH A, int tid, int G) {
    unsigned char* ws = A.ws(); const float* S = (const float*)(ws + WS_SUMM); float* HIN = (float*)(ws + WS_HIN);
    const int cpb = (4096 + G - 1) / G;
    for (int chain = blockIdx.x * cpb + tid; tid < cpb && chain < 4096; chain += 4096) { const int bd = chain >> 9, ch = chain & 511; float h = 0.f;
        typedef float f32x2s __attribute__((ext_vector_type(2)));
#pragma unroll 1
        for (int p0 = 0; p0 < 68; p0 += 17) { f32x2s ph_[17];
#pragma unroll
            for (int i = 0; i < 17; ++i) ph_[i] = *(const f32x2s*)(S + ((size_t)(bd * 68 + p0 + i) * 512 + ch) * 2);
#pragma unroll
            for (int i = 0; i < 17; ++i) { HIN[(size_t)(bd * 68 + p0 + i) * 512 + ch] = h; h = ph_[i].x * h + ph_[i].y; } } }
}

#define EN(k) (((MASK) >> (k)) & 1)
template <int MASK> __global__ void __launch_bounds__(NWAVES * 64, 2) fwd_kernel(Args args) {
    extern __shared__ __attribute__((aligned(16))) unsigned char lds_raw[];
    LAS unsigned char* lds0 = (LAS unsigned char*)lds_raw;
    cg::grid_group grid = cg::this_grid();
    { const unsigned* aw = (const unsigned*)&args; const int tid = threadIdx.x; if (tid < 54) ((LAS unsigned*)(lds0 + ARGS_LDS_OFF))[tid] = aw[tid];
      if (tid >= 64 && tid < 66) ((LAS unsigned*)(lds0 + ARGS_LDS_OFF + 256))[tid - 64] = 0u; }
    __syncthreads();
    XcdBarrier xbar = xcd_barrier_post((unsigned*)args.ws, (volatile LAS unsigned*)(lds0 + ARGS_LDS_OFF + 256), threadIdx.x == 0);
    const int ph_lo = args.ph_lo, ph_hi = args.ph_hi;
    const int wave0 = __builtin_amdgcn_readfirstlane((int)threadIdx.x >> 6);
#ifndef PROBE_MASK
#define PROBE_MASK 0
#endif
#ifndef PROBE_SUB
#define PROBE_SUB 0
#endif
#define SUBOFF(bit) (rep && ((PROBE_SUB) & (bit)))
#define PROBE_HIT(ph) ((PROBE_MASK) != 0 && ((ph) == 0 ? (((PROBE_MASK) >> 13) & 1) : (ph) == 53 ? (((PROBE_MASK) >> 14) & 1) : (((PROBE_MASK) >> (((ph) - 1) % 13)) & 1)))
    for (int ph2 = 2 * ph_lo; ph2 < 2 * ph_hi; ++ph2) {
        const int ph = ph2 >> 1, rep = ph2 & 1;
        if (rep && !PROBE_HIT(ph)) continue;
        if (ph2 != 2 * ph_lo) {
            if (ph_lo < 0) grid.sync();
            else { int mk2_ = -1; asm volatile("" : "+s"(mk2_)); const bool t0_ = (wave0 == 0) && (__builtin_amdgcn_mbcnt_hi(mk2_, __builtin_amdgcn_mbcnt_lo(mk2_, 0)) == 0); xcd_barrier(xbar, t0_); }
        }
#define PH_PROLOG int wv_ = wave0; int mk_ = -1; asm volatile("" : "+s"(wv_), "+s"(mk_)); int tid = wv_ * 64 + (int)__builtin_amdgcn_mbcnt_hi(mk_, __builtin_amdgcn_mbcnt_lo(mk_, 0)); int G = gridDim.x, bx = blockIdx.x; asm volatile("" : "+s"(G), "+s"(bx)); \
        unsigned ldsi = (unsigned)(unsigned long long)lds0; asm volatile("" : "+s"(ldsi)); LAS unsigned char* lds = (LAS unsigned char*)(unsigned long long)ldsi; \
        const AH AHv{(const LAS unsigned*)(lds + ARGS_LDS_OFF)}; const int lane = tid & 63, wave = wv_; \
        const int gw = bx * NWAVES + wave, NGW = G * NWAVES; (void)gw; (void)NGW; (void)lane; (void)wave; (void)G; (void)bx; (void)tid;
        if (EN(13) && ph == 0) { PH_PROLOG phase_p0(AHv, lds, tid, G); __syncthreads(); convert_layer(AHv, 0, 0, CV_NIT, lds, gw, NGW, wave, lane); }
        else if (EN(14) && ph == 53) { PH_PROLOG final_rows(AHv, gw, NGW, lane); }
        else {
            const int l = (ph - 1) / 13, k = (ph - 1) - l * 13; const bool last = (l == DEPTH - 1);
#define ws (AHv.ws())
#define HN ((bf16*)(ws + WS_HN))
#define Zb ((bf16*)(ws + WS_Z))
#define X ((float*)(ws + WS_X))
#define modbuf ((const float*)(ws + WS_MOD))
            if (EN(0) && k == 0) { PH_PROLOG norm_rows(AHv, l, 0, gw, NGW, lane, l > 0 ? 11 : 0, modbuf + (size_t)(l > 0 ? l - 1 : 0) * 5 * MODW + 4 * MODW + 2 * 3072 + 2048, 0.5f); }
            else if (EN(3) && k == 3) { PH_PROLOG norm_rows(AHv, l, 1, gw, NGW, lane, 11, modbuf + (size_t)l * 5 * MODW + 4 * MODW + 0 * 3072 + 2048, 0.5f); }
            else if (EN(10) && k == 10) { PH_PROLOG norm_rows(AHv, l, 2, gw, NGW, lane, last ? 0 : 4, modbuf + (size_t)l * 5 * MODW + 4 * MODW + 1 * 3072 + 2048, 1.0f); }
            else if (EN(1) && (k == 1 || k == 11)) { PH_PROLOG const int j = (k == 1) ? 0 : 1;
                pg8::Gemm gm{HN, (const bf16*)(ws + (size_t)(l & 1) * WS_WSET + WS_WFI) + (size_t)j * 5632 * 1024, MTOK, 5632, 1024};
                pg8::EpiSwiglu E{Zb};
                if (last && k == 11) { pg8::LastLayerOrder S; S.init(5632, G, bx, 0); pg8::gemm_phase<1024, pg8::EpiSwiglu, pg8::LastLayerOrder, true, true>(lds, gm, S, E, tid); }
                else { pg8::StaticOrder S; S.init(MTOK, 5632, G, bx); pg8::gemm_phase<1024, pg8::EpiSwiglu, pg8::StaticOrder, true, true>(lds, gm, S, E, tid); } }
            else if (EN(2) && (k == 2 || k == 12)) { PH_PROLOG const int j = (k == 2) ? 0 : 1, sub = (k == 2) ? 0 : 2;
                pg8::Gemm gm{Zb, (const bf16*)(ws + (size_t)(l & 1) * WS_WSET + WS_WFO) + (size_t)j * 1024 * DFF, MTOK, 1024, DFF};
                pg8::EpiResid E{X, modbuf + (size_t)l * 5 * MODW + sub * 3072 + 2048, rep ? 0.0f : 0.5f, (float*)(ws + WS_PARTC)};
                if (last && k == 12) { pg8::LatOrder S{G, bx}; pg8::gemm_phase<DFF, pg8::EpiResid, pg8::LatOrder, true, true>(lds, gm, S, E, tid); }
                else { pg8::SplitOrder S{G, bx, 11, 4}; pg8::gemm_phase<DFF, pg8::EpiResid, pg8::SplitOrder, true, true>(lds, gm, S, E, tid); } }
            else if (EN(4) && k == 4) { PH_PROLOG
                pg8::Gemm gm{HN, (const bf16*)(ws + (size_t)(l & 1) * WS_WSET + WS_WIN), MTOK, DIN, 1024};
                pg8::EpiZ E{Zb, DIN};
                if (last) { pg8::LastLayerOrder S; S.init(DIN, G, bx, 28); pg8::gemm_phase<1024, pg8::EpiZ, pg8::LastLayerOrder, true, true>(lds, gm, S, E, tid); }
                else { pg8::StaticOrder S; S.init(MTOK, DIN, G, bx); pg8::gemm_phase<1024, pg8::EpiZ, pg8::StaticOrder, true, true>(lds, gm, S, E, tid); } }
            else if (EN(5) && k == 5) { PH_PROLOG
                if (!SUBOFF(1)) prep_qk(AHv, l, gw, NGW, lane);
                if (!SUBOFF(2)) for (int it = bx; it < 544; it += G) ret_u_item(AHv, l, it, lds, tid, wave, lane);
                __syncthreads();
                if (!SUBOFF(4)) { PH_PROLOG
                    const int H = 2 * 272, n3 = (544 > 2 * G && 544 <= 3 * G) ? 544 - 2 * G : 0, nb = G - n3;
                    for (int hi = bx; hi < H; hi += (bx < n3) ? H : nb) { const int li = hi >> 1; lru_task<false>(AHv, l, li / 68, li % 68, wave, lds, wave, lane, hi & 1); } } }
            else if (EN(6) && k == 6) { PH_PROLOG
                for (int it = bx; it < 256; it += G) ret_scan_item(AHv, l, it, tid);
                lru_scan(AHv, tid, G);
                const int nunits = last ? 512 : 544;
                for (int i = 0;; ++i) { const int u = i * G + bx; if (u >= nunits) break;
                    long qrow0, kvrow0; int hq, kvh, NT;
                    if (u < 512) { const int combo = u & 7, j = u >> 3; const int b = combo >> 1; kvh = combo & 1; hq = kvh * 4 + (j & 3); const int qb = j >> 2;
                        qrow0 = (long)b * SROW + LCTX + qb * 256; kvrow0 = (long)b * SROW; NT = 68; }
                    else { const int v = u - 512; const int b = v >> 3; hq = v & 7; kvh = hq >> 2; qrow0 = (long)b * SROW; kvrow0 = qrow0; NT = 4; }
                    attn_body::attn_unit<8>(qrow0, kvrow0, hq, kvh, NT, (const attn_body::bf16*)(Zb + ZC_AQ), (const attn_body::bf16*)(ws + WS_KN), (const attn_body::bf16*)(Zb + ZC_AV),
                                            (attn_body::bf16*)((bf16*)(ws + WS_Y) + (size_t)2 * MTOK * 512), (char*)lds, tid,
                                            AHv.in(I_QG) + l * 64, (const float*)(ws + WS_ROPE) + 64 * 32 * 2, (u < 512) ? (long)(qrow0 - kvrow0 - LCTX) : -1L); } }
            else if ((EN(7) || EN(15)) && k == 7) { PH_PROLOG
                const int nret = last ? 512 : 544, nlru = last ? 256 : 272;
                if (EN(7) && !SUBOFF(8)) for (int it = bx; it < nret; it += G) { const int item = last ? ((it >> 5) * 34 + 2 + (it & 31)) : it; ret_out_item(AHv, l, item, lds, tid, wave, lane); }
                __syncthreads();
                if (EN(15) && !SUBOFF(16)) { PH_PROLOG
                    const int H = 2 * nlru, n3 = (nret > 2 * G && nret <= 3 * G) ? nret - 2 * G : 0, nb = G - n3;
                    for (int hi = bx; hi < H; hi += (bx < n3) ? H : nb) { const int li = hi >> 1; const int b = last ? (li >> 6) : (li / 68), c64 = last ? (4 + (li & 63)) : (li % 68);
                        lru_final(AHv, l, b, c64, wave, lds, wave, lane, hi & 1); } } }
            else if (EN(8) && k == 8) { PH_PROLOG
                pg8::Gemm gm{(const bf16*)(ws + WS_Y), (const bf16*)(ws + (size_t)(l & 1) * WS_WSET + WS_WB), 3 * MTOK, 3 * 1024, 512}; pg8::MergeOrder S{G, bx, last ? 1 : 0};
                pg8::EpiMerge E{Zb, HN};
                pg8::gemm_phase<512, pg8::EpiMerge, pg8::MergeOrder, true, true>(lds, gm, S, E, tid);
                if (!last) {
                    const int nsec = (272 > G) ? ((272 - G < G) ? 272 - G : 0) : 0;
                    if (bx >= nsec) convert_layer(AHv, l + 1, 0, CV_NIT, lds, (bx - nsec) * NWAVES + wave, (G - nsec) * NWAVES, wave, lane); } }
            else if (EN(9) && k == 9) { PH_PROLOG
                pg8::Gemm gm{HN, (const bf16*)(ws + (size_t)(l & 1) * WS_WSET + WS_WO), MTOK, 1024, 1024};
                pg8::EpiResid E{X, modbuf + (size_t)l * 5 * MODW + 1 * 3072 + 2048, rep ? 0.0f : 1.0f, (float*)(ws + WS_PARTC)};
                if (last) { pg8::LatOrder S{G, bx}; pg8::gemm_phase<1024, pg8::EpiResid, pg8::LatOrder, true, true>(lds, gm, S, E, tid); }
                else { pg8::SplitOrder S{G, bx, 4, 4}; pg8::gemm_phase<1024, pg8::EpiResid, pg8::SplitOrder, true, true>(lds, gm, S, E, tid); } }
        }
#undef ws
#undef HN
#undef Zb
#undef X
#undef modbuf
    }
}

#ifndef MK_N_LAUNCHES
#define MK_N_LAUNCHES 1
#endif
#if MK_N_LAUNCHES == 1
#define FULLK fwd_kernel<0xffff>
#else
template <int MASK> static void launch_one(int grid, const Args& a, hipStream_t stream) {
    static bool init = false;
    if (!init) { (void)hipFuncSetAttribute((const void*)fwd_kernel<MASK>, hipFuncAttributeMaxDynamicSharedMemorySize, LDS_BYTES); init = true; }
    hipLaunchKernelGGL(fwd_kernel<MASK>, dim3(grid), dim3(NWAVES * 64), LDS_BYTES, stream, a);
}
#endif
extern "C" void kernel_launch(void* const* d_in, const int* in_sizes, int n_in, void* d_out, int out_size, void* d_ws, size_t ws_size, hipStream_t stream) {
    static int grid = 0;
    if (grid == 0) {
        if (n_in != 24 || ws_size < WS_END) { fprintf(stderr, "kernel_launch: unexpected n_in %d / ws %zu (need %zu)\n", n_in, ws_size, (size_t)WS_END); grid = -1; return; }
        int dev = 0, cus = 0;
        (void)hipGetDevice(&dev); (void)hipDeviceGetAttribute(&cus, hipDeviceAttributeMultiprocessorCount, dev);
#if MK_N_LAUNCHES == 1
        int per_cu = 0;
        (void)hipFuncSetAttribute((const void*)FULLK, hipFuncAttributeMaxDynamicSharedMemorySize, LDS_BYTES);
        if (hipOccupancyMaxActiveBlocksPerMultiprocessor(&per_cu, (const void*)FULLK, NWAVES * 64, LDS_BYTES) != hipSuccess || per_cu < 1) per_cu = 1;
        (void)hipGetLastError();
        grid = cus * per_cu;
#else
        grid = cus;
#endif
        if (grid <= 0) grid = 256;
    }
    if (grid < 0) return;
    (void)hipMemsetAsync(d_ws, 0, 16384, stream);
    Args a{};
    for (int i = 0; i < 24; ++i) a.in[i] = (const float*)d_in[i];
    a.out = (float*)d_out; a.ws = (unsigned char*)d_ws;
#if MK_N_LAUNCHES == 1
    a.ph_lo = 0; a.ph_hi = 54;
    void* params[] = {(void*)&a};
    hipError_t e = hipLaunchCooperativeKernel((const void*)FULLK, dim3(grid), dim3(NWAVES * 64), params, LDS_BYTES, stream);
    if (e != hipSuccess) fprintf(stderr, "cooperative launch failed: %s (grid %d)\n", hipGetErrorString(e), grid);
#else
    for (int ph = 0; ph < 54; ++ph) { a.ph_lo = ph; a.ph_hi = ph + 1;
        if (ph == 0) { launch_one<1 << 13>(grid, a, stream); continue; }
        if (ph == 53) { launch_one<1 << 14>(grid, a, stream); continue; }
        const int k = (ph - 1) % 13;
        switch (k) {
            case 0: launch_one<1 << 0>(grid, a, stream); break;
            case 1: case 11: launch_one<1 << 1>(grid, a, stream); break;
            case 2: case 12: launch_one<1 << 2>(grid, a, stream); break;
            case 3: launch_one<1 << 3>(grid, a, stream); break;
            case 4: launch_one<1 << 4>(grid, a, stream); break;
            case 5: launch_one<1 << 5>(grid, a, stream); break;
            case 6: launch_one<1 << 6>(grid, a, stream); break;
            case 7: launch_one<1 << 7>(grid, a, stream); launch_one<1 << 15>(grid, a, stream); break;
            case 8: launch_one<1 << 8>(grid, a, stream); break;
            case 9: launch_one<1 << 9>(grid, a, stream); break;
            case 10: launch_one<1 << 10>(grid, a, stream); break;
        }
    }
#endif
}
```

```cpp
#include <hip/hip_runtime.h>
#include <hip/hip_cooperative_groups.h>
#include <hip/hip_bf16.h>
#include <cstdio>
#include <cstdint>
#include <cmath>
namespace cg = cooperative_groups;
namespace pg8 {
#define PG8_LAS __attribute__((address_space(3)))
typedef unsigned short bf16_t;
typedef short bf16x8 __attribute__((ext_vector_type(8)));
typedef float f32x4 __attribute__((ext_vector_type(4)));
typedef unsigned u32x4 __attribute__((ext_vector_type(4)));
constexpr int BM = 256, BK = 64, HALF = 128, HTB = HALF * BK * 2  , STAGE_BYTES = 8 * HTB, NXCD = 8, WGM = 4;

__host__ __device__ __forceinline__ int lds_byte(int r, int c) { const int st = (r >> 4) * 2 + (c >> 5), rr = r & 15, cc = c & 31, ob = rr * 64 + cc * 2; return st * 1024 + (ob ^ (((ob >> 9) & 1) << 5)); }
__host__ __device__ __forceinline__ void stage_rc(int b, int& R, int& C) { const int st = b / 1024, sb = b % 1024, swz = sb ^ (((sb >> 9) & 1) << 5); R = (st >> 1) * 16 + swz / 64; C = (st & 1) * 32 + (swz % 64) / 2; }
__host__ __device__ __forceinline__ int perm32(int rho) { const int n = rho >> 4, i = rho & 15; return 8 * (i >> 2) + 4 * n + (i & 3); }

struct Unit { int pm, pn, k0, nk; };
struct Gemm { const bf16_t* A; const bf16_t* Bt; int M, N, K; };

struct StaticOrder {
    int nM, nN, nwg, G, c;
    __host__ __device__ void init(int M, int N, int G_, int c_) { nM = M / BM; nN = N / BM; nwg = nM * nN; G = G_; c = c_; }
    __host__ __device__ bool next(int i, Unit& u) const {
        const long L = (long)i * G + c; if (L >= nwg) return false;
        int wgid = (int)L; { const int q = nwg / NXCD, r = nwg % NXCD, xcd = wgid % NXCD, off = wgid / NXCD; wgid = (xcd < r ? xcd * (q + 1) : r * (q + 1) + (xcd - r) * q) + off; }
        const int nig = WGM * nN, gid = wgid / nig, fm = gid * WGM, gsz = (nM - fm) < WGM ? (nM - fm) : WGM;
        u.pm = fm + ((wgid % nig) % gsz); u.pn = (wgid % nig) / gsz; u.k0 = 0; u.nk = 0; return true;
    }
    __device__ __forceinline__ void a_ready(const Unit&) const {}
    __device__ __forceinline__ void done(const Unit&) const {}
};

typedef unsigned u32x2 __attribute__((ext_vector_type(2)));
__device__ __forceinline__ unsigned cvt_pk_bf16(float lo, float hi) { unsigned r; asm volatile("v_cvt_pk_bf16_f32 %0, %1, %2" : "=v"(r) : "v"(lo), "v"(hi)); return r; }
__device__ __forceinline__ float fast_sigmoid(float v) { return __builtin_amdgcn_rcpf(1.0f + __expf(-v)); }
__device__ __forceinline__ float bf_lo(unsigned w) { return __uint_as_float(w << 16); }
__device__ __forceinline__ float bf_hi(unsigned w) { return __uint_as_float(w & 0xffff0000u); }
struct EpiZ {
    static constexpr bool PERM = true, AFTER_DRAIN = false, CHAIN = false;
    bf16_t* O; int ldc;
    __device__ __forceinline__ void operator()(const f32x4 (&acc)[2][2][4][2], const Unit& u, int wr, int wc, int fr, int fq) const {
        const int row0 = u.pm * BM + wr * 64 + fr; const int col0 = u.pn * BM + wc * 32 + 8 * fq;
#pragma unroll
        for (int ai = 0; ai < 2; ++ai)
#pragma unroll
            for (int m = 0; m < 4; ++m) { bf16_t* rowp = O + (size_t)(row0 + ai * HALF + m * 16) * ldc + col0;
#pragma unroll
                for (int bj = 0; bj < 2; ++bj) { const f32x4 v0 = acc[ai][bj][m][0], v1 = acc[ai][bj][m][1];
                    u32x4 w; w.x = cvt_pk_bf16(v0[0], v0[1]); w.y = cvt_pk_bf16(v0[2], v0[3]); w.z = cvt_pk_bf16(v1[0], v1[1]); w.w = cvt_pk_bf16(v1[2], v1[3]);
                    *(u32x4*)(rowp + bj * HALF) = w; } }
    }
};
struct EpiSwiglu {
    static constexpr bool PERM = true, AFTER_DRAIN = false, CHAIN = false;
    bf16_t* O;
    __device__ __forceinline__ void operator()(const f32x4 (&acc)[2][2][4][2], const Unit& u, int wr, int wc, int fr, int fq) const {
        const int row0 = u.pm * BM + wr * 64 + fr; const int col0 = u.pn * HALF + wc * 32 + 8 * fq;
#pragma unroll
        for (int ai = 0; ai < 2; ++ai)
#pragma unroll
            for (int m = 0; m < 4; ++m) { bf16_t* rowp = O + (size_t)(row0 + ai * HALF + m * 16) * 2816 + col0;
                float h[8];
#pragma unroll
                for (int n = 0; n < 2; ++n)
#pragma unroll
                    for (int j = 0; j < 4; ++j) { const float a = acc[ai][0][m][n][j], b = acc[ai][1][m][n][j]; h[n * 4 + j] = a * fast_sigmoid(a) * b; }
                u32x4 w; w.x = cvt_pk_bf16(h[0], h[1]); w.y = cvt_pk_bf16(h[2], h[3]); w.z = cvt_pk_bf16(h[4], h[5]); w.w = cvt_pk_bf16(h[6], h[7]);
                *(u32x4*)rowp = w; }
    }
};
struct EpiResid {
    static constexpr bool PERM = false, AFTER_DRAIN = false, CHAIN = false;
    float* X; const float* gate; float scale; float* PARTC;
    __device__ __forceinline__ void operator()(const f32x4 (&acc)[2][2][4][2], const Unit& u, int wr, int wc, int fr, int fq) const {
        const int bb = u.pm / 17, mrow = (u.pm - bb * 17 == 0) ? 4 : bb;
        const int col0 = u.pn * BM + wc * 32 + 4 * fq;
        if (u.nk != 0) {
            const int sp = u.k0 / (u.nk * 64); bf16_t* base = (bf16_t*)PARTC + ((size_t)sp * 1024 + (size_t)bb * 256 + wr * 64 + fr) * 1024 + col0;
#pragma unroll
            for (int ai = 0; ai < 2; ++ai)
#pragma unroll
                for (int m = 0; m < 4; ++m)
#pragma unroll
                    for (int bj = 0; bj < 2; ++bj)
#pragma unroll
                        for (int n = 0; n < 2; ++n) { const f32x4 v = acc[ai][bj][m][n]; u32x2 w; w.x = cvt_pk_bf16(v[0], v[1]); w.y = cvt_pk_bf16(v[2], v[3]);
                            *(u32x2*)(base + (size_t)(ai * HALF + m * 16) * 1024 + bj * HALF + n * 16) = w; }
            return; }
        const float* g = gate + (size_t)mrow * 9216;
        const int row0 = u.pm * BM + wr * 64 + fr;
        f32x4 gv[2][2];
#pragma unroll
        for (int bj = 0; bj < 2; ++bj)
#pragma unroll
            for (int n = 0; n < 2; ++n) gv[bj][n] = *(const f32x4*)(g + col0 + bj * HALF + n * 16) * scale;
#pragma unroll
        for (int ai = 0; ai < 2; ++ai)
#pragma unroll
            for (int m = 0; m < 4; ++m) { float* rowp = X + (size_t)(row0 + ai * HALF + m * 16) * 1024 + col0;
#pragma unroll
                for (int bj = 0; bj < 2; ++bj)
#pragma unroll
                    for (int n = 0; n < 2; ++n) { f32x4* p = (f32x4*)(rowp + bj * HALF + n * 16); *p = *p + gv[bj][n] * acc[ai][bj][m][n]; }
                asm volatile("" ::: "memory"); }
    }
};
struct EpiMerge {
    static constexpr bool PERM = false, AFTER_DRAIN = false, CHAIN = true;
    const bf16_t* Z; bf16_t* MG;
    __device__ __forceinline__ void operator()(const f32x4 (&acc)[2][2][4][2], const Unit& u, int wr, int wc, int fr, int fq) const {}
    __device__ __forceinline__ bool chain(f32x4 (&acc)[2][2][4][2], const Unit& u, int wr, int wc, int fr, int fq) const {
        const int n = u.pm / 68, pm = u.pm - n * 68, pn = u.pn & 3;
        const int row0 = pm * BM + wr * 64 + fr; const int col0 = pn * BM + wc * 32 + 4 * fq;
#pragma unroll
        for (int ai = 0; ai < 2; ++ai)
#pragma unroll
            for (int m = 0; m < 4; ++m) { const size_t row = (size_t)(row0 + ai * HALF + m * 16);
#pragma unroll
                for (int bj = 0; bj < 2; ++bj)
#pragma unroll
                    for (int nn = 0; nn < 2; ++nn) { const int col = col0 + bj * HALF + nn * 16;
                        const bf16_t* zp = Z + row * 6912 + 3840 + n * 1024 + col;
                        const u32x2 ga = *(const u32x2*)zp;
                        const float ea0 = 1.0f + __expf(-bf_lo(ga.x)), ea1 = 1.0f + __expf(-bf_hi(ga.x)), ea2 = 1.0f + __expf(-bf_lo(ga.y)), ea3 = 1.0f + __expf(-bf_hi(ga.y));
                        f32x4 sc;
                        if (n < 2) { const u32x2 gb = *(const u32x2*)(zp + 1024);
                            sc[0] = (1.0f + __expf(-bf_lo(gb.x))) * __builtin_amdgcn_rcpf(ea0); sc[1] = (1.0f + __expf(-bf_hi(gb.x))) * __builtin_amdgcn_rcpf(ea1);
                            sc[2] = (1.0f + __expf(-bf_lo(gb.y))) * __builtin_amdgcn_rcpf(ea2); sc[3] = (1.0f + __expf(-bf_hi(gb.y))) * __builtin_amdgcn_rcpf(ea3);
                            acc[ai][bj][m][nn] = acc[ai][bj][m][nn] * sc; }
                        else { sc[0] = __builtin_amdgcn_rcpf(ea0); sc[1] = __builtin_amdgcn_rcpf(ea1); sc[2] = __builtin_amdgcn_rcpf(ea2); sc[3] = __builtin_amdgcn_rcpf(ea3);
                            const f32x4 v = acc[ai][bj][m][nn] * sc; u32x2 w; w.x = cvt_pk_bf16(v[0], v[1]); w.y = cvt_pk_bf16(v[2], v[3]); *(u32x2*)(MG + row * 1024 + col) = w; } }
                asm volatile("" ::: "memory"); }
        return n < 2;
    }
};
struct MergeOrder {
    int G, c, latonly;
    __device__ bool next(int i, Unit& u) const {
        const int ti = i / 3, n = i - ti * 3; const int L = ti * G + c; if (L >= (latonly ? 256 : 272)) return false;
        const int t = L >> 2; const int pm = latonly ? ((t >> 4) * 17 + 1 + (t & 15)) : t;
        u.pm = n * 68 + pm; u.pn = n * 4 + (L & 3); u.k0 = 0; u.nk = 0; return true;
    }
    __device__ __forceinline__ void a_ready(const Unit&) const {}
    __device__ __forceinline__ void done(const Unit&) const {}
};
struct LastLayerOrder {
    StaticOrder so; int nextra;
    __device__ void init(int N, int G, int c, int nextra_) { so.init(64 * BM, N, G, c); nextra = nextra_; }
    __device__ bool next(int i, Unit& u) const {
        if (so.next(i, u)) { const int v = u.pm; u.pm = (v >> 4) * 17 + 1 + (v & 15); return true; }
        const int L = i * so.G + so.c - so.nwg; if (L < 0 || L >= nextra) return false;
        const int t = L / 7, q = L - t * 7; u.pm = t * 17; u.pn = (q < 4) ? 2 + q : (q < 6) ? 4 + q : 14; u.k0 = 0; u.nk = 0; return true;
    }
    __device__ __forceinline__ void a_ready(const Unit&) const {}
    __device__ __forceinline__ void done(const Unit&) const {}
};
struct LatOrder {
    int G, c;
    __device__ bool next(int i, Unit& u) const {
        const int L = i * G + c; if (L >= 256) return false;
        const int t = L >> 2; u.pm = (t >> 4) * 17 + 1 + (t & 15); u.pn = L & 3; u.k0 = 0; u.nk = 0; return true;
    }
    __device__ __forceinline__ void a_ready(const Unit&) const {}
    __device__ __forceinline__ void done(const Unit&) const {}
};
struct SplitOrder {
    int G, c, nsplit, nkt;
    __device__ bool next(int i, Unit& u) const {
        int L = i * G + c;
        if (L < 256) { const int t = L >> 2; u.pm = (t >> 4) * 17 + 1 + (t & 15); u.pn = L & 3; u.k0 = 0; u.nk = 0; return true; }
        L -= 256; if (L >= 16 * nsplit) return false;
        const int t = L / nsplit, s = L - t * nsplit;
        u.pm = (t >> 2) * 17; u.pn = t & 3; u.k0 = s * nkt * 64; u.nk = nkt; return true;
    }
    __device__ __forceinline__ void a_ready(const Unit&) const {}
    __device__ __forceinline__ void done(const Unit&) const {}
};
template <int KT, class Epi, class Sched, bool ALIGN_EPI = false, bool SP2 = false>
__device__ __forceinline__ void gemm_phase(PG8_LAS unsigned char* lds, const Gemm g, const Sched& S, const Epi& E, const int tid) {
    const int wid = __builtin_amdgcn_readfirstlane(tid >> 6), lane = tid & 63, wr = wid >> 2, wc = wid & 3, fr = lane & 15, fq = lane >> 4;
    constexpr int K = KT, nt = K / BK;
    unsigned voffA[2], voffB[2];
#pragma unroll
    for (int i = 0; i < 2; ++i) { int R, C; stage_rc(tid * 16 + i * 8192, R, C); const int Rb = Epi::PERM ? ((R & ~31) + perm32(R & 31)) : R;
        voffA[i] = (unsigned)(R * K + C) * 2u; voffB[i] = (unsigned)(Rb * K + C) * 2u; }
    const size_t kstep = (size_t)(BK * 2);
    const size_t hstep = (size_t)HALF * K * 2;
    const size_t tstep = 2 * hstep;
    const unsigned ldsw = (unsigned)wid * 1024u;
    const int aoff = lds_byte(wr * 64 + fr, fq * 8), boff = lds_byte(wc * 32 + fr, fq * 8);
#define PG8_SA(b, h) (((b) * 2 + (h)) * HTB)
#define PG8_SB(b, h) ((4 + (b) * 2 + (h)) * HTB)
#define PG8_STAGE(bufoff, gbase, voff) do { _Pragma("unroll") for (int _i = 0; _i < 2; ++_i) \
        __builtin_amdgcn_global_load_lds((const unsigned*)((const char*)(gbase) + (voff)[_i]), (PG8_LAS unsigned*)(lds + (bufoff) + ldsw + _i * 8192), 16, 0, 0); } while (0)
#define PG8_LDA(dst, b, h) do { _Pragma("unroll") for (int m = 0; m < 4; ++m) _Pragma("unroll") for (int k = 0; k < 2; ++k) dst[m][k] = *(const PG8_LAS bf16x8*)(lds + PG8_SA(b, h) + aoff + m * 2048 + k * 1024); } while (0)
#define PG8_LDB(dst, b, h) do { _Pragma("unroll") for (int n = 0; n < 2; ++n) _Pragma("unroll") for (int k = 0; k < 2; ++k) dst[n][k] = *(const PG8_LAS bf16x8*)(lds + PG8_SB(b, h) + boff + n * 2048 + k * 1024); } while (0)
#define PG8_MMA(ai, bj, At, Bt) do { __builtin_amdgcn_s_setprio(1); _Pragma("unroll") for (int m = 0; m < 4; ++m) _Pragma("unroll") for (int n = 0; n < 2; ++n) _Pragma("unroll") for (int k = 0; k < 2; ++k) \
        acc[ai][bj][m][n] = __builtin_amdgcn_mfma_f32_16x16x32_bf16(Bt[n][k], At[m][k], acc[ai][bj][m][n], 0, 0, 0); __builtin_amdgcn_s_setprio(0); } while (0)
#define PG8_WAIT_V(n) asm volatile("s_waitcnt vmcnt(" #n ")" ::: "memory")
#define PG8_WAIT_L(n) asm volatile("s_waitcnt lgkmcnt(" #n ")" ::: "memory")
#define PG8_BAR __builtin_amdgcn_s_barrier()
#define PG8_SCHED __builtin_amdgcn_sched_barrier(0)
    Unit cur{0, 0, 0, 0}, nxt{0, 0, 0, 0}; int ui = 0;
    if (!S.next(0, cur)) return;
    f32x4 acc[2][2][4][2];
#pragma unroll
    for (int a = 0; a < 2; ++a)
#pragma unroll
        for (int b = 0; b < 2; ++b)
#pragma unroll
            for (int m = 0; m < 4; ++m)
#pragma unroll
                for (int n = 0; n < 2; ++n) acc[a][b][m][n] = (f32x4){0.f, 0.f, 0.f, 0.f};
    bf16x8 At[4][2], B0[2][2], B1[2][2];
    const char* cA = (const char*)g.A + (size_t)cur.pm * tstep + (size_t)cur.k0 * 2; const char* cB = (const char*)g.Bt + (size_t)cur.pn * tstep + (size_t)cur.k0 * 2;
    S.a_ready(cur);
    if constexpr (SP2) {
        PG8_STAGE(PG8_SB(0, 0), cB, voffB); PG8_STAGE(PG8_SB(0, 1), cB + hstep, voffB); PG8_STAGE(PG8_SA(0, 0), cA, voffA); PG8_STAGE(PG8_SA(0, 1), cA + hstep, voffA);
        if (wr == 1) PG8_BAR;
        PG8_WAIT_V(2); PG8_BAR;
        PG8_STAGE(PG8_SB(1, 0), cB + kstep, voffB); PG8_STAGE(PG8_SA(1, 0), cA + kstep, voffA); PG8_STAGE(PG8_SB(1, 1), cB + hstep + kstep, voffB);
        PG8_WAIT_V(6); PG8_BAR;
    } else {
        PG8_STAGE(PG8_SB(0, 0), cB, voffB); PG8_STAGE(PG8_SA(0, 0), cA, voffA); PG8_STAGE(PG8_SB(0, 1), cB + hstep, voffB); PG8_STAGE(PG8_SA(0, 1), cA + hstep, voffA);
        if (wr == 1) PG8_BAR;
        PG8_WAIT_V(4); PG8_BAR;
        PG8_STAGE(PG8_SB(1, 0), cB + kstep, voffB); PG8_STAGE(PG8_SA(1, 0), cA + kstep, voffA); PG8_STAGE(PG8_SB(1, 1), cB + hstep + kstep, voffB);
        PG8_WAIT_V(6); PG8_BAR;
    }
    for (;;) {
        const bool has_next = S.next(ui + 1, nxt);
        const char* nA = has_next ? (const char*)g.A + (size_t)nxt.pm * tstep + (size_t)nxt.k0 * 2 : cA; const char* nB = has_next ? (const char*)g.Bt + (size_t)nxt.pn * tstep + (size_t)nxt.k0 * 2 : cB;
        const int ntu = cur.nk ? cur.nk : nt;
        for (int t = 0; t < ntu; t += 2) {
            const bool last = (t == ntu - 2);
            const char* a1 = cA + (size_t)(t + 1) * kstep;
            const char* a2 = last ? nA : cA + (size_t)(t + 2) * kstep; const char* b2 = last ? nB : cB + (size_t)(t + 2) * kstep;
            const char* a3 = a2 + kstep; const char* b3 = b2 + kstep;
            if (last && has_next) S.a_ready(nxt);
            if constexpr (SP2) {
            PG8_LDB(B0, 0, 0); PG8_LDB(B1, 0, 1); PG8_SCHED; PG8_LDA(At, 0, 0); PG8_STAGE(PG8_SA(1, 1), a1 + hstep, voffA);
            PG8_WAIT_V(8); PG8_WAIT_L(0); PG8_BAR; PG8_MMA(0, 0, At, B0); PG8_MMA(0, 1, At, B1); PG8_BAR; PG8_SCHED;
            PG8_LDA(At, 0, 1); PG8_STAGE(PG8_SB(0, 0), b2, voffB); PG8_STAGE(PG8_SB(0, 1), b2 + hstep, voffB); PG8_STAGE(PG8_SA(0, 0), a2, voffA);
            PG8_WAIT_V(8); PG8_WAIT_L(0); PG8_BAR; PG8_MMA(1, 0, At, B0); PG8_MMA(1, 1, At, B1); PG8_BAR; PG8_SCHED;
            PG8_LDB(B0, 1, 0); PG8_LDB(B1, 1, 1); PG8_SCHED; PG8_LDA(At, 1, 0); PG8_STAGE(PG8_SA(0, 1), a2 + hstep, voffA);
            PG8_WAIT_V(8); PG8_WAIT_L(0); PG8_BAR; PG8_MMA(0, 0, At, B0); PG8_MMA(0, 1, At, B1); PG8_BAR; PG8_SCHED;
            PG8_LDA(At, 1, 1); PG8_STAGE(PG8_SB(1, 0), b3, voffB); PG8_STAGE(PG8_SB(1, 1), b3 + hstep, voffB); PG8_STAGE(PG8_SA(1, 0), a3, voffA);
            PG8_WAIT_V(8); PG8_WAIT_L(0); PG8_BAR; PG8_MMA(1, 0, At, B0); PG8_MMA(1, 1, At, B1); PG8_BAR; PG8_SCHED;
            } else {
            PG8_LDB(B0, 0, 0); PG8_SCHED; PG8_LDA(At, 0, 0); PG8_STAGE(PG8_SA(1, 1), a1 + hstep, voffA);
            PG8_WAIT_L(8); PG8_BAR; PG8_WAIT_L(0); PG8_MMA(0, 0, At, B0); PG8_BAR; PG8_SCHED;
            PG8_LDB(B1, 0, 1); PG8_STAGE(PG8_SB(0, 0), b2, voffB);
            PG8_BAR; PG8_WAIT_L(0); PG8_MMA(0, 1, At, B1); PG8_BAR;
            PG8_LDA(At, 0, 1); PG8_STAGE(PG8_SA(0, 0), a2, voffA);
            PG8_BAR; PG8_WAIT_L(0); PG8_MMA(1, 0, At, B0); PG8_BAR; PG8_SCHED;
            PG8_STAGE(PG8_SB(0, 1), b2 + hstep, voffB);
            PG8_WAIT_V(6); PG8_BAR; PG8_MMA(1, 1, At, B1); PG8_BAR;
            PG8_LDB(B0, 1, 0); PG8_SCHED; PG8_LDA(At, 1, 0); PG8_STAGE(PG8_SA(0, 1), a2 + hstep, voffA);
            PG8_WAIT_L(8); PG8_BAR; PG8_WAIT_L(0); PG8_MMA(0, 0, At, B0); PG8_BAR; PG8_SCHED;
            PG8_LDB(B1, 1, 1); PG8_STAGE(PG8_SB(1, 0), b3, voffB);
            PG8_BAR; PG8_WAIT_L(0); PG8_MMA(0, 1, At, B1); PG8_BAR;
            PG8_LDA(At, 1, 1); PG8_STAGE(PG8_SA(1, 0), a3, voffA);
            PG8_BAR; PG8_WAIT_L(0); PG8_MMA(1, 0, At, B0); PG8_BAR; PG8_SCHED;
            PG8_STAGE(PG8_SB(1, 1), b3 + hstep, voffB);
            PG8_WAIT_V(6); PG8_BAR; PG8_MMA(1, 1, At, B1); PG8_BAR;
            }
        }
        if constexpr (ALIGN_EPI) { if (wr == 0) PG8_BAR; }
        bool keep_acc = false;
        if constexpr (!Epi::AFTER_DRAIN) { if constexpr (Epi::CHAIN) keep_acc = E.chain(acc, cur, wr, wc, fr, fq); else E(acc, cur, wr, wc, fr, fq); S.done(cur); }
        if (!has_next) break;
        if (!keep_acc) {
#pragma unroll
        for (int a = 0; a < 2; ++a)
#pragma unroll
            for (int b = 0; b < 2; ++b)
#pragma unroll
                for (int m = 0; m < 4; ++m)
#pragma unroll
                    for (int n = 0; n < 2; ++n) acc[a][b][m][n] = (f32x4){0.f, 0.f, 0.f, 0.f};
        }
        cur = nxt; cA = nA; cB = nB; ++ui;
        if constexpr (ALIGN_EPI) { if (wr == 1) PG8_BAR; }
    }
    PG8_WAIT_V(0);
    if constexpr (!ALIGN_EPI) { if (wr == 0) PG8_BAR; }
    PG8_BAR;
    if constexpr (Epi::AFTER_DRAIN) { E.fused(acc, cur, wr, wc, fr, fq, lds, wid, lane); S.done(cur); }
#undef PG8_SA
#undef PG8_SB
#undef PG8_STAGE
#undef PG8_LDA
#undef PG8_LDB
#undef PG8_MMA
#undef PG8_WAIT_V
#undef PG8_WAIT_L
#undef PG8_BAR
#undef PG8_SCHED
}
}
namespace attn_body {
using bf16=__hip_bfloat16;
using bf16x8=__attribute__((ext_vector_type(8)))short;
using s16x4=__attribute__((ext_vector_type(4)))short;
using f32x16=__attribute__((ext_vector_type(16)))float;
using u32x4=__attribute__((ext_vector_type(4)))unsigned;
constexpr int D=64,QP=512,KP=128,VP=6912,OP=512;
constexpr int NW=8,QBLK=32,QB=QBLK*NW,KVBLK=64;
__device__ __forceinline__ int crow(int r,int hi){return (r&3)+8*(r>>2)+4*hi;}
#define SBAR() __builtin_amdgcn_sched_barrier(0)
constexpr int NSLOT=3, SLOTB=8192;
constexpr int LDS_K=0, LDS_V=NSLOT*SLOTB, LDS_WS=2*NSLOT*SLOTB, LDS_OST=LDS_WS+NW*64*4, LDS_BYTES=LDS_OST+NW*4096;
constexpr float C2=0.125f*1.4426950408889634f;
__device__ __forceinline__ void glds16(const void*gsrc,unsigned lds_dst){unsigned keep;
  asm volatile("s_mov_b32 %0, m0\n\ts_mov_b32 m0, %2\n\ts_nop 0\n\tglobal_load_lds_dwordx4 %1, off\n\ts_mov_b32 m0, %0":"=&s"(keep):"v"(gsrc),"s"(lds_dst):"memory");}
__device__ __forceinline__ float max3f(float a,float b,float c){float r;asm("v_max3_f32 %0, %1, %2, %3":"=v"(r):"v"(a),"v"(b),"v"(c));return r;}
__device__ __forceinline__ float max2f(float a,float b){float r;asm("v_max_f32_e32 %0, %1, %2":"=v"(r):"v"(a),"v"(b));return r;}
__device__ __forceinline__ float fadd_s(float a,float b){float r;asm("v_add_f32_e32 %0, %1, %2":"=v"(r):"v"(a),"v"(b));return r;}
__device__ __forceinline__ float fsub_s(float a,float b){float r;asm("v_sub_f32_e32 %0, %1, %2":"=v"(r):"v"(a),"v"(b));return r;}
typedef float f32x2_t __attribute__((ext_vector_type(2))); typedef __bf16 bf16x2_t __attribute__((ext_vector_type(2)));
__device__ __forceinline__ unsigned cvtpk_s(float lo,float hi){f32x2_t v={lo,hi};bf16x2_t b=__builtin_convertvector(v,bf16x2_t);return __builtin_bit_cast(unsigned,b);}
#define WAIT_BAR(N) asm volatile("s_waitcnt vmcnt(" #N ") lgkmcnt(0)\n\ts_barrier":::"memory")

__device__ __forceinline__ void qkt(f32x16&p0,f32x16&p1,const char*Kslot,const bf16x8*qr,const f32x16&negm,int r32,int hi){
  const char*kb=Kslot+hi*1024+r32*16;
  #pragma unroll
  for(int d0=0;d0<4;++d0){
    const bf16x8 b0=*reinterpret_cast<const bf16x8*>(kb+d0*2048);
    const bf16x8 b1=*reinterpret_cast<const bf16x8*>(kb+d0*2048+512);
    if(d0==0){p0=__builtin_amdgcn_mfma_f32_32x32x16_bf16(b0,qr[0],negm,0,0,0);p1=__builtin_amdgcn_mfma_f32_32x32x16_bf16(b1,qr[0],negm,0,0,0);}
    else{p0=__builtin_amdgcn_mfma_f32_32x32x16_bf16(b0,qr[d0],p0,0,0,0);p1=__builtin_amdgcn_mfma_f32_32x32x16_bf16(b1,qr[d0],p1,0,0,0);}}
}
typedef __attribute__((address_space(3))) const char* lds_cptr;
typedef short v4i16_t __attribute__((ext_vector_type(4)));
__device__ __forceinline__ void kload8(bf16x8*kf,lds_cptr kp){
  kf[0]=*(const __attribute__((address_space(3))) bf16x8*)(kp);      kf[1]=*(const __attribute__((address_space(3))) bf16x8*)(kp+512);
  kf[2]=*(const __attribute__((address_space(3))) bf16x8*)(kp+2048); kf[3]=*(const __attribute__((address_space(3))) bf16x8*)(kp+2560);
  kf[4]=*(const __attribute__((address_space(3))) bf16x8*)(kp+4096); kf[5]=*(const __attribute__((address_space(3))) bf16x8*)(kp+4608);
  kf[6]=*(const __attribute__((address_space(3))) bf16x8*)(kp+6144); kf[7]=*(const __attribute__((address_space(3))) bf16x8*)(kp+6656);
}
__device__ __forceinline__ void kload2(bf16x8*kf,lds_cptr kp,int j){ kf[2*j]=*(const __attribute__((address_space(3))) bf16x8*)(kp+j*2048); kf[2*j+1]=*(const __attribute__((address_space(3))) bf16x8*)(kp+j*2048+512); }
__device__ __forceinline__ s16x4 vtr(lds_cptr p){ return __builtin_bit_cast(s16x4,__builtin_amdgcn_ds_read_tr16_b64_v4i16((__attribute__((address_space(3))) v4i16_t*)p)); }
__device__ __forceinline__ float rowmax(const f32x16&p0,const f32x16&p1){
  float a=max3f(p0[0],p0[1],p1[0]),b=max3f(p0[2],p0[3],p1[1]);a=max3f(a,p1[2],p1[3]);
  #pragma unroll
  for(int r=4;r<16;r+=4){a=max3f(a,p0[r],p0[r+1]);b=max3f(b,p0[r+2],p0[r+3]);a=max3f(a,p1[r],p1[r+1]);b=max3f(b,p1[r+2],p1[r+3]);}
  const float m=max2f(a,b);
  auto rr=__builtin_amdgcn_permlane32_swap(__float_as_uint(m),__float_as_uint(m),false,false);
  return max2f(__uint_as_float(rr[0]),__uint_as_float(rr[1]));
}
__device__ __forceinline__ void pv(f32x16*o,int vb,bf16x8 pa0,bf16x8 pa1,bf16x8 pa2,bf16x8 pa3){
  #pragma unroll
  for(int d0=0;d0<2;++d0){s16x4 lo[4],hi[4];
    #pragma unroll
    for(int ks=0;ks<4;++ks){
      asm volatile("ds_read_b64_tr_b16 %0,%1 offset:%c2":"=&v"(lo[ks]):"v"(vb),"i"(d0*4096+ks*1024):"memory");
      asm volatile("ds_read_b64_tr_b16 %0,%1 offset:%c2":"=&v"(hi[ks]):"v"(vb),"i"(d0*4096+ks*1024+512):"memory");}
    asm volatile("s_waitcnt lgkmcnt(0)":::"memory");SBAR();
    #define PK(k) (bf16x8){lo[k][0],lo[k][1],lo[k][2],lo[k][3],hi[k][0],hi[k][1],hi[k][2],hi[k][3]}
    o[d0]=__builtin_amdgcn_mfma_f32_32x32x16_bf16(pa0,PK(0),o[d0],0,0,0);
    o[d0]=__builtin_amdgcn_mfma_f32_32x32x16_bf16(pa1,PK(1),o[d0],0,0,0);
    o[d0]=__builtin_amdgcn_mfma_f32_32x32x16_bf16(pa2,PK(2),o[d0],0,0,0);
    o[d0]=__builtin_amdgcn_mfma_f32_32x32x16_bf16(pa3,PK(3),o[d0],0,0,0);
    #undef PK
  }
}

#ifndef ATTN_STORE16
#define ATTN_STORE16(p,v) (*(u32x4*)(p)=(v))
#endif
template<int THRL> __device__ __forceinline__ void attn_unit(long qrow0,long kvrow0,int hq,int kvh,int NT,const bf16*Q,const bf16*__restrict__ K,const bf16*__restrict__ V,bf16*O,char*shm,const int tid,const float*gqp,const float*rbp,long tq){
  const int lane=tid&63,r32=lane&31,hi=lane>>5; const int wid=__builtin_amdgcn_readfirstlane(tid>>6);
  const bf16*Qw=Q+(qrow0+wid*QBLK)*QP+hq*D;
  const bf16*Kh=K+kvrow0*KP+kvh*D,*Vh=V+kvrow0*VP+kvh*D;
  const unsigned lds0=(unsigned)(uintptr_t)shm;
  float*wsf=(float*)(shm+LDS_WS)+wid*64;
  const bf16*ksrc=Kh+(long)lane*KP+wid*8;
  const bf16*vsrc=Vh+(long)(16*(wid&3)+(lane>>2))*VP+(wid>>2)*32+(lane&3)*8;
  const unsigned kdst=lds0+LDS_K+wid*1024, vdst=lds0+LDS_V+wid*1024;
  #define DMA_K(t,slot) glds16(ksrc+(long)(t)*KVBLK*KP,(unsigned)__builtin_amdgcn_readfirstlane(kdst+(slot)))
  #define DMA_V(t,slot) glds16(vsrc+(long)(t)*KVBLK*VP,(unsigned)__builtin_amdgcn_readfirstlane(vdst+(slot)))
  const int vb0=(int)(lds0+LDS_V)+((lane>>4)&1)*32+(lane&3)*8+(4*hi+((lane&15)>>2))*64;
  const char*Kbase=shm+LDS_K; bf16x8 kf[8];
  const lds_cptr shm3=(lds_cptr)shm; const lds_cptr kp0=shm3+LDS_K+hi*1024+r32*16; const lds_cptr vp0=shm3+LDS_V+((lane>>4)&1)*32+(lane&3)*8+(4*hi+((lane&15)>>2))*64;
  DMA_K(0,0);DMA_V(0,0);DMA_K(1,SLOTB);
  bf16x8 qr[4];
  { const bf16*Zq=Q+(qrow0+wid*QBLK+r32)*(long)VP+hq*D; float f[4][8]; float ss=0.f;
    #pragma unroll
    for(int d0=0;d0<4;++d0){ const bf16x8 raw=*reinterpret_cast<const bf16x8*>(Zq+d0*16+hi*8);
      #pragma unroll
      for(int j=0;j<8;++j){ f[d0][j]=__uint_as_float(((unsigned)(unsigned short)raw[j])<<16); ss+=f[d0][j]*f[d0][j]; } }
    { auto rr=__builtin_amdgcn_permlane32_swap(__float_as_uint(ss),__float_as_uint(ss),false,false); ss=__uint_as_float(rr[0])+__uint_as_float(rr[1]); }
    const float rstd=__builtin_amdgcn_rsqf(ss*(1.0f/64.0f)+1e-6f);
    #pragma unroll
    for(int d0=0;d0<4;++d0){ const float*gp=gqp+d0*16+hi*8;
      #pragma unroll
      for(int j=0;j<8;++j) f[d0][j]*=rstd*gp[j]; }
    if(tq>=0){ const long t=tq+wid*QBLK+r32; const int prow=(int)(t>>6), pcol=(int)(t&63);
      const float*tr=rbp+(prow*16+hi*8)*2; const float*tc=rbp+(pcol*16+hi*8)*2;
      #pragma unroll
      for(int j=0;j<8;++j){ const float cs=tr[2*j],sn=tr[2*j+1]; const float x1=f[0][j],x2=f[1][j]; f[0][j]=x1*cs-x2*sn; f[1][j]=x1*sn+x2*cs;
                            const float cc=tc[2*j],sc=tc[2*j+1]; const float y1=f[2][j],y2=f[3][j]; f[2][j]=y1*cc-y2*sc; f[3][j]=y1*sc+y2*cc; } }
    #pragma unroll
    for(int d0=0;d0<4;++d0){ u32x4 w; w.x=cvtpk_s(f[d0][0]*C2,f[d0][1]*C2); w.y=cvtpk_s(f[d0][2]*C2,f[d0][3]*C2); w.z=cvtpk_s(f[d0][4]*C2,f[d0][5]*C2); w.w=cvtpk_s(f[d0][6]*C2,f[d0][7]*C2);
      qr[d0]=__builtin_bit_cast(bf16x8,w); } }
  float mhat=0.f,l_reg=0.f;float z0_=0.f;asm volatile("":"+v"(z0_));f32x16 o[2];f32x16 negm;
  #pragma unroll
  for(int r=0;r<16;++r){o[0][r]=z0_;o[1][r]=z0_;negm[r]=z0_;}
  asm volatile("":"+v"(negm));
  #define CMASK(P0,P1,t) do{}while(0)
  bool resc=false;
  #define START(P0,P1) do{ const float rm=rowmax(P0,P1); resc=false; \
    { const float dl=rm; mhat=fadd_s(mhat,dl); \
      _Pragma("unroll") for(int r=0;r<16;++r){P0[r]=fsub_s(P0[r],dl);P1[r]=fsub_s(P1[r],dl);} \
      _Pragma("unroll") for(int r=0;r<16;++r)negm[r]=-mhat; asm volatile("":"+v"(negm)); } \
    _Pragma("unroll") for(int r=0;r<16;++r)P0[r]=__builtin_amdgcn_exp2f(P0[r]); }while(0)
  #define RESC() do{ if(resc){ asm volatile("s_waitcnt lgkmcnt(0)":::"memory"); \
      _Pragma("unroll") for(int d_=0;d_<2;++d_) _Pragma("unroll") for(int r=0;r<16;++r)o[d_][r]*=wsf[crow(r,hi)]; } }while(0)
  f32x16 pA0,pA1,pB0,pB1;
  int sl_prev=0,sl_cur=0,sl_next=SLOTB;
  #define ROT() do{sl_prev=sl_cur;sl_cur=sl_next;sl_next=(sl_next==(NSLOT-1)*SLOTB)?0:sl_next+SLOTB;}while(0)
  DMA_K(2,2*SLOTB);
  WAIT_BAR(3);
  qkt(pA0,pA1,Kbase,qr,negm,r32,hi);asm volatile("s_nop 15\n\ts_nop 7":"+v"(pA0),"+v"(pA1));CMASK(pA0,pA1,0);
  START(pA0,pA1);
  _Pragma("unroll") for(int r=0;r<16;++r)pA1[r]=__builtin_amdgcn_exp2f(pA1[r]);
  WAIT_BAR(0);
  DMA_K(3,0);DMA_V(1,SLOTB);
  ROT();
  kload8(kf,kp0+sl_cur);
  WAIT_BAR(2);
  s16x4 vlo[8],vhi[8]; u32x4 pw0,pw1,pw2,pw3;
  #define PKW(P,B) cvtpk_s(P[B],P[B+1])
  #define PAF(k) __builtin_bit_cast(bf16x8,pw##k)
  #define VFR(i) (bf16x8){vlo[i][0],vlo[i][1],vlo[i][2],vlo[i][3],vhi[i][0],vhi[i][1],vhi[i][2],vhi[i][3]}
  #define PIN(x) asm volatile("":"+v"(x))
  #define MX3(a,b,c) __builtin_fmaxf(__builtin_fmaxf((a),(b)),(c))
  #define GAPA(MF,A0,A1,A2,A3,W0,W1,PW) do{ MF; sacc+=A0; sacc+=A1; sacc+=A2; sacc+=A3; PIN(sacc); W0; W1; PIN(PW); SBAR(); }while(0)
  #define EX(v) __builtin_amdgcn_exp2f(v)
  #define GAPB(MF,X,B) do{ MF; X[B]=EX(X[B]); X[B+1]=EX(X[B+1]); X[B+2]=EX(X[B+2]); X[B+3]=EX(X[B+3]); PIN(X); SBAR(); }while(0)
  #define VRD(i) do{ vlo[i]=vtr(vp_+(((i)>>2)*4096+((i)&3)*1024)); vhi[i]=vtr(vp_+(((i)>>2)*4096+((i)&3)*1024+512)); }while(0)
  #define KRD(G,j) do{ if(G){ kload2(kf,kp0+sl_next,j); SBAR(); } }while(0)
  #define STEP(C0,C1,P0,P1,t,GK,GV,GL) do{ SBAR(); \
    const lds_cptr vp_=vp0+sl_prev; \
    VRD(0); SBAR(); float sacc=(P0[0]+P0[1]); \
    GAPA(C0=__builtin_amdgcn_mfma_f32_32x32x16_bf16(kf[0],qr[0],negm,0,0,0), P0[2],P0[3],P0[4],P0[5],     pw0[0]=PKW(P0,0), pw0[1]=PKW(P0,2), pw0); \
    VRD(4); SBAR(); GAPA(C1=__builtin_amdgcn_mfma_f32_32x32x16_bf16(kf[1],qr[0],negm,0,0,0), P0[6],P0[7],P0[8],P0[9],     pw0[2]=PKW(P0,4), pw0[3]=PKW(P0,6), pw0); \
    VRD(1); SBAR(); GAPA(C0=__builtin_amdgcn_mfma_f32_32x32x16_bf16(kf[2],qr[1],C0,0,0,0),   P0[10],P0[11],P0[12],P0[13], pw1[0]=PKW(P0,8), pw1[1]=PKW(P0,10), pw1); \
    VRD(5); SBAR(); GAPA(C1=__builtin_amdgcn_mfma_f32_32x32x16_bf16(kf[3],qr[1],C1,0,0,0),   P0[14],P0[15],P1[0],P1[1],   pw1[2]=PKW(P0,12),pw1[3]=PKW(P0,14), pw1); \
    VRD(2); SBAR(); GAPA(C0=__builtin_amdgcn_mfma_f32_32x32x16_bf16(kf[4],qr[2],C0,0,0,0),   P1[2],P1[3],P1[4],P1[5],     pw2[0]=PKW(P1,0), pw2[1]=PKW(P1,2), pw2); \
    VRD(6); SBAR(); GAPA(C1=__builtin_amdgcn_mfma_f32_32x32x16_bf16(kf[5],qr[2],C1,0,0,0),   P1[6],P1[7],P1[8],P1[9],     pw2[2]=PKW(P1,4), pw2[3]=PKW(P1,6), pw2); \
    VRD(3); SBAR(); GAPA(C0=__builtin_amdgcn_mfma_f32_32x32x16_bf16(kf[6],qr[3],C0,0,0,0),   P1[10],P1[11],P1[12],P1[13], pw3[0]=PKW(P1,8), pw3[1]=PKW(P1,10), pw3); \
    VRD(7); SBAR(); GAPA(C1=__builtin_amdgcn_mfma_f32_32x32x16_bf16(kf[7],qr[3],C1,0,0,0),   P1[14],P1[15],0.f,0.f,       pw3[2]=PKW(P1,12),pw3[3]=PKW(P1,14), pw3); \
    l_reg+=sacc; \
    if(GK){DMA_K((t)+3,sl_cur);} if(GV){DMA_V((t)+1,sl_next);} \
    CMASK(C0,C1,t); \
    { float a=MX3(C0[0],C0[1],C1[0]),b=MX3(C0[2],C0[3],C1[1]); a=MX3(a,C1[2],C1[3]); \
      _Pragma("unroll") for(int r=4;r<16;r+=4){a=MX3(a,C0[r],C0[r+1]);b=MX3(b,C0[r+2],C0[r+3]);a=MX3(a,C1[r],C1[r+1]);b=MX3(b,C1[r+2],C1[r+3]);} \
      float rm=__builtin_fmaxf(a,b); { auto rr=__builtin_amdgcn_permlane32_swap(__float_as_uint(rm),__float_as_uint(rm),false,false); rm=__builtin_fmaxf(__uint_as_float(rr[0]),__uint_as_float(rr[1])); } \
      resc=false; \
      if(__builtin_expect(__any(rm>(float)THRL),0)){ const float dl=__builtin_fmaxf(rm,0.f); mhat+=dl; \
        _Pragma("unroll") for(int r=0;r<16;++r){C0[r]-=dl;C1[r]-=dl;} \
        _Pragma("unroll") for(int r=0;r<16;++r)negm[r]=-mhat; asm volatile("":"+v"(negm)); \
        const float f=__builtin_amdgcn_exp2f(-dl); l_reg*=f; if(hi==0)wsf[r32]=f; resc=true; } } \
    SBAR(); \
    GAPB(o[0]=__builtin_amdgcn_mfma_f32_32x32x16_bf16(PAF(0),VFR(0),o[0],0,0,0), C0,0); \
    GAPB(o[1]=__builtin_amdgcn_mfma_f32_32x32x16_bf16(PAF(0),VFR(4),o[1],0,0,0), C0,4); \
    KRD(GL,0); GAPB(o[0]=__builtin_amdgcn_mfma_f32_32x32x16_bf16(PAF(1),VFR(1),o[0],0,0,0), C0,8); \
    KRD(GL,1); GAPB(o[1]=__builtin_amdgcn_mfma_f32_32x32x16_bf16(PAF(1),VFR(5),o[1],0,0,0), C0,12); \
    KRD(GL,2); GAPB(o[0]=__builtin_amdgcn_mfma_f32_32x32x16_bf16(PAF(2),VFR(2),o[0],0,0,0), C1,0); \
    KRD(GL,3); GAPB(o[1]=__builtin_amdgcn_mfma_f32_32x32x16_bf16(PAF(2),VFR(6),o[1],0,0,0), C1,4); \
    GAPB(o[0]=__builtin_amdgcn_mfma_f32_32x32x16_bf16(PAF(3),VFR(3),o[0],0,0,0), C1,8); \
    GAPB(o[1]=__builtin_amdgcn_mfma_f32_32x32x16_bf16(PAF(3),VFR(7),o[1],0,0,0), C1,12); \
    }while(0)
  int t=1;
  #undef CMASK
  #define CMASK(P0,P1,t) do{}while(0)
  for(;t+5<NT;t+=2){
    STEP(pB0,pB1,pA0,pA1,t,true,true,true);     WAIT_BAR(2); RESC(); ROT();
    STEP(pA0,pA1,pB0,pB1,t+1,true,true,true);   WAIT_BAR(2); RESC(); ROT();
  }
  #undef CMASK
  #define CMASK(P0,P1,t) do{}while(0)
  #define ENDW(tt) do{ if((tt)+3<NT){WAIT_BAR(2);} else if((tt)+2<NT){WAIT_BAR(1);} else {WAIT_BAR(0);} }while(0)
  for(;t+1<NT;t+=2){
    STEP(pB0,pB1,pA0,pA1,t,(t+3<NT),(t+1<NT),(t+1<NT));       ENDW(t);   RESC(); ROT();
    STEP(pA0,pA1,pB0,pB1,t+1,(t+4<NT),(t+2<NT),(t+2<NT));     ENDW(t+1); RESC(); ROT();
  }
  STEP(pB0,pB1,pA0,pA1,NT-1,false,false,false); RESC();
  { float sacc=pB0[0]+pB0[1]; _Pragma("unroll") for(int r=2;r<16;++r)sacc+=pB0[r]; _Pragma("unroll") for(int r=0;r<16;++r)sacc+=pB1[r]; l_reg+=sacc;
    pw0=(u32x4){PKW(pB0,0),PKW(pB0,2),PKW(pB0,4),PKW(pB0,6)};pw1=(u32x4){PKW(pB0,8),PKW(pB0,10),PKW(pB0,12),PKW(pB0,14)};pw2=(u32x4){PKW(pB1,0),PKW(pB1,2),PKW(pB1,4),PKW(pB1,6)};pw3=(u32x4){PKW(pB1,8),PKW(pB1,10),PKW(pB1,12),PKW(pB1,14)};
    SBAR(); pv(o,vb0+sl_cur,PAF(0),PAF(1),PAF(2),PAF(3)); }
  #undef PKW
  #undef PAF
  #undef VFR
  #undef PIN
  #undef MX3
  #undef GAPA
  #undef GAPB
  #undef EX
  #undef VRD
  #undef KRD
  #undef STEP
  #undef ENDW
  {auto rr=__builtin_amdgcn_permlane32_swap(__float_as_uint(l_reg),__float_as_uint(l_reg),false,false);l_reg=__uint_as_float(rr[0])+__uint_as_float(rr[1]);}
  if(hi==0)wsf[32+r32]=l_reg;asm volatile("s_waitcnt lgkmcnt(0)":::"memory");
  float rli[16];
  #pragma unroll
  for(int r=0;r<16;++r)rli[r]=__builtin_amdgcn_rcpf(wsf[32+crow(r,hi)]);
  bf16*Ow=O+(qrow0+wid*QBLK)*OP+hq*D;
  { bf16*stg=(bf16*)(shm+LDS_OST)+wid*2048;
    #pragma unroll
    for(int r=0;r<16;++r){const int orow=crow(r,hi);
      #pragma unroll
      for(int d0=0;d0<2;++d0)stg[orow*64+d0*32+r32]=__float2bfloat16(o[d0][r]*rli[r]);}
    asm volatile("s_waitcnt lgkmcnt(0)":::"memory");
    #pragma unroll
    for(int i=0;i<4;++i){const int row=i*8+(lane>>3),ch=lane&7; const u32x4 v=*(const u32x4*)(stg+row*64+ch*8); ATTN_STORE16(Ow+(long)row*OP+ch*8,v);} }
  asm volatile("s_waitcnt lgkmcnt(0)\n\ts_barrier":::"memory");
  #undef DMA_K
  #undef DMA_V
  #undef CMASK
  #undef START
  #undef RESC
  #undef ROT
}
constexpr int ATTN_LDS_BYTES=LDS_BYTES;
#undef SBAR
#undef WAIT_BAR
}
#define LAS __attribute__((address_space(3)))
typedef unsigned short bf16;
typedef unsigned v4u __attribute__((ext_vector_type(4)));
typedef unsigned v2u __attribute__((ext_vector_type(2)));
typedef float f32x4 __attribute__((ext_vector_type(4)));
typedef short bf16x8 __attribute__((ext_vector_type(8)));
constexpr int NWAVES = 8;
constexpr int NB = 4, LAT = 4096, LCTX = 256, SROW = 4352, MTOK = 17408, DMODEL = 1024, DEPTH = 4, DFF = 2816, DIN = 6912, MODW = 9216;
constexpr int ZC_RQ = 0, ZC_RK = 512, ZC_RV = 1024, ZC_RG = 1536, ZC_LX = 2048, ZC_LZ = 2560, ZC_AQ = 3072, ZC_AK = 3584, ZC_AV = 3712, ZC_GT = 3840;
constexpr float NORM_EPS = 1e-6f;
constexpr size_t MiB = 1u << 20;
constexpr size_t WS_MOD = 1 * MiB, WS_ROPE = 2 * MiB, WS_SUMM = 3 * MiB, WS_HIN = 6 * MiB;
constexpr size_t WS_WSET = 54 * MiB;
constexpr size_t WS_WFI = 8 * MiB;
constexpr size_t WS_WFO = 30 * MiB;
constexpr size_t WS_WIN = 41 * MiB;
constexpr size_t WS_WB = 55 * MiB;
constexpr size_t WS_WO = 58 * MiB;
constexpr size_t WS_LRUW = 60 * MiB;
constexpr size_t WS_X = 116 * MiB;
constexpr size_t WS_HN = 184 * MiB;
constexpr size_t WS_Z = 218 * MiB;
constexpr size_t WS_QN = 448 * MiB;
constexpr size_t WS_KN = 465 * MiB;
constexpr size_t WS_Y = 470 * MiB;
constexpr size_t WS_U = 521 * MiB;
constexpr size_t WS_SIN = 589 * MiB;
constexpr size_t WS_PARTC = 624 * MiB;
constexpr size_t WS_END = 670 * MiB;
constexpr int LDS_BYTES = 147456;

__device__ __forceinline__ unsigned f2bf(float f) { unsigned u = __builtin_bit_cast(unsigned, f); return (u + 0x7fffu + ((u >> 16) & 1u)) >> 16; }
__device__ __forceinline__ unsigned pk2(float lo, float hi) { return f2bf(lo) | (f2bf(hi) << 16); }
__device__ __forceinline__ float bflo(unsigned w) { return __uint_as_float(w << 16); }
__device__ __forceinline__ float bfhi(unsigned w) { return __uint_as_float(w & 0xffff0000u); }
__device__ __forceinline__ float bf1(bf16 h) { return __uint_as_float(((unsigned)h) << 16); }
__device__ __forceinline__ void unpack8(const v4u w, float* f) { f[0] = bflo(w.x); f[1] = bfhi(w.x); f[2] = bflo(w.y); f[3] = bfhi(w.y); f[4] = bflo(w.z); f[5] = bfhi(w.z); f[6] = bflo(w.w); f[7] = bfhi(w.w); }
__device__ __forceinline__ float sigmoidf_(float v) { return __builtin_amdgcn_rcpf(1.0f + __expf(-v)); }
__device__ __forceinline__ float shx(float v, int m, int lane) { return __builtin_bit_cast(float, __builtin_amdgcn_ds_bpermute((lane ^ m) << 2, __builtin_bit_cast(int, v))); }
__device__ __forceinline__ float shi(float v, int src) { return __builtin_bit_cast(float, __builtin_amdgcn_ds_bpermute(src << 2, __builtin_bit_cast(int, v))); }
__device__ __forceinline__ float wave_sum(float v, int lane) {
#pragma unroll
    for (int o = 1; o < 64; o <<= 1) v += shx(v, o, lane);
    return v;
}
#define LDS_WAIT() asm volatile("s_waitcnt lgkmcnt(0)" ::: "memory")

struct Args { const float* in[24]; float* out; unsigned char* ws; int ph_lo, ph_hi; };
constexpr int ARGS_LDS_OFF = 139520;
struct AH { const LAS unsigned* w;
    __device__ __forceinline__ const float* in(int i) const { const unsigned lo = __builtin_amdgcn_readfirstlane(w[2 * i]), hi = __builtin_amdgcn_readfirstlane(w[2 * i + 1]); return (const float*)(((unsigned long long)hi << 32) | lo); }
    __device__ __forceinline__ float* out() const { const unsigned lo = __builtin_amdgcn_readfirstlane(w[48]), hi = __builtin_amdgcn_readfirstlane(w[49]); return (float*)(((unsigned long long)hi << 32) | lo); }
    __device__ __forceinline__ unsigned char* ws() const { const unsigned lo = __builtin_amdgcn_readfirstlane(w[50]), hi = __builtin_amdgcn_readfirstlane(w[51]); return (unsigned char*)(((unsigned long long)hi << 32) | lo); }
};
enum { I_X = 0, I_C, I_CTX, I_CCTX, I_WMOD, I_BMOD, I_NORMG, I_FFNIN, I_FFNOUT, I_WIN, I_RETLOGIT, I_RETG, I_CONVW, I_CONVB, I_LWA, I_LBA, I_LWX, I_LBX, I_LAM, I_QG, I_KG, I_WBR, I_WOUT, I_FG };

__device__ __forceinline__ void tr_item(const float* W, int N, int k0, int n0, bf16* WT, int K, int orow0, LAS float* scr, int lane) {
    const float* src = W + (size_t)k0 * N + n0 + lane;
#pragma unroll 1
    for (int i = 0; i < 64; i += 16) { float v[16];
#pragma unroll
        for (int r = 0; r < 16; ++r) v[r] = src[(size_t)(i + r) * N];
#pragma unroll
        for (int r = 0; r < 16; ++r) scr[(i + r) * 65 + lane] = v[r]; }
    LDS_WAIT(); asm volatile("" ::: "memory");
    const int c = lane & 7;
#pragma unroll
    for (int j = 0; j < 8; ++j) { const int n = (lane >> 3) + 8 * j; const LAS float* s = scr + (8 * c) * 65 + n;
        v4u o; o.x = pk2(s[0 * 65], s[1 * 65]); o.y = pk2(s[2 * 65], s[3 * 65]); o.z = pk2(s[4 * 65], s[5 * 65]); o.w = pk2(s[6 * 65], s[7 * 65]);
        *(v4u*)(WT + (size_t)(orow0 + n) * K + k0 + 8 * c) = o; }
    LDS_WAIT(); asm volatile("" ::: "memory");
}

__device__ __forceinline__ void phase_p0(const AH A, LAS unsigned char* lds, int tid, int G) {
    unsigned char* ws = A.ws();
    constexpr int NGEMV = 144;
    const int bx = blockIdx.x;
    if (bx < NGEMV || G <= NGEMV) {
        LAS float* sv = (LAS float*)lds;
        LAS float* red = sv + 5 * 1024;
        const float* c = A.in(I_C); const float* cctx = A.in(I_CCTX);
        for (int i = tid; i < 5 * 1024; i += 512) { const int r = i >> 10, k = i & 1023; const float v = (r < 4) ? c[r * 1024 + k] : cctx[k]; sv[i] = v / (1.0f + __expf(-v)); }
        __syncthreads();
        float* modbuf = (float*)(ws + WS_MOD);
        const float* wmod = A.in(I_WMOD); const float* bmod = A.in(I_BMOD);
        for (int item = bx; item < NGEMV; item += G) {
            const int l = item / 36, n0 = (item - l * 36) * 256, c4 = tid & 63, kg = tid >> 6;
            const f32x4* W = (const f32x4*)(wmod + (size_t)l * 1024 * MODW + n0) + c4;
            f32x4 acc[5];
#pragma unroll
            for (int r = 0; r < 5; ++r) acc[r] = (f32x4){0.f, 0.f, 0.f, 0.f};
#pragma unroll 8
            for (int k = kg * 128; k < kg * 128 + 128; ++k) { const f32x4 w = W[(size_t)k * (MODW / 4)];
#pragma unroll
                for (int r = 0; r < 5; ++r) acc[r] += w * sv[r * 1024 + k]; }
#pragma unroll
            for (int r = 0; r < 5; ++r) *(LAS f32x4*)(red + (kg * 5 + r) * 256 + c4 * 4) = acc[r];
            __syncthreads();
            for (int o = tid; o < 5 * 256; o += 512) { const int r = o >> 8, cc = o & 255; float s = 0.f;
#pragma unroll
                for (int q = 0; q < 8; ++q) s += red[(q * 5 + r) * 256 + cc];
                modbuf[(size_t)(l * 5 + r) * MODW + n0 + cc] = s + bmod[(size_t)l * MODW + n0 + cc]; }
            __syncthreads();
        }
    }
    if (bx >= NGEMV || G <= NGEMV) {
        const int wb = (G > NGEMV) ? bx - NGEMV : bx, nwb = (G > NGEMV) ? G - NGEMV : G;
        const f32x4* x4 = (const f32x4*)A.in(I_X); const f32x4* c4p = (const f32x4*)A.in(I_CTX); f32x4* X4 = (f32x4*)(ws + WS_X);
        const int total = MTOK * 256, stride = nwb * 512;
        for (int i = wb * 512 + tid; i < total; i += 4 * stride) { f32x4 v[4];
#pragma unroll
            for (int q = 0; q < 4; ++q) { const int ii = i + q * stride; if (ii < total) { const int row = ii >> 8, qq = ii & 255; const int b = row / SROW, s = row - b * SROW;
                v[q] = (s < LCTX) ? c4p[(size_t)(b * LCTX + s) * 256 + qq] : x4[(size_t)(b * LAT + s - LCTX) * 256 + qq]; } }
#pragma unroll
            for (int q = 0; q < 4; ++q) { const int ii = i + q * stride; if (ii < total) X4[ii] = v[q]; } }
        float* ra = (float*)(ws + WS_ROPE); float* rb = ra + 64 * 32 * 2;
        for (int i = wb * 512 + tid; i < 64 * 32 + 64 * 16; i += nwb * 512) {
            if (i < 64 * 32) { const int pos = i >> 5, f = i & 31; const float fr = powf(10000.0f, -(float)(2 * f) / 64.0f); const float ang = (float)pos * fr; ra[2 * i] = cosf(ang); ra[2 * i + 1] = sinf(ang); }
            else { const int j = i - 64 * 32; const int pos = j >> 4, f = j & 15; const float fr = powf(10000.0f, -(float)(2 * f) / 32.0f); const float ang = (float)pos * fr; rb[2 * j] = cosf(ang); rb[2 * j + 1] = sinf(ang); } }
    }
}

constexpr int CV_FI = 16 * 88, CV_FO = 44 * 16, CV_IN = 16 * 108, CV_BR = 8 * 16, CV_OUT = 16 * 16, CV_LRU = 32;
constexpr int CV_NIT = 2 * CV_FI + 2 * CV_FO + CV_IN + 3 * CV_BR + CV_OUT + CV_LRU;
__device__ __forceinline__ void convert_layer(const AH A, int l, int it_lo, int it_hi, LAS unsigned char* lds, int gw, int NGW, int wave, int lane) {
    unsigned char* ws = A.ws() + (size_t)(l & 1) * WS_WSET;
    LAS float* scr = (LAS float*)(lds + wave * 16640);
    for (int it = it_lo + gw; it < it_hi; it += NGW) {
        int r = it; bool done = false;
#pragma unroll
        for (int j = 0; j < 2; ++j) { if (!done) { if (r < CV_FI) { const int kb = r / 88, nb = r - kb * 88, n0 = nb * 64;
                const int orow0 = (n0 < DFF) ? ((n0 >> 7) * 256 + (n0 & 127)) : (((n0 - DFF) >> 7) * 256 + 128 + ((n0 - DFF) & 127));
                tr_item(A.in(I_FFNIN) + (size_t)(l * 2 + j) * 1024 * 5632, 5632, kb * 64, n0, (bf16*)(ws + WS_WFI) + (size_t)j * 5632 * 1024, 1024, orow0, scr, lane); done = true; } else r -= CV_FI; } }
#pragma unroll
        for (int j = 0; j < 2; ++j) { if (!done) { if (r < CV_FO) { const int kb = r >> 4, nb = r & 15;
                tr_item(A.in(I_FFNOUT) + (size_t)(l * 2 + j) * DFF * 1024, 1024, kb * 64, nb * 64, (bf16*)(ws + WS_WFO) + (size_t)j * 1024 * DFF, DFF, nb * 64, scr, lane); done = true; } else r -= CV_FO; } }
        if (!done) { if (r < CV_IN) { const int kb = r / 108, nb = r - kb * 108;
                tr_item(A.in(I_WIN) + (size_t)l * 1024 * DIN, DIN, kb * 64, nb * 64, (bf16*)(ws + WS_WIN), 1024, nb * 64, scr, lane); done = true; } else r -= CV_IN; }
#pragma unroll
        for (int n = 0; n < 3; ++n) { if (!done) { if (r < CV_BR) { const int kb = r >> 4, nb = r & 15;
                tr_item(A.in(I_WBR) + (size_t)(l * 3 + n) * 512 * 1024, 1024, kb * 64, nb * 64, (bf16*)(ws + WS_WB) + (size_t)n * 1024 * 512, 512, nb * 64, scr, lane); done = true; } else r -= CV_BR; } }
        if (!done) { if (r < CV_OUT) { const int kb = r >> 4, nb = r & 15;
                tr_item(A.in(I_WOUT) + (size_t)l * 1024 * 1024, 1024, kb * 64, nb * 64, (bf16*)(ws + WS_WO), 1024, nb * 64, scr, lane); done = true; } else r -= CV_OUT; }
        if (!done) { const int mat = r; const int g = mat >> 4, d = (mat >> 3) & 1, blk = mat & 7;
                const float* src = (g ? A.in(I_LWX) : A.in(I_LWA)) + (size_t)((l * 2 + d) * 8 + blk) * 4096;
                tr_item(src, 64, 0, 0, (bf16*)(ws + WS_LRUW) + (size_t)mat * 4096, 64, 0, scr, lane); }
    }
}

__device__ __forceinline__ void norm_rows(const AH A, int l, int sub, int gw, int NGW, int lane, int pend_ns, const float* pend_gate, float pend_scale) {
    unsigned char* ws = A.ws();
    const float* X = (const float*)(ws + WS_X); bf16* HN = (bf16*)(ws + WS_HN);
    const float* g = A.in(I_NORMG) + (size_t)(l * 3 + sub) * 1024;
    const float* modl = (const float*)(ws + WS_MOD) + (size_t)l * 5 * MODW + sub * 3072;
    f32x4 gv[4];
#pragma unroll
    for (int j = 0; j < 4; ++j) gv[j] = ((const f32x4*)g)[lane + 64 * j];
    f32x4 nx[4];
    if (gw < MTOK) {
#pragma unroll
        for (int j = 0; j < 4; ++j) nx[j] = ((const f32x4*)(X + (size_t)gw * 1024))[lane + 64 * j]; }
    for (int row = gw; row < MTOK; row += NGW) {
        const int b = row / SROW, s = row - b * SROW; const int mr = (s < LCTX) ? 4 : b;
        const f32x4* sh = (const f32x4*)(modl + (size_t)mr * MODW); const f32x4* sc = (const f32x4*)(modl + (size_t)mr * MODW + 1024);
        f32x4 v[4]; float ss = 0.f;
#pragma unroll
        for (int j = 0; j < 4; ++j) v[j] = nx[j];
        if (row + NGW < MTOK) {
#pragma unroll
            for (int j = 0; j < 4; ++j) nx[j] = ((const f32x4*)(X + (size_t)(row + NGW) * 1024))[lane + 64 * j]; }
        f32x4 scv[4], shv[4];
#pragma unroll
        for (int j = 0; j < 4; ++j) { scv[j] = sc[lane + 64 * j]; shv[j] = sh[lane + 64 * j]; }
        if (pend_ns > 0 && s < LCTX) {
            const v2u* pc = (const v2u*)((const bf16*)(ws + WS_PARTC) + (size_t)(b * LCTX + s) * 1024); const f32x4* pg = (const f32x4*)pend_gate;
            f32x4 a4[4] = {(f32x4){0.f, 0.f, 0.f, 0.f}, (f32x4){0.f, 0.f, 0.f, 0.f}, (f32x4){0.f, 0.f, 0.f, 0.f}, (f32x4){0.f, 0.f, 0.f, 0.f}};
            for (int sp = 0; sp < pend_ns; ++sp) {
#pragma unroll
                for (int j = 0; j < 4; ++j) { const v2u w = pc[(size_t)sp * 262144 + lane + 64 * j]; a4[j] += (f32x4){bflo(w.x), bfhi(w.x), bflo(w.y), bfhi(w.y)}; } }
            f32x4* xw = (f32x4*)(ws + WS_X) + (size_t)row * 256;
#pragma unroll
            for (int j = 0; j < 4; ++j) { v[j] += (pg[lane + 64 * j] * pend_scale) * a4[j]; xw[lane + 64 * j] = v[j]; }
        }
#pragma unroll
        for (int j = 0; j < 4; ++j) ss += (v[j].x * v[j].x + v[j].y * v[j].y) + (v[j].z * v[j].z + v[j].w * v[j].w);
        const float rstd = rsqrtf(wave_sum(ss, lane) * (1.0f / 1024.0f) + NORM_EPS);
        v2u* o = (v2u*)(HN + (size_t)row * 1024);
#pragma unroll
        for (int j = 0; j < 4; ++j) { const f32x4 y = (v[j] * rstd) * gv[j] * (scv[j] + 1.0f) + shv[j];
            v2u w; w.x = pk2(y.x, y.y); w.y = pk2(y.z, y.w); o[lane + 64 * j] = w; }
    }
}
__device__ __forceinline__ void final_rows(const AH A, int gw, int NGW, int lane) {
    const float* X = (const float*)(A.ws() + WS_X); const float* g = A.in(I_FG);
    f32x4 gv[4];
#pragma unroll
    for (int j = 0; j < 4; ++j) gv[j] = ((const f32x4*)g)[lane + 64 * j];
    f32x4 nx[4];
    if (gw < NB * LAT) { const int b = gw >> 12, t = gw & 4095;
#pragma unroll
        for (int j = 0; j < 4; ++j) nx[j] = ((const f32x4*)(X + (size_t)(b * SROW + LCTX + t) * 1024))[lane + 64 * j]; }
    for (int r = gw; r < NB * LAT; r += NGW) {
        f32x4 v[4]; float ss = 0.f;
#pragma unroll
        for (int j = 0; j < 4; ++j) v[j] = nx[j];
        if (r + NGW < NB * LAT) { const int r2 = r + NGW, b = r2 >> 12, t = r2 & 4095;
#pragma unroll
            for (int j = 0; j < 4; ++j) nx[j] = ((const f32x4*)(X + (size_t)(b * SROW + LCTX + t) * 1024))[lane + 64 * j]; }
#pragma unroll
        for (int j = 0; j < 4; ++j) ss += (v[j].x * v[j].x + v[j].y * v[j].y) + (v[j].z * v[j].z + v[j].w * v[j].w);
        const float rstd = rsqrtf(wave_sum(ss, lane) * (1.0f / 1024.0f) + NORM_EPS);
        f32x4* o = (f32x4*)(A.out() + (size_t)r * 1024);
#pragma unroll
        for (int j = 0; j < 4; ++j) o[lane + 64 * j] = (v[j] * rstd) * gv[j];
    }
}
#define XB_TMO      128
#define XB_XCNT(j)  (256  + 64 * (j))
#define XB_XSUB(j)  (1280 + 64 * (j))
#define XB_XGEN(j)  (2304 + 64 * (j))
#define XB_TOP      3328
#define XB_TOPGEN   3392
#define XCD_BAR_WORDS 3456
#define XB_SPIN_CAP (1u << 22)

__device__ __forceinline__ unsigned xb_ld(unsigned* p)              { return __hip_atomic_load(p, __ATOMIC_RELAXED, __HIP_MEMORY_SCOPE_AGENT); }
__device__ __forceinline__ unsigned xb_add(unsigned* p, unsigned v) { return __hip_atomic_fetch_add(p, v, __ATOMIC_RELAXED, __HIP_MEMORY_SCOPE_AGENT); }
__device__ __forceinline__ unsigned xb_xcc_id() { return (unsigned)__builtin_amdgcn_s_getreg((3 << 11) | 20) & 0xFu; }
#define XB_SPIN(cond, bar) do { unsigned _sp = 0; while (cond) { __builtin_amdgcn_s_sleep(1); \
    if ((++_sp & 255u) == 0u) { if (xb_ld(&(bar)[XB_TMO])) break; if (_sp > XB_SPIN_CAP) { atomicAdd(&(bar)[XB_TMO], 1u); break; } } } } while (0)

struct XcdBarrier {
    unsigned* bar; unsigned x;
    volatile LAS unsigned* st;
};

__device__ __forceinline__ XcdBarrier xcd_barrier_post(unsigned* bar, volatile LAS unsigned* st, bool t0) {
    XcdBarrier b; b.bar = bar; b.x = xb_xcc_id(); b.st = st;
    if (t0) (void)xb_add(&bar[XB_XCNT(b.x)], 1u);
    return b;
}
__device__ __forceinline__ void xcd_barrier_complete(unsigned* bar, unsigned x, unsigned& nloc, unsigned& nx) {
    const unsigned G = gridDim.x * gridDim.y * gridDim.z;
    unsigned sum, cnt, mine, sp = 0u;
    for (;;) {
        sum = 0u; cnt = 0u; mine = 0u;
#pragma unroll
        for (unsigned j = 0; j < 16; ++j) { const unsigned c = xb_ld(&bar[XB_XCNT(j)]); sum += c; cnt += (c > 0u) ? 1u : 0u; mine = (j == x) ? c : mine; }
        if (sum == G) break;
        __builtin_amdgcn_s_sleep(1);
        if ((++sp & 255u) == 0u) { if (xb_ld(&bar[XB_TMO])) break; if (sp > XB_SPIN_CAP) { atomicAdd(&bar[XB_TMO], 1u); break; } }
    }
    nloc = mine > 0u ? mine : 1u; nx = cnt > 0u ? cnt : 1u;
}

__device__ __forceinline__ void xcd_barrier(const XcdBarrier& b, bool t0) {
    asm volatile("s_waitcnt vmcnt(0)" ::: "memory");
    __syncthreads();
    if (t0) {
        unsigned* bar = b.bar;
        __builtin_amdgcn_s_waitcnt(0);
        unsigned nloc = b.st[0], nx = b.st[1];
        if (nloc == 0u) { xcd_barrier_complete(bar, b.x, nloc, nx); b.st[0] = nloc; b.st[1] = nx; }
        const unsigned old = xb_add(&bar[XB_XSUB(b.x)], 1u);
        const unsigned gen = old / nloc;
        if (old + 1u == (gen + 1u) * nloc) {
            __builtin_amdgcn_fence(__ATOMIC_RELEASE, "agent");
            asm volatile("s_waitcnt vmcnt(0)" ::: "memory");
            const unsigned og = xb_add(&bar[XB_TOP], 1u);
            const unsigned tg = og / nx;
            if (og + 1u == (tg + 1u) * nx) xb_add(&bar[XB_TOPGEN], 1u);
            else XB_SPIN(xb_ld(&bar[XB_TOPGEN]) == tg, bar);
            __builtin_amdgcn_fence(__ATOMIC_ACQUIRE, "agent");
            xb_add(&bar[XB_XGEN(b.x)], 1u);
            asm volatile("s_waitcnt vmcnt(0)" ::: "memory");
        } else {
            XB_SPIN(xb_ld(&bar[XB_XGEN(b.x)]) == gen, bar);
            __builtin_amdgcn_fence(__ATOMIC_ACQUIRE, "agent");
            asm volatile("s_waitcnt vmcnt(0)" ::: "memory");
        }
    }
    __syncthreads();
}
__device__ __forceinline__ void prep_qk(const AH A, int l, int gw, int NGW, int lane) {
    unsigned char* ws = A.ws();
    const bf16* Z = (const bf16*)(ws + WS_Z); bf16* KN = (bf16*)(ws + WS_KN);
    const float* rb = (const float*)(ws + WS_ROPE) + 64 * 32 * 2;
    const int e0 = (lane & 7) * 8, kh = (lane >> 3) & 1, sub = lane >> 4;
    float gk[8];
#pragma unroll
    for (int j = 0; j < 8; ++j) gk[j] = A.in(I_KG)[l * 64 + e0 + j];
    v4u nxt = (v4u){0u, 0u, 0u, 0u};
    { const int r = gw * 4 + sub; if (r < MTOK) nxt = *(const v4u*)(Z + (size_t)r * DIN + ZC_AK + kh * 64 + e0); }
    for (int row = gw * 4 + sub; row < MTOK; row += NGW * 4) {
        const int b = row / SROW, s = row - b * SROW; const bool lat = s >= LCTX; const int t = s - LCTX;
        const int pos = (lane & 4) ? (t & 63) : (t >> 6);
        const v4u cur = nxt;
        if (row + NGW * 4 < MTOK) nxt = *(const v4u*)(Z + (size_t)(row + NGW * 4) * DIN + ZC_AK + kh * 64 + e0);
        float f[8]; unpack8(cur, f);
        float ss = 0.f;
#pragma unroll
        for (int j = 0; j < 8; ++j) ss += f[j] * f[j];
        ss += shx(ss, 1, lane); ss += shx(ss, 2, lane); ss += shx(ss, 4, lane);
        const float rstd = rsqrtf(ss * (1.0f / 64.0f) + NORM_EPS);
        float y[8], o[8];
#pragma unroll
        for (int j = 0; j < 8; ++j) y[j] = f[j] * rstd * gk[j];
#pragma unroll
        for (int j = 0; j < 8; ++j) { const float p = shx(y[j], 2, lane);
            if (lat) { const int fi = (lane & 1) * 8 + j; const float cs = rb[(pos * 16 + fi) * 2], sn = rb[(pos * 16 + fi) * 2 + 1];
                o[j] = ((lane & 2) == 0) ? (y[j] * cs - p * sn) : (p * sn + y[j] * cs); }
            else o[j] = y[j]; }
        v4u w; w.x = pk2(o[0], o[1]); w.y = pk2(o[2], o[3]); w.z = pk2(o[4], o[5]); w.w = pk2(o[6], o[7]);
        *(v4u*)(KN + (size_t)row * 128 + kh * 64 + e0) = w;
    }
}

constexpr int RLDP = 136;
constexpr int RBUF = 128 * RLDP * 2;
__device__ __forceinline__ float log_sigmoid_f(float x) { return (x < 0.f ? x : 0.f) - log1pf(__expf(-fabsf(x))); }
template <bool TRANSPOSED, bool ROPE>
__device__ __forceinline__ void ret_stage_pair(const bf16* Z, int r0, int zc, int h, bool lat, int t0, const float* ra, float scl, float lgdec, int decmode  , LAS bf16* dst, int tid) {
#pragma unroll
    for (int it = 0; it < 2; ++it) { const int task = tid + 512 * it; const int j = task & 127, pr = task >> 7; const int c = (pr & 3) + (pr >> 2) * 8;
        const bf16* p = Z + (size_t)(r0 + j) * DIN + zc + h * 128;
        float a[8], bq[8]; unpack8(*(const v4u*)(p + 8 * c), a); unpack8(*(const v4u*)(p + 8 * (c + 4)), bq);
        float sc = scl; if (decmode == 1) sc *= __expf(lgdec * (float)(127 - j)); else if (decmode == 2) sc *= __expf(lgdec * (float)j);
        if (ROPE && lat) { const int t = t0 + j; const int pos = (c < 8) ? (t >> 6) : (t & 63);
#pragma unroll
            for (int e = 0; e < 8; ++e) { const int fi = (c & 3) * 8 + e; const float cs = ra[(pos * 32 + fi) * 2], sn = ra[(pos * 32 + fi) * 2 + 1];
                const float x1 = a[e], x2 = bq[e]; a[e] = x1 * cs - x2 * sn; bq[e] = x1 * sn + x2 * cs; } }
        if (TRANSPOSED) {
#pragma unroll
            for (int e = 0; e < 8; ++e) { dst[(8 * c + e) * RLDP + j] = (bf16)f2bf(a[e] * sc); dst[(8 * (c + 4) + e) * RLDP + j] = (bf16)f2bf(bq[e] * sc); }
        } else {
            v4u w; w.x = pk2(a[0] * sc, a[1] * sc); w.y = pk2(a[2] * sc, a[3] * sc); w.z = pk2(a[4] * sc, a[5] * sc); w.w = pk2(a[6] * sc, a[7] * sc);
            *(LAS v4u*)(dst + j * RLDP + 8 * c) = w;
            w.x = pk2(bq[0] * sc, bq[1] * sc); w.y = pk2(bq[2] * sc, bq[3] * sc); w.z = pk2(bq[4] * sc, bq[5] * sc); w.w = pk2(bq[6] * sc, bq[7] * sc);
            *(LAS v4u*)(dst + j * RLDP + 8 * (c + 4)) = w;
        } }
}
__device__ __forceinline__ void wave_mm(f32x4 (&acc)[8], const LAS bf16* Am, int row0, const LAS bf16* Bm, int lane) {
    const int r = lane & 15, g = lane >> 4;
#pragma unroll
    for (int ks = 0; ks < 4; ++ks) { const bf16x8 a = *(const LAS bf16x8*)(Am + (row0 + r) * RLDP + ks * 32 + g * 8);
#pragma unroll
        for (int nt = 0; nt < 8; ++nt) { const bf16x8 bfr = *(const LAS bf16x8*)(Bm + (nt * 16 + r) * RLDP + ks * 32 + g * 8);
            acc[nt] = __builtin_amdgcn_mfma_f32_16x16x32_bf16(a, bfr, acc[nt], 0, 0, 0); } }
}
__device__ __forceinline__ int ret_chain_pos(int d, int cidx) { return d == 0 ? cidx : (cidx == 1 ? 0 : (cidx == 0 ? 1 : 35 - cidx)); }

__device__ __forceinline__ void ret_stage_k_both(const bf16* Z, int r0, int h, bool lat, int t0, const float* ra, float scl, float lgf, float lgb, LAS bf16* dstf, LAS bf16* dstb, int tid) {
#pragma unroll
    for (int it = 0; it < 2; ++it) { const int task = tid + 512 * it; const int j = task & 127, pr = task >> 7; const int c = (pr & 3) + (pr >> 2) * 8;
        const bf16* p = Z + (size_t)(r0 + j) * DIN + ZC_RK + h * 128;
        float a[8], bq[8]; unpack8(*(const v4u*)(p + 8 * c), a); unpack8(*(const v4u*)(p + 8 * (c + 4)), bq);
        const float sf = scl * __expf(lgf * (float)(127 - j)), sb = scl * __expf(lgb * (float)j);
        if (lat) { const int t = t0 + j; const int pos = (c < 8) ? (t >> 6) : (t & 63);
#pragma unroll
            for (int e = 0; e < 8; ++e) { const int fi = (c & 3) * 8 + e; const float cs = ra[(pos * 32 + fi) * 2], sn = ra[(pos * 32 + fi) * 2 + 1];
                const float x1 = a[e], x2 = bq[e]; a[e] = x1 * cs - x2 * sn; bq[e] = x1 * sn + x2 * cs; } }
#pragma unroll
        for (int e = 0; e < 8; ++e) { dstf[(8 * c + e) * RLDP + j] = (bf16)f2bf(a[e] * sf); dstf[(8 * (c + 4) + e) * RLDP + j] = (bf16)f2bf(bq[e] * sf);
                                      dstb[(8 * c + e) * RLDP + j] = (bf16)f2bf(a[e] * sb); dstb[(8 * (c + 4) + e) * RLDP + j] = (bf16)f2bf(bq[e] * sb); } }
}
__device__ __forceinline__ void ret_u_item(const AH A, int l, int item, LAS unsigned char* lds, int tid, int wave, int lane) {
    unsigned char* ws = A.ws(); const bf16* Z = (const bf16*)(ws + WS_Z); const float* ra = (const float*)(ws + WS_ROPE);
    const int cidx = item % 34, bh = item / 34, b = bh >> 2, h = bh & 3;
    const int pf = ret_chain_pos(0, cidx), pb = ret_chain_pos(1, cidx);
    const bool lat = cidx >= 2; const int r0 = b * SROW + cidx * 128, t0 = (cidx - 2) * 128;
    const float lgf = log_sigmoid_f(A.in(I_RETLOGIT)[(l * 2 + 0) * 4 + h]), lgb = log_sigmoid_f(A.in(I_RETLOGIT)[(l * 2 + 1) * 4 + h]);
    LAS bf16* Ktf = (LAS bf16*)lds; LAS bf16* Ktb = (LAS bf16*)(lds + RBUF); LAS bf16* Vt = (LAS bf16*)(lds + 2 * RBUF);
    ret_stage_k_both(Z, r0, h, lat, t0, ra, 0.08838834764831845f, lgf, lgb, Ktf, Ktb, tid);
    ret_stage_pair<true, false>(Z, r0, ZC_RV, h, false, 0, ra, 1.0f, 0.f, 0, Vt, tid);
    __syncthreads();
    const int g = lane >> 4, c = lane & 15;
    f32x4 accf[8], accb[8];
#pragma unroll
    for (int nt = 0; nt < 8; ++nt) { accf[nt] = (f32x4){0.f, 0.f, 0.f, 0.f}; accb[nt] = (f32x4){0.f, 0.f, 0.f, 0.f}; }
    if (pf != 33) wave_mm(accf, Vt, wave * 16, Ktf, lane);
    if (pb != 33) wave_mm(accb, Vt, wave * 16, Ktb, lane);
    __syncthreads();
    LAS bf16* stg = (LAS bf16*)lds + wave * (16 * RLDP);
#pragma unroll 1
    for (int d = 0; d < 2; ++d) { const int p = d ? pb : pf;
        if (p == 33) continue;
#pragma unroll
        for (int nt = 0; nt < 8; ++nt)
#pragma unroll
            for (int jj = 0; jj < 4; ++jj) stg[(4 * g + jj) * RLDP + nt * 16 + c] = (bf16)f2bf(d ? accb[nt][jj] : accf[nt][jj]);
        LDS_WAIT(); asm volatile("" ::: "memory");
        bf16* U = (bf16*)(ws + WS_U) + ((size_t)((b * 4 + h) * 2 + d) * 34 + p) * 16384 + (size_t)(wave * 16) * 128;
#pragma unroll
        for (int it = 0; it < 4; ++it) { const int id = lane + 64 * it, rr = id >> 4, ch = id & 15;
            *(v4u*)(U + rr * 128 + ch * 8) = *(const LAS v4u*)(stg + rr * RLDP + ch * 8); }
        LDS_WAIT(); asm volatile("" ::: "memory"); }
    __syncthreads();
}
__device__ __forceinline__ void ret_scan_item(const AH A, int l, int item, int tid) {
    unsigned char* ws = A.ws();
    const int bhd = item >> 3, sl = item & 7; const int d = bhd & 1, h = (bhd >> 1) & 3;
    const float lg = log_sigmoid_f(A.in(I_RETLOGIT)[(l * 2 + d) * 4 + h]); const float sdec = __expf(128.0f * lg);
    const v2u* U = (const v2u*)((const bf16*)(ws + WS_U) + (size_t)bhd * 34 * 16384) + sl * 512 + tid;
    v2u* S = (v2u*)((bf16*)(ws + WS_SIN) + (size_t)bhd * 34 * 16384) + sl * 512 + tid;
    f32x4 s = (f32x4){0.f, 0.f, 0.f, 0.f};
#pragma unroll 1
    for (int p0 = 0; p0 < 33; p0 += 11) { v2u u[11];
#pragma unroll
        for (int i = 0; i < 11; ++i) u[i] = U[(size_t)(p0 + i) * 4096];
#pragma unroll
        for (int i = 0; i < 11; ++i) { v2u w; w.x = pk2(s.x, s.y); w.y = pk2(s.z, s.w); S[(size_t)(p0 + i) * 4096] = w;
            const f32x4 uf = (f32x4){bflo(u[i].x), bfhi(u[i].x), bflo(u[i].y), bfhi(u[i].y)}; s = s * sdec + uf; } }
    { v2u w; w.x = pk2(s.x, s.y); w.y = pk2(s.z, s.w); S[(size_t)33 * 4096] = w; }
}
__device__ __forceinline__ void ret_out_item(const AH A, int l, int item, LAS unsigned char* lds, int tid, int wave, int lane) {
    unsigned char* ws = A.ws(); const bf16* Z = (const bf16*)(ws + WS_Z); const float* ra = (const float*)(ws + WS_ROPE);
    const int cidx = item % 34, bh = item / 34, b = bh >> 2, h = bh & 3;
    const bool lat = cidx >= 2; const int r0 = b * SROW + cidx * 128, t0 = (cidx - 2) * 128;
    const float lgf = log_sigmoid_f(A.in(I_RETLOGIT)[(l * 2 + 0) * 4 + h]) * 1.4426950408889634f, lgb = log_sigmoid_f(A.in(I_RETLOGIT)[(l * 2 + 1) * 4 + h]) * 1.4426950408889634f;
    LAS bf16* Qs = (LAS bf16*)lds; LAS bf16* Ks = (LAS bf16*)(lds + RBUF); LAS bf16* Vt = (LAS bf16*)(lds + 2 * RBUF); LAS bf16* Ss = (LAS bf16*)(lds + 3 * RBUF);
    const bf16* SINf = (const bf16*)(ws + WS_SIN) + ((size_t)((b * 4 + h) * 2 + 0) * 34 + ret_chain_pos(0, cidx)) * 16384;
    const bf16* SINb = (const bf16*)(ws + WS_SIN) + ((size_t)((b * 4 + h) * 2 + 1) * 34 + ret_chain_pos(1, cidx)) * 16384;
    ret_stage_pair<false, true>(Z, r0, ZC_RQ, h, lat, t0, ra, 1.0f, 0.f, 0, Qs, tid);
    ret_stage_pair<false, true>(Z, r0, ZC_RK, h, lat, t0, ra, 0.08838834764831845f, 0.f, 0, Ks, tid);
    ret_stage_pair<true, false>(Z, r0, ZC_RV, h, false, 0, ra, 1.0f, 0.f, 0, Vt, tid);
#pragma unroll
    for (int it = 0; it < 4; ++it) { const int task = tid + 512 * it, row = task >> 4, ch = task & 15; *(LAS v4u*)(Ss + row * RLDP + ch * 8) = *(const v4u*)(SINf + row * 128 + ch * 8); }
    v4u sbv[4];
#pragma unroll
    for (int it = 0; it < 4; ++it) { const int task = tid + 512 * it, row = task >> 4, ch = task & 15; sbv[it] = *(const v4u*)(SINb + row * 128 + ch * 8); }
    __syncthreads();
    const int g = lane >> 4, c = lane & 15, i0 = wave * 16 + 4 * g;
    f32x4 accs[8], acco[8];
#pragma unroll
    for (int nt = 0; nt < 8; ++nt) { accs[nt] = (f32x4){0.f, 0.f, 0.f, 0.f}; acco[nt] = (f32x4){0.f, 0.f, 0.f, 0.f}; }
    wave_mm(accs, Qs, wave * 16, Ks, lane);
    wave_mm(acco, Qs, wave * 16, Ss, lane);
#pragma unroll
    for (int jj = 0; jj < 4; ++jj) { const float qd = __builtin_amdgcn_exp2f(lgf * (float)(i0 + jj + 1));
#pragma unroll
        for (int nt = 0; nt < 8; ++nt) acco[nt][jj] *= qd; }
    int i0w = i0; asm volatile("" : "+v"(i0w));
#pragma unroll
    for (int nt = 0; nt < 8; ++nt)
#pragma unroll
        for (int jj = 0; jj < 4; ++jj) { const int diff = (i0w + jj) - (nt * 16 + c);
            const float w = diff > 0 ? __builtin_amdgcn_exp2f(lgf * (float)diff) : (diff < 0 ? __builtin_amdgcn_exp2f(lgb * (float)(-diff)) : 2.0f);
            accs[nt][jj] *= w; }
    __syncthreads();
#pragma unroll
    for (int nt = 0; nt < 8; ++nt)
#pragma unroll
        for (int jj = 0; jj < 4; ++jj) Ks[(i0 + jj) * RLDP + nt * 16 + c] = (bf16)f2bf(accs[nt][jj]);
#pragma unroll
    for (int it = 0; it < 4; ++it) { const int task = tid + 512 * it, row = task >> 4, ch = task & 15; *(LAS v4u*)(Ss + row * RLDP + ch * 8) = sbv[it]; }
    __syncthreads();
#pragma unroll
    for (int nt = 0; nt < 8; ++nt) accs[nt] = (f32x4){0.f, 0.f, 0.f, 0.f};
    wave_mm(accs, Qs, wave * 16, Ss, lane);
#pragma unroll
    for (int jj = 0; jj < 4; ++jj) { const float qd = __builtin_amdgcn_exp2f(lgb * (float)(128 - (i0 + jj)));
#pragma unroll
        for (int nt = 0; nt < 8; ++nt) acco[nt][jj] += qd * accs[nt][jj]; }
    wave_mm(acco, Ks, wave * 16, Vt, lane);
    const float* gn = A.in(I_RETG) + (size_t)l * 512 + h * 128;
    bf16* Y = (bf16*)(ws + WS_Y);
    float gnv[8];
#pragma unroll
    for (int nt = 0; nt < 8; ++nt) gnv[nt] = gn[nt * 16 + c];
#pragma unroll
    for (int jj = 0; jj < 4; ++jj) {
        float s1 = 0.f;
#pragma unroll
        for (int nt = 0; nt < 8; ++nt) s1 += acco[nt][jj];
        s1 += shx(s1, 1, lane); s1 += shx(s1, 2, lane); s1 += shx(s1, 4, lane); s1 += shx(s1, 8, lane);
        const float mu = s1 * (1.0f / 128.0f); float s2 = 0.f;
#pragma unroll
        for (int nt = 0; nt < 8; ++nt) { const float dlt = acco[nt][jj] - mu; s2 += dlt * dlt; }
        s2 += shx(s2, 1, lane); s2 += shx(s2, 2, lane); s2 += shx(s2, 4, lane); s2 += shx(s2, 8, lane);
        const float rstd = rsqrtf(s2 * (1.0f / 128.0f) + NORM_EPS);
#pragma unroll
        for (int nt = 0; nt < 8; ++nt) Qs[(i0 + jj) * RLDP + nt * 16 + c] = (bf16)f2bf((acco[nt][jj] - mu) * rstd * gnv[nt]);
    }
    LDS_WAIT(); asm volatile("" ::: "memory");
#pragma unroll
    for (int it = 0; it < 4; ++it) { const int id = lane + 64 * it, rr = wave * 16 + (id >> 4), ch = id & 15; const size_t row = (size_t)(r0 + rr);
        float yv[8], rg[8]; unpack8(*(const LAS v4u*)(Qs + rr * RLDP + ch * 8), yv); unpack8(*(const v4u*)(Z + row * DIN + ZC_RG + h * 128 + ch * 8), rg);
#pragma unroll
        for (int e = 0; e < 8; ++e) yv[e] *= rg[e] * sigmoidf_(rg[e]);
        v4u w; w.x = pk2(yv[0], yv[1]); w.y = pk2(yv[2], yv[3]); w.z = pk2(yv[4], yv[5]); w.w = pk2(yv[6], yv[7]);
        *(v4u*)(Y + row * 512 + h * 128 + ch * 8) = w; }
    __syncthreads();
}
constexpr int XLDP = 68;
constexpr int XWAVE_BYTES = 64 * XLDP * 4;
__device__ __forceinline__ float gelu_tanh(float x) { const float u = 0.7978845608028654f * (x + 0.044715f * x * x * x); const float th = 1.0f - 2.0f * __builtin_amdgcn_rcpf(1.0f + __expf(2.0f * u)); return 0.5f * x * (1.0f + th); }
__device__ __forceinline__ int lru_chain_pos(int d, int c64) { return d == 0 ? c64 : (c64 < 4 ? 3 - c64 : 71 - c64); }

struct LruFrag { bf16x8 ba[2], bx[2]; };
__device__ __forceinline__ LruFrag lru_frag_load(const unsigned char* ws, int l, int dir, int blk, int nt, int lane) {
    const int g = lane >> 4, c = lane & 15; LruFrag f;
    const bf16* wa = (const bf16*)(ws + (size_t)(l & 1) * WS_WSET + WS_LRUW) + (size_t)((0 * 2 + dir) * 8 + blk) * 4096 + (nt * 16 + c) * 64 + g * 8;
    const bf16* wx = (const bf16*)(ws + (size_t)(l & 1) * WS_WSET + WS_LRUW) + (size_t)((1 * 2 + dir) * 8 + blk) * 4096 + (nt * 16 + c) * 64 + g * 8;
#pragma unroll
    for (int ks = 0; ks < 2; ++ks) { f.ba[ks] = *(const bf16x8*)(wa + ks * 32); f.bx[ks] = *(const bf16x8*)(wx + ks * 32); }
    return f;
}
template <int DIR, bool FINAL>
__device__ __forceinline__ void lru_dir(const AH A, int l, int b, int c64, int blk, int nt, const bf16x8 (&af)[4][2], const float (&xv)[16], float (&hs)[16], int lane,
                                        const LruFrag& fr, float b_a, float b_x, float lam, float hin) {
    unsigned char* ws = A.ws();
    const int g = lane >> 4, c = lane & 15; const int ch = blk * 64 + nt * 16 + c;
    f32x4 accr[4], acci[4];
#pragma unroll
    for (int mt = 0; mt < 4; ++mt) { accr[mt] = (f32x4){0.f, 0.f, 0.f, 0.f}; acci[mt] = (f32x4){0.f, 0.f, 0.f, 0.f};
#pragma unroll
        for (int ks = 0; ks < 2; ++ks) { accr[mt] = __builtin_amdgcn_mfma_f32_16x16x32_bf16(af[mt][ks], fr.ba[ks], accr[mt], 0, 0, 0);
                                         acci[mt] = __builtin_amdgcn_mfma_f32_16x16x32_bf16(af[mt][ks], fr.bx[ks], acci[mt], 0, 0, 0); } }
    const float sp = fmaxf(-lam, 0.f) + log1pf(__expf(-fabsf(lam)));
    float a_[16], u_[16], la_[16];
#pragma unroll
    for (int q = 0; q < 16; ++q) { const int mt = q >> 2, jj = q & 3;
        const float r = sigmoidf_(accr[mt][jj] + b_a), ii = sigmoidf_(acci[mt][jj] + b_x);
        const float la = -8.0f * r * sp; a_[q] = __expf(la); la_[q] = la;
        const float x2 = 2.0f * la;
        const float em = -x2 * (1.0f + x2 * (0.5f + x2 * (0.16666667f + x2 * (0.041666668f + x2 * (0.0083333338f + x2 * 0.0013888889f)))));
        u_[q] = __builtin_amdgcn_sqrtf(em) * (ii * xv[q]); }
    float P = 1.f, H = 0.f;
#pragma unroll
    for (int qi = 0; qi < 16; ++qi) { const int q = DIR ? 15 - qi : qi; H = a_[q] * H + u_[q]; P *= a_[q]; }
    float Pg[4], Hg[4];
#pragma unroll
    for (int k = 0; k < 4; ++k) { Pg[k] = shi(P, c + 16 * k); Hg[k] = shi(H, c + 16 * k); }
    if (!FINAL) {
        const int p = lru_chain_pos(DIR, c64);
        const size_t idx = ((size_t)((b * 2 + DIR) * 68 + p)) * 512 + ch;
        float Hc, Pc = (Pg[0] * Pg[1]) * (Pg[2] * Pg[3]);
        if (DIR == 0) Hc = ((Hg[0] * Pg[1] + Hg[1]) * Pg[2] + Hg[2]) * Pg[3] + Hg[3];
        else          Hc = ((Hg[3] * Pg[2] + Hg[2]) * Pg[1] + Hg[1]) * Pg[0] + Hg[0];
        if (g == 0) { float* S = (float*)(ws + WS_SUMM); S[idx * 2] = Pc; S[idx * 2 + 1] = Hc; }
        const size_t e0 = ((((size_t)((b * 68 + c64) * 8 + blk) * 4 + nt) * 2 + DIR) * 64 + lane) * 16;
        bf16* LA = (bf16*)(ws + WS_HN) + e0; bf16* LU = (bf16*)(ws + WS_PARTC) + e0;
        v4u w;
        w.x = pk2(la_[0], la_[1]); w.y = pk2(la_[2], la_[3]); w.z = pk2(la_[4], la_[5]); w.w = pk2(la_[6], la_[7]); *(v4u*)LA = w;
        w.x = pk2(la_[8], la_[9]); w.y = pk2(la_[10], la_[11]); w.z = pk2(la_[12], la_[13]); w.w = pk2(la_[14], la_[15]); *(v4u*)(LA + 8) = w;
        w.x = pk2(u_[0], u_[1]); w.y = pk2(u_[2], u_[3]); w.z = pk2(u_[4], u_[5]); w.w = pk2(u_[6], u_[7]); *(v4u*)LU = w;
        w.x = pk2(u_[8], u_[9]); w.y = pk2(u_[10], u_[11]); w.z = pk2(u_[12], u_[13]); w.w = pk2(u_[14], u_[15]); *(v4u*)(LU + 8) = w;
    } else {
        float s0, s1, s2, s3;
        if (DIR == 0) { s0 = hin; s1 = s0 * Pg[0] + Hg[0]; s2 = s1 * Pg[1] + Hg[1]; s3 = s2 * Pg[2] + Hg[2]; }
        else          { s3 = hin; s2 = s3 * Pg[3] + Hg[3]; s1 = s2 * Pg[2] + Hg[2]; s0 = s1 * Pg[1] + Hg[1]; }
        float h = (g == 0) ? s0 : (g == 1) ? s1 : (g == 2) ? s2 : s3;
#pragma unroll
        for (int qi = 0; qi < 16; ++qi) { const int q = DIR ? 15 - qi : qi; h = a_[q] * h + u_[q]; hs[q] += h; }
    }
}
template <bool FINAL>
__device__ __forceinline__ void lru_task(const AH A, int l, int b, int c64, int blk, LAS unsigned char* lds, int wave, int lane, int half) {
    unsigned char* ws = A.ws(); const bf16* Z = (const bf16*)(ws + WS_Z);
    LAS float* xs = (LAS float*)(lds + wave * XWAVE_BYTES);
    const int r0 = b * SROW + c64 * 64;
    const int seq_lo = (c64 < 4) ? b * SROW : b * SROW + LCTX, seq_hi = (c64 < 4) ? b * SROW + LCTX : (b + 1) * SROW;
    const int g = lane >> 4, c = lane & 15;
    const int cgx = lane & 7, tg = lane >> 3, ch0 = blk * 64 + cgx * 8;
    v4u raw[11];
#pragma unroll
    for (int q = 0; q < 11; ++q) { const int row = r0 + tg * 8 - 1 + q;
        raw[q] = (row >= seq_lo && row < seq_hi) ? *(const v4u*)(Z + (size_t)row * DIN + ZC_LX + ch0) : (v4u){0u, 0u, 0u, 0u}; }
    f32x4 cwv[4][2], cbv[2];
#pragma unroll
    for (int e2 = 0; e2 < 2; ++e2) { cbv[e2] = *(const f32x4*)(A.in(I_CONVB) + l * 512 + ch0 + 4 * e2);
#pragma unroll
        for (int j = 0; j < 4; ++j) cwv[j][e2] = *(const f32x4*)(A.in(I_CONVW) + (l * 4 + j) * 512 + ch0 + 4 * e2); }
    float pba[2][2], pbx[2][2], plam[2][2], phin[2][2];
#pragma unroll
    for (int nti = 0; nti < 2; ++nti)
#pragma unroll
        for (int d = 0; d < 2; ++d) { const int ch = blk * 64 + (2 * half + nti) * 16 + c; const int pidx = (l * 2 + d) * 512 + ch;
            pba[nti][d] = A.in(I_LBA)[pidx]; pbx[nti][d] = A.in(I_LBX)[pidx]; plam[nti][d] = A.in(I_LAM)[pidx];
            phin[nti][d] = FINAL ? ((const float*)(ws + WS_HIN))[((size_t)((b * 2 + d) * 68 + lru_chain_pos(d, c64))) * 512 + ch] : 0.f; }
    LruFrag fcur = lru_frag_load(ws, l, 0, blk, 2 * half, lane);
    {
        float xw[4][8];
#pragma unroll
        for (int q = 0; q < 3; ++q) unpack8(raw[q], xw[q]);
#pragma unroll
        for (int tt = 0; tt < 8; ++tt) { unpack8(raw[tt + 3], xw[3]);
            float y[8];
#pragma unroll
            for (int e = 0; e < 8; ++e) { float sacc = cbv[e >> 2][e & 3];
#pragma unroll
                for (int j = 0; j < 4; ++j) sacc += cwv[j][e >> 2][e & 3] * xw[j][e];
                y[e] = sacc; }
            LAS f32x4* o = (LAS f32x4*)(xs + (tg * 8 + tt) * XLDP + cgx * 8);
            o[0] = (f32x4){y[0], y[1], y[2], y[3]}; o[1] = (f32x4){y[4], y[5], y[6], y[7]};
#pragma unroll
            for (int e = 0; e < 8; ++e) { xw[0][e] = xw[1][e]; xw[1][e] = xw[2][e]; xw[2][e] = xw[3][e]; } }
    }
    LDS_WAIT(); asm volatile("" ::: "memory");
    bf16x8 af[4][2];
    { const int m = lane & 15, gq = m >> 2, jq = m & 3, kq = (lane >> 4) * 8;
#pragma unroll
      for (int mt = 0; mt < 4; ++mt) { const int tok = 16 * gq + 4 * mt + jq;
#pragma unroll
          for (int ks = 0; ks < 2; ++ks) { const LAS f32x4* s = (const LAS f32x4*)(xs + tok * XLDP + ks * 32 + kq); const f32x4 v0 = s[0], v1 = s[1];
              v4u w; w.x = pk2(v0.x, v0.y); w.y = pk2(v0.z, v0.w); w.z = pk2(v1.x, v1.y); w.w = pk2(v1.z, v1.w); af[mt][ks] = __builtin_bit_cast(bf16x8, w); } } }
#pragma unroll
    for (int nti = 0; nti < 2; ++nti) { const int nt = 2 * half + nti;
        float xv[16], hs[16];
#pragma unroll
        for (int q = 0; q < 16; ++q) { xv[q] = xs[(16 * g + q) * XLDP + nt * 16 + c]; hs[q] = 0.f; }
        const LruFrag f1 = lru_frag_load(ws, l, 1, blk, nt, lane);
        lru_dir<0, FINAL>(A, l, b, c64, blk, nt, af, xv, hs, lane, fcur, pba[nti][0], pbx[nti][0], plam[nti][0], phin[nti][0]);
        if (nti == 0) fcur = lru_frag_load(ws, l, 0, blk, nt + 1, lane);
        lru_dir<1, FINAL>(A, l, b, c64, blk, nt, af, xv, hs, lane, f1, pba[nti][1], pbx[nti][1], plam[nti][1], phin[nti][1]);
        if (FINAL) {
#pragma unroll
            for (int q = 0; q < 16; ++q) xs[(16 * g + q) * XLDP + nt * 16 + c] = hs[q]; }
    }
    if (FINAL) {
        LDS_WAIT(); asm volatile("" ::: "memory");
        bf16* Y = (bf16*)(ws + WS_Y) + (size_t)MTOK * 512;
#pragma unroll
        for (int it = 0; it < 4; ++it) { const int id = lane + 64 * it, tok = id >> 2, chn = 4 * half + (id & 3); const size_t row = (size_t)(r0 + tok);
            const LAS f32x4* sp = (const LAS f32x4*)(xs + tok * XLDP + chn * 8); const f32x4 h0 = sp[0], h1 = sp[1];
            float lz[8]; unpack8(*(const v4u*)(Z + row * DIN + ZC_LZ + blk * 64 + chn * 8), lz);
            v4u w; w.x = pk2(gelu_tanh(lz[0]) * h0.x, gelu_tanh(lz[1]) * h0.y); w.y = pk2(gelu_tanh(lz[2]) * h0.z, gelu_tanh(lz[3]) * h0.w);
            w.z = pk2(gelu_tanh(lz[4]) * h1.x, gelu_tanh(lz[5]) * h1.y); w.w = pk2(gelu_tanh(lz[6]) * h1.z, gelu_tanh(lz[7]) * h1.w);
            *(v4u*)(Y + row * 512 + blk * 64 + chn * 8) = w; }
    }
    LDS_WAIT(); asm volatile("" ::: "memory");
}
template <int DIR>
__device__ __forceinline__ void lru_apply(const float (&a_)[16], const float (&u_)[16], float hin, float (&hs)[16], int lane) {
    const int g = lane >> 4, c = lane & 15;
    float P = 1.f, H = 0.f;
#pragma unroll
    for (int qi = 0; qi < 16; ++qi) { const int q = DIR ? 15 - qi : qi; H = a_[q] * H + u_[q]; P *= a_[q]; }
    float Pg[4], Hg[4];
#pragma unroll
    for (int k = 0; k < 4; ++k) { Pg[k] = shi(P, c + 16 * k); Hg[k] = shi(H, c + 16 * k); }
    float s0, s1, s2, s3;
    if (DIR == 0) { s0 = hin; s1 = s0 * Pg[0] + Hg[0]; s2 = s1 * Pg[1] + Hg[1]; s3 = s2 * Pg[2] + Hg[2]; }
    else          { s3 = hin; s2 = s3 * Pg[3] + Hg[3]; s1 = s2 * Pg[2] + Hg[2]; s0 = s1 * Pg[1] + Hg[1]; }
    float h = (g == 0) ? s0 : (g == 1) ? s1 : (g == 2) ? s2 : s3;
#pragma unroll
    for (int qi = 0; qi < 16; ++qi) { const int q = DIR ? 15 - qi : qi; h = a_[q] * h + u_[q]; hs[q] += h; }
}
__device__ __forceinline__ void lru_final(const AH A, int l, int b, int c64, int blk, LAS unsigned char* lds, int wave, int lane, int half) {
    unsigned char* ws = A.ws(); const bf16* Z = (const bf16*)(ws + WS_Z);
    LAS float* xs = (LAS float*)(lds + wave * XWAVE_BYTES);
    const int r0 = b * SROW + c64 * 64;
    const int g = lane >> 4, c = lane & 15;
    float phin[2][2];
#pragma unroll
    for (int nti = 0; nti < 2; ++nti)
#pragma unroll
        for (int d = 0; d < 2; ++d) { const int ch = blk * 64 + (2 * half + nti) * 16 + c;
            phin[nti][d] = ((const float*)(ws + WS_HIN))[((size_t)((b * 2 + d) * 68 + lru_chain_pos(d, c64))) * 512 + ch]; }
    v4u wl[2][2][2], wu[2][2][2];
#pragma unroll
    for (int nti = 0; nti < 2; ++nti)
#pragma unroll
        for (int d = 0; d < 2; ++d) { const size_t e0 = ((((size_t)((b * 68 + c64) * 8 + blk) * 4 + (2 * half + nti)) * 2 + d) * 64 + lane) * 16;
            const bf16* LA = (const bf16*)(ws + WS_HN) + e0; const bf16* LU = (const bf16*)(ws + WS_PARTC) + e0;
            wl[nti][d][0] = *(const v4u*)LA; wl[nti][d][1] = *(const v4u*)(LA + 8); wu[nti][d][0] = *(const v4u*)LU; wu[nti][d][1] = *(const v4u*)(LU + 8); }
#pragma unroll
    for (int nti = 0; nti < 2; ++nti) { const int nt = 2 * half + nti;
        float hs[16];
#pragma unroll
        for (int q = 0; q < 16; ++q) hs[q] = 0.f;
#pragma unroll
        for (int d = 0; d < 2; ++d) { float a_[16], u_[16];
            unpack8(wl[nti][d][0], a_); unpack8(wl[nti][d][1], a_ + 8); unpack8(wu[nti][d][0], u_); unpack8(wu[nti][d][1], u_ + 8);
#pragma unroll
            for (int q = 0; q < 16; ++q) a_[q] = __expf(a_[q]);
            if (d == 0) lru_apply<0>(a_, u_, phin[nti][0], hs, lane); else lru_apply<1>(a_, u_, phin[nti][1], hs, lane); }
#pragma unroll
        for (int q = 0; q < 16; ++q) xs[(16 * g + q) * XLDP + nt * 16 + c] = hs[q];
    }
    LDS_WAIT(); asm volatile("" ::: "memory");
    bf16* Y = (bf16*)(ws + WS_Y) + (size_t)MTOK * 512;
#pragma unroll
    for (int it = 0; it < 4; ++it) { const int id = lane + 64 * it, tok = id >> 2, chn = 4 * half + (id & 3); const size_t row = (size_t)(r0 + tok);
        const LAS f32x4* sp = (const LAS f32x4*)(xs + tok * XLDP + chn * 8); const f32x4 h0 = sp[0], h1 = sp[1];
        float lz[8]; unpack8(*(const v4u*)(Z + row * DIN + ZC_LZ + blk * 64 + chn * 8), lz);
        v4u w; w.x = pk2(gelu_tanh(lz[0]) * h0.x, gelu_tanh(lz[1]) * h0.y); w.y = pk2(gelu_tanh(lz[2]) * h0.z, gelu_tanh(lz[3]) * h0.w);
        w.z = pk2(gelu_tanh(lz[4]) * h1.x, gelu_tanh(lz[5]) * h1.y); w.w = pk2(gelu_tanh(lz[6]) * h1.z, gelu_tanh(lz[7]) * h1.w);
        *(v4u*)(Y + row * 512 + blk * 64 + chn * 8) = w; }
    LDS_WAIT(); asm volatile("" ::: "memory");
}
__device__ __forceinline__ void lru_scan(const AH A, int tid, int G) {
    unsigned char* ws = A.ws(); const float* S = (const float*)(ws + WS_SUMM); float* HIN = (float*)(ws + WS_HIN);
    const int cpb = (4096 + G - 1) / G;
    typedef float f32x2s __attribute__((ext_vector_type(2)));
    if (cpb <= 16) {
        if (tid < 64) { const int c = tid & 15, q = tid >> 4; const int chain0 = blockIdx.x * cpb + c; const bool valid = (c < cpb) && (chain0 < 4096); const int chain = valid ? chain0 : 0;
            const int bd = chain >> 9, ch = chain & 511; f32x2s ph_[17];
#pragma unroll
            for (int i = 0; i < 17; ++i) ph_[i] = *(const f32x2s*)(S + ((size_t)(bd * 68 + q * 17 + i) * 512 + ch) * 2);
            float Aq = 1.f, Bq = 0.f;
#pragma unroll
            for (int i = 0; i < 17; ++i) { Bq = ph_[i].x * Bq + ph_[i].y; Aq *= ph_[i].x; }
            float Ag[4], Bg[4];
#pragma unroll
            for (int k = 0; k < 4; ++k) { Ag[k] = shi(Aq, c + 16 * k); Bg[k] = shi(Bq, c + 16 * k); }
            const float s1 = Bg[0], s2 = Ag[1] * s1 + Bg[1], s3 = Ag[2] * s2 + Bg[2];
            float h = (q == 0) ? 0.f : (q == 1) ? s1 : (q == 2) ? s2 : s3;
            if (valid) {
#pragma unroll
                for (int i = 0; i < 17; ++i) { HIN[(size_t)(bd * 68 + q * 17 + i) * 512 + ch] = h; h = ph_[i].x * h + ph_[i].y; } } }
    } else {
        for (int chain = blockIdx.x * cpb + tid; tid < cpb && chain < 4096; chain += 4096) { const int bd = chain >> 9, ch = chain & 511; float h = 0.f;
#pragma unroll 1
            for (int p0 = 0; p0 < 68; p0 += 17) { f32x2s ph_[17];
#pragma unroll
                for (int i = 0; i < 17; ++i) ph_[i] = *(const f32x2s*)(S + ((size_t)(bd * 68 + p0 + i) * 512 + ch) * 2);
#pragma unroll
                for (int i = 0; i < 17; ++i) { HIN[(size_t)(bd * 68 + p0 + i) * 512 + ch] = h; h = ph_[i].x * h + ph_[i].y; } } }
    }
}

#define EN(k) (((MASK) >> (k)) & 1)
template <int MASK> __global__ void __launch_bounds__(NWAVES * 64, 2) fwd_kernel(Args args) {
    extern __shared__ __attribute__((aligned(16))) unsigned char lds_raw[];
    LAS unsigned char* lds0 = (LAS unsigned char*)lds_raw;
    cg::grid_group grid = cg::this_grid();
    { const unsigned* aw = (const unsigned*)&args; const int tid = threadIdx.x; if (tid < 54) ((LAS unsigned*)(lds0 + ARGS_LDS_OFF))[tid] = aw[tid];
      if (tid >= 64 && tid < 66) ((LAS unsigned*)(lds0 + ARGS_LDS_OFF + 256))[tid - 64] = 0u; }
    __syncthreads();
    XcdBarrier xbar = xcd_barrier_post((unsigned*)args.ws, (volatile LAS unsigned*)(lds0 + ARGS_LDS_OFF + 256), threadIdx.x == 0);
    const int ph_lo = args.ph_lo, ph_hi = args.ph_hi;
    const int wave0 = __builtin_amdgcn_readfirstlane((int)threadIdx.x >> 6);
#ifndef PROBE_MASK
#define PROBE_MASK 0
#endif
#ifndef PROBE_SUB
#define PROBE_SUB 0
#endif
#define SUBOFF(bit) (rep && ((PROBE_SUB) & (bit)))
#define PROBE_HIT(ph) ((PROBE_MASK) != 0 && ((ph) == 0 ? (((PROBE_MASK) >> 13) & 1) : (ph) == 53 ? (((PROBE_MASK) >> 14) & 1) : (((PROBE_MASK) >> (((ph) - 1) % 13)) & 1)))
    for (int ph2 = 2 * ph_lo; ph2 < 2 * ph_hi; ++ph2) {
        const int ph = ph2 >> 1, rep = ph2 & 1;
        if (rep && !PROBE_HIT(ph)) continue;
        if (ph2 != 2 * ph_lo) {
            if (ph_lo < 0) grid.sync();
            else { int mk2_ = -1; asm volatile("" : "+s"(mk2_)); const bool t0_ = (wave0 == 0) && (__builtin_amdgcn_mbcnt_hi(mk2_, __builtin_amdgcn_mbcnt_lo(mk2_, 0)) == 0); xcd_barrier(xbar, t0_); }
        }
#define PH_PROLOG int wv_ = wave0; int mk_ = -1; asm volatile("" : "+s"(wv_), "+s"(mk_)); int tid = wv_ * 64 + (int)__builtin_amdgcn_mbcnt_hi(mk_, __builtin_amdgcn_mbcnt_lo(mk_, 0)); int G = gridDim.x, bx = blockIdx.x; asm volatile("" : "+s"(G), "+s"(bx)); \
        unsigned ldsi = (unsigned)(unsigned long long)lds0; asm volatile("" : "+s"(ldsi)); LAS unsigned char* lds = (LAS unsigned char*)(unsigned long long)ldsi; \
        const AH AHv{(const LAS unsigned*)(lds + ARGS_LDS_OFF)}; const int lane = tid & 63, wave = wv_; \
        const int gw = bx * NWAVES + wave, NGW = G * NWAVES; (void)gw; (void)NGW; (void)lane; (void)wave; (void)G; (void)bx; (void)tid;
        if (EN(13) && ph == 0) { PH_PROLOG phase_p0(AHv, lds, tid, G); __syncthreads(); convert_layer(AHv, 0, 0, CV_NIT, lds, gw, NGW, wave, lane); }
        else if (EN(14) && ph == 53) { PH_PROLOG final_rows(AHv, gw, NGW, lane); }
        else {
            const int l = (ph - 1) / 13, k = (ph - 1) - l * 13; const bool last = (l == DEPTH - 1);
#define ws (AHv.ws())
#define HN ((bf16*)(ws + WS_HN))
#define Zb ((bf16*)(ws + WS_Z))
#define X ((float*)(ws + WS_X))
#define modbuf ((const float*)(ws + WS_MOD))
            if (EN(0) && k == 0) { PH_PROLOG norm_rows(AHv, l, 0, gw, NGW, lane, l > 0 ? 11 : 0, modbuf + (size_t)(l > 0 ? l - 1 : 0) * 5 * MODW + 4 * MODW + 2 * 3072 + 2048, 0.5f); }
            else if (EN(3) && k == 3) { PH_PROLOG norm_rows(AHv, l, 1, gw, NGW, lane, 11, modbuf + (size_t)l * 5 * MODW + 4 * MODW + 0 * 3072 + 2048, 0.5f); }
            else if (EN(10) && k == 10) { PH_PROLOG norm_rows(AHv, l, 2, gw, NGW, lane, last ? 0 : 4, modbuf + (size_t)l * 5 * MODW + 4 * MODW + 1 * 3072 + 2048, 1.0f); }
            else if (EN(1) && (k == 1 || k == 11)) { PH_PROLOG const int j = (k == 1) ? 0 : 1;
                pg8::Gemm gm{HN, (const bf16*)(ws + (size_t)(l & 1) * WS_WSET + WS_WFI) + (size_t)j * 5632 * 1024, MTOK, 5632, 1024};
                pg8::EpiSwiglu E{Zb};
                if (last && k == 11) { pg8::LastLayerOrder S; S.init(5632, G, bx, 0); pg8::gemm_phase<1024, pg8::EpiSwiglu, pg8::LastLayerOrder, true, true>(lds, gm, S, E, tid); }
                else { pg8::StaticOrder S; S.init(MTOK, 5632, G, bx); pg8::gemm_phase<1024, pg8::EpiSwiglu, pg8::StaticOrder, true, true>(lds, gm, S, E, tid); } }
            else if (EN(2) && (k == 2 || k == 12)) { PH_PROLOG const int j = (k == 2) ? 0 : 1, sub = (k == 2) ? 0 : 2;
                pg8::Gemm gm{Zb, (const bf16*)(ws + (size_t)(l & 1) * WS_WSET + WS_WFO) + (size_t)j * 1024 * DFF, MTOK, 1024, DFF};
                pg8::EpiResid E{X, modbuf + (size_t)l * 5 * MODW + sub * 3072 + 2048, rep ? 0.0f : 0.5f, (float*)(ws + WS_PARTC)};
                if (last && k == 12) { pg8::LatOrder S{G, bx}; pg8::gemm_phase<DFF, pg8::EpiResid, pg8::LatOrder, true, true>(lds, gm, S, E, tid); }
                else { pg8::SplitOrder S{G, bx, 11, 4}; pg8::gemm_phase<DFF, pg8::EpiResid, pg8::SplitOrder, true, true>(lds, gm, S, E, tid); } }
            else if (EN(4) && k == 4) { PH_PROLOG
                pg8::Gemm gm{HN, (const bf16*)(ws + (size_t)(l & 1) * WS_WSET + WS_WIN), MTOK, DIN, 1024};
                pg8::EpiZ E{Zb, DIN};
                if (last) { pg8::LastLayerOrder S; S.init(DIN, G, bx, 28); pg8::gemm_phase<1024, pg8::EpiZ, pg8::LastLayerOrder, true, true>(lds, gm, S, E, tid); }
                else { pg8::StaticOrder S; S.init(MTOK, DIN, G, bx); pg8::gemm_phase<1024, pg8::EpiZ, pg8::StaticOrder, true, true>(lds, gm, S, E, tid); } }
            else if (EN(5) && k == 5) { PH_PROLOG
                if (!SUBOFF(1)) prep_qk(AHv, l, gw, NGW, lane);
                if (!SUBOFF(2)) for (int it = bx; it < 544; it += G) ret_u_item(AHv, l, it, lds, tid, wave, lane);
                __syncthreads();
                if (!SUBOFF(4)) { PH_PROLOG
                    const int H = 2 * 272, n3 = (544 > 2 * G && 544 <= 3 * G) ? 544 - 2 * G : 0, nb = G - n3;
                    for (int hi = bx; hi < H; hi += (bx < n3) ? H : nb) { const int li = hi >> 1; lru_task<false>(AHv, l, li / 68, li % 68, wave, lds, wave, lane, hi & 1); } } }
            else if (EN(6) && k == 6) { PH_PROLOG
                for (int it = bx; it < 256; it += G) ret_scan_item(AHv, l, it, tid);
                lru_scan(AHv, tid, G);
                const int nunits = last ? 512 : 544;
                for (int i = 0;; ++i) { const int u = i * G + bx; if (u >= nunits) break;
                    long qrow0, kvrow0; int hq, kvh, NT;
                    if (u < 512) { const int combo = u & 7, j = u >> 3; const int b = combo >> 1; kvh = combo & 1; hq = kvh * 4 + (j & 3); const int qb = j >> 2;
                        qrow0 = (long)b * SROW + LCTX + qb * 256; kvrow0 = (long)b * SROW; NT = 68; }
                    else { const int v = u - 512; const int b = v >> 3; hq = v & 7; kvh = hq >> 2; qrow0 = (long)b * SROW; kvrow0 = qrow0; NT = 4; }
                    attn_body::attn_unit<8>(qrow0, kvrow0, hq, kvh, NT, (const attn_body::bf16*)(Zb + ZC_AQ), (const attn_body::bf16*)(ws + WS_KN), (const attn_body::bf16*)(Zb + ZC_AV),
                                            (attn_body::bf16*)((bf16*)(ws + WS_Y) + (size_t)2 * MTOK * 512), (char*)lds, tid,
                                            AHv.in(I_QG) + l * 64, (const float*)(ws + WS_ROPE) + 64 * 32 * 2, (u < 512) ? (long)(qrow0 - kvrow0 - LCTX) : -1L); } }
            else if ((EN(7) || EN(15)) && k == 7) { PH_PROLOG
                const int nret = last ? 512 : 544, nlru = last ? 256 : 272;
                if (EN(7) && !SUBOFF(8)) for (int it = bx; it < nret; it += G) { const int item = last ? ((it >> 5) * 34 + 2 + (it & 31)) : it; ret_out_item(AHv, l, item, lds, tid, wave, lane); }
                __syncthreads();
                if (EN(15) && !SUBOFF(16)) { PH_PROLOG
                    const int H = 2 * nlru, n3 = (nret > 2 * G && nret <= 3 * G) ? nret - 2 * G : 0, nb = G - n3;
                    for (int hi = bx; hi < H; hi += (bx < n3) ? H : nb) { const int li = hi >> 1; const int b = last ? (li >> 6) : (li / 68), c64 = last ? (4 + (li & 63)) : (li % 68);
                        lru_final(AHv, l, b, c64, wave, lds, wave, lane, hi & 1); } } }
            else if (EN(8) && k == 8) { PH_PROLOG
                pg8::Gemm gm{(const bf16*)(ws + WS_Y), (const bf16*)(ws + (size_t)(l & 1) * WS_WSET + WS_WB), 3 * MTOK, 3 * 1024, 512}; pg8::MergeOrder S{G, bx, last ? 1 : 0};
                pg8::EpiMerge E{Zb, HN};
                pg8::gemm_phase<512, pg8::EpiMerge, pg8::MergeOrder, true, true>(lds, gm, S, E, tid);
                if (!last) {
                    const int nsec = (272 > G) ? ((272 - G < G) ? 272 - G : 0) : 0;
                    if (bx >= nsec) convert_layer(AHv, l + 1, 0, CV_NIT, lds, (bx - nsec) * NWAVES + wave, (G - nsec) * NWAVES, wave, lane); } }
            else if (EN(9) && k == 9) { PH_PROLOG
                pg8::Gemm gm{HN, (const bf16*)(ws + (size_t)(l & 1) * WS_WSET + WS_WO), MTOK, 1024, 1024};
                pg8::EpiResid E{X, modbuf + (size_t)l * 5 * MODW + 1 * 3072 + 2048, rep ? 0.0f : 1.0f, (float*)(ws + WS_PARTC)};
                if (last) { pg8::LatOrder S{G, bx}; pg8::gemm_phase<1024, pg8::EpiResid, pg8::LatOrder, true, true>(lds, gm, S, E, tid); }
                else { pg8::SplitOrder S{G, bx, 4, 4}; pg8::gemm_phase<1024, pg8::EpiResid, pg8::SplitOrder, true, true>(lds, gm, S, E, tid); } }
        }
#undef ws
#undef HN
#undef Zb
#undef X
#undef modbuf
    }
}

#ifndef MK_N_LAUNCHES
#define MK_N_LAUNCHES 1
#endif
#if MK_N_LAUNCHES == 1
#define FULLK fwd_kernel<0xffff>
#else
template <int MASK> static void launch_one(int grid, const Args& a, hipStream_t stream) {
    static bool init = false;
    if (!init) { (void)hipFuncSetAttribute((const void*)fwd_kernel<MASK>, hipFuncAttributeMaxDynamicSharedMemorySize, LDS_BYTES); init = true; }
    hipLaunchKernelGGL(fwd_kernel<MASK>, dim3(grid), dim3(NWAVES * 64), LDS_BYTES, stream, a);
}
#endif
extern "C" void kernel_launch(void* const* d_in, const int* in_sizes, int n_in, void* d_out, int out_size, void* d_ws, size_t ws_size, hipStream_t stream) {
    static int grid = 0;
    if (grid == 0) {
        if (n_in != 24 || ws_size < WS_END) { fprintf(stderr, "kernel_launch: unexpected n_in %d / ws %zu (need %zu)\n", n_in, ws_size, (size_t)WS_END); grid = -1; return; }
        int dev = 0, cus = 0;
        (void)hipGetDevice(&dev); (void)hipDeviceGetAttribute(&cus, hipDeviceAttributeMultiprocessorCount, dev);
#if MK_N_LAUNCHES == 1
        int per_cu = 0;
        (void)hipFuncSetAttribute((const void*)FULLK, hipFuncAttributeMaxDynamicSharedMemorySize, LDS_BYTES);
        if (hipOccupancyMaxActiveBlocksPerMultiprocessor(&per_cu, (const void*)FULLK, NWAVES * 64, LDS_BYTES) != hipSuccess || per_cu < 1) per_cu = 1;
        (void)hipGetLastError();
        grid = cus * per_cu;
#else
        grid = cus;
#endif
        if (grid <= 0) grid = 256;
    }
    if (grid < 0) return;
    (void)hipMemsetAsync(d_ws, 0, 16384, stream);
    Args a{};
    for (int i = 0; i < 24; ++i) a.in[i] = (const float*)d_in[i];
    a.out = (float*)d_out; a.ws = (unsigned char*)d_ws;
#if MK_N_LAUNCHES == 1
    a.ph_lo = 0; a.ph_hi = 54;
    void* params[] = {(void*)&a};
    hipError_t e = hipLaunchCooperativeKernel((const void*)FULLK, dim3(grid), dim3(NWAVES * 64), params, LDS_BYTES, stream);
    if (e != hipSuccess) fprintf(stderr, "cooperative launch failed: %s (grid %d)\n", hipGetErrorString(e), grid);
#else
    for (int ph = 0; ph < 54; ++ph) { a.ph_lo = ph; a.ph_hi = ph + 1;
        if (ph == 0) { launch_one<1 << 13>(grid, a, stream); continue; }
        if (ph == 53) { launch_one<1 << 14>(grid, a, stream); continue; }
        const int k = (ph - 1) % 13;
        switch (k) {
            case 0: launch_one<1 << 0>(grid, a, stream); break;
            case 1: case 11: launch_one<1 << 1>(grid, a, stream); break;
            case 2: case 12: launch_one<1 << 2>(grid, a, stream); break;
            case 3: launch_one<1 << 3>(grid, a, stream); break;
            case 4: launch_one<1 << 4>(grid, a, stream); break;
            case 5: launch_one<1 << 5>(grid, a, stream); break;
            case 6: launch_one<1 << 6>(grid, a, stream); break;
            case 7: launch_one<1 << 7>(grid, a, stream); launch_one<1 << 15>(grid, a, stream); break;
            case 8: launch_one<1 << 8>(grid, a, stream); break;
            case 9: launch_one<1 << 9>(grid, a, stream); break;
            case 10: launch_one<1 << 10>(grid, a, stream); break;
        }
    }
#endif
}
```

```cpp
#include <hip/hip_runtime.h>
#include <hip/hip_cooperative_groups.h>
#include <hip/hip_bf16.h>
#include <cstdio>
#include <cstdint>
#include <cmath>
namespace cg = cooperative_groups;
namespace pg8 {
#define PG8_LAS __attribute__((address_space(3)))
typedef unsigned short bf16_t;
typedef short bf16x8 __attribute__((ext_vector_type(8)));
typedef float f32x4 __attribute__((ext_vector_type(4)));
typedef unsigned u32x4 __attribute__((ext_vector_type(4)));
constexpr int BM = 256, BK = 64, HALF = 128, HTB = HALF * BK * 2  , STAGE_BYTES = 8 * HTB, NXCD = 8, WGM = 4;

__host__ __device__ __forceinline__ int lds_byte(int r, int c) { const int st = (r >> 4) * 2 + (c >> 5), rr = r & 15, cc = c & 31, ob = rr * 64 + cc * 2; return st * 1024 + (ob ^ (((ob >> 9) & 1) << 5)); }
__host__ __device__ __forceinline__ void stage_rc(int b, int& R, int& C) { const int st = b / 1024, sb = b % 1024, swz = sb ^ (((sb >> 9) & 1) << 5); R = (st >> 1) * 16 + swz / 64; C = (st & 1) * 32 + (swz % 64) / 2; }
__host__ __device__ __forceinline__ int perm32(int rho) { const int n = rho >> 4, i = rho & 15; return 8 * (i >> 2) + 4 * n + (i & 3); }

struct Unit { int pm, pn, k0, nk; };
struct Gemm { const bf16_t* A; const bf16_t* Bt; int M, N, K; };

struct StaticOrder {
    int nM, nN, nwg, G, c;
    __host__ __device__ void init(int M, int N, int G_, int c_) { nM = M / BM; nN = N / BM; nwg = nM * nN; G = G_; c = c_; }
    __host__ __device__ bool next(int i, Unit& u) const {
        const long L = (long)i * G + c; if (L >= nwg) return false;
        int wgid = (int)L; { const int q = nwg / NXCD, r = nwg % NXCD, xcd = wgid % NXCD, off = wgid / NXCD; wgid = (xcd < r ? xcd * (q + 1) : r * (q + 1) + (xcd - r) * q) + off; }
        const int nig = WGM * nN, gid = wgid / nig, fm = gid * WGM, gsz = (nM - fm) < WGM ? (nM - fm) : WGM;
        u.pm = fm + ((wgid % nig) % gsz); u.pn = (wgid % nig) / gsz; u.k0 = 0; u.nk = 0; return true;
    }
    __device__ __forceinline__ void a_ready(const Unit&) const {}
    __device__ __forceinline__ void done(const Unit&) const {}
};

typedef unsigned u32x2 __attribute__((ext_vector_type(2)));
__device__ __forceinline__ unsigned cvt_pk_bf16(float lo, float hi) { unsigned r; asm volatile("v_cvt_pk_bf16_f32 %0, %1, %2" : "=v"(r) : "v"(lo), "v"(hi)); return r; }
__device__ __forceinline__ float fast_sigmoid(float v) { return __builtin_amdgcn_rcpf(1.0f + __expf(-v)); }
__device__ __forceinline__ float bf_lo(unsigned w) { return __uint_as_float(w << 16); }
__device__ __forceinline__ float bf_hi(unsigned w) { return __uint_as_float(w & 0xffff0000u); }
struct EpiZ {
    static constexpr bool PERM = true, AFTER_DRAIN = false, CHAIN = false;
    bf16_t* O; int ldc;
    __device__ __forceinline__ void operator()(const f32x4 (&acc)[2][2][4][2], const Unit& u, int wr, int wc, int fr, int fq) const {
        const int row0 = u.pm * BM + wr * 64 + fr; const int col0 = u.pn * BM + wc * 32 + 8 * fq; const bool gates = u.pn >= 15;
#pragma unroll
        for (int ai = 0; ai < 2; ++ai)
#pragma unroll
            for (int m = 0; m < 4; ++m) { bf16_t* rowp = O + (size_t)(row0 + ai * HALF + m * 16) * ldc + col0;
#pragma unroll
                for (int bj = 0; bj < 2; ++bj) { f32x4 v0 = acc[ai][bj][m][0], v1 = acc[ai][bj][m][1];
                    if (gates) {
#pragma unroll
                        for (int j = 0; j < 4; ++j) { v0[j] = 1.0f + __expf(-v0[j]); v1[j] = 1.0f + __expf(-v1[j]); } }
                    u32x4 w; w.x = cvt_pk_bf16(v0[0], v0[1]); w.y = cvt_pk_bf16(v0[2], v0[3]); w.z = cvt_pk_bf16(v1[0], v1[1]); w.w = cvt_pk_bf16(v1[2], v1[3]);
                    *(u32x4*)(rowp + bj * HALF) = w; } }
    }
};
struct EpiSwiglu {
    static constexpr bool PERM = true, AFTER_DRAIN = false, CHAIN = false;
    bf16_t* O;
    __device__ __forceinline__ void operator()(const f32x4 (&acc)[2][2][4][2], const Unit& u, int wr, int wc, int fr, int fq) const {
        const int row0 = u.pm * BM + wr * 64 + fr; const int col0 = u.pn * HALF + wc * 32 + 8 * fq;
#pragma unroll
        for (int ai = 0; ai < 2; ++ai)
#pragma unroll
            for (int m = 0; m < 4; ++m) { bf16_t* rowp = O + (size_t)(row0 + ai * HALF + m * 16) * 2816 + col0;
                float h[8];
#pragma unroll
                for (int n = 0; n < 2; ++n)
#pragma unroll
                    for (int j = 0; j < 4; ++j) { const float a = acc[ai][0][m][n][j], b = acc[ai][1][m][n][j]; h[n * 4 + j] = a * fast_sigmoid(a) * b; }
                u32x4 w; w.x = cvt_pk_bf16(h[0], h[1]); w.y = cvt_pk_bf16(h[2], h[3]); w.z = cvt_pk_bf16(h[4], h[5]); w.w = cvt_pk_bf16(h[6], h[7]);
                *(u32x4*)rowp = w; }
    }
};
struct EpiResid {
    static constexpr bool PERM = false, AFTER_DRAIN = false, CHAIN = false;
    float* X; const float* gate; float scale; float* PARTC;
    __device__ __forceinline__ void operator()(const f32x4 (&acc)[2][2][4][2], const Unit& u, int wr, int wc, int fr, int fq) const {
        const int bb = u.pm / 17, mrow = (u.pm - bb * 17 == 0) ? 4 : bb;
        const int col0 = u.pn * BM + wc * 32 + 4 * fq;
        if (u.nk != 0) {
            const int sp = u.k0 / (u.nk * 64); bf16_t* base = (bf16_t*)PARTC + ((size_t)sp * 1024 + (size_t)bb * 256 + wr * 64 + fr) * 1024 + col0;
#pragma unroll
            for (int ai = 0; ai < 2; ++ai)
#pragma unroll
                for (int m = 0; m < 4; ++m)
#pragma unroll
                    for (int bj = 0; bj < 2; ++bj)
#pragma unroll
                        for (int n = 0; n < 2; ++n) { const f32x4 v = acc[ai][bj][m][n]; u32x2 w; w.x = cvt_pk_bf16(v[0], v[1]); w.y = cvt_pk_bf16(v[2], v[3]);
                            *(u32x2*)(base + (size_t)(ai * HALF + m * 16) * 1024 + bj * HALF + n * 16) = w; }
            return; }
        const float* g = gate + (size_t)mrow * 9216;
        const int row0 = u.pm * BM + wr * 64 + fr;
        f32x4 gv[2][2];
#pragma unroll
        for (int bj = 0; bj < 2; ++bj)
#pragma unroll
            for (int n = 0; n < 2; ++n) gv[bj][n] = *(const f32x4*)(g + col0 + bj * HALF + n * 16) * scale;
#pragma unroll
        for (int ai = 0; ai < 2; ++ai)
#pragma unroll
            for (int m = 0; m < 4; ++m) { float* rowp = X + (size_t)(row0 + ai * HALF + m * 16) * 1024 + col0;
#pragma unroll
                for (int bj = 0; bj < 2; ++bj)
#pragma unroll
                    for (int n = 0; n < 2; ++n) { f32x4* p = (f32x4*)(rowp + bj * HALF + n * 16); *p = *p + gv[bj][n] * acc[ai][bj][m][n]; }
                asm volatile("" ::: "memory"); }
    }
};
struct EpiMerge {
    static constexpr bool PERM = false, AFTER_DRAIN = false, CHAIN = true;
    const bf16_t* Z; bf16_t* MG;
    __device__ __forceinline__ void operator()(const f32x4 (&acc)[2][2][4][2], const Unit& u, int wr, int wc, int fr, int fq) const {}
    __device__ __forceinline__ bool chain(f32x4 (&acc)[2][2][4][2], const Unit& u, int wr, int wc, int fr, int fq) const {
        const int n = u.pm / 68, pm = u.pm - n * 68, pn = u.pn & 3;
        const int row0 = pm * BM + wr * 64 + fr; const int col0 = pn * BM + wc * 32 + 4 * fq;
#pragma unroll
        for (int ai = 0; ai < 2; ++ai)
#pragma unroll
            for (int m = 0; m < 4; ++m) { const size_t row = (size_t)(row0 + ai * HALF + m * 16);
#pragma unroll
                for (int bj = 0; bj < 2; ++bj)
#pragma unroll
                    for (int nn = 0; nn < 2; ++nn) { const int col = col0 + bj * HALF + nn * 16;
                        const bf16_t* zp = Z + row * 6912 + 3840 + n * 1024 + col;
                        const u32x2 ga = *(const u32x2*)zp;
                        const float ea0 = bf_lo(ga.x), ea1 = bf_hi(ga.x), ea2 = bf_lo(ga.y), ea3 = bf_hi(ga.y);
                        f32x4 sc;
                        if (n < 2) { const u32x2 gb = *(const u32x2*)(zp + 1024);
                            sc[0] = bf_lo(gb.x) * __builtin_amdgcn_rcpf(ea0); sc[1] = bf_hi(gb.x) * __builtin_amdgcn_rcpf(ea1);
                            sc[2] = bf_lo(gb.y) * __builtin_amdgcn_rcpf(ea2); sc[3] = bf_hi(gb.y) * __builtin_amdgcn_rcpf(ea3);
                            acc[ai][bj][m][nn] = acc[ai][bj][m][nn] * sc; }
                        else { sc[0] = __builtin_amdgcn_rcpf(ea0); sc[1] = __builtin_amdgcn_rcpf(ea1); sc[2] = __builtin_amdgcn_rcpf(ea2); sc[3] = __builtin_amdgcn_rcpf(ea3);
                            const f32x4 v = acc[ai][bj][m][nn] * sc; u32x2 w; w.x = cvt_pk_bf16(v[0], v[1]); w.y = cvt_pk_bf16(v[2], v[3]); *(u32x2*)(MG + row * 1024 + col) = w; } }
                asm volatile("" ::: "memory"); }
        return n < 2;
    }
};
struct MergeOrder {
    int G, c, latonly;
    __device__ bool next(int i, Unit& u) const {
        const int ti = i / 3, n = i - ti * 3; const int L = ti * G + c; if (L >= (latonly ? 256 : 272)) return false;
        const int t = L >> 2; const int pm = latonly ? ((t >> 4) * 17 + 1 + (t & 15)) : t;
        u.pm = n * 68 + pm; u.pn = n * 4 + (L & 3); u.k0 = 0; u.nk = 0; return true;
    }
    __device__ __forceinline__ void a_ready(const Unit&) const {}
    __device__ __forceinline__ void done(const Unit&) const {}
};
struct LastLayerOrder {
    StaticOrder so; int nextra;
    __device__ void init(int N, int G, int c, int nextra_) { so.init(64 * BM, N, G, c); nextra = nextra_; }
    __device__ bool next(int i, Unit& u) const {
        if (so.next(i, u)) { const int v = u.pm; u.pm = (v >> 4) * 17 + 1 + (v & 15); return true; }
        const int L = i * so.G + so.c - so.nwg; if (L < 0 || L >= nextra) return false;
        const int t = L / 7, q = L - t * 7; u.pm = t * 17; u.pn = (q < 4) ? 2 + q : (q < 6) ? 4 + q : 14; u.k0 = 0; u.nk = 0; return true;
    }
    __device__ __forceinline__ void a_ready(const Unit&) const {}
    __device__ __forceinline__ void done(const Unit&) const {}
};
struct LatOrder {
    int G, c;
    __device__ bool next(int i, Unit& u) const {
        const int L = i * G + c; if (L >= 256) return false;
        const int t = L >> 2; u.pm = (t >> 4) * 17 + 1 + (t & 15); u.pn = L & 3; u.k0 = 0; u.nk = 0; return true;
    }
    __device__ __forceinline__ void a_ready(const Unit&) const {}
    __device__ __forceinline__ void done(const Unit&) const {}
};
struct SplitOrder {
    int G, c, nsplit, nkt;
    __device__ bool next(int i, Unit& u) const {
        int L = i * G + c;
        if (L < 256) { const int t = L >> 2; u.pm = (t >> 4) * 17 + 1 + (t & 15); u.pn = L & 3; u.k0 = 0; u.nk = 0; return true; }
        L -= 256; if (L >= 16 * nsplit) return false;
        const int t = L / nsplit, s = L - t * nsplit;
        u.pm = (t >> 2) * 17; u.pn = t & 3; u.k0 = s * nkt * 64; u.nk = nkt; return true;
    }
    __device__ __forceinline__ void a_ready(const Unit&) const {}
    __device__ __forceinline__ void done(const Unit&) const {}
};
template <int KT, class Epi, class Sched, bool ALIGN_EPI = false, bool SP2 = false>
__device__ __forceinline__ void gemm_phase(PG8_LAS unsigned char* lds, const Gemm g, const Sched& S, const Epi& E, const int tid) {
    const int wid = __builtin_amdgcn_readfirstlane(tid >> 6), lane = tid & 63, wr = wid >> 2, wc = wid & 3, fr = lane & 15, fq = lane >> 4;
    constexpr int K = KT, nt = K / BK;
    unsigned voffA[2], voffB[2];
#pragma unroll
    for (int i = 0; i < 2; ++i) { int R, C; stage_rc(tid * 16 + i * 8192, R, C); const int Rb = Epi::PERM ? ((R & ~31) + perm32(R & 31)) : R;
        voffA[i] = (unsigned)(R * K + C) * 2u; voffB[i] = (unsigned)(Rb * K + C) * 2u; }
    const size_t kstep = (size_t)(BK * 2);
    const size_t hstep = (size_t)HALF * K * 2;
    const size_t tstep = 2 * hstep;
    const unsigned ldsw = (unsigned)wid * 1024u;
    const int aoff = lds_byte(wr * 64 + fr, fq * 8), boff = lds_byte(wc * 32 + fr, fq * 8);
#define PG8_SA(b, h) (((b) * 2 + (h)) * HTB)
#define PG8_SB(b, h) ((4 + (b) * 2 + (h)) * HTB)
#define PG8_STAGE(bufoff, gbase, voff) do { _Pragma("unroll") for (int _i = 0; _i < 2; ++_i) \
        __builtin_amdgcn_global_load_lds((const unsigned*)((const char*)(gbase) + (voff)[_i]), (PG8_LAS unsigned*)(lds + (bufoff) + ldsw + _i * 8192), 16, 0, 0); } while (0)
#define PG8_LDA(dst, b, h) do { _Pragma("unroll") for (int m = 0; m < 4; ++m) _Pragma("unroll") for (int k = 0; k < 2; ++k) dst[m][k] = *(const PG8_LAS bf16x8*)(lds + PG8_SA(b, h) + aoff + m * 2048 + k * 1024); } while (0)
#define PG8_LDB(dst, b, h) do { _Pragma("unroll") for (int n = 0; n < 2; ++n) _Pragma("unroll") for (int k = 0; k < 2; ++k) dst[n][k] = *(const PG8_LAS bf16x8*)(lds + PG8_SB(b, h) + boff + n * 2048 + k * 1024); } while (0)
#define PG8_MMA(ai, bj, At, Bt) do { __builtin_amdgcn_s_setprio(1); _Pragma("unroll") for (int m = 0; m < 4; ++m) _Pragma("unroll") for (int n = 0; n < 2; ++n) _Pragma("unroll") for (int k = 0; k < 2; ++k) \
        acc[ai][bj][m][n] = __builtin_amdgcn_mfma_f32_16x16x32_bf16(Bt[n][k], At[m][k], acc[ai][bj][m][n], 0, 0, 0); __builtin_amdgcn_s_setprio(0); } while (0)
#define PG8_WAIT_V(n) asm volatile("s_waitcnt vmcnt(" #n ")" ::: "memory")
#define PG8_WAIT_L(n) asm volatile("s_waitcnt lgkmcnt(" #n ")" ::: "memory")
#define PG8_BAR __builtin_amdgcn_s_barrier()
#define PG8_SCHED __builtin_amdgcn_sched_barrier(0)
    Unit cur{0, 0, 0, 0}, nxt{0, 0, 0, 0}; int ui = 0;
    if (!S.next(0, cur)) return;
    f32x4 acc[2][2][4][2];
#pragma unroll
    for (int a = 0; a < 2; ++a)
#pragma unroll
        for (int b = 0; b < 2; ++b)
#pragma unroll
            for (int m = 0; m < 4; ++m)
#pragma unroll
                for (int n = 0; n < 2; ++n) acc[a][b][m][n] = (f32x4){0.f, 0.f, 0.f, 0.f};
    bf16x8 At[4][2], B0[2][2], B1[2][2];
    const char* cA = (const char*)g.A + (size_t)cur.pm * tstep + (size_t)cur.k0 * 2; const char* cB = (const char*)g.Bt + (size_t)cur.pn * tstep + (size_t)cur.k0 * 2;
    S.a_ready(cur);
    if constexpr (SP2) {
        PG8_STAGE(PG8_SB(0, 0), cB, voffB); PG8_STAGE(PG8_SB(0, 1), cB + hstep, voffB); PG8_STAGE(PG8_SA(0, 0), cA, voffA); PG8_STAGE(PG8_SA(0, 1), cA + hstep, voffA);
        if (wr == 1) PG8_BAR;
        PG8_WAIT_V(2); PG8_BAR;
        PG8_STAGE(PG8_SB(1, 0), cB + kstep, voffB); PG8_STAGE(PG8_SA(1, 0), cA + kstep, voffA); PG8_STAGE(PG8_SB(1, 1), cB + hstep + kstep, voffB);
        PG8_WAIT_V(6); PG8_BAR;
    } else {
        PG8_STAGE(PG8_SB(0, 0), cB, voffB); PG8_STAGE(PG8_SA(0, 0), cA, voffA); PG8_STAGE(PG8_SB(0, 1), cB + hstep, voffB); PG8_STAGE(PG8_SA(0, 1), cA + hstep, voffA);
        if (wr == 1) PG8_BAR;
        PG8_WAIT_V(4); PG8_BAR;
        PG8_STAGE(PG8_SB(1, 0), cB + kstep, voffB); PG8_STAGE(PG8_SA(1, 0), cA + kstep, voffA); PG8_STAGE(PG8_SB(1, 1), cB + hstep + kstep, voffB);
        PG8_WAIT_V(6); PG8_BAR;
    }
    for (;;) {
        const bool has_next = S.next(ui + 1, nxt);
        const char* nA = has_next ? (const char*)g.A + (size_t)nxt.pm * tstep + (size_t)nxt.k0 * 2 : cA; const char* nB = has_next ? (const char*)g.Bt + (size_t)nxt.pn * tstep + (size_t)nxt.k0 * 2 : cB;
        const int ntu = cur.nk ? cur.nk : nt;
        for (int t = 0; t < ntu; t += 2) {
            const bool last = (t == ntu - 2);
            const char* a1 = cA + (size_t)(t + 1) * kstep;
            const char* a2 = last ? nA : cA + (size_t)(t + 2) * kstep; const char* b2 = last ? nB : cB + (size_t)(t + 2) * kstep;
            const char* a3 = a2 + kstep; const char* b3 = b2 + kstep;
            if (last && has_next) S.a_ready(nxt);
            if constexpr (SP2) {
            PG8_LDB(B0, 0, 0); PG8_LDB(B1, 0, 1); PG8_SCHED; PG8_LDA(At, 0, 0); PG8_STAGE(PG8_SA(1, 1), a1 + hstep, voffA);
            PG8_WAIT_V(8); PG8_WAIT_L(0); PG8_BAR; PG8_MMA(0, 0, At, B0); PG8_MMA(0, 1, At, B1); PG8_BAR; PG8_SCHED;
            PG8_LDA(At, 0, 1); PG8_STAGE(PG8_SB(0, 0), b2, voffB); PG8_STAGE(PG8_SB(0, 1), b2 + hstep, voffB); PG8_STAGE(PG8_SA(0, 0), a2, voffA);
            PG8_WAIT_V(8); PG8_WAIT_L(0); PG8_BAR; PG8_MMA(1, 0, At, B0); PG8_MMA(1, 1, At, B1); PG8_BAR; PG8_SCHED;
            PG8_LDB(B0, 1, 0); PG8_LDB(B1, 1, 1); PG8_SCHED; PG8_LDA(At, 1, 0); PG8_STAGE(PG8_SA(0, 1), a2 + hstep, voffA);
            PG8_WAIT_V(8); PG8_WAIT_L(0); PG8_BAR; PG8_MMA(0, 0, At, B0); PG8_MMA(0, 1, At, B1); PG8_BAR; PG8_SCHED;
            PG8_LDA(At, 1, 1); PG8_STAGE(PG8_SB(1, 0), b3, voffB); PG8_STAGE(PG8_SB(1, 1), b3 + hstep, voffB); PG8_STAGE(PG8_SA(1, 0), a3, voffA);
            PG8_WAIT_V(8); PG8_WAIT_L(0); PG8_BAR; PG8_MMA(1, 0, At, B0); PG8_MMA(1, 1, At, B1); PG8_BAR; PG8_SCHED;
            } else {
            PG8_LDB(B0, 0, 0); PG8_SCHED; PG8_LDA(At, 0, 0); PG8_STAGE(PG8_SA(1, 1), a1 + hstep, voffA);
            PG8_WAIT_L(8); PG8_BAR; PG8_WAIT_L(0); PG8_MMA(0, 0, At, B0); PG8_BAR; PG8_SCHED;
            PG8_LDB(B1, 0, 1); PG8_STAGE(PG8_SB(0, 0), b2, voffB);
            PG8_BAR; PG8_WAIT_L(0); PG8_MMA(0, 1, At, B1); PG8_BAR;
            PG8_LDA(At, 0, 1); PG8_STAGE(PG8_SA(0, 0), a2, voffA);
            PG8_BAR; PG8_WAIT_L(0); PG8_MMA(1, 0, At, B0); PG8_BAR; PG8_SCHED;
            PG8_STAGE(PG8_SB(0, 1), b2 + hstep, voffB);
            PG8_WAIT_V(6); PG8_BAR; PG8_MMA(1, 1, At, B1); PG8_BAR;
            PG8_LDB(B0, 1, 0); PG8_SCHED; PG8_LDA(At, 1, 0); PG8_STAGE(PG8_SA(0, 1), a2 + hstep, voffA);
            PG8_WAIT_L(8); PG8_BAR; PG8_WAIT_L(0); PG8_MMA(0, 0, At, B0); PG8_BAR; PG8_SCHED;
            PG8_LDB(B1, 1, 1); PG8_STAGE(PG8_SB(1, 0), b3, voffB);
            PG8_BAR; PG8_WAIT_L(0); PG8_MMA(0, 1, At, B1); PG8_BAR;
            PG8_LDA(At, 1, 1); PG8_STAGE(PG8_SA(1, 0), a3, voffA);
            PG8_BAR; PG8_WAIT_L(0); PG8_MMA(1, 0, At, B0); PG8_BAR; PG8_SCHED;
            PG8_STAGE(PG8_SB(1, 1), b3 + hstep, voffB);
            PG8_WAIT_V(6); PG8_BAR; PG8_MMA(1, 1, At, B1); PG8_BAR;
            }
        }
        if constexpr (ALIGN_EPI) { if (wr == 0) PG8_BAR; }
        bool keep_acc = false;
        if constexpr (!Epi::AFTER_DRAIN) { if constexpr (Epi::CHAIN) keep_acc = E.chain(acc, cur, wr, wc, fr, fq); else E(acc, cur, wr, wc, fr, fq); S.done(cur); }
        if (!has_next) break;
        if (!keep_acc) {
#pragma unroll
        for (int a = 0; a < 2; ++a)
#pragma unroll
            for (int b = 0; b < 2; ++b)
#pragma unroll
                for (int m = 0; m < 4; ++m)
#pragma unroll
                    for (int n = 0; n < 2; ++n) acc[a][b][m][n] = (f32x4){0.f, 0.f, 0.f, 0.f};
        }
        cur = nxt; cA = nA; cB = nB; ++ui;
        if constexpr (ALIGN_EPI) { if (wr == 1) PG8_BAR; }
    }
    PG8_WAIT_V(0);
    if constexpr (!ALIGN_EPI) { if (wr == 0) PG8_BAR; }
    PG8_BAR;
    if constexpr (Epi::AFTER_DRAIN) { E.fused(acc, cur, wr, wc, fr, fq, lds, wid, lane); S.done(cur); }
#undef PG8_SA
#undef PG8_SB
#undef PG8_STAGE
#undef PG8_LDA
#undef PG8_LDB
#undef PG8_MMA
#undef PG8_WAIT_V
#undef PG8_WAIT_L
#undef PG8_BAR
#undef PG8_SCHED
}
}
namespace attn_body {
using bf16=__hip_bfloat16;
using bf16x8=__attribute__((ext_vector_type(8)))short;
using s16x4=__attribute__((ext_vector_type(4)))short;
using f32x16=__attribute__((ext_vector_type(16)))float;
using u32x4=__attribute__((ext_vector_type(4)))unsigned;
constexpr int D=64,QP=512,KP=128,VP=6912,OP=512;
constexpr int NW=8,QBLK=32,QB=QBLK*NW,KVBLK=64;
__device__ __forceinline__ int crow(int r,int hi){return (r&3)+8*(r>>2)+4*hi;}
#define SBAR() __builtin_amdgcn_sched_barrier(0)
constexpr int NSLOT=3, SLOTB=8192;
constexpr int LDS_K=0, LDS_V=NSLOT*SLOTB, LDS_WS=2*NSLOT*SLOTB, LDS_OST=LDS_WS+NW*64*4, LDS_BYTES=LDS_OST+NW*4096;
constexpr float C2=0.125f*1.4426950408889634f;
__device__ __forceinline__ void glds16(const void*gsrc,unsigned lds_dst){unsigned keep;
  asm volatile("s_mov_b32 %0, m0\n\ts_mov_b32 m0, %2\n\ts_nop 0\n\tglobal_load_lds_dwordx4 %1, off\n\ts_mov_b32 m0, %0":"=&s"(keep):"v"(gsrc),"s"(lds_dst):"memory");}
__device__ __forceinline__ float max3f(float a,float b,float c){float r;asm("v_max3_f32 %0, %1, %2, %3":"=v"(r):"v"(a),"v"(b),"v"(c));return r;}
__device__ __forceinline__ float max2f(float a,float b){float r;asm("v_max_f32_e32 %0, %1, %2":"=v"(r):"v"(a),"v"(b));return r;}
__device__ __forceinline__ float fadd_s(float a,float b){float r;asm("v_add_f32_e32 %0, %1, %2":"=v"(r):"v"(a),"v"(b));return r;}
__device__ __forceinline__ float fsub_s(float a,float b){float r;asm("v_sub_f32_e32 %0, %1, %2":"=v"(r):"v"(a),"v"(b));return r;}
typedef float f32x2_t __attribute__((ext_vector_type(2))); typedef __bf16 bf16x2_t __attribute__((ext_vector_type(2)));
__device__ __forceinline__ unsigned cvtpk_s(float lo,float hi){f32x2_t v={lo,hi};bf16x2_t b=__builtin_convertvector(v,bf16x2_t);return __builtin_bit_cast(unsigned,b);}
#define WAIT_BAR(N) asm volatile("s_waitcnt vmcnt(" #N ") lgkmcnt(0)\n\ts_barrier":::"memory")

__device__ __forceinline__ void qkt(f32x16&p0,f32x16&p1,const char*Kslot,const bf16x8*qr,const f32x16&negm,int r32,int hi){
  const char*kb=Kslot+hi*1024+r32*16;
  #pragma unroll
  for(int d0=0;d0<4;++d0){
    const bf16x8 b0=*reinterpret_cast<const bf16x8*>(kb+d0*2048);
    const bf16x8 b1=*reinterpret_cast<const bf16x8*>(kb+d0*2048+512);
    if(d0==0){p0=__builtin_amdgcn_mfma_f32_32x32x16_bf16(b0,qr[0],negm,0,0,0);p1=__builtin_amdgcn_mfma_f32_32x32x16_bf16(b1,qr[0],negm,0,0,0);}
    else{p0=__builtin_amdgcn_mfma_f32_32x32x16_bf16(b0,qr[d0],p0,0,0,0);p1=__builtin_amdgcn_mfma_f32_32x32x16_bf16(b1,qr[d0],p1,0,0,0);}}
}
typedef __attribute__((address_space(3))) const char* lds_cptr;
typedef short v4i16_t __attribute__((ext_vector_type(4)));
__device__ __forceinline__ void kload8(bf16x8*kf,lds_cptr kp){
  kf[0]=*(const __attribute__((address_space(3))) bf16x8*)(kp);      kf[1]=*(const __attribute__((address_space(3))) bf16x8*)(kp+512);
  kf[2]=*(const __attribute__((address_space(3))) bf16x8*)(kp+2048); kf[3]=*(const __attribute__((address_space(3))) bf16x8*)(kp+2560);
  kf[4]=*(const __attribute__((address_space(3))) bf16x8*)(kp+4096); kf[5]=*(const __attribute__((address_space(3))) bf16x8*)(kp+4608);
  kf[6]=*(const __attribute__((address_space(3))) bf16x8*)(kp+6144); kf[7]=*(const __attribute__((address_space(3))) bf16x8*)(kp+6656);
}
__device__ __forceinline__ void kload2(bf16x8*kf,lds_cptr kp,int j){ kf[2*j]=*(const __attribute__((address_space(3))) bf16x8*)(kp+j*2048); kf[2*j+1]=*(const __attribute__((address_space(3))) bf16x8*)(kp+j*2048+512); }
__device__ __forceinline__ s16x4 vtr(lds_cptr p){ return __builtin_bit_cast(s16x4,__builtin_amdgcn_ds_read_tr16_b64_v4i16((__attribute__((address_space(3))) v4i16_t*)p)); }
__device__ __forceinline__ float rowmax(const f32x16&p0,const f32x16&p1){
  float a=max3f(p0[0],p0[1],p1[0]),b=max3f(p0[2],p0[3],p1[1]);a=max3f(a,p1[2],p1[3]);
  #pragma unroll
  for(int r=4;r<16;r+=4){a=max3f(a,p0[r],p0[r+1]);b=max3f(b,p0[r+2],p0[r+3]);a=max3f(a,p1[r],p1[r+1]);b=max3f(b,p1[r+2],p1[r+3]);}
  const float m=max2f(a,b);
  auto rr=__builtin_amdgcn_permlane32_swap(__float_as_uint(m),__float_as_uint(m),false,false);
  return max2f(__uint_as_float(rr[0]),__uint_as_float(rr[1]));
}
__device__ __forceinline__ void pv(f32x16*o,int vb,bf16x8 pa0,bf16x8 pa1,bf16x8 pa2,bf16x8 pa3){
  #pragma unroll
  for(int d0=0;d0<2;++d0){s16x4 lo[4],hi[4];
    #pragma unroll
    for(int ks=0;ks<4;++ks){
      asm volatile("ds_read_b64_tr_b16 %0,%1 offset:%c2":"=&v"(lo[ks]):"v"(vb),"i"(d0*4096+ks*1024):"memory");
      asm volatile("ds_read_b64_tr_b16 %0,%1 offset:%c2":"=&v"(hi[ks]):"v"(vb),"i"(d0*4096+ks*1024+512):"memory");}
    asm volatile("s_waitcnt lgkmcnt(0)":::"memory");SBAR();
    #define PK(k) (bf16x8){lo[k][0],lo[k][1],lo[k][2],lo[k][3],hi[k][0],hi[k][1],hi[k][2],hi[k][3]}
    o[d0]=__builtin_amdgcn_mfma_f32_32x32x16_bf16(pa0,PK(0),o[d0],0,0,0);
    o[d0]=__builtin_amdgcn_mfma_f32_32x32x16_bf16(pa1,PK(1),o[d0],0,0,0);
    o[d0]=__builtin_amdgcn_mfma_f32_32x32x16_bf16(pa2,PK(2),o[d0],0,0,0);
    o[d0]=__builtin_amdgcn_mfma_f32_32x32x16_bf16(pa3,PK(3),o[d0],0,0,0);
    #undef PK
  }
}

#ifndef ATTN_STORE16
#define ATTN_STORE16(p,v) (*(u32x4*)(p)=(v))
#endif
template<int THRL> __device__ __forceinline__ void attn_unit(long qrow0,long kvrow0,int hq,int kvh,int NT,const bf16*Q,const bf16*__restrict__ K,const bf16*__restrict__ V,bf16*O,char*shm,const int tid,const float*gqp,const float*rbp,long tq){
  const int lane=tid&63,r32=lane&31,hi=lane>>5; const int wid=__builtin_amdgcn_readfirstlane(tid>>6);
  const bf16*Qw=Q+(qrow0+wid*QBLK)*QP+hq*D;
  const bf16*Kh=K+kvrow0*KP+kvh*D,*Vh=V+kvrow0*VP+kvh*D;
  const unsigned lds0=(unsigned)(uintptr_t)shm;
  float*wsf=(float*)(shm+LDS_WS)+wid*64;
  const bf16*ksrc=Kh+(long)lane*KP+wid*8;
  const bf16*vsrc=Vh+(long)(16*(wid&3)+(lane>>2))*VP+(wid>>2)*32+(lane&3)*8;
  const unsigned kdst=lds0+LDS_K+wid*1024, vdst=lds0+LDS_V+wid*1024;
  #define DMA_K(t,slot) glds16(ksrc+(long)(t)*KVBLK*KP,(unsigned)__builtin_amdgcn_readfirstlane(kdst+(slot)))
  #define DMA_V(t,slot) glds16(vsrc+(long)(t)*KVBLK*VP,(unsigned)__builtin_amdgcn_readfirstlane(vdst+(slot)))
  const int vb0=(int)(lds0+LDS_V)+((lane>>4)&1)*32+(lane&3)*8+(4*hi+((lane&15)>>2))*64;
  const char*Kbase=shm+LDS_K; bf16x8 kf[8];
  const lds_cptr shm3=(lds_cptr)shm; const lds_cptr kp0=shm3+LDS_K+hi*1024+r32*16; const lds_cptr vp0=shm3+LDS_V+((lane>>4)&1)*32+(lane&3)*8+(4*hi+((lane&15)>>2))*64;
  DMA_K(0,0);DMA_V(0,0);DMA_K(1,SLOTB);
  bf16x8 qr[4];
  { const bf16*Zq=Q+(qrow0+wid*QBLK+r32)*(long)VP+hq*D; float f[4][8]; float ss=0.f;
    #pragma unroll
    for(int d0=0;d0<4;++d0){ const bf16x8 raw=*reinterpret_cast<const bf16x8*>(Zq+d0*16+hi*8);
      #pragma unroll
      for(int j=0;j<8;++j){ f[d0][j]=__uint_as_float(((unsigned)(unsigned short)raw[j])<<16); ss+=f[d0][j]*f[d0][j]; } }
    { auto rr=__builtin_amdgcn_permlane32_swap(__float_as_uint(ss),__float_as_uint(ss),false,false); ss=__uint_as_float(rr[0])+__uint_as_float(rr[1]); }
    const float rstd=__builtin_amdgcn_rsqf(ss*(1.0f/64.0f)+1e-6f);
    #pragma unroll
    for(int d0=0;d0<4;++d0){ const float*gp=gqp+d0*16+hi*8;
      #pragma unroll
      for(int j=0;j<8;++j) f[d0][j]*=rstd*gp[j]; }
    if(tq>=0){ const long t=tq+wid*QBLK+r32; const int prow=(int)(t>>6), pcol=(int)(t&63);
      const float*tr=rbp+(prow*16+hi*8)*2; const float*tc=rbp+(pcol*16+hi*8)*2;
      #pragma unroll
      for(int j=0;j<8;++j){ const float cs=tr[2*j],sn=tr[2*j+1]; const float x1=f[0][j],x2=f[1][j]; f[0][j]=x1*cs-x2*sn; f[1][j]=x1*sn+x2*cs;
                            const float cc=tc[2*j],sc=tc[2*j+1]; const float y1=f[2][j],y2=f[3][j]; f[2][j]=y1*cc-y2*sc; f[3][j]=y1*sc+y2*cc; } }
    #pragma unroll
    for(int d0=0;d0<4;++d0){ u32x4 w; w.x=cvtpk_s(f[d0][0]*C2,f[d0][1]*C2); w.y=cvtpk_s(f[d0][2]*C2,f[d0][3]*C2); w.z=cvtpk_s(f[d0][4]*C2,f[d0][5]*C2); w.w=cvtpk_s(f[d0][6]*C2,f[d0][7]*C2);
      qr[d0]=__builtin_bit_cast(bf16x8,w); } }
  float mhat=0.f,l_reg=0.f;float z0_=0.f;asm volatile("":"+v"(z0_));f32x16 o[2];f32x16 negm;
  #pragma unroll
  for(int r=0;r<16;++r){o[0][r]=z0_;o[1][r]=z0_;negm[r]=z0_;}
  asm volatile("":"+v"(negm));
  #define CMASK(P0,P1,t) do{}while(0)
  bool resc=false;
  #define START(P0,P1) do{ const float rm=rowmax(P0,P1); resc=false; \
    { const float dl=rm; mhat=fadd_s(mhat,dl); \
      _Pragma("unroll") for(int r=0;r<16;++r){P0[r]=fsub_s(P0[r],dl);P1[r]=fsub_s(P1[r],dl);} \
      _Pragma("unroll") for(int r=0;r<16;++r)negm[r]=-mhat; asm volatile("":"+v"(negm)); } \
    _Pragma("unroll") for(int r=0;r<16;++r)P0[r]=__builtin_amdgcn_exp2f(P0[r]); }while(0)
  #define RESC() do{ if(resc){ asm volatile("s_waitcnt lgkmcnt(0)":::"memory"); \
      _Pragma("unroll") for(int d_=0;d_<2;++d_) _Pragma("unroll") for(int r=0;r<16;++r)o[d_][r]*=wsf[crow(r,hi)]; } }while(0)
  f32x16 pA0,pA1,pB0,pB1;
  int sl_prev=0,sl_cur=0,sl_next=SLOTB;
  #define ROT() do{sl_prev=sl_cur;sl_cur=sl_next;sl_next=(sl_next==(NSLOT-1)*SLOTB)?0:sl_next+SLOTB;}while(0)
  DMA_K(2,2*SLOTB);
  WAIT_BAR(3);
  qkt(pA0,pA1,Kbase,qr,negm,r32,hi);asm volatile("s_nop 15\n\ts_nop 7":"+v"(pA0),"+v"(pA1));CMASK(pA0,pA1,0);
  START(pA0,pA1);
  _Pragma("unroll") for(int r=0;r<16;++r)pA1[r]=__builtin_amdgcn_exp2f(pA1[r]);
  WAIT_BAR(0);
  DMA_K(3,0);DMA_V(1,SLOTB);
  ROT();
  kload8(kf,kp0+sl_cur);
  WAIT_BAR(2);
  s16x4 vlo[8],vhi[8]; u32x4 pw0,pw1,pw2,pw3;
  #define PKW(P,B) cvtpk_s(P[B],P[B+1])
  #define PAF(k) __builtin_bit_cast(bf16x8,pw##k)
  #define VFR(i) (bf16x8){vlo[i][0],vlo[i][1],vlo[i][2],vlo[i][3],vhi[i][0],vhi[i][1],vhi[i][2],vhi[i][3]}
  #define PIN(x) asm volatile("":"+v"(x))
  #define MX3(a,b,c) __builtin_fmaxf(__builtin_fmaxf((a),(b)),(c))
  #define GAPA(MF,A0,A1,A2,A3,W0,W1,PW) do{ MF; sacc+=A0; sacc+=A1; sacc+=A2; sacc+=A3; PIN(sacc); W0; W1; PIN(PW); SBAR(); }while(0)
  #define EX(v) __builtin_amdgcn_exp2f(v)
  #define GAPB(MF,X,B) do{ MF; X[B]=EX(X[B]); X[B+1]=EX(X[B+1]); X[B+2]=EX(X[B+2]); X[B+3]=EX(X[B+3]); PIN(X); SBAR(); }while(0)
  #define VRD(i) do{ vlo[i]=vtr(vp_+(((i)>>2)*4096+((i)&3)*1024)); vhi[i]=vtr(vp_+(((i)>>2)*4096+((i)&3)*1024+512)); }while(0)
  #define KRD(G,j) do{ if(G){ kload2(kf,kp0+sl_next,j); SBAR(); } }while(0)
  #define STEP(C0,C1,P0,P1,t,GK,GV,GL) do{ SBAR(); \
    const lds_cptr vp_=vp0+sl_prev; \
    VRD(0); SBAR(); float sacc=(P0[0]+P0[1]); \
    GAPA(C0=__builtin_amdgcn_mfma_f32_32x32x16_bf16(kf[0],qr[0],negm,0,0,0), P0[2],P0[3],P0[4],P0[5],     pw0[0]=PKW(P0,0), pw0[1]=PKW(P0,2), pw0); \
    VRD(4); SBAR(); GAPA(C1=__builtin_amdgcn_mfma_f32_32x32x16_bf16(kf[1],qr[0],negm,0,0,0), P0[6],P0[7],P0[8],P0[9],     pw0[2]=PKW(P0,4), pw0[3]=PKW(P0,6), pw0); \
    VRD(1); SBAR(); GAPA(C0=__builtin_amdgcn_mfma_f32_32x32x16_bf16(kf[2],qr[1],C0,0,0,0),   P0[10],P0[11],P0[12],P0[13], pw1[0]=PKW(P0,8), pw1[1]=PKW(P0,10), pw1); \
    VRD(5); SBAR(); GAPA(C1=__builtin_amdgcn_mfma_f32_32x32x16_bf16(kf[3],qr[1],C1,0,0,0),   P0[14],P0[15],P1[0],P1[1],   pw1[2]=PKW(P0,12),pw1[3]=PKW(P0,14), pw1); \
    VRD(2); SBAR(); GAPA(C0=__builtin_amdgcn_mfma_f32_32x32x16_bf16(kf[4],qr[2],C0,0,0,0),   P1[2],P1[3],P1[4],P1[5],     pw2[0]=PKW(P1,0), pw2[1]=PKW(P1,2), pw2); \
    VRD(6); SBAR(); GAPA(C1=__builtin_amdgcn_mfma_f32_32x32x16_bf16(kf[5],qr[2],C1,0,0,0),   P1[6],P1[7],P1[8],P1[9],     pw2[2]=PKW(P1,4), pw2[3]=PKW(P1,6), pw2); \
    VRD(3); SBAR(); GAPA(C0=__builtin_amdgcn_mfma_f32_32x32x16_bf16(kf[6],qr[3],C0,0,0,0),   P1[10],P1[11],P1[12],P1[13], pw3[0]=PKW(P1,8), pw3[1]=PKW(P1,10), pw3); \
    VRD(7); SBAR(); GAPA(C1=__builtin_amdgcn_mfma_f32_32x32x16_bf16(kf[7],qr[3],C1,0,0,0),   P1[14],P1[15],0.f,0.f,       pw3[2]=PKW(P1,12),pw3[3]=PKW(P1,14), pw3); \
    l_reg+=sacc; \
    if(GK){DMA_K((t)+3,sl_cur);} if(GV){DMA_V((t)+1,sl_next);} \
    CMASK(C0,C1,t); \
    { float a=MX3(C0[0],C0[1],C1[0]),b=MX3(C0[2],C0[3],C1[1]); a=MX3(a,C1[2],C1[3]); \
      _Pragma("unroll") for(int r=4;r<16;r+=4){a=MX3(a,C0[r],C0[r+1]);b=MX3(b,C0[r+2],C0[r+3]);a=MX3(a,C1[r],C1[r+1]);b=MX3(b,C1[r+2],C1[r+3]);} \
      float rm=__builtin_fmaxf(a,b); { auto rr=__builtin_amdgcn_permlane32_swap(__float_as_uint(rm),__float_as_uint(rm),false,false); rm=__builtin_fmaxf(__uint_as_float(rr[0]),__uint_as_float(rr[1])); } \
      resc=false; \
      if(__builtin_expect(__any(rm>(float)THRL),0)){ const float dl=__builtin_fmaxf(rm,0.f); mhat+=dl; \
        _Pragma("unroll") for(int r=0;r<16;++r){C0[r]-=dl;C1[r]-=dl;} \
        _Pragma("unroll") for(int r=0;r<16;++r)negm[r]=-mhat; asm volatile("":"+v"(negm)); \
        const float f=__builtin_amdgcn_exp2f(-dl); l_reg*=f; if(hi==0)wsf[r32]=f; resc=true; } } \
    SBAR(); \
    GAPB(o[0]=__builtin_amdgcn_mfma_f32_32x32x16_bf16(PAF(0),VFR(0),o[0],0,0,0), C0,0); \
    GAPB(o[1]=__builtin_amdgcn_mfma_f32_32x32x16_bf16(PAF(0),VFR(4),o[1],0,0,0), C0,4); \
    KRD(GL,0); GAPB(o[0]=__builtin_amdgcn_mfma_f32_32x32x16_bf16(PAF(1),VFR(1),o[0],0,0,0), C0,8); \
    KRD(GL,1); GAPB(o[1]=__builtin_amdgcn_mfma_f32_32x32x16_bf16(PAF(1),VFR(5),o[1],0,0,0), C0,12); \
    KRD(GL,2); GAPB(o[0]=__builtin_amdgcn_mfma_f32_32x32x16_bf16(PAF(2),VFR(2),o[0],0,0,0), C1,0); \
    KRD(GL,3); GAPB(o[1]=__builtin_amdgcn_mfma_f32_32x32x16_bf16(PAF(2),VFR(6),o[1],0,0,0), C1,4); \
    GAPB(o[0]=__builtin_amdgcn_mfma_f32_32x32x16_bf16(PAF(3),VFR(3),o[0],0,0,0), C1,8); \
    GAPB(o[1]=__builtin_amdgcn_mfma_f32_32x32x16_bf16(PAF(3),VFR(7),o[1],0,0,0), C1,12); \
    }while(0)
  int t=1;
  #undef CMASK
  #define CMASK(P0,P1,t) do{}while(0)
  for(;t+5<NT;t+=2){
    STEP(pB0,pB1,pA0,pA1,t,true,true,true);     WAIT_BAR(2); RESC(); ROT();
    STEP(pA0,pA1,pB0,pB1,t+1,true,true,true);   WAIT_BAR(2); RESC(); ROT();
  }
  #undef CMASK
  #define CMASK(P0,P1,t) do{}while(0)
  #define ENDW(tt) do{ if((tt)+3<NT){WAIT_BAR(2);} else if((tt)+2<NT){WAIT_BAR(1);} else {WAIT_BAR(0);} }while(0)
  for(;t+1<NT;t+=2){
    STEP(pB0,pB1,pA0,pA1,t,(t+3<NT),(t+1<NT),(t+1<NT));       ENDW(t);   RESC(); ROT();
    STEP(pA0,pA1,pB0,pB1,t+1,(t+4<NT),(t+2<NT),(t+2<NT));     ENDW(t+1); RESC(); ROT();
  }
  STEP(pB0,pB1,pA0,pA1,NT-1,false,false,false); RESC();
  { float sacc=pB0[0]+pB0[1]; _Pragma("unroll") for(int r=2;r<16;++r)sacc+=pB0[r]; _Pragma("unroll") for(int r=0;r<16;++r)sacc+=pB1[r]; l_reg+=sacc;
    pw0=(u32x4){PKW(pB0,0),PKW(pB0,2),PKW(pB0,4),PKW(pB0,6)};pw1=(u32x4){PKW(pB0,8),PKW(pB0,10),PKW(pB0,12),PKW(pB0,14)};pw2=(u32x4){PKW(pB1,0),PKW(pB1,2),PKW(pB1,4),PKW(pB1,6)};pw3=(u32x4){PKW(pB1,8),PKW(pB1,10),PKW(pB1,12),PKW(pB1,14)};
    SBAR(); pv(o,vb0+sl_cur,PAF(0),PAF(1),PAF(2),PAF(3)); }
  #undef PKW
  #undef PAF
  #undef VFR
  #undef PIN
  #undef MX3
  #undef GAPA
  #undef GAPB
  #undef EX
  #undef VRD
  #undef KRD
  #undef STEP
  #undef ENDW
  {auto rr=__builtin_amdgcn_permlane32_swap(__float_as_uint(l_reg),__float_as_uint(l_reg),false,false);l_reg=__uint_as_float(rr[0])+__uint_as_float(rr[1]);}
  if(hi==0)wsf[32+r32]=l_reg;asm volatile("s_waitcnt lgkmcnt(0)":::"memory");
  float rli[16];
  #pragma unroll
  for(int r=0;r<16;++r)rli[r]=__builtin_amdgcn_rcpf(wsf[32+crow(r,hi)]);
  bf16*Ow=O+(qrow0+wid*QBLK)*OP+hq*D;
  { bf16*stg=(bf16*)(shm+LDS_OST)+wid*2048;
    #pragma unroll
    for(int r=0;r<16;++r){const int orow=crow(r,hi);
      #pragma unroll
      for(int d0=0;d0<2;++d0)stg[orow*64+d0*32+r32]=__float2bfloat16(o[d0][r]*rli[r]);}
    asm volatile("s_waitcnt lgkmcnt(0)":::"memory");
    #pragma unroll
    for(int i=0;i<4;++i){const int row=i*8+(lane>>3),ch=lane&7; const u32x4 v=*(const u32x4*)(stg+row*64+ch*8); ATTN_STORE16(Ow+(long)row*OP+ch*8,v);} }
  asm volatile("s_waitcnt lgkmcnt(0)\n\ts_barrier":::"memory");
  #undef DMA_K
  #undef DMA_V
  #undef CMASK
  #undef START
  #undef RESC
  #undef ROT
}
constexpr int ATTN_LDS_BYTES=LDS_BYTES;
#undef SBAR
#undef WAIT_BAR
}
#define LAS __attribute__((address_space(3)))
typedef unsigned short bf16;
typedef unsigned v4u __attribute__((ext_vector_type(4)));
typedef unsigned v2u __attribute__((ext_vector_type(2)));
typedef float f32x4 __attribute__((ext_vector_type(4)));
typedef short bf16x8 __attribute__((ext_vector_type(8)));
constexpr int NWAVES = 8;
constexpr int NB = 4, LAT = 4096, LCTX = 256, SROW = 4352, MTOK = 17408, DMODEL = 1024, DEPTH = 4, DFF = 2816, DIN = 6912, MODW = 9216;
constexpr int ZC_RQ = 0, ZC_RK = 512, ZC_RV = 1024, ZC_RG = 1536, ZC_LX = 2048, ZC_LZ = 2560, ZC_AQ = 3072, ZC_AK = 3584, ZC_AV = 3712, ZC_GT = 3840;
constexpr float NORM_EPS = 1e-6f;
constexpr size_t MiB = 1u << 20;
constexpr size_t WS_MOD = 1 * MiB, WS_ROPE = 2 * MiB, WS_SUMM = 3 * MiB, WS_HIN = 6 * MiB;
constexpr size_t WS_WSET = 54 * MiB;
constexpr size_t WS_WFI = 8 * MiB;
constexpr size_t WS_WFO = 30 * MiB;
constexpr size_t WS_WIN = 41 * MiB;
constexpr size_t WS_WB = 55 * MiB;
constexpr size_t WS_WO = 58 * MiB;
constexpr size_t WS_LRUW = 60 * MiB;
constexpr size_t WS_X = 116 * MiB;
constexpr size_t WS_HN = 184 * MiB;
constexpr size_t WS_Z = 218 * MiB;
constexpr size_t WS_QN = 448 * MiB;
constexpr size_t WS_KN = 465 * MiB;
constexpr size_t WS_Y = 470 * MiB;
constexpr size_t WS_U = 521 * MiB;
constexpr size_t WS_SIN = 589 * MiB;
constexpr size_t WS_PARTC = 624 * MiB;
constexpr size_t WS_END = 670 * MiB;
constexpr int LDS_BYTES = 147456;

__device__ __forceinline__ unsigned f2bf(float f) { unsigned u = __builtin_bit_cast(unsigned, f); return (u + 0x7fffu + ((u >> 16) & 1u)) >> 16; }
__device__ __forceinline__ unsigned pk2(float lo, float hi) { return f2bf(lo) | (f2bf(hi) << 16); }
__device__ __forceinline__ float bflo(unsigned w) { return __uint_as_float(w << 16); }
__device__ __forceinline__ float bfhi(unsigned w) { return __uint_as_float(w & 0xffff0000u); }
__device__ __forceinline__ float bf1(bf16 h) { return __uint_as_float(((unsigned)h) << 16); }
__device__ __forceinline__ void unpack8(const v4u w, float* f) { f[0] = bflo(w.x); f[1] = bfhi(w.x); f[2] = bflo(w.y); f[3] = bfhi(w.y); f[4] = bflo(w.z); f[5] = bfhi(w.z); f[6] = bflo(w.w); f[7] = bfhi(w.w); }
__device__ __forceinline__ float sigmoidf_(float v) { return __builtin_amdgcn_rcpf(1.0f + __expf(-v)); }
__device__ __forceinline__ float shx(float v, int m, int lane) { return __builtin_bit_cast(float, __builtin_amdgcn_ds_bpermute((lane ^ m) << 2, __builtin_bit_cast(int, v))); }
__device__ __forceinline__ float shi(float v, int src) { return __builtin_bit_cast(float, __builtin_amdgcn_ds_bpermute(src << 2, __builtin_bit_cast(int, v))); }
__device__ __forceinline__ float wave_sum(float v, int lane) {
#pragma unroll
    for (int o = 1; o < 64; o <<= 1) v += shx(v, o, lane);
    return v;
}
#define LDS_WAIT() asm volatile("s_waitcnt lgkmcnt(0)" ::: "memory")

struct Args { const float* in[24]; float* out; unsigned char* ws; int ph_lo, ph_hi; };
constexpr int ARGS_LDS_OFF = 139520;
struct AH { const LAS unsigned* w;
    __device__ __forceinline__ const float* in(int i) const { const unsigned lo = __builtin_amdgcn_readfirstlane(w[2 * i]), hi = __builtin_amdgcn_readfirstlane(w[2 * i + 1]); return (const float*)(((unsigned long long)hi << 32) | lo); }
    __device__ __forceinline__ float* out() const { const unsigned lo = __builtin_amdgcn_readfirstlane(w[48]), hi = __builtin_amdgcn_readfirstlane(w[49]); return (float*)(((unsigned long long)hi << 32) | lo); }
    __device__ __forceinline__ unsigned char* ws() const { const unsigned lo = __builtin_amdgcn_readfirstlane(w[50]), hi = __builtin_amdgcn_readfirstlane(w[51]); return (unsigned char*)(((unsigned long long)hi << 32) | lo); }
};
enum { I_X = 0, I_C, I_CTX, I_CCTX, I_WMOD, I_BMOD, I_NORMG, I_FFNIN, I_FFNOUT, I_WIN, I_RETLOGIT, I_RETG, I_CONVW, I_CONVB, I_LWA, I_LBA, I_LWX, I_LBX, I_LAM, I_QG, I_KG, I_WBR, I_WOUT, I_FG };

__device__ __forceinline__ void tr_item(const float* W, int N, int k0, int n0, bf16* WT, int K, int orow0, LAS float* scr, int lane) {
    const float* src = W + (size_t)k0 * N + n0 + lane;
#pragma unroll 1
    for (int i = 0; i < 64; i += 16) { float v[16];
#pragma unroll
        for (int r = 0; r < 16; ++r) v[r] = src[(size_t)(i + r) * N];
#pragma unroll
        for (int r = 0; r < 16; ++r) scr[(i + r) * 65 + lane] = v[r]; }
    LDS_WAIT(); asm volatile("" ::: "memory");
    const int c = lane & 7;
#pragma unroll
    for (int j = 0; j < 8; ++j) { const int n = (lane >> 3) + 8 * j; const LAS float* s = scr + (8 * c) * 65 + n;
        v4u o; o.x = pk2(s[0 * 65], s[1 * 65]); o.y = pk2(s[2 * 65], s[3 * 65]); o.z = pk2(s[4 * 65], s[5 * 65]); o.w = pk2(s[6 * 65], s[7 * 65]);
        *(v4u*)(WT + (size_t)(orow0 + n) * K + k0 + 8 * c) = o; }
    LDS_WAIT(); asm volatile("" ::: "memory");
}

__device__ __forceinline__ void phase_p0(const AH A, LAS unsigned char* lds, int tid, int G) {
    unsigned char* ws = A.ws();
    constexpr int NGEMV = 144;
    const int bx = blockIdx.x;
    if (bx < NGEMV || G <= NGEMV) {
        LAS float* sv = (LAS float*)lds;
        LAS float* red = sv + 5 * 1024;
        const float* c = A.in(I_C); const float* cctx = A.in(I_CCTX);
        for (int i = tid; i < 5 * 1024; i += 512) { const int r = i >> 10, k = i & 1023; const float v = (r < 4) ? c[r * 1024 + k] : cctx[k]; sv[i] = v / (1.0f + __expf(-v)); }
        __syncthreads();
        float* modbuf = (float*)(ws + WS_MOD);
        const float* wmod = A.in(I_WMOD); const float* bmod = A.in(I_BMOD);
        for (int item = bx; item < NGEMV; item += G) {
            const int l = item / 36, n0 = (item - l * 36) * 256, c4 = tid & 63, kg = tid >> 6;
            const f32x4* W = (const f32x4*)(wmod + (size_t)l * 1024 * MODW + n0) + c4;
            f32x4 acc[5];
#pragma unroll
            for (int r = 0; r < 5; ++r) acc[r] = (f32x4){0.f, 0.f, 0.f, 0.f};
#pragma unroll 8
            for (int k = kg * 128; k < kg * 128 + 128; ++k) { const f32x4 w = W[(size_t)k * (MODW / 4)];
#pragma unroll
                for (int r = 0; r < 5; ++r) acc[r] += w * sv[r * 1024 + k]; }
#pragma unroll
            for (int r = 0; r < 5; ++r) *(LAS f32x4*)(red + (kg * 5 + r) * 256 + c4 * 4) = acc[r];
            __syncthreads();
            for (int o = tid; o < 5 * 256; o += 512) { const int r = o >> 8, cc = o & 255; float s = 0.f;
#pragma unroll
                for (int q = 0; q < 8; ++q) s += red[(q * 5 + r) * 256 + cc];
                modbuf[(size_t)(l * 5 + r) * MODW + n0 + cc] = s + bmod[(size_t)l * MODW + n0 + cc]; }
            __syncthreads();
        }
    }
    if (bx >= NGEMV || G <= NGEMV) {
        const int wb = (G > NGEMV) ? bx - NGEMV : bx, nwb = (G > NGEMV) ? G - NGEMV : G;
        const f32x4* x4 = (const f32x4*)A.in(I_X); const f32x4* c4p = (const f32x4*)A.in(I_CTX); f32x4* X4 = (f32x4*)(ws + WS_X);
        const int total = MTOK * 256, stride = nwb * 512;
        for (int i = wb * 512 + tid; i < total; i += 4 * stride) { f32x4 v[4];
#pragma unroll
            for (int q = 0; q < 4; ++q) { const int ii = i + q * stride; if (ii < total) { const int row = ii >> 8, qq = ii & 255; const int b = row / SROW, s = row - b * SROW;
                v[q] = (s < LCTX) ? c4p[(size_t)(b * LCTX + s) * 256 + qq] : x4[(size_t)(b * LAT + s - LCTX) * 256 + qq]; } }
#pragma unroll
            for (int q = 0; q < 4; ++q) { const int ii = i + q * stride; if (ii < total) X4[ii] = v[q]; } }
        float* ra = (float*)(ws + WS_ROPE); float* rb = ra + 64 * 32 * 2;
        for (int i = wb * 512 + tid; i < 64 * 32 + 64 * 16; i += nwb * 512) {
            if (i < 64 * 32) { const int pos = i >> 5, f = i & 31; const float fr = powf(10000.0f, -(float)(2 * f) / 64.0f); const float ang = (float)pos * fr; ra[2 * i] = cosf(ang); ra[2 * i + 1] = sinf(ang); }
            else { const int j = i - 64 * 32; const int pos = j >> 4, f = j & 15; const float fr = powf(10000.0f, -(float)(2 * f) / 32.0f); const float ang = (float)pos * fr; rb[2 * j] = cosf(ang); rb[2 * j + 1] = sinf(ang); } }
    }
}

constexpr int CV_FI = 16 * 88, CV_FO = 44 * 16, CV_IN = 16 * 108, CV_BR = 8 * 16, CV_OUT = 16 * 16, CV_LRU = 32;
constexpr int CV_NIT = 2 * CV_FI + 2 * CV_FO + CV_IN + 3 * CV_BR + CV_OUT + CV_LRU;
__device__ __forceinline__ void convert_layer(const AH A, int l, int it_lo, int it_hi, LAS unsigned char* lds, int gw, int NGW, int wave, int lane) {
    unsigned char* ws = A.ws() + (size_t)(l & 1) * WS_WSET;
    LAS float* scr = (LAS float*)(lds + wave * 16640);
    for (int it = it_lo + gw; it < it_hi; it += NGW) {
        int r = it; bool done = false;
#pragma unroll
        for (int j = 0; j < 2; ++j) { if (!done) { if (r < CV_FI) { const int kb = r / 88, nb = r - kb * 88, n0 = nb * 64;
                const int orow0 = (n0 < DFF) ? ((n0 >> 7) * 256 + (n0 & 127)) : (((n0 - DFF) >> 7) * 256 + 128 + ((n0 - DFF) & 127));
                tr_item(A.in(I_FFNIN) + (size_t)(l * 2 + j) * 1024 * 5632, 5632, kb * 64, n0, (bf16*)(ws + WS_WFI) + (size_t)j * 5632 * 1024, 1024, orow0, scr, lane); done = true; } else r -= CV_FI; } }
#pragma unroll
        for (int j = 0; j < 2; ++j) { if (!done) { if (r < CV_FO) { const int kb = r >> 4, nb = r & 15;
                tr_item(A.in(I_FFNOUT) + (size_t)(l * 2 + j) * DFF * 1024, 1024, kb * 64, nb * 64, (bf16*)(ws + WS_WFO) + (size_t)j * 1024 * DFF, DFF, nb * 64, scr, lane); done = true; } else r -= CV_FO; } }
        if (!done) { if (r < CV_IN) { const int kb = r / 108, nb = r - kb * 108;
                tr_item(A.in(I_WIN) + (size_t)l * 1024 * DIN, DIN, kb * 64, nb * 64, (bf16*)(ws + WS_WIN), 1024, nb * 64, scr, lane); done = true; } else r -= CV_IN; }
#pragma unroll
        for (int n = 0; n < 3; ++n) { if (!done) { if (r < CV_BR) { const int kb = r >> 4, nb = r & 15;
                tr_item(A.in(I_WBR) + (size_t)(l * 3 + n) * 512 * 1024, 1024, kb * 64, nb * 64, (bf16*)(ws + WS_WB) + (size_t)n * 1024 * 512, 512, nb * 64, scr, lane); done = true; } else r -= CV_BR; } }
        if (!done) { if (r < CV_OUT) { const int kb = r >> 4, nb = r & 15;
                tr_item(A.in(I_WOUT) + (size_t)l * 1024 * 1024, 1024, kb * 64, nb * 64, (bf16*)(ws + WS_WO), 1024, nb * 64, scr, lane); done = true; } else r -= CV_OUT; }
        if (!done) { const int mat = r; const int g = mat >> 4, d = (mat >> 3) & 1, blk = mat & 7;
                const float* src = (g ? A.in(I_LWX) : A.in(I_LWA)) + (size_t)((l * 2 + d) * 8 + blk) * 4096;
                tr_item(src, 64, 0, 0, (bf16*)(ws + WS_LRUW) + (size_t)mat * 4096, 64, 0, scr, lane); }
    }
}

__device__ __forceinline__ void norm_rows(const AH A, int l, int sub, int gw, int NGW, int lane, int pend_ns, const float* pend_gate, float pend_scale) {
    unsigned char* ws = A.ws();
    const float* X = (const float*)(ws + WS_X); bf16* HN = (bf16*)(ws + WS_HN);
    const float* g = A.in(I_NORMG) + (size_t)(l * 3 + sub) * 1024;
    const float* modl = (const float*)(ws + WS_MOD) + (size_t)l * 5 * MODW + sub * 3072;
    f32x4 gv[4];
#pragma unroll
    for (int j = 0; j < 4; ++j) gv[j] = ((const f32x4*)g)[lane + 64 * j];
    f32x4 nx[4];
    if (gw < MTOK) {
#pragma unroll
        for (int j = 0; j < 4; ++j) nx[j] = ((const f32x4*)(X + (size_t)gw * 1024))[lane + 64 * j]; }
    for (int row = gw; row < MTOK; row += NGW) {
        const int b = row / SROW, s = row - b * SROW; const int mr = (s < LCTX) ? 4 : b;
        const f32x4* sh = (const f32x4*)(modl + (size_t)mr * MODW); const f32x4* sc = (const f32x4*)(modl + (size_t)mr * MODW + 1024);
        f32x4 v[4]; float ss = 0.f;
#pragma unroll
        for (int j = 0; j < 4; ++j) v[j] = nx[j];
        if (row + NGW < MTOK) {
#pragma unroll
            for (int j = 0; j < 4; ++j) nx[j] = ((const f32x4*)(X + (size_t)(row + NGW) * 1024))[lane + 64 * j]; }
        f32x4 scv[4], shv[4];
#pragma unroll
        for (int j = 0; j < 4; ++j) { scv[j] = sc[lane + 64 * j]; shv[j] = sh[lane + 64 * j]; }
        if (pend_ns > 0 && s < LCTX) {
            const v2u* pc = (const v2u*)((const bf16*)(ws + WS_PARTC) + (size_t)(b * LCTX + s) * 1024); const f32x4* pg = (const f32x4*)pend_gate;
            f32x4 a4[4] = {(f32x4){0.f, 0.f, 0.f, 0.f}, (f32x4){0.f, 0.f, 0.f, 0.f}, (f32x4){0.f, 0.f, 0.f, 0.f}, (f32x4){0.f, 0.f, 0.f, 0.f}};
            for (int sp = 0; sp < pend_ns; ++sp) {
#pragma unroll
                for (int j = 0; j < 4; ++j) { const v2u w = pc[(size_t)sp * 262144 + lane + 64 * j]; a4[j] += (f32x4){bflo(w.x), bfhi(w.x), bflo(w.y), bfhi(w.y)}; } }
            f32x4* xw = (f32x4*)(ws + WS_X) + (size_t)row * 256;
#pragma unroll
            for (int j = 0; j < 4; ++j) { v[j] += (pg[lane + 64 * j] * pend_scale) * a4[j]; xw[lane + 64 * j] = v[j]; }
        }
#pragma unroll
        for (int j = 0; j < 4; ++j) ss += (v[j].x * v[j].x + v[j].y * v[j].y) + (v[j].z * v[j].z + v[j].w * v[j].w);
        const float rstd = rsqrtf(wave_sum(ss, lane) * (1.0f / 1024.0f) + NORM_EPS);
        v2u* o = (v2u*)(HN + (size_t)row * 1024);
#pragma unroll
        for (int j = 0; j < 4; ++j) { const f32x4 y = (v[j] * rstd) * gv[j] * (scv[j] + 1.0f) + shv[j];
            v2u w; w.x = pk2(y.x, y.y); w.y = pk2(y.z, y.w); o[lane + 64 * j] = w; }
    }
}
__device__ __forceinline__ void final_rows(const AH A, int gw, int NGW, int lane) {
    const float* X = (const float*)(A.ws() + WS_X); const float* g = A.in(I_FG);
    f32x4 gv[4];
#pragma unroll
    for (int j = 0; j < 4; ++j) gv[j] = ((const f32x4*)g)[lane + 64 * j];
    f32x4 nx[4];
    if (gw < NB * LAT) { const int b = gw >> 12, t = gw & 4095;
#pragma unroll
        for (int j = 0; j < 4; ++j) nx[j] = ((const f32x4*)(X + (size_t)(b * SROW + LCTX + t) * 1024))[lane + 64 * j]; }
    for (int r = gw; r < NB * LAT; r += NGW) {
        f32x4 v[4]; float ss = 0.f;
#pragma unroll
        for (int j = 0; j < 4; ++j) v[j] = nx[j];
        if (r + NGW < NB * LAT) { const int r2 = r + NGW, b = r2 >> 12, t = r2 & 4095;
#pragma unroll
            for (int j = 0; j < 4; ++j) nx[j] = ((const f32x4*)(X + (size_t)(b * SROW + LCTX + t) * 1024))[lane + 64 * j]; }
#pragma unroll
        for (int j = 0; j < 4; ++j) ss += (v[j].x * v[j].x + v[j].y * v[j].y) + (v[j].z * v[j].z + v[j].w * v[j].w);
        const float rstd = rsqrtf(wave_sum(ss, lane) * (1.0f / 1024.0f) + NORM_EPS);
        f32x4* o = (f32x4*)(A.out() + (size_t)r * 1024);
#pragma unroll
        for (int j = 0; j < 4; ++j) o[lane + 64 * j] = (v[j] * rstd) * gv[j];
    }
}
#define XB_TMO      128
#define XB_XCNT(j)  (256  + 64 * (j))
#define XB_XSUB(j)  (1280 + 64 * (j))
#define XB_XGEN(j)  (2304 + 64 * (j))
#define XB_TOP      3328
#define XB_TOPGEN   3392
#define XCD_BAR_WORDS 3456
#define XB_SPIN_CAP (1u << 22)

__device__ __forceinline__ unsigned xb_ld(unsigned* p)              { return __hip_atomic_load(p, __ATOMIC_RELAXED, __HIP_MEMORY_SCOPE_AGENT); }
__device__ __forceinline__ unsigned xb_add(unsigned* p, unsigned v) { return __hip_atomic_fetch_add(p, v, __ATOMIC_RELAXED, __HIP_MEMORY_SCOPE_AGENT); }
__device__ __forceinline__ unsigned xb_xcc_id() { return (unsigned)__builtin_amdgcn_s_getreg((3 << 11) | 20) & 0xFu; }
#define XB_SPIN(cond, bar) do { unsigned _sp = 0; while (cond) { __builtin_amdgcn_s_sleep(1); \
    if ((++_sp & 255u) == 0u) { if (xb_ld(&(bar)[XB_TMO])) break; if (_sp > XB_SPIN_CAP) { atomicAdd(&(bar)[XB_TMO], 1u); break; } } } } while (0)

struct XcdBarrier {
    unsigned* bar; unsigned x;
    volatile LAS unsigned* st;
};

__device__ __forceinline__ XcdBarrier xcd_barrier_post(unsigned* bar, volatile LAS unsigned* st, bool t0) {
    XcdBarrier b; b.bar = bar; b.x = xb_xcc_id(); b.st = st;
    if (t0) (void)xb_add(&bar[XB_XCNT(b.x)], 1u);
    return b;
}
__device__ __forceinline__ void xcd_barrier_complete(unsigned* bar, unsigned x, unsigned& nloc, unsigned& nx) {
    const unsigned G = gridDim.x * gridDim.y * gridDim.z;
    unsigned sum, cnt, mine, sp = 0u;
    for (;;) {
        sum = 0u; cnt = 0u; mine = 0u;
#pragma unroll
        for (unsigned j = 0; j < 16; ++j) { const unsigned c = xb_ld(&bar[XB_XCNT(j)]); sum += c; cnt += (c > 0u) ? 1u : 0u; mine = (j == x) ? c : mine; }
        if (sum == G) break;
        __builtin_amdgcn_s_sleep(1);
        if ((++sp & 255u) == 0u) { if (xb_ld(&bar[XB_TMO])) break; if (sp > XB_SPIN_CAP) { atomicAdd(&bar[XB_TMO], 1u); break; } }
    }
    nloc = mine > 0u ? mine : 1u; nx = cnt > 0u ? cnt : 1u;
}

__device__ __forceinline__ void xcd_barrier(const XcdBarrier& b, bool t0) {
    asm volatile("s_waitcnt vmcnt(0)" ::: "memory");
    __syncthreads();
    if (t0) {
        unsigned* bar = b.bar;
        __builtin_amdgcn_s_waitcnt(0);
        unsigned nloc = b.st[0], nx = b.st[1];
        if (nloc == 0u) { xcd_barrier_complete(bar, b.x, nloc, nx); b.st[0] = nloc; b.st[1] = nx; }
        const unsigned old = xb_add(&bar[XB_XSUB(b.x)], 1u);
        const unsigned gen = old / nloc;
        if (old + 1u == (gen + 1u) * nloc) {
            __builtin_amdgcn_fence(__ATOMIC_RELEASE, "agent");
            asm volatile("s_waitcnt vmcnt(0)" ::: "memory");
            const unsigned og = xb_add(&bar[XB_TOP], 1u);
            const unsigned tg = og / nx;
            if (og + 1u == (tg + 1u) * nx) xb_add(&bar[XB_TOPGEN], 1u);
            else XB_SPIN(xb_ld(&bar[XB_TOPGEN]) == tg, bar);
            __builtin_amdgcn_fence(__ATOMIC_ACQUIRE, "agent");
            xb_add(&bar[XB_XGEN(b.x)], 1u);
            asm volatile("s_waitcnt vmcnt(0)" ::: "memory");
        } else {
            XB_SPIN(xb_ld(&bar[XB_XGEN(b.x)]) == gen, bar);
            __builtin_amdgcn_fence(__ATOMIC_ACQUIRE, "agent");
            asm volatile("s_waitcnt vmcnt(0)" ::: "memory");
        }
    }
    __syncthreads();
}
__device__ __forceinline__ void prep_qk(const AH A, int l, int gw, int NGW, int lane) {
    unsigned char* ws = A.ws();
    const bf16* Z = (const bf16*)(ws + WS_Z); bf16* KN = (bf16*)(ws + WS_KN);
    const float* rb = (const float*)(ws + WS_ROPE) + 64 * 32 * 2;
    const int e0 = (lane & 7) * 8, kh = (lane >> 3) & 1, sub = lane >> 4;
    float gk[8];
#pragma unroll
    for (int j = 0; j < 8; ++j) gk[j] = A.in(I_KG)[l * 64 + e0 + j];
    v4u nxt = (v4u){0u, 0u, 0u, 0u};
    { const int r = gw * 4 + sub; if (r < MTOK) nxt = *(const v4u*)(Z + (size_t)r * DIN + ZC_AK + kh * 64 + e0); }
    for (int row = gw * 4 + sub; row < MTOK; row += NGW * 4) {
        const int b = row / SROW, s = row - b * SROW; const bool lat = s >= LCTX; const int t = s - LCTX;
        const int pos = (lane & 4) ? (t & 63) : (t >> 6);
        const v4u cur = nxt;
        if (row + NGW * 4 < MTOK) nxt = *(const v4u*)(Z + (size_t)(row + NGW * 4) * DIN + ZC_AK + kh * 64 + e0);
        float f[8]; unpack8(cur, f);
        float ss = 0.f;
#pragma unroll
        for (int j = 0; j < 8; ++j) ss += f[j] * f[j];
        ss += shx(ss, 1, lane); ss += shx(ss, 2, lane); ss += shx(ss, 4, lane);
        const float rstd = rsqrtf(ss * (1.0f / 64.0f) + NORM_EPS);
        float y[8], o[8];
#pragma unroll
        for (int j = 0; j < 8; ++j) y[j] = f[j] * rstd * gk[j];
#pragma unroll
        for (int j = 0; j < 8; ++j) { const float p = shx(y[j], 2, lane);
            if (lat) { const int fi = (lane & 1) * 8 + j; const float cs = rb[(pos * 16 + fi) * 2], sn = rb[(pos * 16 + fi) * 2 + 1];
                o[j] = ((lane & 2) == 0) ? (y[j] * cs - p * sn) : (p * sn + y[j] * cs); }
            else o[j] = y[j]; }
        v4u w; w.x = pk2(o[0], o[1]); w.y = pk2(o[2], o[3]); w.z = pk2(o[4], o[5]); w.w = pk2(o[6], o[7]);
        *(v4u*)(KN + (size_t)row * 128 + kh * 64 + e0) = w;
    }
}

constexpr int RLDP = 136;
constexpr int RBUF = 128 * RLDP * 2;
__device__ __forceinline__ float log_sigmoid_f(float x) { return (x < 0.f ? x : 0.f) - log1pf(__expf(-fabsf(x))); }
template <bool TRANSPOSED, bool ROPE>
__device__ __forceinline__ void ret_stage_pair(const bf16* Z, int r0, int zc, int h, bool lat, int t0, const float* ra, float scl, float lgdec, int decmode  , LAS bf16* dst, int tid) {
#pragma unroll
    for (int it = 0; it < 2; ++it) { const int task = tid + 512 * it; const int j = task & 127, pr = task >> 7; const int c = (pr & 3) + (pr >> 2) * 8;
        const bf16* p = Z + (size_t)(r0 + j) * DIN + zc + h * 128;
        float a[8], bq[8]; unpack8(*(const v4u*)(p + 8 * c), a); unpack8(*(const v4u*)(p + 8 * (c + 4)), bq);
        float sc = scl; if (decmode == 1) sc *= __expf(lgdec * (float)(127 - j)); else if (decmode == 2) sc *= __expf(lgdec * (float)j);
        if (ROPE && lat) { const int t = t0 + j; const int pos = (c < 8) ? (t >> 6) : (t & 63);
#pragma unroll
            for (int e = 0; e < 8; ++e) { const int fi = (c & 3) * 8 + e; const float cs = ra[(pos * 32 + fi) * 2], sn = ra[(pos * 32 + fi) * 2 + 1];
                const float x1 = a[e], x2 = bq[e]; a[e] = x1 * cs - x2 * sn; bq[e] = x1 * sn + x2 * cs; } }
        if (TRANSPOSED) {
#pragma unroll
            for (int e = 0; e < 8; ++e) { dst[(8 * c + e) * RLDP + j] = (bf16)f2bf(a[e] * sc); dst[(8 * (c + 4) + e) * RLDP + j] = (bf16)f2bf(bq[e] * sc); }
        } else {
            v4u w; w.x = pk2(a[0] * sc, a[1] * sc); w.y = pk2(a[2] * sc, a[3] * sc); w.z = pk2(a[4] * sc, a[5] * sc); w.w = pk2(a[6] * sc, a[7] * sc);
            *(LAS v4u*)(dst + j * RLDP + 8 * c) = w;
            w.x = pk2(bq[0] * sc, bq[1] * sc); w.y = pk2(bq[2] * sc, bq[3] * sc); w.z = pk2(bq[4] * sc, bq[5] * sc); w.w = pk2(bq[6] * sc, bq[7] * sc);
            *(LAS v4u*)(dst + j * RLDP + 8 * (c + 4)) = w;
        } }
}
__device__ __forceinline__ void wave_mm(f32x4 (&acc)[8], const LAS bf16* Am, int row0, const LAS bf16* Bm, int lane) {
    const int r = lane & 15, g = lane >> 4;
#pragma unroll
    for (int ks = 0; ks < 4; ++ks) { const bf16x8 a = *(const LAS bf16x8*)(Am + (row0 + r) * RLDP + ks * 32 + g * 8);
#pragma unroll
        for (int nt = 0; nt < 8; ++nt) { const bf16x8 bfr = *(const LAS bf16x8*)(Bm + (nt * 16 + r) * RLDP + ks * 32 + g * 8);
            acc[nt] = __builtin_amdgcn_mfma_f32_16x16x32_bf16(a, bfr, acc[nt], 0, 0, 0); } }
}
__device__ __forceinline__ int ret_chain_pos(int d, int cidx) { return d == 0 ? cidx : (cidx == 1 ? 0 : (cidx == 0 ? 1 : 35 - cidx)); }

__device__ __forceinline__ void ret_stage_k_both(const bf16* Z, int r0, int h, bool lat, int t0, const float* ra, float scl, float lgf, float lgb, LAS bf16* dstf, LAS bf16* dstb, int tid) {
#pragma unroll
    for (int it = 0; it < 2; ++it) { const int task = tid + 512 * it; const int j = task & 127, pr = task >> 7; const int c = (pr & 3) + (pr >> 2) * 8;
        const bf16* p = Z + (size_t)(r0 + j) * DIN + ZC_RK + h * 128;
        float a[8], bq[8]; unpack8(*(const v4u*)(p + 8 * c), a); unpack8(*(const v4u*)(p + 8 * (c + 4)), bq);
        const float sf = scl * __expf(lgf * (float)(127 - j)), sb = scl * __expf(lgb * (float)j);
        if (lat) { const int t = t0 + j; const int pos = (c < 8) ? (t >> 6) : (t & 63);
#pragma unroll
            for (int e = 0; e < 8; ++e) { const int fi = (c & 3) * 8 + e; const float cs = ra[(pos * 32 + fi) * 2], sn = ra[(pos * 32 + fi) * 2 + 1];
                const float x1 = a[e], x2 = bq[e]; a[e] = x1 * cs - x2 * sn; bq[e] = x1 * sn + x2 * cs; } }
#pragma unroll
        for (int e = 0; e < 8; ++e) { dstf[(8 * c + e) * RLDP + j] = (bf16)f2bf(a[e] * sf); dstf[(8 * (c + 4) + e) * RLDP + j] = (bf16)f2bf(bq[e] * sf);
                                      dstb[(8 * c + e) * RLDP + j] = (bf16)f2bf(a[e] * sb); dstb[(8 * (c + 4) + e) * RLDP + j] = (bf16)f2bf(bq[e] * sb); } }
}
__device__ __forceinline__ void ret_u_item(const AH A, int l, int item, LAS unsigned char* lds, int tid, int wave, int lane) {
    unsigned char* ws = A.ws(); const bf16* Z = (const bf16*)(ws + WS_Z); const float* ra = (const float*)(ws + WS_ROPE);
    const int cidx = item % 34, bh = item / 34, b = bh >> 2, h = bh & 3;
    const int pf = ret_chain_pos(0, cidx), pb = ret_chain_pos(1, cidx);
    const bool lat = cidx >= 2; const int r0 = b * SROW + cidx * 128, t0 = (cidx - 2) * 128;
    const float lgf = log_sigmoid_f(A.in(I_RETLOGIT)[(l * 2 + 0) * 4 + h]), lgb = log_sigmoid_f(A.in(I_RETLOGIT)[(l * 2 + 1) * 4 + h]);
    LAS bf16* Ktf = (LAS bf16*)lds; LAS bf16* Ktb = (LAS bf16*)(lds + RBUF); LAS bf16* Vt = (LAS bf16*)(lds + 2 * RBUF);
    ret_stage_k_both(Z, r0, h, lat, t0, ra, 0.08838834764831845f, lgf, lgb, Ktf, Ktb, tid);
    ret_stage_pair<true, false>(Z, r0, ZC_RV, h, false, 0, ra, 1.0f, 0.f, 0, Vt, tid);
    __syncthreads();
    const int g = lane >> 4, c = lane & 15;
    f32x4 accf[8], accb[8];
#pragma unroll
    for (int nt = 0; nt < 8; ++nt) { accf[nt] = (f32x4){0.f, 0.f, 0.f, 0.f}; accb[nt] = (f32x4){0.f, 0.f, 0.f, 0.f}; }
    if (pf != 33) wave_mm(accf, Vt, wave * 16, Ktf, lane);
    if (pb != 33) wave_mm(accb, Vt, wave * 16, Ktb, lane);
    __syncthreads();
    LAS bf16* stg = (LAS bf16*)lds + wave * (16 * RLDP);
#pragma unroll 1
    for (int d = 0; d < 2; ++d) { const int p = d ? pb : pf;
        if (p == 33) continue;
#pragma unroll
        for (int nt = 0; nt < 8; ++nt)
#pragma unroll
            for (int jj = 0; jj < 4; ++jj) stg[(4 * g + jj) * RLDP + nt * 16 + c] = (bf16)f2bf(d ? accb[nt][jj] : accf[nt][jj]);
        LDS_WAIT(); asm volatile("" ::: "memory");
        bf16* U = (bf16*)(ws + WS_U) + ((size_t)((b * 4 + h) * 2 + d) * 34 + p) * 16384 + (size_t)(wave * 16) * 128;
#pragma unroll
        for (int it = 0; it < 4; ++it) { const int id = lane + 64 * it, rr = id >> 4, ch = id & 15;
            *(v4u*)(U + rr * 128 + ch * 8) = *(const LAS v4u*)(stg + rr * RLDP + ch * 8); }
        LDS_WAIT(); asm volatile("" ::: "memory"); }
    __syncthreads();
}
__device__ __forceinline__ void ret_scan_item(const AH A, int l, int item, int tid) {
    unsigned char* ws = A.ws();
    const int bhd = item >> 3, sl = item & 7; const int d = bhd & 1, h = (bhd >> 1) & 3;
    const float lg = log_sigmoid_f(A.in(I_RETLOGIT)[(l * 2 + d) * 4 + h]); const float sdec = __expf(128.0f * lg);
    const v2u* U = (const v2u*)((const bf16*)(ws + WS_U) + (size_t)bhd * 34 * 16384) + sl * 512 + tid;
    v2u* S = (v2u*)((bf16*)(ws + WS_SIN) + (size_t)bhd * 34 * 16384) + sl * 512 + tid;
    f32x4 s = (f32x4){0.f, 0.f, 0.f, 0.f};
#pragma unroll 1
    for (int p0 = 0; p0 < 33; p0 += 11) { v2u u[11];
#pragma unroll
        for (int i = 0; i < 11; ++i) u[i] = U[(size_t)(p0 + i) * 4096];
#pragma unroll
        for (int i = 0; i < 11; ++i) { v2u w; w.x = pk2(s.x, s.y); w.y = pk2(s.z, s.w); S[(size_t)(p0 + i) * 4096] = w;
            const f32x4 uf = (f32x4){bflo(u[i].x), bfhi(u[i].x), bflo(u[i].y), bfhi(u[i].y)}; s = s * sdec + uf; } }
    { v2u w; w.x = pk2(s.x, s.y); w.y = pk2(s.z, s.w); S[(size_t)33 * 4096] = w; }
}
__device__ __forceinline__ void ret_out_item(const AH A, int l, int item, LAS unsigned char* lds, int tid, int wave, int lane) {
    unsigned char* ws = A.ws(); const bf16* Z = (const bf16*)(ws + WS_Z); const float* ra = (const float*)(ws + WS_ROPE);
    const int cidx = item % 34, bh = item / 34, b = bh >> 2, h = bh & 3;
    const bool lat = cidx >= 2; const int r0 = b * SROW + cidx * 128, t0 = (cidx - 2) * 128;
    const float lgf = log_sigmoid_f(A.in(I_RETLOGIT)[(l * 2 + 0) * 4 + h]) * 1.4426950408889634f, lgb = log_sigmoid_f(A.in(I_RETLOGIT)[(l * 2 + 1) * 4 + h]) * 1.4426950408889634f;
    LAS bf16* Qs = (LAS bf16*)lds; LAS bf16* Ks = (LAS bf16*)(lds + RBUF); LAS bf16* Vt = (LAS bf16*)(lds + 2 * RBUF); LAS bf16* Ss = (LAS bf16*)(lds + 3 * RBUF);
    const bf16* SINf = (const bf16*)(ws + WS_SIN) + ((size_t)((b * 4 + h) * 2 + 0) * 34 + ret_chain_pos(0, cidx)) * 16384;
    const bf16* SINb = (const bf16*)(ws + WS_SIN) + ((size_t)((b * 4 + h) * 2 + 1) * 34 + ret_chain_pos(1, cidx)) * 16384;
    ret_stage_pair<false, true>(Z, r0, ZC_RQ, h, lat, t0, ra, 1.0f, 0.f, 0, Qs, tid);
    ret_stage_pair<false, true>(Z, r0, ZC_RK, h, lat, t0, ra, 0.08838834764831845f, 0.f, 0, Ks, tid);
    ret_stage_pair<true, false>(Z, r0, ZC_RV, h, false, 0, ra, 1.0f, 0.f, 0, Vt, tid);
#pragma unroll
    for (int it = 0; it < 4; ++it) { const int task = tid + 512 * it, row = task >> 4, ch = task & 15; *(LAS v4u*)(Ss + row * RLDP + ch * 8) = *(const v4u*)(SINf + row * 128 + ch * 8); }
    v4u sbv[4];
#pragma unroll
    for (int it = 0; it < 4; ++it) { const int task = tid + 512 * it, row = task >> 4, ch = task & 15; sbv[it] = *(const v4u*)(SINb + row * 128 + ch * 8); }
    __syncthreads();
    const int g = lane >> 4, c = lane & 15, i0 = wave * 16 + 4 * g;
    f32x4 accs[8], acco[8];
#pragma unroll
    for (int nt = 0; nt < 8; ++nt) { accs[nt] = (f32x4){0.f, 0.f, 0.f, 0.f}; acco[nt] = (f32x4){0.f, 0.f, 0.f, 0.f}; }
    wave_mm(accs, Qs, wave * 16, Ks, lane);
    wave_mm(acco, Qs, wave * 16, Ss, lane);
#pragma unroll
    for (int jj = 0; jj < 4; ++jj) { const float qd = __builtin_amdgcn_exp2f(lgf * (float)(i0 + jj + 1));
#pragma unroll
        for (int nt = 0; nt < 8; ++nt) acco[nt][jj] *= qd; }
    int i0w = i0; asm volatile("" : "+v"(i0w));
#pragma unroll
    for (int nt = 0; nt < 8; ++nt)
#pragma unroll
        for (int jj = 0; jj < 4; ++jj) { const int diff = (i0w + jj) - (nt * 16 + c);
            const float w = diff > 0 ? __builtin_amdgcn_exp2f(lgf * (float)diff) : (diff < 0 ? __builtin_amdgcn_exp2f(lgb * (float)(-diff)) : 2.0f);
            accs[nt][jj] *= w; }
    __syncthreads();
#pragma unroll
    for (int nt = 0; nt < 8; ++nt)
#pragma unroll
        for (int jj = 0; jj < 4; ++jj) Ks[(i0 + jj) * RLDP + nt * 16 + c] = (bf16)f2bf(accs[nt][jj]);
#pragma unroll
    for (int it = 0; it < 4; ++it) { const int task = tid + 512 * it, row = task >> 4, ch = task & 15; *(LAS v4u*)(Ss + row * RLDP + ch * 8) = sbv[it]; }
    __syncthreads();
#pragma unroll
    for (int nt = 0; nt < 8; ++nt) accs[nt] = (f32x4){0.f, 0.f, 0.f, 0.f};
    wave_mm(accs, Qs, wave * 16, Ss, lane);
#pragma unroll
    for (int jj = 0; jj < 4; ++jj) { const float qd = __builtin_amdgcn_exp2f(lgb * (float)(128 - (i0 + jj)));
#pragma unroll
        for (int nt = 0; nt < 8; ++nt) acco[nt][jj] += qd * accs[nt][jj]; }
    wave_mm(acco, Ks, wave * 16, Vt, lane);
    const float* gn = A.in(I_RETG) + (size_t)l * 512 + h * 128;
    bf16* Y = (bf16*)(ws + WS_Y);
    float gnv[8];
#pragma unroll
    for (int nt = 0; nt < 8; ++nt) gnv[nt] = gn[nt * 16 + c];
#pragma unroll
    for (int jj = 0; jj < 4; ++jj) {
        float s1 = 0.f;
#pragma unroll
        for (int nt = 0; nt < 8; ++nt) s1 += acco[nt][jj];
        s1 += shx(s1, 1, lane); s1 += shx(s1, 2, lane); s1 += shx(s1, 4, lane); s1 += shx(s1, 8, lane);
        const float mu = s1 * (1.0f / 128.0f); float s2 = 0.f;
#pragma unroll
        for (int nt = 0; nt < 8; ++nt) { const float dlt = acco[nt][jj] - mu; s2 += dlt * dlt; }
        s2 += shx(s2, 1, lane); s2 += shx(s2, 2, lane); s2 += shx(s2, 4, lane); s2 += shx(s2, 8, lane);
        const float rstd = rsqrtf(s2 * (1.0f / 128.0f) + NORM_EPS);
#pragma unroll
        for (int nt = 0; nt < 8; ++nt) Qs[(i0 + jj) * RLDP + nt * 16 + c] = (bf16)f2bf((acco[nt][jj] - mu) * rstd * gnv[nt]);
    }
    LDS_WAIT(); asm volatile("" ::: "memory");
#pragma unroll
    for (int it = 0; it < 4; ++it) { const int id = lane + 64 * it, rr = wave * 16 + (id >> 4), ch = id & 15; const size_t row = (size_t)(r0 + rr);
        float yv[8], rg[8]; unpack8(*(const LAS v4u*)(Qs + rr * RLDP + ch * 8), yv); unpack8(*(const v4u*)(Z + row * DIN + ZC_RG + h * 128 + ch * 8), rg);
#pragma unroll
        for (int e = 0; e < 8; ++e) yv[e] *= rg[e] * sigmoidf_(rg[e]);
        v4u w; w.x = pk2(yv[0], yv[1]); w.y = pk2(yv[2], yv[3]); w.z = pk2(yv[4], yv[5]); w.w = pk2(yv[6], yv[7]);
        *(v4u*)(Y + row * 512 + h * 128 + ch * 8) = w; }
    __syncthreads();
}
constexpr int XLDP = 68;
constexpr int XWAVE_BYTES = 64 * XLDP * 4;
__device__ __forceinline__ float gelu_tanh(float x) { const float u = 0.7978845608028654f * (x + 0.044715f * x * x * x); const float th = 1.0f - 2.0f * __builtin_amdgcn_rcpf(1.0f + __expf(2.0f * u)); return 0.5f * x * (1.0f + th); }
__device__ __forceinline__ int lru_chain_pos(int d, int c64) { return d == 0 ? c64 : (c64 < 4 ? 3 - c64 : 71 - c64); }

struct LruFrag { bf16x8 ba[2], bx[2]; };
__device__ __forceinline__ LruFrag lru_frag_load(const unsigned char* ws, int l, int dir, int blk, int nt, int lane) {
    const int g = lane >> 4, c = lane & 15; LruFrag f;
    const bf16* wa = (const bf16*)(ws + (size_t)(l & 1) * WS_WSET + WS_LRUW) + (size_t)((0 * 2 + dir) * 8 + blk) * 4096 + (nt * 16 + c) * 64 + g * 8;
    const bf16* wx = (const bf16*)(ws + (size_t)(l & 1) * WS_WSET + WS_LRUW) + (size_t)((1 * 2 + dir) * 8 + blk) * 4096 + (nt * 16 + c) * 64 + g * 8;
#pragma unroll
    for (int ks = 0; ks < 2; ++ks) { f.ba[ks] = *(const bf16x8*)(wa + ks * 32); f.bx[ks] = *(const bf16x8*)(wx + ks * 32); }
    return f;
}
template <int DIR, bool FINAL>
__device__ __forceinline__ void lru_dir(const AH A, int l, int b, int c64, int blk, int nt, const bf16x8 (&af)[4][2], const float (&xv)[16], float (&hs)[16], int lane,
                                        const LruFrag& fr, float b_a, float b_x, float lam, float hin) {
    unsigned char* ws = A.ws();
    const int g = lane >> 4, c = lane & 15; const int ch = blk * 64 + nt * 16 + c;
    f32x4 accr[4], acci[4];
#pragma unroll
    for (int mt = 0; mt < 4; ++mt) { accr[mt] = (f32x4){0.f, 0.f, 0.f, 0.f}; acci[mt] = (f32x4){0.f, 0.f, 0.f, 0.f};
#pragma unroll
        for (int ks = 0; ks < 2; ++ks) { accr[mt] = __builtin_amdgcn_mfma_f32_16x16x32_bf16(af[mt][ks], fr.ba[ks], accr[mt], 0, 0, 0);
                                         acci[mt] = __builtin_amdgcn_mfma_f32_16x16x32_bf16(af[mt][ks], fr.bx[ks], acci[mt], 0, 0, 0); } }
    const float sp = fmaxf(-lam, 0.f) + log1pf(__expf(-fabsf(lam)));
    float a_[16], u_[16], la_[16];
#pragma unroll
    for (int q = 0; q < 16; ++q) { const int mt = q >> 2, jj = q & 3;
        const float r = sigmoidf_(accr[mt][jj] + b_a), ii = sigmoidf_(acci[mt][jj] + b_x);
        const float la = -8.0f * r * sp; a_[q] = __expf(la); la_[q] = la;
        const float x2 = 2.0f * la;
        const float em = -x2 * (1.0f + x2 * (0.5f + x2 * (0.16666667f + x2 * (0.041666668f + x2 * (0.0083333338f + x2 * 0.0013888889f)))));
        u_[q] = __builtin_amdgcn_sqrtf(em) * (ii * xv[q]); }
    float P = 1.f, H = 0.f;
#pragma unroll
    for (int qi = 0; qi < 16; ++qi) { const int q = DIR ? 15 - qi : qi; H = a_[q] * H + u_[q]; P *= a_[q]; }
    float Pg[4], Hg[4];
#pragma unroll
    for (int k = 0; k < 4; ++k) { Pg[k] = shi(P, c + 16 * k); Hg[k] = shi(H, c + 16 * k); }
    if (!FINAL) {
        const int p = lru_chain_pos(DIR, c64);
        const size_t idx = ((size_t)((b * 2 + DIR) * 68 + p)) * 512 + ch;
        float Hc, Pc = (Pg[0] * Pg[1]) * (Pg[2] * Pg[3]);
        if (DIR == 0) Hc = ((Hg[0] * Pg[1] + Hg[1]) * Pg[2] + Hg[2]) * Pg[3] + Hg[3];
        else          Hc = ((Hg[3] * Pg[2] + Hg[2]) * Pg[1] + Hg[1]) * Pg[0] + Hg[0];
        if (g == 0) { float* S = (float*)(ws + WS_SUMM); S[idx * 2] = Pc; S[idx * 2 + 1] = Hc; }
        const size_t e0 = ((((size_t)((b * 68 + c64) * 8 + blk) * 4 + nt) * 2 + DIR) * 64 + lane) * 16;
        bf16* LA = (bf16*)(ws + WS_HN) + e0; bf16* LU = (bf16*)(ws + WS_PARTC) + e0;
        v4u w;
        w.x = pk2(la_[0], la_[1]); w.y = pk2(la_[2], la_[3]); w.z = pk2(la_[4], la_[5]); w.w = pk2(la_[6], la_[7]); *(v4u*)LA = w;
        w.x = pk2(la_[8], la_[9]); w.y = pk2(la_[10], la_[11]); w.z = pk2(la_[12], la_[13]); w.w = pk2(la_[14], la_[15]); *(v4u*)(LA + 8) = w;
        w.x = pk2(u_[0], u_[1]); w.y = pk2(u_[2], u_[3]); w.z = pk2(u_[4], u_[5]); w.w = pk2(u_[6], u_[7]); *(v4u*)LU = w;
        w.x = pk2(u_[8], u_[9]); w.y = pk2(u_[10], u_[11]); w.z = pk2(u_[12], u_[13]); w.w = pk2(u_[14], u_[15]); *(v4u*)(LU + 8) = w;
    } else {
        float s0, s1, s2, s3;
        if (DIR == 0) { s0 = hin; s1 = s0 * Pg[0] + Hg[0]; s2 = s1 * Pg[1] + Hg[1]; s3 = s2 * Pg[2] + Hg[2]; }
        else          { s3 = hin; s2 = s3 * Pg[3] + Hg[3]; s1 = s2 * Pg[2] + Hg[2]; s0 = s1 * Pg[1] + Hg[1]; }
        float h = (g == 0) ? s0 : (g == 1) ? s1 : (g == 2) ? s2 : s3;
#pragma unroll
        for (int qi = 0; qi < 16; ++qi) { const int q = DIR ? 15 - qi : qi; h = a_[q] * h + u_[q]; hs[q] += h; }
    }
}
template <bool FINAL>
__device__ __forceinline__ void lru_task(const AH A, int l, int b, int c64, int blk, LAS unsigned char* lds, int wave, int lane, int half) {
    unsigned char* ws = A.ws(); const bf16* Z = (const bf16*)(ws + WS_Z);
    LAS float* xs = (LAS float*)(lds + wave * XWAVE_BYTES);
    const int r0 = b * SROW + c64 * 64;
    const int seq_lo = (c64 < 4) ? b * SROW : b * SROW + LCTX, seq_hi = (c64 < 4) ? b * SROW + LCTX : (b + 1) * SROW;
    const int g = lane >> 4, c = lane & 15;
    const int cgx = lane & 7, tg = lane >> 3, ch0 = blk * 64 + cgx * 8;
    v4u raw[11];
#pragma unroll
    for (int q = 0; q < 11; ++q) { const int row = r0 + tg * 8 - 1 + q;
        raw[q] = (row >= seq_lo && row < seq_hi) ? *(const v4u*)(Z + (size_t)row * DIN + ZC_LX + ch0) : (v4u){0u, 0u, 0u, 0u}; }
    f32x4 cwv[4][2], cbv[2];
#pragma unroll
    for (int e2 = 0; e2 < 2; ++e2) { cbv[e2] = *(const f32x4*)(A.in(I_CONVB) + l * 512 + ch0 + 4 * e2);
#pragma unroll
        for (int j = 0; j < 4; ++j) cwv[j][e2] = *(const f32x4*)(A.in(I_CONVW) + (l * 4 + j) * 512 + ch0 + 4 * e2); }
    float pba[2][2], pbx[2][2], plam[2][2], phin[2][2];
#pragma unroll
    for (int nti = 0; nti < 2; ++nti)
#pragma unroll
        for (int d = 0; d < 2; ++d) { const int ch = blk * 64 + (2 * half + nti) * 16 + c; const int pidx = (l * 2 + d) * 512 + ch;
            pba[nti][d] = A.in(I_LBA)[pidx]; pbx[nti][d] = A.in(I_LBX)[pidx]; plam[nti][d] = A.in(I_LAM)[pidx];
            phin[nti][d] = FINAL ? ((const float*)(ws + WS_HIN))[((size_t)((b * 2 + d) * 68 + lru_chain_pos(d, c64))) * 512 + ch] : 0.f; }
    LruFrag fcur = lru_frag_load(ws, l, 0, blk, 2 * half, lane);
    {
        float xw[4][8];
#pragma unroll
        for (int q = 0; q < 3; ++q) unpack8(raw[q], xw[q]);
#pragma unroll
        for (int tt = 0; tt < 8; ++tt) { unpack8(raw[tt + 3], xw[3]);
            float y[8];
#pragma unroll
            for (int e = 0; e < 8; ++e) { float sacc = cbv[e >> 2][e & 3];
#pragma unroll
                for (int j = 0; j < 4; ++j) sacc += cwv[j][e >> 2][e & 3] * xw[j][e];
                y[e] = sacc; }
            LAS f32x4* o = (LAS f32x4*)(xs + (tg * 8 + tt) * XLDP + cgx * 8);
            o[0] = (f32x4){y[0], y[1], y[2], y[3]}; o[1] = (f32x4){y[4], y[5], y[6], y[7]};
#pragma unroll
            for (int e = 0; e < 8; ++e) { xw[0][e] = xw[1][e]; xw[1][e] = xw[2][e]; xw[2][e] = xw[3][e]; } }
    }
    LDS_WAIT(); asm volatile("" ::: "memory");
    bf16x8 af[4][2];
    { const int m = lane & 15, gq = m >> 2, jq = m & 3, kq = (lane >> 4) * 8;
#pragma unroll
      for (int mt = 0; mt < 4; ++mt) { const int tok = 16 * gq + 4 * mt + jq;
#pragma unroll
          for (int ks = 0; ks < 2; ++ks) { const LAS f32x4* s = (const LAS f32x4*)(xs + tok * XLDP + ks * 32 + kq); const f32x4 v0 = s[0], v1 = s[1];
              v4u w; w.x = pk2(v0.x, v0.y); w.y = pk2(v0.z, v0.w); w.z = pk2(v1.x, v1.y); w.w = pk2(v1.z, v1.w); af[mt][ks] = __builtin_bit_cast(bf16x8, w); } } }
#pragma unroll
    for (int nti = 0; nti < 2; ++nti) { const int nt = 2 * half + nti;
        float xv[16], hs[16];
#pragma unroll
        for (int q = 0; q < 16; ++q) { xv[q] = xs[(16 * g + q) * XLDP + nt * 16 + c]; hs[q] = 0.f; }
        const LruFrag f1 = lru_frag_load(ws, l, 1, blk, nt, lane);
        lru_dir<0, FINAL>(A, l, b, c64, blk, nt, af, xv, hs, lane, fcur, pba[nti][0], pbx[nti][0], plam[nti][0], phin[nti][0]);
        if (nti == 0) fcur = lru_frag_load(ws, l, 0, blk, nt + 1, lane);
        lru_dir<1, FINAL>(A, l, b, c64, blk, nt, af, xv, hs, lane, f1, pba[nti][1], pbx[nti][1], plam[nti][1], phin[nti][1]);
        if (FINAL) {
#pragma unroll
            for (int q = 0; q < 16; ++q) xs[(16 * g + q) * XLDP + nt * 16 + c] = hs[q]; }
    }
    if (FINAL) {
        LDS_WAIT(); asm volatile("" ::: "memory");
        bf16* Y = (bf16*)(ws + WS_Y) + (size_t)MTOK * 512;
#pragma unroll
        for (int it = 0; it < 4; ++it) { const int id = lane + 64 * it, tok = id >> 2, chn = 4 * half + (id & 3); const size_t row = (size_t)(r0 + tok);
            const LAS f32x4* sp = (const LAS f32x4*)(xs + tok * XLDP + chn * 8); const f32x4 h0 = sp[0], h1 = sp[1];
            float lz[8]; unpack8(*(const v4u*)(Z + row * DIN + ZC_LZ + blk * 64 + chn * 8), lz);
            v4u w; w.x = pk2(gelu_tanh(lz[0]) * h0.x, gelu_tanh(lz[1]) * h0.y); w.y = pk2(gelu_tanh(lz[2]) * h0.z, gelu_tanh(lz[3]) * h0.w);
            w.z = pk2(gelu_tanh(lz[4]) * h1.x, gelu_tanh(lz[5]) * h1.y); w.w = pk2(gelu_tanh(lz[6]) * h1.z, gelu_tanh(lz[7]) * h1.w);
            *(v4u*)(Y + row * 512 + blk * 64 + chn * 8) = w; }
    }
    LDS_WAIT(); asm volatile("" ::: "memory");
}
template <int DIR>
__device__ __forceinline__ void lru_apply(const float (&a_)[16], const float (&u_)[16], float hin, float (&hs)[16], int lane) {
    const int g = lane >> 4, c = lane & 15;
    float P = 1.f, H = 0.f;
#pragma unroll
    for (int qi = 0; qi < 16; ++qi) { const int q = DIR ? 15 - qi : qi; H = a_[q] * H + u_[q]; P *= a_[q]; }
    float Pg[4], Hg[4];
#pragma unroll
    for (int k = 0; k < 4; ++k) { Pg[k] = shi(P, c + 16 * k); Hg[k] = shi(H, c + 16 * k); }
    float s0, s1, s2, s3;
    if (DIR == 0) { s0 = hin; s1 = s0 * Pg[0] + Hg[0]; s2 = s1 * Pg[1] + Hg[1]; s3 = s2 * Pg[2] + Hg[2]; }
    else          { s3 = hin; s2 = s3 * Pg[3] + Hg[3]; s1 = s2 * Pg[2] + Hg[2]; s0 = s1 * Pg[1] + Hg[1]; }
    float h = (g == 0) ? s0 : (g == 1) ? s1 : (g == 2) ? s2 : s3;
#pragma unroll
    for (int qi = 0; qi < 16; ++qi) { const int q = DIR ? 15 - qi : qi; h = a_[q] * h + u_[q]; hs[q] += h; }
}
__device__ __forceinline__ void lru_final(const AH A, int l, int b, int c64, int blk, LAS unsigned char* lds, int wave, int lane, int half) {
    unsigned char* ws = A.ws(); const bf16* Z = (const bf16*)(ws + WS_Z);
    LAS float* xs = (LAS float*)(lds + wave * XWAVE_BYTES);
    const int r0 = b * SROW + c64 * 64;
    const int g = lane >> 4, c = lane & 15;
    float phin[2][2];
#pragma unroll
    for (int nti = 0; nti < 2; ++nti)
#pragma unroll
        for (int d = 0; d < 2; ++d) { const int ch = blk * 64 + (2 * half + nti) * 16 + c;
            phin[nti][d] = ((const float*)(ws + WS_HIN))[((size_t)((b * 2 + d) * 68 + lru_chain_pos(d, c64))) * 512 + ch]; }
    v4u wl[2][2][2], wu[2][2][2];
#pragma unroll
    for (int nti = 0; nti < 2; ++nti)
#pragma unroll
        for (int d = 0; d < 2; ++d) { const size_t e0 = ((((size_t)((b * 68 + c64) * 8 + blk) * 4 + (2 * half + nti)) * 2 + d) * 64 + lane) * 16;
            const bf16* LA = (const bf16*)(ws + WS_HN) + e0; const bf16* LU = (const bf16*)(ws + WS_PARTC) + e0;
            wl[nti][d][0] = *(const v4u*)LA; wl[nti][d][1] = *(const v4u*)(LA + 8); wu[nti][d][0] = *(const v4u*)LU; wu[nti][d][1] = *(const v4u*)(LU + 8); }
#pragma unroll
    for (int nti = 0; nti < 2; ++nti) { const int nt = 2 * half + nti;
        float hs[16];
#pragma unroll
        for (int q = 0; q < 16; ++q) hs[q] = 0.f;
#pragma unroll
        for (int d = 0; d < 2; ++d) { float a_[16], u_[16];
            unpack8(wl[nti][d][0], a_); unpack8(wl[nti][d][1], a_ + 8); unpack8(wu[nti][d][0], u_); unpack8(wu[nti][d][1], u_ + 8);
#pragma unroll
            for (int q = 0; q < 16; ++q) a_[q] = __expf(a_[q]);
            if (d == 0) lru_apply<0>(a_, u_, phin[nti][0], hs, lane); else lru_apply<1>(a_, u_, phin[nti][1], hs, lane); }
#pragma unroll
        for (int q = 0; q < 16; ++q) xs[(16 * g + q) * XLDP + nt * 16 + c] = hs[q];
    }
    LDS_WAIT(); asm volatile("" ::: "memory");
    bf16* Y = (bf16*)(ws + WS_Y) + (size_t)MTOK * 512;
#pragma unroll
    for (int it = 0; it < 4; ++it) { const int id = lane + 64 * it, tok = id >> 2, chn = 4 * half + (id & 3); const size_t row = (size_t)(r0 + tok);
        const LAS f32x4* sp = (const LAS f32x4*)(xs + tok * XLDP + chn * 8); const f32x4 h0 = sp[0], h1 = sp[1];
        float lz[8]; unpack8(*(const v4u*)(Z + row * DIN + ZC_LZ + blk * 64 + chn * 8), lz);
        v4u w; w.x = pk2(gelu_tanh(lz[0]) * h0.x, gelu_tanh(lz[1]) * h0.y); w.y = pk2(gelu_tanh(lz[2]) * h0.z, gelu_tanh(lz[3]) * h0.w);
        w.z = pk2(gelu_tanh(lz[4]) * h1.x, gelu_tanh(lz[5]) * h1.y); w.w = pk2(gelu_tanh(lz[6]) * h1.z, gelu_tanh(lz[7]) * h1.w);
        *(v4u*)(Y + row * 512 + blk * 64 + chn * 8) = w; }
    LDS_WAIT(); asm volatile("" ::: "memory");
}
__device__ __forceinline__ void lru_scan(const AH A, int tid, int G) {
    unsigned char* ws = A.ws(); const float* S = (const float*)(ws + WS_SUMM); float* HIN = (float*)(ws + WS_HIN);
    const int cpb = (4096 + G - 1) / G;
    typedef float f32x2s __attribute__((ext_vector_type(2)));
    if (cpb <= 16) {
        if (tid < 64) { const int c = tid & 15, q = tid >> 4; const int chain0 = blockIdx.x * cpb + c; const bool valid = (c < cpb) && (chain0 < 4096); const int chain = valid ? chain0 : 0;
            const int bd = chain >> 9, ch = chain & 511; f32x2s ph_[17];
#pragma unroll
            for (int i = 0; i < 17; ++i) ph_[i] = *(const f32x2s*)(S + ((size_t)(bd * 68 + q * 17 + i) * 512 + ch) * 2);
            float Aq = 1.f, Bq = 0.f;
#pragma unroll
            for (int i = 0; i < 17; ++i) { Bq = ph_[i].x * Bq + ph_[i].y; Aq *= ph_[i].x; }
            float Ag[4], Bg[4];
#pragma unroll
            for (int k = 0; k < 4; ++k) { Ag[k] = shi(Aq, c + 16 * k); Bg[k] = shi(Bq, c + 16 * k); }
            const float s1 = Bg[0], s2 = Ag[1] * s1 + Bg[1], s3 = Ag[2] * s2 + Bg[2];
            float h = (q == 0) ? 0.f : (q == 1) ? s1 : (q == 2) ? s2 : s3;
            if (valid) {
#pragma unroll
                for (int i = 0; i < 17; ++i) { HIN[(size_t)(bd * 68 + q * 17 + i) * 512 + ch] = h; h = ph_[i].x * h + ph_[i].y; } } }
    } else {
        for (int chain = blockIdx.x * cpb + tid; tid < cpb && chain < 4096; chain += 4096) { const int bd = chain >> 9, ch = chain & 511; float h = 0.f;
#pragma unroll 1
            for (int p0 = 0; p0 < 68; p0 += 17) { f32x2s ph_[17];
#pragma unroll
                for (int i = 0; i < 17; ++i) ph_[i] = *(const f32x2s*)(S + ((size_t)(bd * 68 + p0 + i) * 512 + ch) * 2);
#pragma unroll
                for (int i = 0; i < 17; ++i) { HIN[(size_t)(bd * 68 + p0 + i) * 512 + ch] = h; h = ph_[i].x * h + ph_[i].y; } } }
    }
}

#define EN(k) (((MASK) >> (k)) & 1)
template <int MASK> __global__ void __launch_bounds__(NWAVES * 64, 2) fwd_kernel(Args args) {
    extern __shared__ __attribute__((aligned(16))) unsigned char lds_raw[];
    LAS unsigned char* lds0 = (LAS unsigned char*)lds_raw;
    cg::grid_group grid = cg::this_grid();
    { const unsigned* aw = (const unsigned*)&args; const int tid = threadIdx.x; if (tid < 54) ((LAS unsigned*)(lds0 + ARGS_LDS_OFF))[tid] = aw[tid];
      if (tid >= 64 && tid < 66) ((LAS unsigned*)(lds0 + ARGS_LDS_OFF + 256))[tid - 64] = 0u; }
    __syncthreads();
    XcdBarrier xbar = xcd_barrier_post((unsigned*)args.ws, (volatile LAS unsigned*)(lds0 + ARGS_LDS_OFF + 256), threadIdx.x == 0);
    const int ph_lo = args.ph_lo, ph_hi = args.ph_hi;
    const int wave0 = __builtin_amdgcn_readfirstlane((int)threadIdx.x >> 6);
#ifndef PROBE_MASK
#define PROBE_MASK 0
#endif
#ifndef PROBE_SUB
#define PROBE_SUB 0
#endif
#define SUBOFF(bit) (rep && ((PROBE_SUB) & (bit)))
#define PROBE_HIT(ph) ((PROBE_MASK) != 0 && ((ph) == 0 ? (((PROBE_MASK) >> 13) & 1) : (ph) == 53 ? (((PROBE_MASK) >> 14) & 1) : (((PROBE_MASK) >> (((ph) - 1) % 13)) & 1)))
    for (int ph2 = 2 * ph_lo; ph2 < 2 * ph_hi; ++ph2) {
        const int ph = ph2 >> 1, rep = ph2 & 1;
        if (rep && !PROBE_HIT(ph)) continue;
        if (ph2 != 2 * ph_lo) {
            if (ph_lo < 0) grid.sync();
            else { int mk2_ = -1; asm volatile("" : "+s"(mk2_)); const bool t0_ = (wave0 == 0) && (__builtin_amdgcn_mbcnt_hi(mk2_, __builtin_amdgcn_mbcnt_lo(mk2_, 0)) == 0); xcd_barrier(xbar, t0_); }
        }
#define PH_PROLOG int wv_ = wave0; int mk_ = -1; asm volatile("" : "+s"(wv_), "+s"(mk_)); int tid = wv_ * 64 + (int)__builtin_amdgcn_mbcnt_hi(mk_, __builtin_amdgcn_mbcnt_lo(mk_, 0)); int G = gridDim.x, bx = blockIdx.x; asm volatile("" : "+s"(G), "+s"(bx)); \
        unsigned ldsi = (unsigned)(unsigned long long)lds0; asm volatile("" : "+s"(ldsi)); LAS unsigned char* lds = (LAS unsigned char*)(unsigned long long)ldsi; \
        const AH AHv{(const LAS unsigned*)(lds + ARGS_LDS_OFF)}; const int lane = tid & 63, wave = wv_; \
        const int gw = bx * NWAVES + wave, NGW = G * NWAVES; (void)gw; (void)NGW; (void)lane; (void)wave; (void)G; (void)bx; (void)tid;
        if (EN(13) && ph == 0) { PH_PROLOG phase_p0(AHv, lds, tid, G); __syncthreads(); convert_layer(AHv, 0, 0, CV_NIT, lds, gw, NGW, wave, lane); }
        else if (EN(14) && ph == 53) { PH_PROLOG final_rows(AHv, gw, NGW, lane); }
        else {
            const int l = (ph - 1) / 13, k = (ph - 1) - l * 13; const bool last = (l == DEPTH - 1);
#define ws (AHv.ws())
#define HN ((bf16*)(ws + WS_HN))
#define Zb ((bf16*)(ws + WS_Z))
#define X ((float*)(ws + WS_X))
#define modbuf ((const float*)(ws + WS_MOD))
            if (EN(0) && k == 0) { PH_PROLOG norm_rows(AHv, l, 0, gw, NGW, lane, l > 0 ? 11 : 0, modbuf + (size_t)(l > 0 ? l - 1 : 0) * 5 * MODW + 4 * MODW + 2 * 3072 + 2048, 0.5f); }
            else if (EN(3) && k == 3) { PH_PROLOG norm_rows(AHv, l, 1, gw, NGW, lane, 11, modbuf + (size_t)l * 5 * MODW + 4 * MODW + 0 * 3072 + 2048, 0.5f); }
            else if (EN(10) && k == 10) { PH_PROLOG norm_rows(AHv, l, 2, gw, NGW, lane, last ? 0 : 4, modbuf + (size_t)l * 5 * MODW + 4 * MODW + 1 * 3072 + 2048, 1.0f); }
            else if (EN(1) && (k == 1 || k == 11)) { PH_PROLOG const int j = (k == 1) ? 0 : 1;
                pg8::Gemm gm{HN, (const bf16*)(ws + (size_t)(l & 1) * WS_WSET + WS_WFI) + (size_t)j * 5632 * 1024, MTOK, 5632, 1024};
                pg8::EpiSwiglu E{Zb};
                if (last && k == 11) { pg8::LastLayerOrder S; S.init(5632, G, bx, 0); pg8::gemm_phase<1024, pg8::EpiSwiglu, pg8::LastLayerOrder, true, true>(lds, gm, S, E, tid); }
                else { pg8::StaticOrder S; S.init(MTOK, 5632, G, bx); pg8::gemm_phase<1024, pg8::EpiSwiglu, pg8::StaticOrder, true, true>(lds, gm, S, E, tid); } }
            else if (EN(2) && (k == 2 || k == 12)) { PH_PROLOG const int j = (k == 2) ? 0 : 1, sub = (k == 2) ? 0 : 2;
                pg8::Gemm gm{Zb, (const bf16*)(ws + (size_t)(l & 1) * WS_WSET + WS_WFO) + (size_t)j * 1024 * DFF, MTOK, 1024, DFF};
                pg8::EpiResid E{X, modbuf + (size_t)l * 5 * MODW + sub * 3072 + 2048, rep ? 0.0f : 0.5f, (float*)(ws + WS_PARTC)};
                if (last && k == 12) { pg8::LatOrder S{G, bx}; pg8::gemm_phase<DFF, pg8::EpiResid, pg8::LatOrder, true, true>(lds, gm, S, E, tid); }
                else { pg8::SplitOrder S{G, bx, 11, 4}; pg8::gemm_phase<DFF, pg8::EpiResid, pg8::SplitOrder, true, true>(lds, gm, S, E, tid); } }
            else if (EN(4) && k == 4) { PH_PROLOG
                pg8::Gemm gm{HN, (const bf16*)(ws + (size_t)(l & 1) * WS_WSET + WS_WIN), MTOK, DIN, 1024};
                pg8::EpiZ E{Zb, DIN};
                if (last) { pg8::LastLayerOrder S; S.init(DIN, G, bx, 28); pg8::gemm_phase<1024, pg8::EpiZ, pg8::LastLayerOrder, true, true>(lds, gm, S, E, tid); }
                else { pg8::StaticOrder S; S.init(MTOK, DIN, G, bx); pg8::gemm_phase<1024, pg8::EpiZ, pg8::StaticOrder, true, true>(lds, gm, S, E, tid); } }
            else if (EN(5) && k == 5) { PH_PROLOG
                if (!SUBOFF(1)) prep_qk(AHv, l, gw, NGW, lane);
                if (!SUBOFF(2)) for (int it = bx; it < 544; it += G) ret_u_item(AHv, l, it, lds, tid, wave, lane);
                __syncthreads();
                if (!SUBOFF(4)) { PH_PROLOG
                    const int H = 2 * 272, n3 = (544 > 2 * G && 544 <= 3 * G) ? 544 - 2 * G : 0, nb = G - n3;
                    for (int hi = bx; hi < H; hi += (bx < n3) ? H : nb) { const int li = hi >> 1; lru_task<false>(AHv, l, li / 68, li % 68, wave, lds, wave, lane, hi & 1); } } }
            else if (EN(6) && k == 6) { PH_PROLOG
                for (int it = bx; it < 256; it += G) ret_scan_item(AHv, l, it, tid);
                lru_scan(AHv, tid, G);
                const int nunits = last ? 512 : 544;
                for (int i = 0;; ++i) { const int u = i * G + bx; if (u >= nunits) break;
                    long qrow0, kvrow0; int hq, kvh, NT;
                    if (u < 512) { const int combo = u & 7, j = u >> 3; const int b = combo >> 1; kvh = combo & 1; hq = kvh * 4 + (j & 3); const int qb = j >> 2;
                        qrow0 = (long)b * SROW + LCTX + qb * 256; kvrow0 = (long)b * SROW; NT = 68; }
                    else { const int v = u - 512; const int b = v >> 3; hq = v & 7; kvh = hq >> 2; qrow0 = (long)b * SROW; kvrow0 = qrow0; NT = 4; }
                    attn_body::attn_unit<8>(qrow0, kvrow0, hq, kvh, NT, (const attn_body::bf16*)(Zb + ZC_AQ), (const attn_body::bf16*)(ws + WS_KN), (const attn_body::bf16*)(Zb + ZC_AV),
                                            (attn_body::bf16*)((bf16*)(ws + WS_Y) + (size_t)2 * MTOK * 512), (char*)lds, tid,
                                            AHv.in(I_QG) + l * 64, (const float*)(ws + WS_ROPE) + 64 * 32 * 2, (u < 512) ? (long)(qrow0 - kvrow0 - LCTX) : -1L); } }
            else if ((EN(7) || EN(15)) && k == 7) { PH_PROLOG
                const int nret = last ? 512 : 544, nlru = last ? 256 : 272;
                if (EN(7) && !SUBOFF(8)) for (int it = bx; it < nret; it += G) { const int item = last ? ((it >> 5) * 34 + 2 + (it & 31)) : it; ret_out_item(AHv, l, item, lds, tid, wave, lane); }
                __syncthreads();
                if (EN(15) && !SUBOFF(16)) { PH_PROLOG
                    const int H = 2 * nlru, n3 = (nret > 2 * G && nret <= 3 * G) ? nret - 2 * G : 0, nb = G - n3;
                    for (int hi = bx; hi < H; hi += (bx < n3) ? H : nb) { const int li = hi >> 1; const int b = last ? (li >> 6) : (li / 68), c64 = last ? (4 + (li & 63)) : (li % 68);
                        lru_final(AHv, l, b, c64, wave, lds, wave, lane, hi & 1); } } }
            else if (EN(8) && k == 8) { PH_PROLOG
                pg8::Gemm gm{(const bf16*)(ws + WS_Y), (const bf16*)(ws + (size_t)(l & 1) * WS_WSET + WS_WB), 3 * MTOK, 3 * 1024, 512}; pg8::MergeOrder S{G, bx, last ? 1 : 0};
                pg8::EpiMerge E{Zb, HN};
                pg8::gemm_phase<512, pg8::EpiMerge, pg8::MergeOrder, true, true>(lds, gm, S, E, tid);
                if (!last) {
                    const int nsec = (272 > G) ? ((272 - G < G) ? 272 - G : 0) : 0;
                    if (bx >= nsec) convert_layer(AHv, l + 1, 0, CV_NIT, lds, (bx - nsec) * NWAVES + wave, (G - nsec) * NWAVES, wave, lane); } }
            else if (EN(9) && k == 9) { PH_PROLOG
                pg8::Gemm gm{HN, (const bf16*)(ws + (size_t)(l & 1) * WS_WSET + WS_WO), MTOK, 1024, 1024};
                pg8::EpiResid E{X, modbuf + (size_t)l * 5 * MODW + 1 * 3072 + 2048, rep ? 0.0f : 1.0f, (float*)(ws + WS_PARTC)};
                if (last) { pg8::LatOrder S{G, bx}; pg8::gemm_phase<1024, pg8::EpiResid, pg8::LatOrder, true, true>(lds, gm, S, E, tid); }
                else { pg8::SplitOrder S{G, bx, 4, 4}; pg8::gemm_phase<1024, pg8::EpiResid, pg8::SplitOrder, true, true>(lds, gm, S, E, tid); } }
        }
#undef ws
#undef HN
#undef Zb
#undef X
#undef modbuf
    }
}

#ifndef MK_N_LAUNCHES
#define MK_N_LAUNCHES 1
#endif
#if MK_N_LAUNCHES == 1
#define FULLK fwd_kernel<0xffff>
#else
template <int MASK> static void launch_one(int grid, const Args& a, hipStream_t stream) {
    static bool init = false;
    if (!init) { (void)hipFuncSetAttribute((const void*)fwd_kernel<MASK>, hipFuncAttributeMaxDynamicSharedMemorySize, LDS_BYTES); init = true; }
    hipLaunchKernelGGL(fwd_kernel<MASK>, dim3(grid), dim3(NWAVES * 64), LDS_BYTES, stream, a);
}
#endif
extern "C" void kernel_launch(void* const* d_in, const int* in_sizes, int n_in, void* d_out, int out_size, void* d_ws, size_t ws_size, hipStream_t stream) {
    static int grid = 0;
    if (grid == 0) {
        if (n_in != 24 || ws_size < WS_END) { fprintf(stderr, "kernel_launch: unexpected n_in %d / ws %zu (need %zu)\n", n_in, ws_size, (size_t)WS_END); grid = -1; return; }
        int dev = 0, cus = 0;
        (void)hipGetDevice(&dev); (void)hipDeviceGetAttribute(&cus, hipDeviceAttributeMultiprocessorCount, dev);
#if MK_N_LAUNCHES == 1
        int per_cu = 0;
        (void)hipFuncSetAttribute((const void*)FULLK, hipFuncAttributeMaxDynamicSharedMemorySize, LDS_BYTES);
        if (hipOccupancyMaxActiveBlocksPerMultiprocessor(&per_cu, (const void*)FULLK, NWAVES * 64, LDS_BYTES) != hipSuccess || per_cu < 1) per_cu = 1;
        (void)hipGetLastError();
        grid = cus * per_cu;
#else
        grid = cus;
#endif
        if (grid <= 0) grid = 256;
    }
    if (grid < 0) return;
    (void)hipMemsetAsync(d_ws, 0, 16384, stream);
    Args a{};
    for (int i = 0; i < 24; ++i) a.in[i] = (const float*)d_in[i];
    a.out = (float*)d_out; a.ws = (unsigned char*)d_ws;
#if MK_N_LAUNCHES == 1
    a.ph_lo = 0; a.ph_hi = 54;
    void* params[] = {(void*)&a};
    hipError_t e = hipLaunchCooperativeKernel((const void*)FULLK, dim3(grid), dim3(NWAVES * 64), params, LDS_BYTES, stream);
    if (e != hipSuccess) fprintf(stderr, "cooperative launch failed: %s (grid %d)\n", hipGetErrorString(e), grid);
#else
    for (int ph = 0; ph < 54; ++ph) { a.ph_lo = ph; a.ph_hi = ph + 1;
        if (ph == 0) { launch_one<1 << 13>(grid, a, stream); continue; }
        if (ph == 53) { launch_one<1 << 14>(grid, a, stream); continue; }
        const int k = (ph - 1) % 13;
        switch (k) {
            case 0: launch_one<1 << 0>(grid, a, stream); break;
            case 1: case 11: launch_one<1 << 1>(grid, a, stream); break;
            case 2: case 12: launch_one<1 << 2>(grid, a, stream); break;
            case 3: launch_one<1 << 3>(grid, a, stream); break;
            case 4: launch_one<1 << 4>(grid, a, stream); break;
            case 5: launch_one<1 << 5>(grid, a, stream); break;
            case 6: launch_one<1 << 6>(grid, a, stream); break;
            case 7: launch_one<1 << 7>(grid, a, stream); launch_one<1 << 15>(grid, a, stream); break;
            case 8: launch_one<1 << 8>(grid, a, stream); break;
            case 9: launch_one<1 << 9>(grid, a, stream); break;
            case 10: launch_one<1 << 10>(grid, a, stream); break;
        }
    }
#endif
}
```
